# Optimizing an MI355X kernel written in HIP

```python
import jax
import jax.numpy as jnp
from jax import lax
import numpy as np

D_MODEL = 1024
BATCH = 8
SEQ = 2048
DEPTH = 1

HEAD_DIM = 64
ROPE_THETA = 10000.0
NORM_EPS = 1e-6
NEG_INF = -1e30

NSA_HEADS = 8
NSA_KV_HEADS = 2
NSA_GROUP = NSA_HEADS // NSA_KV_HEADS
CMP_BLOCK = 32
CMP_STRIDE = 16
SLC_BLOCK = 64
SLC_TOPN = 16
WINDOW = 512
SLC_QBLOCK = 64
WIN_QBLOCK = 128

DSA_HEADS = 8
DSA_KV_RANK = 128
IDX_HEADS = 8
IDX_DIM = 64
DSA_TOPK = 256
DSA_QBLOCK = 128

PEER_HEADS = 8
PEER_KEYS = 128
PEER_EXPERTS = PEER_KEYS * PEER_KEYS
PEER_KEY_DIM = 128
PEER_HALF = PEER_KEY_DIM // 2
PEER_TOPK = 16
PEER_CHUNK = 128

NSA_Q_DIM = NSA_HEADS * HEAD_DIM
NSA_KV_DIM = NSA_KV_HEADS * HEAD_DIM
DSA_Q_DIM = DSA_HEADS * HEAD_DIM
IDX_Q_DIM = IDX_HEADS * IDX_DIM
IN_SPLITS = (NSA_Q_DIM, NSA_KV_DIM, NSA_KV_DIM, NSA_KV_DIM, NSA_KV_DIM, NSA_KV_DIM, NSA_KV_DIM,
             3 * NSA_HEADS, DSA_Q_DIM, DSA_KV_RANK, IDX_Q_DIM, IDX_DIM, IDX_HEADS, 2 * D_MODEL)
D_IN = sum(IN_SPLITS)

kernel_name = "hybrid_nsa_dsa_peer_adaln_block"


def rms_norm(x, g):
    xf = x.astype(jnp.float32)
    y = xf * lax.rsqrt(jnp.mean(xf * xf, axis=-1, keepdims=True) + NORM_EPS)
    return (y * g.astype(jnp.float32)).astype(x.dtype)


def rope(x, pos):
    half = x.shape[-1] // 2
    inv = ROPE_THETA ** (-jnp.arange(half, dtype=jnp.float32) / half)
    ang = pos[:, None] * inv[None, :]
    cos = jnp.cos(ang)[:, None, :]
    sin = jnp.sin(ang)[:, None, :]
    xf = x.astype(jnp.float32)
    x1, x2 = xf[..., :half], xf[..., half:]
    return jnp.concatenate([x1 * cos - x2 * sin, x2 * cos + x1 * sin], axis=-1).astype(x.dtype)


def masked_softmax(s, mask):
    s = jnp.where(mask, s.astype(jnp.float32), NEG_INF)
    m = jnp.max(s, axis=-1, keepdims=True)
    p = jnp.where(mask, jnp.exp(s - m), 0.0)
    return p / jnp.maximum(jnp.sum(p, axis=-1, keepdims=True), 1e-30)


def compress_blocks(x, pos_emb, w1, w2):
    B, S, G, dh = x.shape
    r = CMP_BLOCK // CMP_STRIDE
    n_chunk = S // CMP_STRIDE
    ch = x.reshape(B, n_chunk, CMP_STRIDE, G, dh)
    blk = jnp.concatenate([ch[:, i:n_chunk - r + 1 + i] for i in range(r)], axis=2)
    blk = blk + pos_emb[:, None, :]
    hid = jax.nn.gelu(jnp.einsum("bnlgd,lde->bnge", blk, w1))
    return jnp.einsum("bnge,ef->bngf", hid, w2)


def selected_attention(qg, ks, vs, sel, scale):
    B, S, G, hg, dh = qg.shape
    n_slc = S // SLC_BLOCK
    nqb = S // SLC_QBLOCK
    kb = ks.reshape(B, n_slc, SLC_BLOCK, G, dh).transpose(0, 3, 1, 2, 4)
    vb = vs.reshape(B, n_slc, SLC_BLOCK, G, dh).transpose(0, 3, 1, 2, 4)
    q_blk = jnp.moveaxis(qg.reshape(B, nqb, SLC_QBLOCK, G, hg, dh), 1, 0)
    sel_blk = jnp.moveaxis(sel.reshape(B, G, nqb, SLC_QBLOCK, -1), 2, 0)
    t_blk = jnp.arange(S).reshape(nqb, SLC_QBLOCK)
    bi = jnp.arange(B)[:, None, None, None]
    gi = jnp.arange(G)[None, :, None, None]

    def one_block(args):
        qb, sb, tb = args
        n = sb.shape[-1]
        kg = kb[bi, gi, sb].reshape(B, G, SLC_QBLOCK, n * SLC_BLOCK, dh)
        vg = vb[bi, gi, sb].reshape(B, G, SLC_QBLOCK, n * SLC_BLOCK, dh)
        kpos = (sb[..., None] * SLC_BLOCK + jnp.arange(SLC_BLOCK)).reshape(B, G, SLC_QBLOCK, n * SLC_BLOCK)
        mask = (kpos <= tb[None, None, :, None])[:, :, None]
        s = jnp.einsum("bqghd,bgqkd->bghqk", qb, kg) * scale
        p = masked_softmax(s, mask)
        return jnp.einsum("bghqk,bgqkd->bqghd", p.astype(vg.dtype), vg)

    o = lax.map(one_block, (q_blk, sel_blk, t_blk))
    return jnp.moveaxis(o, 0, 1).reshape(B, S, G, hg, dh)


def window_attention(qg, kw, vw, scale):
    B, S, G, hg, dh = qg.shape
    nwb = S // WIN_QBLOCK
    kspan = WINDOW + WIN_QBLOCK
    pad = ((0, 0), (WINDOW, 0), (0, 0), (0, 0))
    kpad = jnp.pad(kw, pad)
    vpad = jnp.pad(vw, pad)
    q_blk = jnp.moveaxis(qg.reshape(B, nwb, WIN_QBLOCK, G, hg, dh), 1, 0)

    def one_block(args):
        qb, i = args
        start = i * WIN_QBLOCK
        kb = lax.dynamic_slice_in_dim(kpad, start, kspan, axis=1)
        vb = lax.dynamic_slice_in_dim(vpad, start, kspan, axis=1)
        tq = start + jnp.arange(WIN_QBLOCK)
        tk = start - WINDOW + jnp.arange(kspan)
        diff = tq[:, None] - tk[None, :]
        mask = (tk[None, :] >= 0) & (diff >= 0) & (diff < WINDOW)
        s = jnp.einsum("bqghd,bkgd->bghqk", qb, kb) * scale
        p = masked_softmax(s, mask)
        return jnp.einsum("bghqk,bkgd->bqghd", p.astype(vb.dtype), vb)

    o = lax.map(one_block, (q_blk, jnp.arange(nwb)))
    return jnp.moveaxis(o, 0, 1).reshape(B, S, G, hg, dh)


def nsa_attention(q, kc, vc, ks, vs, kw, vw, gate_logits, cmp_pos, w1k, w2k, w1v, w2v):
    B, S, H, dh = q.shape
    G, hg = NSA_KV_HEADS, NSA_GROUP
    scale = dh ** -0.5
    t = jnp.arange(S)
    qg = q.reshape(B, S, G, hg, dh)

    k_cmp = compress_blocks(kc, cmp_pos, w1k, w2k)
    v_cmp = compress_blocks(vc, cmp_pos, w1v, w2v)
    nc = k_cmp.shape[1]
    blk_end = jnp.arange(nc) * CMP_STRIDE + CMP_BLOCK - 1
    m_cmp = blk_end[None, :] <= t[:, None]
    s_cmp = jnp.einsum("bsghd,bngd->bghsn", qg, k_cmp) * scale
    p_cmp = masked_softmax(s_cmp, m_cmp)
    o_cmp = jnp.einsum("bghsn,bngd->bsghd", p_cmp.astype(v_cmp.dtype), v_cmp)

    r = CMP_BLOCK // CMP_STRIDE
    imp = jnp.sum(p_cmp, axis=2)
    imp = sum(jnp.pad(imp, ((0, 0), (0, 0), (0, 0), (i, r - 1 - i))) for i in range(r))
    n_slc = S // SLC_BLOCK
    imp = imp.reshape(B, G, S, n_slc, SLC_BLOCK // CMP_STRIDE).sum(-1)
    j = jnp.arange(n_slc)[None, :]
    cur = (t // SLC_BLOCK)[:, None]
    forced = (j == 0) | (j == cur) | (j == cur - 1)
    admissible = j * SLC_BLOCK <= t[:, None]
    imp = jnp.where(forced, jnp.inf, jnp.where(admissible, imp, -jnp.inf))
    n_sel = min(SLC_TOPN, n_slc)
    _, sel = lax.top_k(imp, n_sel)
    o_slc = selected_attention(qg, ks, vs, sel, scale)

    o_win = window_attention(qg, kw, vw, scale)

    g = jax.nn.sigmoid(gate_logits)
    o = (g[..., 0:1] * o_cmp.reshape(B, S, H, dh)
         + g[..., 1:2] * o_slc.reshape(B, S, H, dh)
         + g[..., 2:3] * o_win.reshape(B, S, H, dh))
    return o.reshape(B, S, H * dh)


def dsa_attention(q, k, v, qi, ki, wi):
    B, S, H, dh = q.shape
    scale = dh ** -0.5
    topk = min(DSA_TOPK, S // 4)
    nqb = S // DSA_QBLOCK
    q_blk = jnp.moveaxis(q.reshape(B, nqb, DSA_QBLOCK, H, dh), 1, 0)
    qi_blk = jnp.moveaxis(qi.reshape(B, nqb, DSA_QBLOCK, IDX_HEADS, IDX_DIM), 1, 0)
    wi_blk = jnp.moveaxis(wi.reshape(B, nqb, DSA_QBLOCK, IDX_HEADS), 1, 0)
    t_blk = jnp.arange(S).reshape(nqb, DSA_QBLOCK)
    kpos = jnp.arange(S)
    ki32 = ki.astype(jnp.float32)

    def one_block(args):
        qb, qib, wib, tb = args
        logits = jnp.einsum("bqhd,bkd->bqhk", qib.astype(jnp.float32), ki32) * (IDX_DIM ** -0.5)
        score = jnp.einsum("bqh,bqhk->bqk", wib.astype(jnp.float32) * (IDX_HEADS ** -0.5), jax.nn.relu(logits))
        score = jnp.where(kpos[None, None, :] <= tb[None, :, None], score, -jnp.inf)
        _, sel = lax.top_k(score, topk)
        kg = jax.vmap(lambda kk, ss: kk[ss])(k, sel)
        vg = jax.vmap(lambda vv, ss: vv[ss])(v, sel)
        mask = (sel <= tb[None, :, None])[:, None]
        s = jnp.einsum("bqhd,bqkd->bhqk", qb, kg) * scale
        p = masked_softmax(s, mask)
        return jnp.einsum("bhqk,bqkd->bqhd", p.astype(vg.dtype), vg)

    o = lax.map(one_block, (q_blk, qi_blk, wi_blk, t_blk))
    return jnp.moveaxis(o, 0, 1).reshape(B, S, H * dh)


def token_mixer(h, w_in, cmp_pos, cmp_w1_k, cmp_w2_k, cmp_w1_v, cmp_w2_v,
                kv_norm_g, w_uk, w_uv, w_br_nsa, w_br_dsa, w_out):
    B, S, _ = h.shape
    pos = jnp.arange(S, dtype=jnp.float32)
    z = h @ w_in
    offs = [int(o) for o in np.cumsum(IN_SPLITS)[:-1]]
    (q_n, kc, vc, ks, vs, kw, vw, g_n, q_d, ckv, qi, ki, wi, g_m) = jnp.split(z, offs, axis=-1)
    G = NSA_KV_HEADS
    heads = lambda a, n: a.reshape(B, S, n, -1)

    o_nsa = nsa_attention(
        rope(heads(q_n, NSA_HEADS), pos),
        rope(heads(kc, G), pos), heads(vc, G),
        rope(heads(ks, G), pos), heads(vs, G),
        rope(heads(kw, G), pos), heads(vw, G),
        g_n.reshape(B, S, NSA_HEADS, 3), cmp_pos, cmp_w1_k, cmp_w2_k, cmp_w1_v, cmp_w2_v)

    c_kv = rms_norm(ckv, kv_norm_g)
    k_d = rope((c_kv @ w_uk)[:, :, None, :], pos)[:, :, 0]
    v_d = c_kv @ w_uv
    o_dsa = dsa_attention(
        rope(heads(q_d, DSA_HEADS), pos), k_d, v_d,
        rope(heads(qi, IDX_HEADS), pos), rope(ki[:, :, None, :], pos)[:, :, 0], wi)

    g_nsa, g_dsa = jnp.split(g_m, 2, axis=-1)
    merged = jax.nn.sigmoid(g_nsa) * (o_nsa @ w_br_nsa) + jax.nn.sigmoid(g_dsa) * (o_dsa @ w_br_dsa)
    return merged @ w_out


def peer_ffn(h, wq, subkeys, u, v):
    B, S, D = h.shape
    T = B * S
    xf = h.reshape(T, D)
    q = (xf @ wq).reshape(T, PEER_HEADS, 2, PEER_HALF)
    s_sub = jnp.einsum("thcd,hcnd->thcn", q, subkeys).astype(jnp.float32)
    s_half, i_half = lax.top_k(s_sub, PEER_TOPK)
    cand = s_half[:, :, 0, :, None] + s_half[:, :, 1, None, :]
    cidx = i_half[:, :, 0, :, None] * PEER_KEYS + i_half[:, :, 1, None, :]
    cand = cand.reshape(T, PEER_HEADS, PEER_TOPK * PEER_TOPK)
    cidx = cidx.reshape(T, PEER_HEADS, PEER_TOPK * PEER_TOPK)
    top_s, top_p = lax.top_k(cand, PEER_TOPK)
    eidx = jnp.take_along_axis(cidx, top_p, axis=-1)
    gate = jax.nn.softmax(top_s, axis=-1)
    nch = T // PEER_CHUNK

    def one_chunk(args):
        xc, ec, gc = args
        ue = u[ec]
        ve = v[ec]
        act = jax.nn.gelu(jnp.einsum("cd,chkd->chk", xc, ue), approximate=False)
        return jnp.einsum("chk,chkd->cd", (gc * act).astype(ve.dtype), ve)

    out = lax.map(one_chunk, (xf.reshape(nch, PEER_CHUNK, D),
                              eidx.reshape(nch, PEER_CHUNK, PEER_HEADS, PEER_TOPK),
                              gate.reshape(nch, PEER_CHUNK, PEER_HEADS, PEER_TOPK)))
    return out.reshape(B, S, D).astype(h.dtype)


def setup_inputs(seed: int = 0) -> dict:
    key = jax.random.key(seed)
    ks = jax.random.split(key, 24)
    L, D = DEPTH, D_MODEL
    nrm = lambda k, shape, std: jax.random.normal(k, shape, jnp.float32) * std
    gain = lambda k, shape: 1.0 + 0.05 * jax.random.normal(k, shape, jnp.float32)
    return {
        "x": nrm(ks[0], (BATCH, SEQ, D), 1.0),
        "c": nrm(ks[1], (BATCH, D), 1.0),
        "ada_w": nrm(ks[2], (L, D, 6 * D), 0.5 * D ** -0.5),
        "ada_b": nrm(ks[3], (L, 6 * D), 0.01),
        "norm1_g": gain(ks[4], (L, D)),
        "w_in": nrm(ks[5], (L, D, D_IN), D ** -0.5),
        "cmp_pos": nrm(ks[6], (L, CMP_BLOCK, HEAD_DIM), 0.1),
        "cmp_w1_k": nrm(ks[7], (L, CMP_BLOCK, HEAD_DIM, HEAD_DIM), (CMP_BLOCK * HEAD_DIM) ** -0.5),
        "cmp_w2_k": nrm(ks[8], (L, HEAD_DIM, HEAD_DIM), HEAD_DIM ** -0.5),
        "cmp_w1_v": nrm(ks[9], (L, CMP_BLOCK, HEAD_DIM, HEAD_DIM), (CMP_BLOCK * HEAD_DIM) ** -0.5),
        "cmp_w2_v": nrm(ks[10], (L, HEAD_DIM, HEAD_DIM), HEAD_DIM ** -0.5),
        "kv_norm_g": gain(ks[11], (L, DSA_KV_RANK)),
        "w_uk": nrm(ks[12], (L, DSA_KV_RANK, HEAD_DIM), DSA_KV_RANK ** -0.5),
        "w_uv": nrm(ks[13], (L, DSA_KV_RANK, HEAD_DIM), DSA_KV_RANK ** -0.5),
        "w_br_nsa": nrm(ks[14], (L, NSA_Q_DIM, D), NSA_Q_DIM ** -0.5),
        "w_br_dsa": nrm(ks[15], (L, DSA_Q_DIM, D), DSA_Q_DIM ** -0.5),
        "w_out": nrm(ks[16], (L, D, D), D ** -0.5),
        "norm2_g": gain(ks[17], (L, D)),
        "peer_wq": nrm(ks[18], (L, D, PEER_HEADS * PEER_KEY_DIM), D ** -0.5),
        "peer_subkeys": nrm(ks[19], (L, PEER_HEADS, 2, PEER_KEYS, PEER_HALF), PEER_HALF ** -0.5),
        "peer_u": nrm(ks[20], (L, PEER_EXPERTS, D), D ** -0.5),
        "peer_v": nrm(ks[21], (L, PEER_EXPERTS, D), 0.5),
        "final_g": gain(ks[22], (D,)),
    }


def reference(x, c, ada_w, ada_b, norm1_g, w_in, cmp_pos, cmp_w1_k, cmp_w2_k, cmp_w1_v, cmp_w2_v,
              kv_norm_g, w_uk, w_uv, w_br_nsa, w_br_dsa, w_out, norm2_g,
              peer_wq, peer_subkeys, peer_u, peer_v, final_g):
    for l in range(DEPTH):
        mod = jax.nn.silu(c) @ ada_w[l] + ada_b[l]
        sh1, sc1, g1, sh2, sc2, g2 = jnp.split(mod[:, None, :], 6, axis=-1)
        h = rms_norm(x, norm1_g[l]) * (1.0 + sc1) + sh1
        x = x + g1 * token_mixer(h, w_in[l], cmp_pos[l], cmp_w1_k[l], cmp_w2_k[l], cmp_w1_v[l], cmp_w2_v[l],
                                 kv_norm_g[l], w_uk[l], w_uv[l], w_br_nsa[l], w_br_dsa[l], w_out[l])
        h = rms_norm(x, norm2_g[l]) * (1.0 + sc2) + sh2
        x = x + g2 * peer_ffn(h, peer_wq[l], peer_subkeys[l], peer_u[l], peer_v[l])
    return rms_norm(x, final_g)
```

```cpp
#include <hip/hip_runtime.h>
#include <stdint.h>
#include <stdio.h>

#define LAS __attribute__((address_space(3)))
typedef unsigned short bf16_t;
typedef unsigned int u32;

constexpr int T = 16384, SEQ = 2048, NB = 8, D = 1024, NZ = 4608, DIN = 4576;
constexpr int NTHR = 512;
constexpr float EPS = 1e-6f;
constexpr int ZC_QN = 0, ZC_KC = 512, ZC_VC = 640, ZC_KS = 768, ZC_VS = 896, ZC_KW = 1024, ZC_VW = 1152, ZC_QD = 1280, ZC_CKV = 1792,
              ZC_QI = 1920, ZC_KI = 2432, ZC_GN = 2496, ZC_WI = 2520, ZC_GM = 2560;
constexpr unsigned long long ROPE_MASK = 0xFFull | (3ull << 8) | (3ull << 12) | (3ull << 16) | (0xFFull << 20) | (0xFFull << 30) | (1ull << 38);
constexpr unsigned long long SCALE_MASK = 0xFFull | (0xFFull << 20) | (0xFFull << 30);

constexpr size_t WS_Z = 0;
constexpr size_t WS_SSUB = 0;
constexpr size_t WS_EIDX = 134217728;
constexpr size_t WS_GATE = 142606336;
constexpr size_t WS_MERGED = 150994944;
constexpr size_t WS_U16 = WS_MERGED;
constexpr size_t WS_HB = 184549376;
constexpr size_t WS_ONSA = WS_HB;
constexpr size_t WS_ODSA = WS_HB + 16777216;
constexpr size_t WS_V16 = WS_HB;
constexpr size_t WS_H2 = 218103808;
constexpr size_t WS_W = 251658240;
constexpr size_t WS_WINT = WS_W;
constexpr size_t WS_WNSAT = WS_WINT + 9437184;
constexpr size_t WS_WDSAT = WS_WNSAT + 1048576;
constexpr size_t WS_WOUTT = WS_WDSAT + 1048576;
constexpr size_t WS_SMALL = WS_WOUTT + 2097152;
constexpr size_t WS_MOD = WS_SMALL;
constexpr size_t WS_COS = WS_MOD + 196608;
constexpr size_t WS_SIN = WS_COS + 262144;
constexpr size_t WS_BAR = WS_SIN + 262144;
constexpr size_t WS_END_SMALL = WS_BAR + 16384;
static_assert(WS_END_SMALL <= 268435456, "ws overflow");
constexpr size_t DO_KD = 0;
constexpr size_t DO_VDT = 2097152;
constexpr size_t DO_VST = 4194304;
constexpr size_t DO_VWT = 8388608;
constexpr size_t DO_KCMP = 12582912;
constexpr size_t DO_VCMPT = 12845056;
constexpr size_t DO_HID = 13107200;
constexpr size_t DO_MASK = 14680064;
constexpr size_t DO_END = DO_MASK + 4194304;

struct Params {
    const float *x, *c, *ada_w, *ada_b, *norm1_g, *w_in, *cmp_pos, *w1k, *w2k, *w1v, *w2v, *kvg, *w_uk, *w_uv, *w_nsa, *w_dsa, *w_out, *norm2_g, *wq,
        *subkeys, *pu, *pv, *final_g;
    float* out;
    unsigned char* ws;
};

__device__ __forceinline__ bf16_t f2bf(float f) { u32 u = __float_as_uint(f); u += 0x7fffu + ((u >> 16) & 1u); return (bf16_t)(u >> 16); }
__device__ __forceinline__ float bf2f(bf16_t h) { return __uint_as_float((u32)h << 16); }
__device__ __forceinline__ float bflo(u32 w) { return __uint_as_float(w << 16); }
__device__ __forceinline__ float bfhi(u32 w) { return __uint_as_float(w & 0xffff0000u); }
__device__ __forceinline__ u32 pk2(float lo, float hi) { return (u32)f2bf(lo) | ((u32)f2bf(hi) << 16); }
__device__ __forceinline__ float wave_sum(float v) {
#pragma unroll
    for (int o = 1; o < 64; o <<= 1) v += __shfl_xor(v, o);
    return v;
}
__device__ __forceinline__ float wave_max(float v) {
#pragma unroll
    for (int o = 1; o < 64; o <<= 1) v = fmaxf(v, __shfl_xor(v, o));
    return v;
}
__device__ __forceinline__ float sigmoidf_(float v) { return 1.0f / (1.0f + __expf(-v)); }
__device__ __forceinline__ float gelu_tanh(float v) { const float u = 0.7978845608028654f * (v + 0.044715f * v * v * v); return 0.5f * v * (1.0f + tanhf(u)); }
__device__ __forceinline__ float gelu_erf(float v) { return 0.5f * v * (1.0f + erff(v * 0.7071067811865476f)); }
__device__ __forceinline__ int z_logical_col(int pc) {
    const int g64 = pc >> 6; const int o = pc & 63;
    const int po = (g64 < 64 && ((ROPE_MASK >> g64) & 1ull)) ? ((o >> 1) + 32 * (o & 1)) : o;
    const int pp = (pc & ~63) + po;
    if (pc < 1280) return pp;
    if (pc < 1792) return 1304 + (pp - 1280);
    if (pc < 1920) return 1816 + (pp - 1792);
    if (pc < 2432) return 1944 + (pp - 1920);
    if (pc < 2496) return 2456 + (pp - 2432);
    if (pc < 2520) return 1280 + (pc - 2496);
    if (pc < 2528) return 2520 + (pc - 2520);
    if (pc < 2560) return -1;
    return 2528 + (pc - 2560);
}
__device__ __forceinline__ void z_post(int t, int pc, float& v0, float& v1, const float* cosT, const float* sinT) {
    const int g64 = pc >> 6;
    if (g64 < 64 && ((ROPE_MASK >> g64) & 1ull)) {
        const int i = (pc & 63) >> 1, pos = t & (SEQ - 1);
        const float c = cosT[pos * 32 + i], s = sinT[pos * 32 + i];
        const float a = v0 * c - v1 * s, b = v1 * c + v0 * s;
        const float sc = ((SCALE_MASK >> g64) & 1ull) ? 0.125f : 1.0f;
        v0 = a * sc; v1 = b * sc;
    } else if (pc >= ZC_GM || (pc >= ZC_GN && pc < ZC_WI)) { v0 = sigmoidf_(v0); v1 = sigmoidf_(v1); }
}
__device__ __forceinline__ void sincos_tab(float ang, float& s, float& c) {
    const double a = (double)ang; const double k = rint(a * 0.63661977236758134308);
    const float r = (float)(a - k * 1.57079632679489661923); const float z = r * r;
    const float sp = ((-1.9515295891e-4f * z + 8.3321608736e-3f) * z - 1.6666654611e-1f) * z * r + r;
    const float cp = ((2.443315711809948e-5f * z - 1.388731625493765e-3f) * z + 4.166664568298827e-2f) * z * z - 0.5f * z + 1.0f;
    const int q = ((int)k) & 3;
    s = (q == 0) ? sp : (q == 1) ? cp : (q == 2) ? -sp : -cp;
    c = (q == 0) ? cp : (q == 1) ? -sp : (q == 2) ? -cp : sp;
}

__device__ void st_adaln(const Params& p, unsigned char* lds) {
    const int tid = threadIdx.x, lane = tid & 63, w = tid >> 6;
    float* cosT = (float*)(p.ws + WS_COS); float* sinT = (float*)(p.ws + WS_SIN);
    for (int i = blockIdx.x * NTHR + tid; i < SEQ * 32; i += gridDim.x * NTHR) {
        const int pos = i >> 5, f = i & 31; const float inv = powf(10000.0f, -(float)f / 32.0f);
        float s, c; sincos_tab((float)pos * inv, s, c); cosT[i] = c; sinT[i] = s;
    }
    float* sc = (float*)lds;
    float* red = sc + 8192;
    for (int i = tid; i < 8192; i += NTHR) { const float v = p.c[i]; sc[i] = v / (1.0f + __expf(-v)); }
    __syncthreads();
    float* mod = (float*)(p.ws + WS_MOD);
    for (int unit = blockIdx.x; unit < 192; unit += gridDim.x) {
        float acc[8];
#pragma unroll
        for (int b = 0; b < 8; ++b) acc[b] = 0.f;
        const int col = unit * 32 + (lane & 31), ks = lane >> 5;
        for (int kk = 0; kk < 64; ++kk) {
            const int k = w * 128 + kk * 2 + ks; const float wv = p.ada_w[(size_t)k * 6144 + col];
#pragma unroll
            for (int b = 0; b < 8; ++b) acc[b] += sc[b * 1024 + k] * wv;
        }
#pragma unroll
        for (int b = 0; b < 8; ++b) red[((w * 2 + ks) * 8 + b) * 32 + (lane & 31)] = acc[b];
        __syncthreads();
        if (tid < 256) { const int b = tid >> 5, c = tid & 31; float s = 0.f;
            for (int j = 0; j < 16; ++j) s += red[(j * 8 + b) * 32 + c];
            mod[b * 6144 + unit * 32 + c] = s + p.ada_b[unit * 32 + c]; }
        __syncthreads();
    }
}
__device__ void st_norm_rows(const Params& p, int which) {
    const int tid = threadIdx.x, lane = tid & 63, w = tid >> 6;
    const float* src = which ? p.out : p.x; const float* g = which ? p.norm2_g : p.norm1_g;
    bf16_t* dst = (bf16_t*)(p.ws + (which ? WS_H2 : WS_HB));
    const float* mod = (const float*)(p.ws + WS_MOD);
    for (int t = blockIdx.x * 8 + w; t < T; t += gridDim.x * 8) {
        const int b = t >> 11; const float* sh = mod + b * 6144 + (which ? 3072 : 0); const float* scl = sh + 1024;
        const float4* xr = (const float4*)(src + (size_t)t * D);
        float4 v[4]; float ss = 0.f;
#pragma unroll
        for (int j = 0; j < 4; ++j) { v[j] = xr[lane + 64 * j]; ss += v[j].x * v[j].x + v[j].y * v[j].y + v[j].z * v[j].z + v[j].w * v[j].w; }
        const float r = rsqrtf(wave_sum(ss) * (1.0f / D) + EPS);
#pragma unroll
        for (int j = 0; j < 4; ++j) { const int d0 = (lane + 64 * j) * 4;
            const float4 gg = *(const float4*)(g + d0), s4 = *(const float4*)(scl + d0), h4 = *(const float4*)(sh + d0);
            const float o0 = v[j].x * r * gg.x * (1.f + s4.x) + h4.x, o1 = v[j].y * r * gg.y * (1.f + s4.y) + h4.y;
            const float o2 = v[j].z * r * gg.z * (1.f + s4.z) + h4.z, o3 = v[j].w * r * gg.w * (1.f + s4.w) + h4.w;
            uint2 o; o.x = pk2(o0, o1); o.y = pk2(o2, o3); *(uint2*)(dst + (size_t)t * D + d0) = o; }
    }
}
__device__ __forceinline__ void naive_dot8(const bf16_t* A, int lda, const float* W, int ldw, int K, int t0, int col, float (&acc)[8]) {
#pragma unroll
    for (int i = 0; i < 8; ++i) acc[i] = 0.f;
    for (int k = 0; k < K; k += 2) {
        const float w0 = W[(size_t)k * ldw + col], w1 = W[(size_t)(k + 1) * ldw + col];
#pragma unroll
        for (int i = 0; i < 8; ++i) { const u32 a = *(const u32*)(A + (size_t)(t0 + i) * lda + k); acc[i] += bflo(a) * w0 + bfhi(a) * w1; }
    }
}
__device__ void st_z_naive(const Params& p) {
    const int tid = threadIdx.x; const bf16_t* hb = (const bf16_t*)(p.ws + WS_HB); bf16_t* Z = (bf16_t*)(p.ws + WS_Z);
    const float* cosT = (const float*)(p.ws + WS_COS); const float* sinT = (const float*)(p.ws + WS_SIN);
    const int nitems = (T / 8) * 9;
    for (int it = blockIdx.x * 2 + (tid >> 8); it < nitems; it += gridDim.x * 2) {
        const int tt = it / 9, ch = it % 9; const int t0 = tt * 8; const int pc = (ch * 256 + (tid & 255)) * 2;
        const int l0 = z_logical_col(pc), l1 = z_logical_col(pc + 1);
        float a0[8], a1[8];
        if (l0 >= 0) { naive_dot8(hb, D, p.w_in, DIN, D, t0, l0, a0); naive_dot8(hb, D, p.w_in, DIN, D, t0, l1, a1); }
        else {
#pragma unroll
            for (int i = 0; i < 8; ++i) { a0[i] = 0.f; a1[i] = 0.f; } }
#pragma unroll
        for (int i = 0; i < 8; ++i) { float v0 = a0[i], v1 = a1[i]; z_post(t0 + i, pc, v0, v1, cosT, sinT); *(u32*)(Z + (size_t)(t0 + i) * NZ + pc) = pk2(v0, v1); }
    }
}
__device__ void st_prep_a_naive(const Params& p) {
    const int tid = threadIdx.x; const bf16_t* Z = (const bf16_t*)(p.ws + WS_Z);
    const float* cosT = (const float*)(p.ws + WS_COS); const float* sinT = (const float*)(p.ws + WS_SIN);
    unsigned char* dob = (unsigned char*)p.out;
    bf16_t* kd = (bf16_t*)(dob + DO_KD); bf16_t* vdT = (bf16_t*)(dob + DO_VDT); bf16_t* vsT = (bf16_t*)(dob + DO_VST); bf16_t* vwT = (bf16_t*)(dob + DO_VWT);
    float* hid = (float*)(dob + DO_HID);
    for (int it = blockIdx.x * NTHR + tid; it < T * 32; it += gridDim.x * NTHR) {
        const int t = it >> 5, i = it & 31; const bf16_t* cr = Z + (size_t)t * NZ + ZC_CKV;
        float ss = 0.f; for (int r = 0; r < 128; ++r) { const float v = bf2f(cr[r]); ss += v * v; }
        const float rn = rsqrtf(ss * (1.0f / 128.0f) + EPS);
        float k1 = 0.f, k2 = 0.f, v1 = 0.f, v2 = 0.f;
        for (int r = 0; r < 128; ++r) { const float cn = bf2f(cr[r]) * rn * p.kvg[r];
            k1 += cn * p.w_uk[r * 64 + i]; k2 += cn * p.w_uk[r * 64 + i + 32]; v1 += cn * p.w_uv[r * 64 + i]; v2 += cn * p.w_uv[r * 64 + i + 32]; }
        const int pos = t & (SEQ - 1), b = t >> 11; const float c = cosT[pos * 32 + i], s = sinT[pos * 32 + i];
        *(u32*)(kd + (size_t)t * 64 + 2 * i) = pk2(k1 * c - k2 * s, k2 * c + k1 * s);
        vdT[((size_t)b * 64 + i) * SEQ + pos] = f2bf(v1); vdT[((size_t)b * 64 + i + 32) * SEQ + pos] = f2bf(v2);
    }
    for (int it = blockIdx.x * NTHR + tid; it < T * 128; it += gridDim.x * NTHR) {
        const int t = it >> 7, gd = it & 127, b = t >> 11, pos = t & (SEQ - 1);
        vsT[((size_t)b * 128 + gd) * SEQ + pos] = Z[(size_t)t * NZ + ZC_VS + gd];
        vwT[((size_t)b * 128 + gd) * SEQ + pos] = Z[(size_t)t * NZ + ZC_VW + gd];
    }
    for (int it = blockIdx.x * NTHR + tid; it < 2 * 8 * 2 * 128 * 64; it += gridDim.x * NTHR) {
        const int e = it & 63, n = (it >> 6) & 127, g = (it >> 13) & 1, b = (it >> 14) & 7, kv = it >> 17;
        float acc = 0.f;
        if (n < 127) {
            const float* w1 = kv ? p.w1v : p.w1k;
            for (int l = 0; l < 32; ++l) { const bf16_t* xr = Z + (size_t)(b * SEQ + 16 * n + l) * NZ + (kv ? ZC_VC : ZC_KC) + g * 64;
                for (int d = 0; d < 64; ++d) { const int pd = kv ? d : (2 * (d & 31) + (d >> 5));
                    acc += (bf2f(xr[pd]) + p.cmp_pos[l * 64 + d]) * w1[(l * 64 + d) * 64 + e]; } }
            acc = gelu_tanh(acc);
        }
        hid[it] = acc;
    }
}
__device__ void st_prep_b_naive(const Params& p) {
    const int tid = threadIdx.x; unsigned char* dob = (unsigned char*)p.out;
    const float* hid = (const float*)(dob + DO_HID); bf16_t* kcmp = (bf16_t*)(dob + DO_KCMP); bf16_t* vcmpT = (bf16_t*)(dob + DO_VCMPT);
    for (int it = blockIdx.x * NTHR + tid; it < 2 * 8 * 2 * 128 * 64; it += gridDim.x * NTHR) {
        const int f = it & 63, n = (it >> 6) & 127, g = (it >> 13) & 1, b = (it >> 14) & 7, kv = it >> 17;
        const float* w2 = kv ? p.w2v : p.w2k; const float* h = hid + (size_t)(it & ~63);
        float acc = 0.f;
        if (n < 127) for (int e = 0; e < 64; ++e) acc += h[e] * w2[e * 64 + f];
        if (kv == 0) kcmp[(((size_t)b * 2 + g) * 128 + n) * 64 + (2 * (f & 31) + (f >> 5))] = f2bf(acc);
        else vcmpT[(((size_t)b * 2 + g) * 64 + f) * 128 + n] = f2bf(acc);
    }
}
__device__ __forceinline__ float dot64(const float* q, const bf16_t* kr) {
    float s = 0.f;
#pragma unroll
    for (int j = 0; j < 8; ++j) { const uint4 v = *(const uint4*)(kr + 8 * j); const float* qq = q + 8 * j;
        s += qq[0] * bflo(v.x) + qq[1] * bfhi(v.x) + qq[2] * bflo(v.y) + qq[3] * bfhi(v.y) + qq[4] * bflo(v.z) + qq[5] * bfhi(v.z) + qq[6] * bflo(v.w) + qq[7] * bfhi(v.w); }
    return s;
}
__device__ void st_nsa_naive(const Params& p, unsigned char* lds) {
    const int tid = threadIdx.x, lane = tid & 63, h = tid >> 6, g = h >> 2;
    const bf16_t* Z = (const bf16_t*)(p.ws + WS_Z); unsigned char* dob = (unsigned char*)p.out;
    const bf16_t* kcmp = (const bf16_t*)(dob + DO_KCMP); const bf16_t* vcmpT = (const bf16_t*)(dob + DO_VCMPT);
    bf16_t* onsa = (bf16_t*)(p.ws + WS_ONSA);
    float* qs = (float*)lds;
    float* pc = qs + 512;
    float* vals = pc + 1024;
    u32* selm = (u32*)(vals + 64);
    for (int t = blockIdx.x; t < T; t += gridDim.x) {
        const int b = t >> 11, pos = t & (SEQ - 1); const bf16_t* zr = Z + (size_t)t * NZ;
        __syncthreads();
        qs[h * 64 + lane] = bf2f(zr[ZC_QN + h * 64 + lane]);
        __syncthreads();
        const float* q = qs + h * 64;
        float sc[2]; float m = -1e30f;
#pragma unroll
        for (int c2 = 0; c2 < 2; ++c2) { const int n = c2 * 64 + lane; const bool valid = (n < 127) && (16 * n + 31 <= pos);
            const float s = dot64(q, kcmp + (((size_t)b * 2 + g) * 128 + n) * 64); sc[c2] = valid ? s : -1e30f; m = fmaxf(m, sc[c2]); }
        m = wave_max(m); float l = 0.f;
#pragma unroll
        for (int c2 = 0; c2 < 2; ++c2) { const int n = c2 * 64 + lane; const bool valid = (n < 127) && (16 * n + 31 <= pos); sc[c2] = valid ? __expf(sc[c2] - m) : 0.f; l += sc[c2]; }
        l = wave_sum(l); const float il = 1.0f / fmaxf(l, 1e-30f);
        pc[h * 128 + lane] = sc[0] * il; pc[h * 128 + 64 + lane] = sc[1] * il;
        __syncthreads();
        float ocmp = 0.f; { const bf16_t* vr = vcmpT + (((size_t)b * 2 + g) * 64 + lane) * 128; const float* pp = pc + h * 128;
            for (int n = 0; n < 128; ++n) ocmp += pp[n] * bf2f(vr[n]); }
        if (tid < 64) { const int gg = tid >> 5, j = tid & 31; const float* p0 = pc + gg * 512;
            auto imp = [&](int n) -> float { return (n < 0 || n > 126) ? 0.f : (p0[n] + p0[128 + n] + p0[256 + n] + p0[384 + n]); };
            const float bl = imp(4 * j - 1) + 2.f * imp(4 * j) + 2.f * imp(4 * j + 1) + 2.f * imp(4 * j + 2) + imp(4 * j + 3);
            const int cur = pos >> 6; const bool forced = (j == 0) || (j == cur) || (j == cur - 1); const bool adm = (j * 64 <= pos);
            vals[tid] = forced ? __builtin_inff() : (adm ? bl : -__builtin_inff()); }
        __syncthreads();
        if (tid < 64) { const int gg = tid >> 5, j = tid & 31; const float v = vals[tid]; int rank = 0;
            for (int j2 = 0; j2 < 32; ++j2) { const float v2 = vals[gg * 32 + j2]; rank += (v2 > v || (v2 == v && j2 < j)) ? 1 : 0; }
            const unsigned long long bal = __ballot(rank < 16);
            if (tid == 0) { selm[0] = (u32)bal; selm[1] = (u32)(bal >> 32); } }
        __syncthreads();
        const u32 sel = selm[g];
        float ms = -1e30f, ls = 0.f, os = 0.f;
        for (int j = 0; j * 64 <= pos; ++j) { if (!((sel >> j) & 1u)) continue;
            const int kp = j * 64 + lane; const bool valid = kp <= pos;
            float s = dot64(q, Z + (size_t)(b * SEQ + kp) * NZ + ZC_KS + g * 64); s = valid ? s : -1e30f;
            const float mn = fmaxf(ms, wave_max(s)); const float al = __expf(ms - mn); const float pr = valid ? __expf(s - mn) : 0.f;
            ls = ls * al + wave_sum(pr); os *= al; ms = mn;
            for (int k = 0; k < 64; ++k) { const float pk = __shfl(pr, k); os += pk * bf2f(Z[(size_t)(b * SEQ + j * 64 + k) * NZ + ZC_VS + g * 64 + lane]); } }
        os = os / fmaxf(ls, 1e-30f);
        float mw = -1e30f, lw = 0.f, ow = 0.f;
        for (int c2 = 0; c2 < 8; ++c2) { const int kp = pos - 511 + c2 * 64 + lane; const bool valid = kp >= 0; if (pos - 511 + c2 * 64 + 63 < 0) continue;
            float s = valid ? dot64(q, Z + (size_t)(b * SEQ + kp) * NZ + ZC_KW + g * 64) : -1e30f;
            const float mn = fmaxf(mw, wave_max(s)); const float al = __expf(mw - mn); const float pr = valid ? __expf(s - mn) : 0.f;
            lw = lw * al + wave_sum(pr); ow *= al; mw = mn;
            for (int k = 0; k < 64; ++k) { const float pk = __shfl(pr, k); const int kk = pos - 511 + c2 * 64 + k;
                if (kk >= 0) ow += pk * bf2f(Z[(size_t)(b * SEQ + kk) * NZ + ZC_VW + g * 64 + lane]); } }
        ow = ow / fmaxf(lw, 1e-30f);
        const float gc = bf2f(zr[ZC_GN + h * 3 + 0]), gs = bf2f(zr[ZC_GN + h * 3 + 1]), gw = bf2f(zr[ZC_GN + h * 3 + 2]);
        onsa[(size_t)t * 512 + h * 64 + lane] = f2bf(gc * ocmp + gs * os + gw * ow);
    }
}
__device__ void st_dsa_naive(const Params& p, unsigned char* lds) {
    const int tid = threadIdx.x, lane = tid & 63, h = tid >> 6;
    const bf16_t* Z = (const bf16_t*)(p.ws + WS_Z); unsigned char* dob = (unsigned char*)p.out;
    const bf16_t* kd = (const bf16_t*)(dob + DO_KD); const bf16_t* vdT = (const bf16_t*)(dob + DO_VDT); u32* maskg = (u32*)(dob + DO_MASK);
    bf16_t* odsa = (bf16_t*)(p.ws + WS_ODSA);
    float* qi = (float*)lds;
    float* qd = qi + 512;
    float* wv = qd + 512;
    float* scv = wv + 8;
    u32* mk = (u32*)(scv + 2048);
    for (int t = blockIdx.x; t < T; t += gridDim.x) {
        const int b = t >> 11, pos = t & (SEQ - 1); const bf16_t* zr = Z + (size_t)t * NZ;
        __syncthreads();
        qi[tid] = bf2f(zr[ZC_QI + tid]); qd[tid] = bf2f(zr[ZC_QD + tid]);
        if (tid < 8) wv[tid] = bf2f(zr[ZC_WI + tid]) * 0.35355339059327373f;
        __syncthreads();
        for (int i = 0; i < 4; ++i) { const int k = tid + 512 * i; float s = -__builtin_inff();
            if (k <= pos) { s = 0.f; const bf16_t* kr = Z + (size_t)(b * SEQ + k) * NZ + ZC_KI;
                for (int hh = 0; hh < 8; ++hh) { const float lg = dot64(qi + hh * 64, kr); s = fmaf(wv[hh], fmaxf(lg, 0.f), s); } }
            scv[k] = s; }
        __syncthreads();
        for (int i = 0; i < 4; ++i) { const int k = tid + 512 * i; bool selb = false;
            if (k <= pos) { if (pos < 256) selb = true; else { const float v = scv[k]; int rank = 0;
                    for (int j = 0; j <= pos; ++j) { const float v2 = scv[j]; rank += (v2 > v || (v2 == v && j < k)) ? 1 : 0; } selb = rank < 256; } }
            const unsigned long long bal = __ballot(selb);
            if (lane == 0) { const int wi = 16 * i + 2 * h; mk[wi] = (u32)bal; mk[wi + 1] = (u32)(bal >> 32); } }
        __syncthreads();
        if (tid < 64) maskg[(size_t)t * 64 + tid] = mk[tid];
        float m = -1e30f, l = 0.f, o = 0.f; const float* q = qd + h * 64;
        for (int c2 = 0; c2 * 64 <= pos; ++c2) { const int kp = c2 * 64 + lane; const bool valid = (mk[kp >> 5] >> (kp & 31)) & 1u;
            if (__ballot(valid) == 0ull) continue;
            float s = valid ? dot64(q, kd + (size_t)(b * SEQ + kp) * 64) : -1e30f;
            const float mn = fmaxf(m, wave_max(s)); const float al = __expf(m - mn); const float pr = valid ? __expf(s - mn) : 0.f;
            l = l * al + wave_sum(pr); o *= al; m = mn;
            const bf16_t* vr = vdT + ((size_t)b * 64 + lane) * SEQ + c2 * 64;
            for (int k = 0; k < 64; ++k) { const float pk = __shfl(pr, k); o += pk * bf2f(vr[k]); } }
        odsa[(size_t)t * 512 + h * 64 + lane] = f2bf(o / fmaxf(l, 1e-30f));
    }
}
__device__ void st_merge_naive(const Params& p) {
    const int tid = threadIdx.x; const bf16_t* Z = (const bf16_t*)(p.ws + WS_Z);
    const bf16_t* onsa = (const bf16_t*)(p.ws + WS_ONSA); const bf16_t* odsa = (const bf16_t*)(p.ws + WS_ODSA); bf16_t* mg = (bf16_t*)(p.ws + WS_MERGED);
    for (int it = blockIdx.x; it < (T / 8) * 2; it += gridDim.x) { const int t0 = (it >> 1) * 8, n = (it & 1) * 512 + tid;
        float a[8], d[8]; naive_dot8(onsa, 512, p.w_nsa, D, 512, t0, n, a); naive_dot8(odsa, 512, p.w_dsa, D, 512, t0, n, d);
#pragma unroll
        for (int i = 0; i < 8; ++i) { const float g1 = bf2f(Z[(size_t)(t0 + i) * NZ + ZC_GM + n]), g2 = bf2f(Z[(size_t)(t0 + i) * NZ + ZC_GM + 1024 + n]);
            mg[(size_t)(t0 + i) * D + n] = f2bf(g1 * a[i] + g2 * d[i]); } }
}
__device__ void st_out_naive(const Params& p) {
    const int tid = threadIdx.x; const bf16_t* mg = (const bf16_t*)(p.ws + WS_MERGED); const float* mod = (const float*)(p.ws + WS_MOD);
    for (int it = blockIdx.x; it < (T / 8) * 2; it += gridDim.x) { const int t0 = (it >> 1) * 8, n = (it & 1) * 512 + tid;
        float a[8]; naive_dot8(mg, D, p.w_out, D, D, t0, n, a); const float g1 = mod[(t0 >> 11) * 6144 + 2048 + n];
#pragma unroll
        for (int i = 0; i < 8; ++i) p.out[(size_t)(t0 + i) * D + n] = p.x[(size_t)(t0 + i) * D + n] + g1 * a[i]; }
}
__device__ void st_peerq_naive(const Params& p) {
    const int tid = threadIdx.x; const bf16_t* h2 = (const bf16_t*)(p.ws + WS_H2); bf16_t* q = (bf16_t*)(p.ws + WS_MERGED);
    for (int it = blockIdx.x; it < (T / 8) * 2; it += gridDim.x) { const int t0 = (it >> 1) * 8, n = (it & 1) * 512 + tid;
        float a[8]; naive_dot8(h2, D, p.wq, D, D, t0, n, a);
#pragma unroll
        for (int i = 0; i < 8; ++i) q[(size_t)(t0 + i) * D + n] = f2bf(a[i]); }
}
__device__ void st_ssub_naive(const Params& p) {
    const int tid = threadIdx.x; const bf16_t* q = (const bf16_t*)(p.ws + WS_MERGED); float* ss = (float*)(p.ws + WS_SSUB);
    for (size_t it = (size_t)blockIdx.x * NTHR + tid; it < (size_t)T * 2048; it += (size_t)gridDim.x * NTHR) {
        const int t = (int)(it >> 11), col = (int)(it & 2047), hc = col >> 7, n = col & 127;
        const bf16_t* qr = q + (size_t)t * D + hc * 64; const float* sk = p.subkeys + ((size_t)hc * 128 + n) * 64;
        float acc = 0.f; for (int d = 0; d < 64; ++d) acc += bf2f(qr[d]) * sk[d];
        ss[it] = acc; }
}
__device__ __forceinline__ u32 ordf(float f) { const u32 u = __float_as_uint(f); return (u & 0x80000000u) ? ~u : (u | 0x80000000u); }
__device__ __forceinline__ void ins16(u32 (&s)[16], u32 key) {
#pragma unroll
    for (int i = 0; i < 16; ++i) { const u32 mx = s[i] > key ? s[i] : key; key = s[i] > key ? key : s[i]; s[i] = mx; }
}
__device__ void st_route(const Params& p) {
    const int tid = threadIdx.x; const float* ss = (const float*)(p.ws + WS_SSUB); int* eidx = (int*)(p.ws + WS_EIDX); float* gate = (float*)(p.ws + WS_GATE);
    for (int it = blockIdx.x * NTHR + tid; it < T * 8; it += gridDim.x * NTHR) {
        const float* s0 = ss + (size_t)it * 256;
        u32 a[16], b[16];
#pragma unroll
        for (int i = 0; i < 16; ++i) { a[i] = 0u; b[i] = 0u; }
        for (int n = 0; n < 128; n += 4) { const float4 x = *(const float4*)(s0 + n), y = *(const float4*)(s0 + 128 + n);
            ins16(a, (ordf(x.x) & ~127u) | (u32)(127 - n)); ins16(a, (ordf(x.y) & ~127u) | (u32)(126 - n)); ins16(a, (ordf(x.z) & ~127u) | (u32)(125 - n)); ins16(a, (ordf(x.w) & ~127u) | (u32)(124 - n));
            ins16(b, (ordf(y.x) & ~127u) | (u32)(127 - n)); ins16(b, (ordf(y.y) & ~127u) | (u32)(126 - n)); ins16(b, (ordf(y.z) & ~127u) | (u32)(125 - n)); ins16(b, (ordf(y.w) & ~127u) | (u32)(124 - n)); }
        float va[16], vb[16]; int na[16], nb[16];
#pragma unroll
        for (int i = 0; i < 16; ++i) { na[i] = 127 - (int)(a[i] & 127u); nb[i] = 127 - (int)(b[i] & 127u); va[i] = s0[na[i]]; vb[i] = s0[128 + nb[i]]; }
        u32 tk[16];
#pragma unroll
        for (int i = 0; i < 16; ++i) tk[i] = 0u;
#pragma unroll
        for (int i = 0; i < 16; ++i)
#pragma unroll
            for (int j = 0; j < 16; ++j) if ((i + 1) * (j + 1) <= 16) ins16(tk, (ordf(va[i] + vb[j]) & ~255u) | (u32)(255 - (i * 16 + j)));
        float ts[16]; int te[16];
#pragma unroll
        for (int r = 0; r < 16; ++r) { const int flat = 255 - (int)(tk[r] & 255u), i = flat >> 4, j = flat & 15; float x = 0.f, y = 0.f; int ni = 0, nj = 0;
#pragma unroll
            for (int q = 0; q < 16; ++q) { if (i == q) { x = va[q]; ni = na[q]; } if (j == q) { y = vb[q]; nj = nb[q]; } }
            ts[r] = x + y; te[r] = ni * 128 + nj; }
        float mx = ts[0];
#pragma unroll
        for (int r = 1; r < 16; ++r) mx = fmaxf(mx, ts[r]);
        float sum = 0.f, ex[16];
#pragma unroll
        for (int r = 0; r < 16; ++r) { ex[r] = __expf(ts[r] - mx); sum += ex[r]; }
        const float inv = 1.0f / sum;
#pragma unroll
        for (int r = 0; r < 16; ++r) { eidx[(size_t)it * 16 + r] = te[r]; gate[(size_t)it * 16 + r] = ex[r] * inv; }
    }
}
__device__ void st_cvt_uv(const Params& p) {
    const int tid = threadIdx.x; bf16_t* u16 = (bf16_t*)(p.ws + WS_U16); bf16_t* v16 = (bf16_t*)(p.ws + WS_V16);
    const size_t n4 = (size_t)16384 * 1024 / 4;
    for (size_t i = (size_t)blockIdx.x * NTHR + tid; i < n4; i += (size_t)gridDim.x * NTHR) {
        const float4 a = ((const float4*)p.pu)[i], b = ((const float4*)p.pv)[i];
        uint2 o; o.x = pk2(a.x, a.y); o.y = pk2(a.z, a.w); ((uint2*)u16)[i] = o; o.x = pk2(b.x, b.y); o.y = pk2(b.z, b.w); ((uint2*)v16)[i] = o; }
}
__device__ void st_expert(const Params& p, unsigned char* lds) {
    const int tid = threadIdx.x, lane = tid & 63, w = tid >> 6;
    const bf16_t* h2 = (const bf16_t*)(p.ws + WS_H2); const bf16_t* u16 = (const bf16_t*)(p.ws + WS_U16); const bf16_t* v16 = (const bf16_t*)(p.ws + WS_V16);
    const int* eidx = (const int*)(p.ws + WS_EIDX); const float* gate = (const float*)(p.ws + WS_GATE); const float* mod = (const float*)(p.ws + WS_MOD);
    float* wl = (float*)lds + w * 128;
    for (int t = blockIdx.x * 8 + w; t < T; t += gridDim.x * 8) {
        float xv[16]; { const uint4 a = *(const uint4*)(h2 + (size_t)t * D + lane * 16), b = *(const uint4*)(h2 + (size_t)t * D + lane * 16 + 8);
            xv[0] = bflo(a.x); xv[1] = bfhi(a.x); xv[2] = bflo(a.y); xv[3] = bfhi(a.y); xv[4] = bflo(a.z); xv[5] = bfhi(a.z); xv[6] = bflo(a.w); xv[7] = bfhi(a.w);
            xv[8] = bflo(b.x); xv[9] = bfhi(b.x); xv[10] = bflo(b.y); xv[11] = bfhi(b.y); xv[12] = bflo(b.z); xv[13] = bfhi(b.z); xv[14] = bflo(b.w); xv[15] = bfhi(b.w); }
        const int e0 = eidx[(size_t)t * 128 + lane], e1 = eidx[(size_t)t * 128 + 64 + lane];
        const float g0 = gate[(size_t)t * 128 + lane], g1 = gate[(size_t)t * 128 + 64 + lane];
        for (int k = 0; k < 128; ++k) { const int e = __shfl(k < 64 ? e0 : e1, k & 63);
            const bf16_t* ur = u16 + (size_t)e * D + lane * 16; const uint4 a = *(const uint4*)ur, b = *(const uint4*)(ur + 8);
            float s = xv[0] * bflo(a.x) + xv[1] * bfhi(a.x) + xv[2] * bflo(a.y) + xv[3] * bfhi(a.y) + xv[4] * bflo(a.z) + xv[5] * bfhi(a.z) + xv[6] * bflo(a.w) + xv[7] * bfhi(a.w)
                    + xv[8] * bflo(b.x) + xv[9] * bfhi(b.x) + xv[10] * bflo(b.y) + xv[11] * bfhi(b.y) + xv[12] * bflo(b.z) + xv[13] * bfhi(b.z) + xv[14] * bflo(b.w) + xv[15] * bfhi(b.w);
            s = wave_sum(s);
            if (lane == (k & 63)) { const float gg = k < 64 ? g0 : g1; wl[k] = gg * gelu_erf(s); } }
        __builtin_amdgcn_s_waitcnt(0);
        float acc[16];
#pragma unroll
        for (int i = 0; i < 16; ++i) acc[i] = 0.f;
        for (int k = 0; k < 128; ++k) { const int e = __shfl(k < 64 ? e0 : e1, k & 63); const float wk = wl[k];
            const bf16_t* vr = v16 + (size_t)e * D + lane * 16; const uint4 a = *(const uint4*)vr, b = *(const uint4*)(vr + 8);
            acc[0] += wk * bflo(a.x); acc[1] += wk * bfhi(a.x); acc[2] += wk * bflo(a.y); acc[3] += wk * bfhi(a.y); acc[4] += wk * bflo(a.z); acc[5] += wk * bfhi(a.z); acc[6] += wk * bflo(a.w); acc[7] += wk * bfhi(a.w);
            acc[8] += wk * bflo(b.x); acc[9] += wk * bfhi(b.x); acc[10] += wk * bflo(b.y); acc[11] += wk * bfhi(b.y); acc[12] += wk * bflo(b.z); acc[13] += wk * bfhi(b.z); acc[14] += wk * bflo(b.w); acc[15] += wk * bfhi(b.w); }
        const float* g2 = mod + (t >> 11) * 6144 + 5120 + lane * 16; float* xr = p.out + (size_t)t * D + lane * 16; float ss = 0.f;
#pragma unroll
        for (int i = 0; i < 16; ++i) { acc[i] = xr[i] + g2[i] * acc[i]; ss += acc[i] * acc[i]; }
        const float r = rsqrtf(wave_sum(ss) * (1.0f / D) + EPS);
#pragma unroll
        for (int i = 0; i < 16; ++i) xr[i] = acc[i] * r * p.final_g[lane * 16 + i];
    }
}

template <int ST> __global__ void __launch_bounds__(NTHR) k_stage(Params p) {
    extern __shared__ __attribute__((aligned(16))) unsigned char smem[];
    if (ST == 0) st_adaln(p, smem);
    if (ST == 1) st_norm_rows(p, 0);
    if (ST == 2) st_z_naive(p);
    if (ST == 3) st_prep_a_naive(p);
    if (ST == 4) st_prep_b_naive(p);
    if (ST == 5) st_nsa_naive(p, smem);
    if (ST == 6) st_dsa_naive(p, smem);
    if (ST == 7) st_merge_naive(p);
    if (ST == 8) st_out_naive(p);
    if (ST == 9) st_norm_rows(p, 1);
    if (ST == 10) st_peerq_naive(p);
    if (ST == 11) st_ssub_naive(p);
    if (ST == 12) st_route(p);
    if (ST == 13) st_cvt_uv(p);
    if (ST == 14) st_expert(p, smem);
}

extern "C" void kernel_launch(void* const* d_in, const int* in_sizes, int n_in, void* d_out, int out_size, void* d_ws, size_t ws_size, hipStream_t stream) {
    Params p{};
    const float** f = (const float**)&p;
    for (int i = 0; i < 23; ++i) f[i] = (const float*)d_in[i];
    p.out = (float*)d_out; p.ws = (unsigned char*)d_ws;
    const int G = 1024; const size_t L = 49152;
#define LAUNCH(ST) hipLaunchKernelGGL(k_stage<ST>, dim3(G), dim3(NTHR), L, stream, p)
    LAUNCH(0); LAUNCH(1); LAUNCH(2); LAUNCH(3); LAUNCH(4); LAUNCH(5); LAUNCH(6); LAUNCH(7); LAUNCH(8); LAUNCH(9); LAUNCH(10); LAUNCH(11); LAUNCH(12); LAUNCH(13); LAUNCH(14);
}
```

```cpp
#include <hip/hip_runtime.h>
#include <stdint.h>
#include <stdio.h>

#define LAS __attribute__((address_space(3)))
typedef unsigned short bf16_t;
typedef unsigned int u32;

constexpr int T = 16384, SEQ = 2048, NB = 8, D = 1024, NZ = 4608, DIN = 4576;
constexpr int NTHR = 512;
constexpr float EPS = 1e-6f;
constexpr int ZC_QN = 0, ZC_KC = 512, ZC_VC = 640, ZC_KS = 768, ZC_VS = 896, ZC_KW = 1024, ZC_VW = 1152, ZC_QD = 1280, ZC_CKV = 1792,
              ZC_QI = 1920, ZC_KI = 2432, ZC_GN = 2496, ZC_WI = 2520, ZC_GM = 2560;
constexpr unsigned long long ROPE_MASK = 0xFFull | (3ull << 8) | (3ull << 12) | (3ull << 16) | (0xFFull << 20) | (0xFFull << 30) | (1ull << 38);
constexpr unsigned long long SCALE_MASK = 0xFFull | (0xFFull << 20) | (0xFFull << 30);

constexpr size_t WS_Z = 0;
constexpr size_t WS_SSUB = 0;
constexpr size_t WS_EIDX = 134217728;
constexpr size_t WS_GATE = 142606336;
constexpr size_t WS_MERGED = 150994944;
constexpr size_t WS_U16 = WS_MERGED;
constexpr size_t WS_HB = 184549376;
constexpr size_t WS_ONSA = WS_HB;
constexpr size_t WS_ODSA = WS_HB + 16777216;
constexpr size_t WS_V16 = WS_HB;
constexpr size_t WS_H2 = 218103808;
constexpr size_t WS_W = 251658240;
constexpr size_t WS_WINT = WS_W;
constexpr size_t WS_WNSAT = WS_WINT + 9437184;
constexpr size_t WS_WDSAT = WS_WNSAT + 1048576;
constexpr size_t WS_WOUTT = WS_WDSAT + 1048576;
constexpr size_t WS_SMALL = WS_WOUTT + 2097152;
constexpr size_t WS_MOD = WS_SMALL;
constexpr size_t WS_COS = WS_MOD + 196608;
constexpr size_t WS_SIN = WS_COS + 262144;
constexpr size_t WS_BAR = WS_SIN + 262144;
constexpr size_t WS_END_SMALL = WS_BAR + 16384;
static_assert(WS_END_SMALL <= 268435456, "ws overflow");
constexpr size_t DO_KD = 0;
constexpr size_t DO_VDT = 2097152;
constexpr size_t DO_VST = 4194304;
constexpr size_t DO_VWT = 8388608;
constexpr size_t DO_KCMP = 12582912;
constexpr size_t DO_VCMPT = 12845056;
constexpr size_t DO_HID = 13107200;
constexpr size_t DO_MASK = 14680064;
constexpr size_t DO_END = DO_MASK + 4194304;

struct Params {
    const float *x, *c, *ada_w, *ada_b, *norm1_g, *w_in, *cmp_pos, *w1k, *w2k, *w1v, *w2v, *kvg, *w_uk, *w_uv, *w_nsa, *w_dsa, *w_out, *norm2_g, *wq,
        *subkeys, *pu, *pv, *final_g;
    float* out;
    unsigned char* ws;
};

__device__ __forceinline__ bf16_t f2bf(float f) { u32 u = __float_as_uint(f); u += 0x7fffu + ((u >> 16) & 1u); return (bf16_t)(u >> 16); }
__device__ __forceinline__ float bf2f(bf16_t h) { return __uint_as_float((u32)h << 16); }
__device__ __forceinline__ float bflo(u32 w) { return __uint_as_float(w << 16); }
__device__ __forceinline__ float bfhi(u32 w) { return __uint_as_float(w & 0xffff0000u); }
__device__ __forceinline__ u32 pk2(float lo, float hi) { return (u32)f2bf(lo) | ((u32)f2bf(hi) << 16); }
__device__ __forceinline__ float wave_sum(float v) {
#pragma unroll
    for (int o = 1; o < 64; o <<= 1) v += __shfl_xor(v, o);
    return v;
}
__device__ __forceinline__ float wave_max(float v) {
#pragma unroll
    for (int o = 1; o < 64; o <<= 1) v = fmaxf(v, __shfl_xor(v, o));
    return v;
}
__device__ __forceinline__ float sigmoidf_(float v) { return 1.0f / (1.0f + __expf(-v)); }
__device__ __forceinline__ float gelu_tanh(float v) { const float u = 0.7978845608028654f * (v + 0.044715f * v * v * v); return 0.5f * v * (1.0f + tanhf(u)); }
__device__ __forceinline__ float gelu_erf(float v) { return 0.5f * v * (1.0f + erff(v * 0.7071067811865476f)); }
__device__ __forceinline__ int z_logical_col(int pc) {
    const int g64 = pc >> 6; const int o = pc & 63;
    const int po = (g64 < 64 && ((ROPE_MASK >> g64) & 1ull)) ? ((o >> 1) + 32 * (o & 1)) : o;
    const int pp = (pc & ~63) + po;
    if (pc < 1280) return pp;
    if (pc < 1792) return 1304 + (pp - 1280);
    if (pc < 1920) return 1816 + (pp - 1792);
    if (pc < 2432) return 1944 + (pp - 1920);
    if (pc < 2496) return 2456 + (pp - 2432);
    if (pc < 2520) return 1280 + (pc - 2496);
    if (pc < 2528) return 2520 + (pc - 2520);
    if (pc < 2560) return -1;
    return 2528 + (pc - 2560);
}
__device__ __forceinline__ void z_post(int t, int pc, float& v0, float& v1, const float* cosT, const float* sinT) {
    const int g64 = pc >> 6;
    if (g64 < 64 && ((ROPE_MASK >> g64) & 1ull)) {
        const int i = (pc & 63) >> 1, pos = t & (SEQ - 1);
        const float c = cosT[pos * 32 + i], s = sinT[pos * 32 + i];
        const float a = v0 * c - v1 * s, b = v1 * c + v0 * s;
        const float sc = ((SCALE_MASK >> g64) & 1ull) ? 0.125f : 1.0f;
        v0 = a * sc; v1 = b * sc;
    } else if (pc >= ZC_GM || (pc >= ZC_GN && pc < ZC_WI)) { v0 = sigmoidf_(v0); v1 = sigmoidf_(v1); }
}
__device__ __forceinline__ void sincos_tab(float ang, float& s, float& c) {
    const double a = (double)ang; const double k = rint(a * 0.63661977236758134308);
    const float r = (float)(a - k * 1.57079632679489661923); const float z = r * r;
    const float sp = ((-1.9515295891e-4f * z + 8.3321608736e-3f) * z - 1.6666654611e-1f) * z * r + r;
    const float cp = ((2.443315711809948e-5f * z - 1.388731625493765e-3f) * z + 4.166664568298827e-2f) * z * z - 0.5f * z + 1.0f;
    const int q = ((int)k) & 3;
    s = (q == 0) ? sp : (q == 1) ? cp : (q == 2) ? -sp : -cp;
    c = (q == 0) ? cp : (q == 1) ? -sp : (q == 2) ? -cp : sp;
}

__device__ void st_adaln(const Params& p, unsigned char* lds) {
    const int tid = threadIdx.x, lane = tid & 63, w = tid >> 6;
    float* cosT = (float*)(p.ws + WS_COS); float* sinT = (float*)(p.ws + WS_SIN);
    for (int i = blockIdx.x * NTHR + tid; i < SEQ * 32; i += gridDim.x * NTHR) {
        const int pos = i >> 5, f = i & 31; const float inv = powf(10000.0f, -(float)f / 32.0f);
        float s, c; sincos_tab((float)pos * inv, s, c); cosT[i] = c; sinT[i] = s;
    }
    float* sc = (float*)lds;
    float* red = sc + 8192;
    for (int i = tid; i < 8192; i += NTHR) { const float v = p.c[i]; sc[i] = v / (1.0f + __expf(-v)); }
    __syncthreads();
    float* mod = (float*)(p.ws + WS_MOD);
    for (int unit = blockIdx.x; unit < 192; unit += gridDim.x) {
        float acc[8];
#pragma unroll
        for (int b = 0; b < 8; ++b) acc[b] = 0.f;
        const int col = unit * 32 + (lane & 31), ks = lane >> 5;
        for (int kk = 0; kk < 64; ++kk) {
            const int k = w * 128 + kk * 2 + ks; const float wv = p.ada_w[(size_t)k * 6144 + col];
#pragma unroll
            for (int b = 0; b < 8; ++b) acc[b] += sc[b * 1024 + k] * wv;
        }
#pragma unroll
        for (int b = 0; b < 8; ++b) red[((w * 2 + ks) * 8 + b) * 32 + (lane & 31)] = acc[b];
        __syncthreads();
        if (tid < 256) { const int b = tid >> 5, c = tid & 31; float s = 0.f;
            for (int j = 0; j < 16; ++j) s += red[(j * 8 + b) * 32 + c];
            mod[b * 6144 + unit * 32 + c] = s + p.ada_b[unit * 32 + c]; }
        __syncthreads();
    }
}
__device__ void st_norm_rows(const Params& p, int which) {
    const int tid = threadIdx.x, lane = tid & 63, w = tid >> 6;
    const float* src = which ? p.out : p.x; const float* g = which ? p.norm2_g : p.norm1_g;
    bf16_t* dst = (bf16_t*)(p.ws + (which ? WS_H2 : WS_HB));
    const float* mod = (const float*)(p.ws + WS_MOD);
    for (int t = blockIdx.x * 8 + w; t < T; t += gridDim.x * 8) {
        const int b = t >> 11; const float* sh = mod + b * 6144 + (which ? 3072 : 0); const float* scl = sh + 1024;
        const float4* xr = (const float4*)(src + (size_t)t * D);
        float4 v[4]; float ss = 0.f;
#pragma unroll
        for (int j = 0; j < 4; ++j) { v[j] = xr[lane + 64 * j]; ss += v[j].x * v[j].x + v[j].y * v[j].y + v[j].z * v[j].z + v[j].w * v[j].w; }
        const float r = rsqrtf(wave_sum(ss) * (1.0f / D) + EPS);
#pragma unroll
        for (int j = 0; j < 4; ++j) { const int d0 = (lane + 64 * j) * 4;
            const float4 gg = *(const float4*)(g + d0), s4 = *(const float4*)(scl + d0), h4 = *(const float4*)(sh + d0);
            const float o0 = v[j].x * r * gg.x * (1.f + s4.x) + h4.x, o1 = v[j].y * r * gg.y * (1.f + s4.y) + h4.y;
            const float o2 = v[j].z * r * gg.z * (1.f + s4.z) + h4.z, o3 = v[j].w * r * gg.w * (1.f + s4.w) + h4.w;
            uint2 o; o.x = pk2(o0, o1); o.y = pk2(o2, o3); *(uint2*)(dst + (size_t)t * D + d0) = o; }
    }
}
__device__ __forceinline__ void naive_dot8(const bf16_t* A, int lda, const float* W, int ldw, int K, int t0, int col, float (&acc)[8]) {
#pragma unroll
    for (int i = 0; i < 8; ++i) acc[i] = 0.f;
    for (int k = 0; k < K; k += 2) {
        const float w0 = W[(size_t)k * ldw + col], w1 = W[(size_t)(k + 1) * ldw + col];
#pragma unroll
        for (int i = 0; i < 8; ++i) { const u32 a = *(const u32*)(A + (size_t)(t0 + i) * lda + k); acc[i] += bflo(a) * w0 + bfhi(a) * w1; }
    }
}
__device__ void st_z_naive(const Params& p) {
    const int tid = threadIdx.x; const bf16_t* hb = (const bf16_t*)(p.ws + WS_HB); bf16_t* Z = (bf16_t*)(p.ws + WS_Z);
    const float* cosT = (const float*)(p.ws + WS_COS); const float* sinT = (const float*)(p.ws + WS_SIN);
    const int nitems = (T / 8) * 9;
    for (int it = blockIdx.x * 2 + (tid >> 8); it < nitems; it += gridDim.x * 2) {
        const int tt = it / 9, ch = it % 9; const int t0 = tt * 8; const int pc = (ch * 256 + (tid & 255)) * 2;
        const int l0 = z_logical_col(pc), l1 = z_logical_col(pc + 1);
        float a0[8], a1[8];
        if (l0 >= 0) { naive_dot8(hb, D, p.w_in, DIN, D, t0, l0, a0); naive_dot8(hb, D, p.w_in, DIN, D, t0, l1, a1); }
        else {
#pragma unroll
            for (int i = 0; i < 8; ++i) { a0[i] = 0.f; a1[i] = 0.f; } }
#pragma unroll
        for (int i = 0; i < 8; ++i) { float v0 = a0[i], v1 = a1[i]; z_post(t0 + i, pc, v0, v1, cosT, sinT); *(u32*)(Z + (size_t)(t0 + i) * NZ + pc) = pk2(v0, v1); }
    }
}
__device__ void st_prep_a_naive(const Params& p) {
    const int tid = threadIdx.x; const bf16_t* Z = (const bf16_t*)(p.ws + WS_Z);
    const float* cosT = (const float*)(p.ws + WS_COS); const float* sinT = (const float*)(p.ws + WS_SIN);
    unsigned char* dob = (unsigned char*)p.out;
    bf16_t* kd = (bf16_t*)(dob + DO_KD); bf16_t* vdT = (bf16_t*)(dob + DO_VDT); bf16_t* vsT = (bf16_t*)(dob + DO_VST); bf16_t* vwT = (bf16_t*)(dob + DO_VWT);
    float* hid = (float*)(dob + DO_HID);
    for (int it = blockIdx.x * NTHR + tid; it < T * 32; it += gridDim.x * NTHR) {
        const int t = it >> 5, i = it & 31; const bf16_t* cr = Z + (size_t)t * NZ + ZC_CKV;
        float ss = 0.f; for (int r = 0; r < 128; ++r) { const float v = bf2f(cr[r]); ss += v * v; }
        const float rn = rsqrtf(ss * (1.0f / 128.0f) + EPS);
        float k1 = 0.f, k2 = 0.f, v1 = 0.f, v2 = 0.f;
        for (int r = 0; r < 128; ++r) { const float cn = bf2f(cr[r]) * rn * p.kvg[r];
            k1 += cn * p.w_uk[r * 64 + i]; k2 += cn * p.w_uk[r * 64 + i + 32]; v1 += cn * p.w_uv[r * 64 + i]; v2 += cn * p.w_uv[r * 64 + i + 32]; }
        const int pos = t & (SEQ - 1), b = t >> 11; const float c = cosT[pos * 32 + i], s = sinT[pos * 32 + i];
        *(u32*)(kd + (size_t)t * 64 + 2 * i) = pk2(k1 * c - k2 * s, k2 * c + k1 * s);
        vdT[((size_t)b * 64 + i) * SEQ + pos] = f2bf(v1); vdT[((size_t)b * 64 + i + 32) * SEQ + pos] = f2bf(v2);
    }
    for (int it = blockIdx.x * NTHR + tid; it < T * 128; it += gridDim.x * NTHR) {
        const int t = it >> 7, gd = it & 127, b = t >> 11, pos = t & (SEQ - 1);
        vsT[((size_t)b * 128 + gd) * SEQ + pos] = Z[(size_t)t * NZ + ZC_VS + gd];
        vwT[((size_t)b * 128 + gd) * SEQ + pos] = Z[(size_t)t * NZ + ZC_VW + gd];
    }
    for (int it = blockIdx.x * NTHR + tid; it < 2 * 8 * 2 * 128 * 64; it += gridDim.x * NTHR) {
        const int e = it & 63, n = (it >> 6) & 127, g = (it >> 13) & 1, b = (it >> 14) & 7, kv = it >> 17;
        float acc = 0.f;
        if (n < 127) {
            const float* w1 = kv ? p.w1v : p.w1k;
            for (int l = 0; l < 32; ++l) { const bf16_t* xr = Z + (size_t)(b * SEQ + 16 * n + l) * NZ + (kv ? ZC_VC : ZC_KC) + g * 64;
                for (int d = 0; d < 64; ++d) { const int pd = kv ? d : (2 * (d & 31) + (d >> 5));
                    acc += (bf2f(xr[pd]) + p.cmp_pos[l * 64 + d]) * w1[(l * 64 + d) * 64 + e]; } }
            acc = gelu_tanh(acc);
        }
        hid[it] = acc;
    }
}
__device__ void st_prep_b_naive(const Params& p) {
    const int tid = threadIdx.x; unsigned char* dob = (unsigned char*)p.out;
    const float* hid = (const float*)(dob + DO_HID); bf16_t* kcmp = (bf16_t*)(dob + DO_KCMP); bf16_t* vcmpT = (bf16_t*)(dob + DO_VCMPT);
    for (int it = blockIdx.x * NTHR + tid; it < 2 * 8 * 2 * 128 * 64; it += gridDim.x * NTHR) {
        const int f = it & 63, n = (it >> 6) & 127, g = (it >> 13) & 1, b = (it >> 14) & 7, kv = it >> 17;
        const float* w2 = kv ? p.w2v : p.w2k; const float* h = hid + (size_t)(it & ~63);
        float acc = 0.f;
        if (n < 127) for (int e = 0; e < 64; ++e) acc += h[e] * w2[e * 64 + f];
        if (kv == 0) kcmp[(((size_t)b * 2 + g) * 128 + n) * 64 + (2 * (f & 31) + (f >> 5))] = f2bf(acc);
        else vcmpT[(((size_t)b * 2 + g) * 64 + f) * 128 + n] = f2bf(acc);
    }
}
__device__ __forceinline__ float dot64(const float* q, const bf16_t* kr) {
    float s = 0.f;
#pragma unroll
    for (int j = 0; j < 8; ++j) { const uint4 v = *(const uint4*)(kr + 8 * j); const float* qq = q + 8 * j;
        s += qq[0] * bflo(v.x) + qq[1] * bfhi(v.x) + qq[2] * bflo(v.y) + qq[3] * bfhi(v.y) + qq[4] * bflo(v.z) + qq[5] * bfhi(v.z) + qq[6] * bflo(v.w) + qq[7] * bfhi(v.w); }
    return s;
}
__device__ void st_nsa_naive(const Params& p, unsigned char* lds) {
    const int tid = threadIdx.x, lane = tid & 63, h = tid >> 6, g = h >> 2;
    const bf16_t* Z = (const bf16_t*)(p.ws + WS_Z); unsigned char* dob = (unsigned char*)p.out;
    const bf16_t* kcmp = (const bf16_t*)(dob + DO_KCMP); const bf16_t* vcmpT = (const bf16_t*)(dob + DO_VCMPT);
    bf16_t* onsa = (bf16_t*)(p.ws + WS_ONSA);
    float* qs = (float*)lds;
    float* pc = qs + 512;
    float* vals = pc + 1024;
    u32* selm = (u32*)(vals + 64);
    for (int t = blockIdx.x; t < T; t += gridDim.x) {
        const int b = t >> 11, pos = t & (SEQ - 1); const bf16_t* zr = Z + (size_t)t * NZ;
        __syncthreads();
        qs[h * 64 + lane] = bf2f(zr[ZC_QN + h * 64 + lane]);
        __syncthreads();
        const float* q = qs + h * 64;
        float sc[2]; float m = -1e30f;
#pragma unroll
        for (int c2 = 0; c2 < 2; ++c2) { const int n = c2 * 64 + lane; const bool valid = (n < 127) && (16 * n + 31 <= pos);
            const float s = dot64(q, kcmp + (((size_t)b * 2 + g) * 128 + n) * 64); sc[c2] = valid ? s : -1e30f; m = fmaxf(m, sc[c2]); }
        m = wave_max(m); float l = 0.f;
#pragma unroll
        for (int c2 = 0; c2 < 2; ++c2) { const int n = c2 * 64 + lane; const bool valid = (n < 127) && (16 * n + 31 <= pos); sc[c2] = valid ? __expf(sc[c2] - m) : 0.f; l += sc[c2]; }
        l = wave_sum(l); const float il = 1.0f / fmaxf(l, 1e-30f);
        pc[h * 128 + lane] = sc[0] * il; pc[h * 128 + 64 + lane] = sc[1] * il;
        __syncthreads();
        float ocmp = 0.f; { const bf16_t* vr = vcmpT + (((size_t)b * 2 + g) * 64 + lane) * 128; const float* pp = pc + h * 128;
            for (int n = 0; n < 128; ++n) ocmp += pp[n] * bf2f(vr[n]); }
        if (tid < 64) { const int gg = tid >> 5, j = tid & 31; const float* p0 = pc + gg * 512;
            auto imp = [&](int n) -> float { return (n < 0 || n > 126) ? 0.f : (p0[n] + p0[128 + n] + p0[256 + n] + p0[384 + n]); };
            const float bl = imp(4 * j - 1) + 2.f * imp(4 * j) + 2.f * imp(4 * j + 1) + 2.f * imp(4 * j + 2) + imp(4 * j + 3);
            const int cur = pos >> 6; const bool forced = (j == 0) || (j == cur) || (j == cur - 1); const bool adm = (j * 64 <= pos);
            vals[tid] = forced ? __builtin_inff() : (adm ? bl : -__builtin_inff()); }
        __syncthreads();
        if (tid < 64) { const int gg = tid >> 5, j = tid & 31; const float v = vals[tid]; int rank = 0;
            for (int j2 = 0; j2 < 32; ++j2) { const float v2 = vals[gg * 32 + j2]; rank += (v2 > v || (v2 == v && j2 < j)) ? 1 : 0; }
            const unsigned long long bal = __ballot(rank < 16);
            if (tid == 0) { selm[0] = (u32)bal; selm[1] = (u32)(bal >> 32); } }
        __syncthreads();
        const u32 sel = selm[g];
        float ms = -1e30f, ls = 0.f, os = 0.f;
        for (int j = 0; j * 64 <= pos; ++j) { if (!((sel >> j) & 1u)) continue;
            const int kp = j * 64 + lane; const bool valid = kp <= pos;
            float s = dot64(q, Z + (size_t)(b * SEQ + kp) * NZ + ZC_KS + g * 64); s = valid ? s : -1e30f;
            const float mn = fmaxf(ms, wave_max(s)); const float al = __expf(ms - mn); const float pr = valid ? __expf(s - mn) : 0.f;
            ls = ls * al + wave_sum(pr); os *= al; ms = mn;
            for (int k = 0; k < 64; ++k) { const float pk = __shfl(pr, k); os += pk * bf2f(Z[(size_t)(b * SEQ + j * 64 + k) * NZ + ZC_VS + g * 64 + lane]); } }
        os = os / fmaxf(ls, 1e-30f);
        float mw = -1e30f, lw = 0.f, ow = 0.f;
        for (int c2 = 0; c2 < 8; ++c2) { const int kp = pos - 511 + c2 * 64 + lane; const bool valid = kp >= 0; if (pos - 511 + c2 * 64 + 63 < 0) continue;
            float s = valid ? dot64(q, Z + (size_t)(b * SEQ + kp) * NZ + ZC_KW + g * 64) : -1e30f;
            const float mn = fmaxf(mw, wave_max(s)); const float al = __expf(mw - mn); const float pr = valid ? __expf(s - mn) : 0.f;
            lw = lw * al + wave_sum(pr); ow *= al; mw = mn;
            for (int k = 0; k < 64; ++k) { const float pk = __shfl(pr, k); const int kk = pos - 511 + c2 * 64 + k;
                if (kk >= 0) ow += pk * bf2f(Z[(size_t)(b * SEQ + kk) * NZ + ZC_VW + g * 64 + lane]); } }
        ow = ow / fmaxf(lw, 1e-30f);
        const float gc = bf2f(zr[ZC_GN + h * 3 + 0]), gs = bf2f(zr[ZC_GN + h * 3 + 1]), gw = bf2f(zr[ZC_GN + h * 3 + 2]);
        onsa[(size_t)t * 512 + h * 64 + lane] = f2bf(gc * ocmp + gs * os + gw * ow);
    }
}
__device__ void st_dsa_naive(const Params& p, unsigned char* lds) {
    const int tid = threadIdx.x, lane = tid & 63, h = tid >> 6;
    const bf16_t* Z = (const bf16_t*)(p.ws + WS_Z); unsigned char* dob = (unsigned char*)p.out;
    const bf16_t* kd = (const bf16_t*)(dob + DO_KD); const bf16_t* vdT = (const bf16_t*)(dob + DO_VDT); u32* maskg = (u32*)(dob + DO_MASK);
    bf16_t* odsa = (bf16_t*)(p.ws + WS_ODSA);
    float* qi = (float*)lds;
    float* qd = qi + 512;
    float* wv = qd + 512;
    float* scv = wv + 8;
    u32* mk = (u32*)(scv + 2048);
    for (int t = blockIdx.x; t < T; t += gridDim.x) {
        const int b = t >> 11, pos = t & (SEQ - 1); const bf16_t* zr = Z + (size_t)t * NZ;
        __syncthreads();
        qi[tid] = bf2f(zr[ZC_QI + tid]); qd[tid] = bf2f(zr[ZC_QD + tid]);
        if (tid < 8) wv[tid] = bf2f(zr[ZC_WI + tid]) * 0.35355339059327373f;
        __syncthreads();
        for (int i = 0; i < 4; ++i) { const int k = tid + 512 * i; float s = -__builtin_inff();
            if (k <= pos) { s = 0.f; const bf16_t* kr = Z + (size_t)(b * SEQ + k) * NZ + ZC_KI;
                for (int hh = 0; hh < 8; ++hh) { const float lg = dot64(qi + hh * 64, kr); s = fmaf(wv[hh], fmaxf(lg, 0.f), s); } }
            scv[k] = s; }
        __syncthreads();
        for (int i = 0; i < 4; ++i) { const int k = tid + 512 * i; bool selb = false;
            if (k <= pos) { if (pos < 256) selb = true; else { const float v = scv[k]; int rank = 0;
                    for (int j = 0; j <= pos; ++j) { const float v2 = scv[j]; rank += (v2 > v || (v2 == v && j < k)) ? 1 : 0; } selb = rank < 256; } }
            const unsigned long long bal = __ballot(selb);
            if (lane == 0) { const int wi = 16 * i + 2 * h; mk[wi] = (u32)bal; mk[wi + 1] = (u32)(bal >> 32); } }
        __syncthreads();
        if (tid < 64) maskg[(size_t)t * 64 + tid] = mk[tid];
        float m = -1e30f, l = 0.f, o = 0.f; const float* q = qd + h * 64;
        for (int c2 = 0; c2 * 64 <= pos; ++c2) { const int kp = c2 * 64 + lane; const bool valid = (mk[kp >> 5] >> (kp & 31)) & 1u;
            if (__ballot(valid) == 0ull) continue;
            float s = valid ? dot64(q, kd + (size_t)(b * SEQ + kp) * 64) : -1e30f;
            const float mn = fmaxf(m, wave_max(s)); const float al = __expf(m - mn); const float pr = valid ? __expf(s - mn) : 0.f;
            l = l * al + wave_sum(pr); o *= al; m = mn;
            const bf16_t* vr = vdT + ((size_t)b * 64 + lane) * SEQ + c2 * 64;
            for (int k = 0; k < 64; ++k) { const float pk = __shfl(pr, k); o += pk * bf2f(vr[k]); } }
        odsa[(size_t)t * 512 + h * 64 + lane] = f2bf(o / fmaxf(l, 1e-30f));
    }
}
__device__ void st_merge_naive(const Params& p) {
    const int tid = threadIdx.x; const bf16_t* Z = (const bf16_t*)(p.ws + WS_Z);
    const bf16_t* onsa = (const bf16_t*)(p.ws + WS_ONSA); const bf16_t* odsa = (const bf16_t*)(p.ws + WS_ODSA); bf16_t* mg = (bf16_t*)(p.ws + WS_MERGED);
    for (int it = blockIdx.x; it < (T / 8) * 2; it += gridDim.x) { const int t0 = (it >> 1) * 8, n = (it & 1) * 512 + tid;
        float a[8], d[8]; naive_dot8(onsa, 512, p.w_nsa, D, 512, t0, n, a); naive_dot8(odsa, 512, p.w_dsa, D, 512, t0, n, d);
#pragma unroll
        for (int i = 0; i < 8; ++i) { const float g1 = bf2f(Z[(size_t)(t0 + i) * NZ + ZC_GM + n]), g2 = bf2f(Z[(size_t)(t0 + i) * NZ + ZC_GM + 1024 + n]);
            mg[(size_t)(t0 + i) * D + n] = f2bf(g1 * a[i] + g2 * d[i]); } }
}
__device__ void st_out_naive(const Params& p) {
    const int tid = threadIdx.x; const bf16_t* mg = (const bf16_t*)(p.ws + WS_MERGED); const float* mod = (const float*)(p.ws + WS_MOD);
    for (int it = blockIdx.x; it < (T / 8) * 2; it += gridDim.x) { const int t0 = (it >> 1) * 8, n = (it & 1) * 512 + tid;
        float a[8]; naive_dot8(mg, D, p.w_out, D, D, t0, n, a); const float g1 = mod[(t0 >> 11) * 6144 + 2048 + n];
#pragma unroll
        for (int i = 0; i < 8; ++i) p.out[(size_t)(t0 + i) * D + n] = p.x[(size_t)(t0 + i) * D + n] + g1 * a[i]; }
}
__device__ void st_peerq_naive(const Params& p) {
    const int tid = threadIdx.x; const bf16_t* h2 = (const bf16_t*)(p.ws + WS_H2); bf16_t* q = (bf16_t*)(p.ws + WS_MERGED);
    for (int it = blockIdx.x; it < (T / 8) * 2; it += gridDim.x) { const int t0 = (it >> 1) * 8, n = (it & 1) * 512 + tid;
        float a[8]; naive_dot8(h2, D, p.wq, D, D, t0, n, a);
#pragma unroll
        for (int i = 0; i < 8; ++i) q[(size_t)(t0 + i) * D + n] = f2bf(a[i]); }
}
__device__ void st_ssub_naive(const Params& p) {
    const int tid = threadIdx.x; const bf16_t* q = (const bf16_t*)(p.ws + WS_MERGED); float* ss = (float*)(p.ws + WS_SSUB);
    for (size_t it = (size_t)blockIdx.x * NTHR + tid; it < (size_t)T * 2048; it += (size_t)gridDim.x * NTHR) {
        const int t = (int)(it >> 11), col = (int)(it & 2047), hc = col >> 7, n = col & 127;
        const bf16_t* qr = q + (size_t)t * D + hc * 64; const float* sk = p.subkeys + ((size_t)hc * 128 + n) * 64;
        float acc = 0.f; for (int d = 0; d < 64; ++d) acc += bf2f(qr[d]) * sk[d];
        ss[it] = acc; }
}
__device__ __forceinline__ u32 ordf(float f) { const u32 u = __float_as_uint(f); return (u & 0x80000000u) ? ~u : (u | 0x80000000u); }
__device__ __forceinline__ void ins16(u32 (&s)[16], u32 key) {
#pragma unroll
    for (int i = 0; i < 16; ++i) { const u32 mx = s[i] > key ? s[i] : key; key = s[i] > key ? key : s[i]; s[i] = mx; }
}
__device__ void st_route(const Params& p) {
    const int tid = threadIdx.x; const float* ss = (const float*)(p.ws + WS_SSUB); int* eidx = (int*)(p.ws + WS_EIDX); float* gate = (float*)(p.ws + WS_GATE);
    for (int it = blockIdx.x * NTHR + tid; it < T * 8; it += gridDim.x * NTHR) {
        const float* s0 = ss + (size_t)it * 256;
        u32 a[16], b[16];
#pragma unroll
        for (int i = 0; i < 16; ++i) { a[i] = 0u; b[i] = 0u; }
        for (int n = 0; n < 128; n += 4) { const float4 x = *(const float4*)(s0 + n), y = *(const float4*)(s0 + 128 + n);
            ins16(a, (ordf(x.x) & ~127u) | (u32)(127 - n)); ins16(a, (ordf(x.y) & ~127u) | (u32)(126 - n)); ins16(a, (ordf(x.z) & ~127u) | (u32)(125 - n)); ins16(a, (ordf(x.w) & ~127u) | (u32)(124 - n));
            ins16(b, (ordf(y.x) & ~127u) | (u32)(127 - n)); ins16(b, (ordf(y.y) & ~127u) | (u32)(126 - n)); ins16(b, (ordf(y.z) & ~127u) | (u32)(125 - n)); ins16(b, (ordf(y.w) & ~127u) | (u32)(124 - n)); }
        float va[16], vb[16]; int na[16], nb[16];
#pragma unroll
        for (int i = 0; i < 16; ++i) { na[i] = 127 - (int)(a[i] & 127u); nb[i] = 127 - (int)(b[i] & 127u); va[i] = s0[na[i]]; vb[i] = s0[128 + nb[i]]; }
        u32 tk[16];
#pragma unroll
        for (int i = 0; i < 16; ++i) tk[i] = 0u;
#pragma unroll
        for (int i = 0; i < 16; ++i)
#pragma unroll
            for (int j = 0; j < 16; ++j) if ((i + 1) * (j + 1) <= 16) ins16(tk, (ordf(va[i] + vb[j]) & ~255u) | (u32)(255 - (i * 16 + j)));
        float ts[16]; int te[16];
#pragma unroll
        for (int r = 0; r < 16; ++r) { const int flat = 255 - (int)(tk[r] & 255u), i = flat >> 4, j = flat & 15; float x = 0.f, y = 0.f; int ni = 0, nj = 0;
#pragma unroll
            for (int q = 0; q < 16; ++q) { if (i == q) { x = va[q]; ni = na[q]; } if (j == q) { y = vb[q]; nj = nb[q]; } }
            ts[r] = x + y; te[r] = ni * 128 + nj; }
        float mx = ts[0];
#pragma unroll
        for (int r = 1; r < 16; ++r) mx = fmaxf(mx, ts[r]);
        float sum = 0.f, ex[16];
#pragma unroll
        for (int r = 0; r < 16; ++r) { ex[r] = __expf(ts[r] - mx); sum += ex[r]; }
        const float inv = 1.0f / sum;
#pragma unroll
        for (int r = 0; r < 16; ++r) { eidx[(size_t)it * 16 + r] = te[r]; gate[(size_t)it * 16 + r] = ex[r] * inv; }
    }
}
__device__ void st_cvt_uv(const Params& p) {
    const int tid = threadIdx.x; bf16_t* u16 = (bf16_t*)(p.ws + WS_U16); bf16_t* v16 = (bf16_t*)(p.ws + WS_V16);
    const size_t n4 = (size_t)16384 * 1024 / 4;
    for (size_t i = (size_t)blockIdx.x * NTHR + tid; i < n4; i += (size_t)gridDim.x * NTHR) {
        const float4 a = ((const float4*)p.pu)[i], b = ((const float4*)p.pv)[i];
        uint2 o; o.x = pk2(a.x, a.y); o.y = pk2(a.z, a.w); ((uint2*)u16)[i] = o; o.x = pk2(b.x, b.y); o.y = pk2(b.z, b.w); ((uint2*)v16)[i] = o; }
}
__device__ void st_expert(const Params& p, unsigned char* lds) {
    const int tid = threadIdx.x, lane = tid & 63, w = tid >> 6;
    const bf16_t* h2 = (const bf16_t*)(p.ws + WS_H2); const bf16_t* u16 = (const bf16_t*)(p.ws + WS_U16); const bf16_t* v16 = (const bf16_t*)(p.ws + WS_V16);
    const int* eidx = (const int*)(p.ws + WS_EIDX); const float* gate = (const float*)(p.ws + WS_GATE); const float* mod = (const float*)(p.ws + WS_MOD);
    float* wl = (float*)lds + w * 128;
    for (int t = blockIdx.x * 8 + w; t < T; t += gridDim.x * 8) {
        float xv[16]; { const uint4 a = *(const uint4*)(h2 + (size_t)t * D + lane * 16), b = *(const uint4*)(h2 + (size_t)t * D + lane * 16 + 8);
            xv[0] = bflo(a.x); xv[1] = bfhi(a.x); xv[2] = bflo(a.y); xv[3] = bfhi(a.y); xv[4] = bflo(a.z); xv[5] = bfhi(a.z); xv[6] = bflo(a.w); xv[7] = bfhi(a.w);
            xv[8] = bflo(b.x); xv[9] = bfhi(b.x); xv[10] = bflo(b.y); xv[11] = bfhi(b.y); xv[12] = bflo(b.z); xv[13] = bfhi(b.z); xv[14] = bflo(b.w); xv[15] = bfhi(b.w); }
        const int e0 = eidx[(size_t)t * 128 + lane], e1 = eidx[(size_t)t * 128 + 64 + lane];
        const float g0 = gate[(size_t)t * 128 + lane], g1 = gate[(size_t)t * 128 + 64 + lane];
        for (int k = 0; k < 128; ++k) { const int e = __shfl(k < 64 ? e0 : e1, k & 63);
            const bf16_t* ur = u16 + (size_t)e * D + lane * 16; const uint4 a = *(const uint4*)ur, b = *(const uint4*)(ur + 8);
            float s = xv[0] * bflo(a.x) + xv[1] * bfhi(a.x) + xv[2] * bflo(a.y) + xv[3] * bfhi(a.y) + xv[4] * bflo(a.z) + xv[5] * bfhi(a.z) + xv[6] * bflo(a.w) + xv[7] * bfhi(a.w)
                    + xv[8] * bflo(b.x) + xv[9] * bfhi(b.x) + xv[10] * bflo(b.y) + xv[11] * bfhi(b.y) + xv[12] * bflo(b.z) + xv[13] * bfhi(b.z) + xv[14] * bflo(b.w) + xv[15] * bfhi(b.w);
            s = wave_sum(s);
            if (lane == (k & 63)) { const float gg = k < 64 ? g0 : g1; wl[k] = gg * gelu_erf(s); } }
        __builtin_amdgcn_s_waitcnt(0);
        float acc[16];
#pragma unroll
        for (int i = 0; i < 16; ++i) acc[i] = 0.f;
        for (int k = 0; k < 128; ++k) { const int e = __shfl(k < 64 ? e0 : e1, k & 63); const float wk = wl[k];
            const bf16_t* vr = v16 + (size_t)e * D + lane * 16; const uint4 a = *(const uint4*)vr, b = *(const uint4*)(vr + 8);
            acc[0] += wk * bflo(a.x); acc[1] += wk * bfhi(a.x); acc[2] += wk * bflo(a.y); acc[3] += wk * bfhi(a.y); acc[4] += wk * bflo(a.z); acc[5] += wk * bfhi(a.z); acc[6] += wk * bflo(a.w); acc[7] += wk * bfhi(a.w);
            acc[8] += wk * bflo(b.x); acc[9] += wk * bfhi(b.x); acc[10] += wk * bflo(b.y); acc[11] += wk * bfhi(b.y); acc[12] += wk * bflo(b.z); acc[13] += wk * bfhi(b.z); acc[14] += wk * bflo(b.w); acc[15] += wk * bfhi(b.w); }
        const float* g2 = mod + (t >> 11) * 6144 + 5120 + lane * 16; float* xr = p.out + (size_t)t * D + lane * 16; float ss = 0.f;
#pragma unroll
        for (int i = 0; i < 16; ++i) { acc[i] = xr[i] + g2[i] * acc[i]; ss += acc[i] * acc[i]; }
        const float r = rsqrtf(wave_sum(ss) * (1.0f / D) + EPS);
#pragma unroll
        for (int i = 0; i < 16; ++i) xr[i] = acc[i] * r * p.final_g[lane * 16 + i];
    }
}

#define XB_TMO      128
#define XB_XCNT(j)  (256  + 64 * (j))
#define XB_XSUB(j)  (1280 + 64 * (j))
#define XB_XGEN(j)  (2304 + 64 * (j))
#define XB_TOP      3328
#define XB_TOPGEN   3392
#define XCD_BAR_WORDS 3456
#define XB_SPIN_CAP (1u << 22)
__device__ __forceinline__ unsigned xb_ld(unsigned* p)              { return __hip_atomic_load(p, __ATOMIC_RELAXED, __HIP_MEMORY_SCOPE_AGENT); }
__device__ __forceinline__ unsigned xb_add(unsigned* p, unsigned v) { return __hip_atomic_fetch_add(p, v, __ATOMIC_RELAXED, __HIP_MEMORY_SCOPE_AGENT); }
__device__ __forceinline__ unsigned xb_xcc_id() { return (unsigned)__builtin_amdgcn_s_getreg((3 << 11) | 20) & 0xFu; }
#define XB_SPIN(cond, bar) do { unsigned _sp = 0; while (cond) { __builtin_amdgcn_s_sleep(1); \
    if ((++_sp & 255u) == 0u) { if (xb_ld(&(bar)[XB_TMO])) break; if (_sp > XB_SPIN_CAP) { atomicAdd(&(bar)[XB_TMO], 1u); break; } } } } while (0)
struct XcdBarrier { unsigned* bar; unsigned x; volatile LAS unsigned* st; };
__device__ __forceinline__ XcdBarrier xcd_barrier_post(unsigned* bar, volatile LAS unsigned* st) {
    XcdBarrier b; b.bar = bar; b.x = xb_xcc_id(); b.st = st;
    if (threadIdx.x == 0) (void)xb_add(&bar[XB_XCNT(b.x)], 1u);
    return b;
}
__device__ __forceinline__ void xcd_barrier_complete(unsigned* bar, unsigned x, unsigned& nloc, unsigned& nx) {
    const unsigned G = gridDim.x * gridDim.y * gridDim.z;
    unsigned sum, cnt, mine, sp = 0u;
    for (;;) {
        sum = 0u; cnt = 0u; mine = 0u;
#pragma unroll
        for (unsigned j = 0; j < 16; ++j) { const unsigned c = xb_ld(&bar[XB_XCNT(j)]); sum += c; cnt += (c > 0u) ? 1u : 0u; mine = (j == x) ? c : mine; }
        if (sum == G) break;
        __builtin_amdgcn_s_sleep(1);
        if ((++sp & 255u) == 0u) { if (xb_ld(&bar[XB_TMO])) break; if (sp > XB_SPIN_CAP) { atomicAdd(&bar[XB_TMO], 1u); break; } }
    }
    nloc = mine > 0u ? mine : 1u; nx = cnt > 0u ? cnt : 1u;
}
__device__ __forceinline__ void xcd_barrier(const XcdBarrier& b) {
    asm volatile("s_waitcnt vmcnt(0)" ::: "memory");
    __syncthreads();
    if (threadIdx.x == 0) {
        unsigned* bar = b.bar;
        __builtin_amdgcn_s_waitcnt(0);
        unsigned nloc = b.st[0], nx = b.st[1];
        if (nloc == 0u) { xcd_barrier_complete(bar, b.x, nloc, nx); b.st[0] = nloc; b.st[1] = nx; }
        const unsigned old = xb_add(&bar[XB_XSUB(b.x)], 1u);
        const unsigned gen = old / nloc;
        if (old + 1u == (gen + 1u) * nloc) {
            __builtin_amdgcn_fence(__ATOMIC_RELEASE, "agent");
            asm volatile("s_waitcnt vmcnt(0)" ::: "memory");
            const unsigned og = xb_add(&bar[XB_TOP], 1u);
            const unsigned tg = og / nx;
            if (og + 1u == (tg + 1u) * nx) xb_add(&bar[XB_TOPGEN], 1u);
            else XB_SPIN(xb_ld(&bar[XB_TOPGEN]) == tg, bar);
            __builtin_amdgcn_fence(__ATOMIC_ACQUIRE, "agent");
            xb_add(&bar[XB_XGEN(b.x)], 1u);
            asm volatile("s_waitcnt vmcnt(0)" ::: "memory");
        } else {
            XB_SPIN(xb_ld(&bar[XB_XGEN(b.x)]) == gen, bar);
            __builtin_amdgcn_fence(__ATOMIC_ACQUIRE, "agent");
            asm volatile("s_waitcnt vmcnt(0)" ::: "memory");
        }
    }
    __syncthreads();
}

constexpr int LDS_BYTES = 131072 + 1024;
constexpr int LDS_CTL = 131072;
__global__ void __launch_bounds__(NTHR, 2) k_mega(Params p) {
    extern __shared__ __attribute__((aligned(16))) unsigned char smem[];
    if (threadIdx.x < 4) ((volatile LAS unsigned*)(smem + LDS_CTL))[threadIdx.x] = 0u;
    __syncthreads();
    XcdBarrier bar = xcd_barrier_post((unsigned*)(p.ws + WS_BAR), (volatile LAS unsigned*)(smem + LDS_CTL));
#define GBAR() xcd_barrier(bar)
    st_adaln(p, smem);        GBAR();
    st_norm_rows(p, 0);       GBAR();
    st_z_naive(p);            GBAR();
    st_prep_a_naive(p);       GBAR();
    st_prep_b_naive(p);       GBAR();
    st_nsa_naive(p, smem);    __syncthreads();
    st_dsa_naive(p, smem);    GBAR();
    st_merge_naive(p);        GBAR();
    st_out_naive(p);          GBAR();
    st_norm_rows(p, 1);       GBAR();
    st_peerq_naive(p);        GBAR();
    st_ssub_naive(p);         GBAR();
    st_route(p);
    st_cvt_uv(p);             GBAR();
    st_expert(p, smem);
}

extern "C" void kernel_launch(void* const* d_in, const int* in_sizes, int n_in, void* d_out, int out_size, void* d_ws, size_t ws_size, hipStream_t stream) {
    static int grid = 0;
    if (grid == 0) {
        int dev = 0, cus = 0, per_cu = 0;
        hipGetDevice(&dev); hipDeviceGetAttribute(&cus, hipDeviceAttributeMultiprocessorCount, dev);
        hipFuncSetAttribute((const void*)k_mega, hipFuncAttributeMaxDynamicSharedMemorySize, LDS_BYTES);
        hipOccupancyMaxActiveBlocksPerMultiprocessor(&per_cu, (const void*)k_mega, NTHR, LDS_BYTES);
        if (per_cu < 1) { fprintf(stderr, "kernel_launch: occupancy query says %d blocks/CU\n", per_cu); per_cu = 1; }
        (void)hipGetLastError();
        grid = cus;
    }
    Params p{};
    const float** f = (const float**)&p;
    for (int i = 0; i < 23; ++i) f[i] = (const float*)d_in[i];
    p.out = (float*)d_out; p.ws = (unsigned char*)d_ws;
    hipMemsetAsync((unsigned char*)d_ws + WS_BAR, 0, 16384, stream);
    hipLaunchKernelGGL(k_mega, dim3(grid), dim3(NTHR), LDS_BYTES, stream, p);
}
```

```cpp
#include <hip/hip_runtime.h>
#include <stdint.h>
#include <stdio.h>

#define LAS __attribute__((address_space(3)))
typedef unsigned short bf16_t;
typedef unsigned int u32;

constexpr int T = 16384, SEQ = 2048, NB = 8, D = 1024, NZ = 4608, DIN = 4576;
constexpr int NTHR = 512;
constexpr float EPS = 1e-6f;
constexpr int ZC_QN = 0, ZC_KC = 512, ZC_VC = 640, ZC_KS = 768, ZC_VS = 896, ZC_KW = 1024, ZC_VW = 1152, ZC_QD = 1280, ZC_CKV = 1792,
              ZC_QI = 1920, ZC_KI = 2432, ZC_GN = 2496, ZC_WI = 2520, ZC_GM = 2560;
constexpr unsigned long long ROPE_MASK = 0xFFull | (3ull << 8) | (3ull << 12) | (3ull << 16) | (0xFFull << 20) | (0xFFull << 30) | (1ull << 38);
constexpr unsigned long long SCALE_MASK = 0xFFull | (0xFFull << 20) | (0xFFull << 30);

constexpr size_t WS_Z = 0;
constexpr size_t WS_SSUB = 0;
constexpr size_t WS_EIDX = 134217728;
constexpr size_t WS_GATE = 142606336;
constexpr size_t WS_MERGED = 150994944;
constexpr size_t WS_U16 = WS_MERGED;
constexpr size_t WS_HB = 184549376;
constexpr size_t WS_ONSA = WS_HB;
constexpr size_t WS_ODSA = WS_HB + 16777216;
constexpr size_t WS_V16 = WS_HB;
constexpr size_t WS_H2 = 218103808;
constexpr size_t WS_W = 251658240;
constexpr size_t WS_WINT = WS_H2;
constexpr size_t WS_WNSAT = WS_W;
constexpr size_t WS_WDSAT = WS_WNSAT + 1048576;
constexpr size_t WS_WOUTT = WS_WDSAT + 1048576;
constexpr size_t WS_WFOLDT = WS_WOUTT + 2097152;
constexpr size_t WS_SMALL = WS_WFOLDT + 4194304;
constexpr size_t WS_MOD = WS_SMALL;
constexpr size_t WS_COS = WS_MOD + 196608;
constexpr size_t WS_SIN = WS_COS + 262144;
constexpr size_t WS_BAR = WS_SIN + 262144;
constexpr size_t WS_END_SMALL = WS_BAR + 16384;
static_assert(WS_END_SMALL <= 268435456, "ws overflow");
constexpr size_t DO_KD = 0;
constexpr size_t DO_VDT = 2097152;
constexpr size_t DO_VST = 4194304;
constexpr size_t DO_VWT = 8388608;
constexpr size_t DO_KCMP = 12582912;
constexpr size_t DO_VCMPT = 12845056;
constexpr size_t DO_HID = 13107200;
constexpr size_t DO_MASK = 14680064;
constexpr size_t DO_END = DO_MASK + 4194304;

struct Params {
    const float *x, *c, *ada_w, *ada_b, *norm1_g, *w_in, *cmp_pos, *w1k, *w2k, *w1v, *w2v, *kvg, *w_uk, *w_uv, *w_nsa, *w_dsa, *w_out, *norm2_g, *wq,
        *subkeys, *pu, *pv, *final_g;
    float* out;
    unsigned char* ws;
};

__device__ __forceinline__ bf16_t f2bf(float f) { u32 u = __float_as_uint(f); u += 0x7fffu + ((u >> 16) & 1u); return (bf16_t)(u >> 16); }
__device__ __forceinline__ float bf2f(bf16_t h) { return __uint_as_float((u32)h << 16); }
__device__ __forceinline__ float bflo(u32 w) { return __uint_as_float(w << 16); }
__device__ __forceinline__ float bfhi(u32 w) { return __uint_as_float(w & 0xffff0000u); }
__device__ __forceinline__ u32 pk2(float lo, float hi) { return (u32)f2bf(lo) | ((u32)f2bf(hi) << 16); }
__device__ __forceinline__ float wave_sum(float v) {
#pragma unroll
    for (int o = 1; o < 64; o <<= 1) v += __shfl_xor(v, o);
    return v;
}
__device__ __forceinline__ float wave_max(float v) {
#pragma unroll
    for (int o = 1; o < 64; o <<= 1) v = fmaxf(v, __shfl_xor(v, o));
    return v;
}
__device__ __forceinline__ float sigmoidf_(float v) { return 1.0f / (1.0f + __expf(-v)); }
__device__ __forceinline__ float gelu_tanh(float v) { const float u = 0.7978845608028654f * (v + 0.044715f * v * v * v); return 0.5f * v * (1.0f + tanhf(u)); }
__device__ __forceinline__ float gelu_erf(float v) { return 0.5f * v * (1.0f + erff(v * 0.7071067811865476f)); }
__device__ __forceinline__ int z_logical_col(int pc) {
    const int g64 = pc >> 6; const int o = pc & 63;
    const int po = (g64 < 64 && ((ROPE_MASK >> g64) & 1ull)) ? ((o >> 1) + 32 * (o & 1)) : o;
    const int pp = (pc & ~63) + po;
    if (pc < 1280) return pp;
    if (pc < 1792) return 1304 + (pp - 1280);
    if (pc < 1920) return 1816 + (pp - 1792);
    if (pc < 2432) return 1944 + (pp - 1920);
    if (pc < 2496) return 2456 + (pp - 2432);
    if (pc < 2520) return 1280 + (pc - 2496);
    if (pc < 2528) return 2520 + (pc - 2520);
    if (pc < 2560) return -1;
    return 2528 + (pc - 2560);
}
__device__ __forceinline__ void z_post(int t, int pc, float& v0, float& v1, const float* cosT, const float* sinT) {
    const int g64 = pc >> 6;
    if (g64 < 64 && ((ROPE_MASK >> g64) & 1ull)) {
        const int i = (pc & 63) >> 1, pos = t & (SEQ - 1);
        const float c = cosT[pos * 32 + i], s = sinT[pos * 32 + i];
        const float a = v0 * c - v1 * s, b = v1 * c + v0 * s;
        const float sc = ((SCALE_MASK >> g64) & 1ull) ? 0.125f : 1.0f;
        v0 = a * sc; v1 = b * sc;
    } else if (pc >= ZC_GM || (pc >= ZC_GN && pc < ZC_WI)) { v0 = sigmoidf_(v0); v1 = sigmoidf_(v1); }
}
__device__ __forceinline__ void sincos_tab(float ang, float& s, float& c) {
    const double a = (double)ang; const double k = rint(a * 0.63661977236758134308);
    const float r = (float)(a - k * 1.57079632679489661923); const float z = r * r;
    const float sp = ((-1.9515295891e-4f * z + 8.3321608736e-3f) * z - 1.6666654611e-1f) * z * r + r;
    const float cp = ((2.443315711809948e-5f * z - 1.388731625493765e-3f) * z + 4.166664568298827e-2f) * z * z - 0.5f * z + 1.0f;
    const int q = ((int)k) & 3;
    s = (q == 0) ? sp : (q == 1) ? cp : (q == 2) ? -sp : -cp;
    c = (q == 0) ? cp : (q == 1) ? -sp : (q == 2) ? -cp : sp;
}

__device__ __forceinline__ void st_adaln(const Params& p, unsigned char* lds) {
    const int tid = threadIdx.x, lane = tid & 63, w = tid >> 6;
    float* cosT = (float*)(p.ws + WS_COS); float* sinT = (float*)(p.ws + WS_SIN);
    for (int i = blockIdx.x * NTHR + tid; i < SEQ * 32; i += gridDim.x * NTHR) {
        const int pos = i >> 5, f = i & 31; const float inv = powf(10000.0f, -(float)f / 32.0f);
        float s, c; sincos_tab((float)pos * inv, s, c); cosT[i] = c; sinT[i] = s;
    }
    float* sc = (float*)lds;
    float* red = sc + 8192;
    for (int i = tid; i < 8192; i += NTHR) { const float v = p.c[i]; sc[i] = v / (1.0f + __expf(-v)); }
    __syncthreads();
    float* mod = (float*)(p.ws + WS_MOD);
    for (int unit = blockIdx.x; unit < 192; unit += gridDim.x) {
        float acc[8];
#pragma unroll
        for (int b = 0; b < 8; ++b) acc[b] = 0.f;
        const int col = unit * 32 + (lane & 31), ks = lane >> 5;
        for (int kk = 0; kk < 64; ++kk) {
            const int k = w * 128 + kk * 2 + ks; const float wv = p.ada_w[(size_t)k * 6144 + col];
#pragma unroll
            for (int b = 0; b < 8; ++b) acc[b] += sc[b * 1024 + k] * wv;
        }
#pragma unroll
        for (int b = 0; b < 8; ++b) red[((w * 2 + ks) * 8 + b) * 32 + (lane & 31)] = acc[b];
        __syncthreads();
        if (tid < 256) { const int b = tid >> 5, c = tid & 31; float s = 0.f;
            for (int j = 0; j < 16; ++j) s += red[(j * 8 + b) * 32 + c];
            mod[b * 6144 + unit * 32 + c] = s + p.ada_b[unit * 32 + c]; }
        __syncthreads();
    }
}
__device__ __forceinline__ void st_norm_rows(const Params& p, int which) {
    const int tid = threadIdx.x, lane = tid & 63, w = tid >> 6;
    const float* src = which ? p.out : p.x; const float* g = which ? p.norm2_g : p.norm1_g;
    bf16_t* dst = (bf16_t*)(p.ws + (which ? WS_H2 : WS_HB));
    const float* mod = (const float*)(p.ws + WS_MOD);
    for (int t = blockIdx.x * 8 + w; t < T; t += gridDim.x * 8) {
        const int b = t >> 11; const float* sh = mod + b * 6144 + (which ? 3072 : 0); const float* scl = sh + 1024;
        const float4* xr = (const float4*)(src + (size_t)t * D);
        float4 v[4]; float ss = 0.f;
#pragma unroll
        for (int j = 0; j < 4; ++j) { v[j] = xr[lane + 64 * j]; ss += v[j].x * v[j].x + v[j].y * v[j].y + v[j].z * v[j].z + v[j].w * v[j].w; }
        const float r = rsqrtf(wave_sum(ss) * (1.0f / D) + EPS);
#pragma unroll
        for (int j = 0; j < 4; ++j) { const int d0 = (lane + 64 * j) * 4;
            const float4 gg = *(const float4*)(g + d0), s4 = *(const float4*)(scl + d0), h4 = *(const float4*)(sh + d0);
            const float o0 = v[j].x * r * gg.x * (1.f + s4.x) + h4.x, o1 = v[j].y * r * gg.y * (1.f + s4.y) + h4.y;
            const float o2 = v[j].z * r * gg.z * (1.f + s4.z) + h4.z, o3 = v[j].w * r * gg.w * (1.f + s4.w) + h4.w;
            uint2 o; o.x = pk2(o0, o1); o.y = pk2(o2, o3); *(uint2*)(dst + (size_t)t * D + d0) = o; }
    }
}
__device__ __forceinline__ void naive_dot8(const bf16_t* A, int lda, const float* W, int ldw, int K, int t0, int col, float (&acc)[8]) {
#pragma unroll
    for (int i = 0; i < 8; ++i) acc[i] = 0.f;
    for (int k = 0; k < K; k += 2) {
        const float w0 = W[(size_t)k * ldw + col], w1 = W[(size_t)(k + 1) * ldw + col];
#pragma unroll
        for (int i = 0; i < 8; ++i) { const u32 a = *(const u32*)(A + (size_t)(t0 + i) * lda + k); acc[i] += bflo(a) * w0 + bfhi(a) * w1; }
    }
}
__device__ __forceinline__ void st_z_naive(const Params& p) {
    const int tid = threadIdx.x; const bf16_t* hb = (const bf16_t*)(p.ws + WS_HB); bf16_t* Z = (bf16_t*)(p.ws + WS_Z);
    const float* cosT = (const float*)(p.ws + WS_COS); const float* sinT = (const float*)(p.ws + WS_SIN);
    const int nitems = (T / 8) * 9;
    for (int it = blockIdx.x * 2 + (tid >> 8); it < nitems; it += gridDim.x * 2) {
        const int tt = it / 9, ch = it % 9; const int t0 = tt * 8; const int pc = (ch * 256 + (tid & 255)) * 2;
        const int l0 = z_logical_col(pc), l1 = z_logical_col(pc + 1);
        float a0[8], a1[8];
        if (l0 >= 0) { naive_dot8(hb, D, p.w_in, DIN, D, t0, l0, a0); naive_dot8(hb, D, p.w_in, DIN, D, t0, l1, a1); }
        else {
#pragma unroll
            for (int i = 0; i < 8; ++i) { a0[i] = 0.f; a1[i] = 0.f; } }
#pragma unroll
        for (int i = 0; i < 8; ++i) { float v0 = a0[i], v1 = a1[i]; z_post(t0 + i, pc, v0, v1, cosT, sinT); *(u32*)(Z + (size_t)(t0 + i) * NZ + pc) = pk2(v0, v1); }
    }
}
__device__ __forceinline__ void st_prep_a_naive(const Params& p) {
    const int tid = threadIdx.x; const bf16_t* Z = (const bf16_t*)(p.ws + WS_Z);
    const float* cosT = (const float*)(p.ws + WS_COS); const float* sinT = (const float*)(p.ws + WS_SIN);
    unsigned char* dob = (unsigned char*)p.out;
    bf16_t* kd = (bf16_t*)(dob + DO_KD); bf16_t* vdT = (bf16_t*)(dob + DO_VDT); bf16_t* vsT = (bf16_t*)(dob + DO_VST); bf16_t* vwT = (bf16_t*)(dob + DO_VWT);
    float* hid = (float*)(dob + DO_HID);
    for (int it = blockIdx.x * NTHR + tid; it < T * 32; it += gridDim.x * NTHR) {
        const int t = it >> 5, i = it & 31; const bf16_t* cr = Z + (size_t)t * NZ + ZC_CKV;
        float ss = 0.f; for (int r = 0; r < 128; ++r) { const float v = bf2f(cr[r]); ss += v * v; }
        const float rn = rsqrtf(ss * (1.0f / 128.0f) + EPS);
        float k1 = 0.f, k2 = 0.f, v1 = 0.f, v2 = 0.f;
        for (int r = 0; r < 128; ++r) { const float cn = bf2f(cr[r]) * rn * p.kvg[r];
            k1 += cn * p.w_uk[r * 64 + i]; k2 += cn * p.w_uk[r * 64 + i + 32]; v1 += cn * p.w_uv[r * 64 + i]; v2 += cn * p.w_uv[r * 64 + i + 32]; }
        const int pos = t & (SEQ - 1), b = t >> 11; const float c = cosT[pos * 32 + i], s = sinT[pos * 32 + i];
        *(u32*)(kd + (size_t)t * 64 + 2 * i) = pk2(k1 * c - k2 * s, k2 * c + k1 * s);
        vdT[((size_t)b * 64 + i) * SEQ + pos] = f2bf(v1); vdT[((size_t)b * 64 + i + 32) * SEQ + pos] = f2bf(v2);
    }
    for (int it = blockIdx.x * NTHR + tid; it < T * 128; it += gridDim.x * NTHR) {
        const int t = it >> 7, gd = it & 127, b = t >> 11, pos = t & (SEQ - 1);
        vsT[((size_t)b * 128 + gd) * SEQ + pos] = Z[(size_t)t * NZ + ZC_VS + gd];
        vwT[((size_t)b * 128 + gd) * SEQ + pos] = Z[(size_t)t * NZ + ZC_VW + gd];
    }
    for (int it = blockIdx.x * NTHR + tid; it < 2 * 8 * 2 * 128 * 64; it += gridDim.x * NTHR) {
        const int e = it & 63, n = (it >> 6) & 127, g = (it >> 13) & 1, b = (it >> 14) & 7, kv = it >> 17;
        float acc = 0.f;
        if (n < 127) {
            const float* w1 = kv ? p.w1v : p.w1k;
            for (int l = 0; l < 32; ++l) { const bf16_t* xr = Z + (size_t)(b * SEQ + 16 * n + l) * NZ + (kv ? ZC_VC : ZC_KC) + g * 64;
                for (int d = 0; d < 64; ++d) { const int pd = kv ? d : (2 * (d & 31) + (d >> 5));
                    acc += (bf2f(xr[pd]) + p.cmp_pos[l * 64 + d]) * w1[(l * 64 + d) * 64 + e]; } }
            acc = gelu_tanh(acc);
        }
        hid[it] = acc;
    }
}
__device__ __forceinline__ void st_prep_b_naive(const Params& p) {
    const int tid = threadIdx.x; unsigned char* dob = (unsigned char*)p.out;
    const float* hid = (const float*)(dob + DO_HID); bf16_t* kcmp = (bf16_t*)(dob + DO_KCMP); bf16_t* vcmpT = (bf16_t*)(dob + DO_VCMPT);
    for (int it = blockIdx.x * NTHR + tid; it < 2 * 8 * 2 * 128 * 64; it += gridDim.x * NTHR) {
        const int f = it & 63, n = (it >> 6) & 127, g = (it >> 13) & 1, b = (it >> 14) & 7, kv = it >> 17;
        const float* w2 = kv ? p.w2v : p.w2k; const float* h = hid + (size_t)(it & ~63);
        float acc = 0.f;
        if (n < 127) for (int e = 0; e < 64; ++e) acc += h[e] * w2[e * 64 + f];
        if (kv == 0) kcmp[(((size_t)b * 2 + g) * 128 + n) * 64 + (2 * (f & 31) + (f >> 5))] = f2bf(acc);
        else vcmpT[(((size_t)b * 2 + g) * 64 + f) * 128 + n] = f2bf(acc);
    }
}
__device__ __forceinline__ float dot64(const float* q, const bf16_t* kr) {
    float s = 0.f;
#pragma unroll
    for (int j = 0; j < 8; ++j) { const uint4 v = *(const uint4*)(kr + 8 * j); const float* qq = q + 8 * j;
        s += qq[0] * bflo(v.x) + qq[1] * bfhi(v.x) + qq[2] * bflo(v.y) + qq[3] * bfhi(v.y) + qq[4] * bflo(v.z) + qq[5] * bfhi(v.z) + qq[6] * bflo(v.w) + qq[7] * bfhi(v.w); }
    return s;
}
__device__ __forceinline__ void st_nsa_naive(const Params& p, unsigned char* lds) {
    const int tid = threadIdx.x, lane = tid & 63, h = tid >> 6, g = h >> 2;
    const bf16_t* Z = (const bf16_t*)(p.ws + WS_Z); unsigned char* dob = (unsigned char*)p.out;
    const bf16_t* kcmp = (const bf16_t*)(dob + DO_KCMP); const bf16_t* vcmpT = (const bf16_t*)(dob + DO_VCMPT);
    bf16_t* onsa = (bf16_t*)(p.ws + WS_ONSA);
    float* qs = (float*)lds;
    float* pc = qs + 512;
    float* vals = pc + 1024;
    u32* selm = (u32*)(vals + 64);
    for (int t = blockIdx.x; t < T; t += gridDim.x) {
        const int b = t >> 11, pos = t & (SEQ - 1); const bf16_t* zr = Z + (size_t)t * NZ;
        __syncthreads();
        qs[h * 64 + lane] = bf2f(zr[ZC_QN + h * 64 + lane]);
        __syncthreads();
        const float* q = qs + h * 64;
        float sc[2]; float m = -1e30f;
#pragma unroll
        for (int c2 = 0; c2 < 2; ++c2) { const int n = c2 * 64 + lane; const bool valid = (n < 127) && (16 * n + 31 <= pos);
            const float s = dot64(q, kcmp + (((size_t)b * 2 + g) * 128 + n) * 64); sc[c2] = valid ? s : -1e30f; m = fmaxf(m, sc[c2]); }
        m = wave_max(m); float l = 0.f;
#pragma unroll
        for (int c2 = 0; c2 < 2; ++c2) { const int n = c2 * 64 + lane; const bool valid = (n < 127) && (16 * n + 31 <= pos); sc[c2] = valid ? __expf(sc[c2] - m) : 0.f; l += sc[c2]; }
        l = wave_sum(l); const float il = 1.0f / fmaxf(l, 1e-30f);
        pc[h * 128 + lane] = sc[0] * il; pc[h * 128 + 64 + lane] = sc[1] * il;
        __syncthreads();
        float ocmp = 0.f; { const bf16_t* vr = vcmpT + (((size_t)b * 2 + g) * 64 + lane) * 128; const float* pp = pc + h * 128;
            for (int n = 0; n < 128; ++n) ocmp += pp[n] * bf2f(vr[n]); }
        if (tid < 64) { const int gg = tid >> 5, j = tid & 31; const float* p0 = pc + gg * 512;
            auto imp = [&](int n) -> float { return (n < 0 || n > 126) ? 0.f : (p0[n] + p0[128 + n] + p0[256 + n] + p0[384 + n]); };
            const float bl = imp(4 * j - 1) + 2.f * imp(4 * j) + 2.f * imp(4 * j + 1) + 2.f * imp(4 * j + 2) + imp(4 * j + 3);
            const int cur = pos >> 6; const bool forced = (j == 0) || (j == cur) || (j == cur - 1); const bool adm = (j * 64 <= pos);
            vals[tid] = forced ? __builtin_inff() : (adm ? bl : -__builtin_inff()); }
        __syncthreads();
        if (tid < 64) { const int gg = tid >> 5, j = tid & 31; const float v = vals[tid]; int rank = 0;
            for (int j2 = 0; j2 < 32; ++j2) { const float v2 = vals[gg * 32 + j2]; rank += (v2 > v || (v2 == v && j2 < j)) ? 1 : 0; }
            const unsigned long long bal = __ballot(rank < 16);
            if (tid == 0) { selm[0] = (u32)bal; selm[1] = (u32)(bal >> 32); } }
        __syncthreads();
        const u32 sel = selm[g];
        float ms = -1e30f, ls = 0.f, os = 0.f;
        for (int j = 0; j * 64 <= pos; ++j) { if (!((sel >> j) & 1u)) continue;
            const int kp = j * 64 + lane; const bool valid = kp <= pos;
            float s = dot64(q, Z + (size_t)(b * SEQ + kp) * NZ + ZC_KS + g * 64); s = valid ? s : -1e30f;
            const float mn = fmaxf(ms, wave_max(s)); const float al = __expf(ms - mn); const float pr = valid ? __expf(s - mn) : 0.f;
            ls = ls * al + wave_sum(pr); os *= al; ms = mn;
            for (int k = 0; k < 64; ++k) { const float pk = __shfl(pr, k); os += pk * bf2f(Z[(size_t)(b * SEQ + j * 64 + k) * NZ + ZC_VS + g * 64 + lane]); } }
        os = os / fmaxf(ls, 1e-30f);
        float mw = -1e30f, lw = 0.f, ow = 0.f;
        for (int c2 = 0; c2 < 8; ++c2) { const int kp = pos - 511 + c2 * 64 + lane; const bool valid = kp >= 0; if (pos - 511 + c2 * 64 + 63 < 0) continue;
            float s = valid ? dot64(q, Z + (size_t)(b * SEQ + kp) * NZ + ZC_KW + g * 64) : -1e30f;
            const float mn = fmaxf(mw, wave_max(s)); const float al = __expf(mw - mn); const float pr = valid ? __expf(s - mn) : 0.f;
            lw = lw * al + wave_sum(pr); ow *= al; mw = mn;
            for (int k = 0; k < 64; ++k) { const float pk = __shfl(pr, k); const int kk = pos - 511 + c2 * 64 + k;
                if (kk >= 0) ow += pk * bf2f(Z[(size_t)(b * SEQ + kk) * NZ + ZC_VW + g * 64 + lane]); } }
        ow = ow / fmaxf(lw, 1e-30f);
        const float gc = bf2f(zr[ZC_GN + h * 3 + 0]), gs = bf2f(zr[ZC_GN + h * 3 + 1]), gw = bf2f(zr[ZC_GN + h * 3 + 2]);
        onsa[(size_t)t * 512 + h * 64 + lane] = f2bf(gc * ocmp + gs * os + gw * ow);
    }
}
__device__ __forceinline__ void st_dsa_naive(const Params& p, unsigned char* lds) {
    const int tid = threadIdx.x, lane = tid & 63, h = tid >> 6;
    const bf16_t* Z = (const bf16_t*)(p.ws + WS_Z); unsigned char* dob = (unsigned char*)p.out;
    const bf16_t* kd = (const bf16_t*)(dob + DO_KD); const bf16_t* vdT = (const bf16_t*)(dob + DO_VDT); u32* maskg = (u32*)(dob + DO_MASK);
    bf16_t* odsa = (bf16_t*)(p.ws + WS_ODSA);
    float* qi = (float*)lds;
    float* qd = qi + 512;
    float* wv = qd + 512;
    float* scv = wv + 8;
    u32* mk = (u32*)(scv + 2048);
    for (int t = blockIdx.x; t < T; t += gridDim.x) {
        const int b = t >> 11, pos = t & (SEQ - 1); const bf16_t* zr = Z + (size_t)t * NZ;
        __syncthreads();
        qi[tid] = bf2f(zr[ZC_QI + tid]); qd[tid] = bf2f(zr[ZC_QD + tid]);
        if (tid < 8) wv[tid] = bf2f(zr[ZC_WI + tid]) * 0.35355339059327373f;
        __syncthreads();
        for (int i = 0; i < 4; ++i) { const int k = tid + 512 * i; float s = -__builtin_inff();
            if (k <= pos) { s = 0.f; const bf16_t* kr = Z + (size_t)(b * SEQ + k) * NZ + ZC_KI;
                for (int hh = 0; hh < 8; ++hh) { const float lg = dot64(qi + hh * 64, kr); s = fmaf(wv[hh], fmaxf(lg, 0.f), s); } }
            scv[k] = s; }
        __syncthreads();
        for (int i = 0; i < 4; ++i) { const int k = tid + 512 * i; bool selb = false;
            if (k <= pos) { if (pos < 256) selb = true; else { const float v = scv[k]; int rank = 0;
                    for (int j = 0; j <= pos; ++j) { const float v2 = scv[j]; rank += (v2 > v || (v2 == v && j < k)) ? 1 : 0; } selb = rank < 256; } }
            const unsigned long long bal = __ballot(selb);
            if (lane == 0) { const int wi = 16 * i + 2 * h; mk[wi] = (u32)bal; mk[wi + 1] = (u32)(bal >> 32); } }
        __syncthreads();
        if (tid < 64) maskg[(size_t)t * 64 + tid] = mk[tid];
        float m = -1e30f, l = 0.f, o = 0.f; const float* q = qd + h * 64;
        for (int c2 = 0; c2 * 64 <= pos; ++c2) { const int kp = c2 * 64 + lane; const bool valid = (mk[kp >> 5] >> (kp & 31)) & 1u;
            if (__ballot(valid) == 0ull) continue;
            float s = valid ? dot64(q, kd + (size_t)(b * SEQ + kp) * 64) : -1e30f;
            const float mn = fmaxf(m, wave_max(s)); const float al = __expf(m - mn); const float pr = valid ? __expf(s - mn) : 0.f;
            l = l * al + wave_sum(pr); o *= al; m = mn;
            const bf16_t* vr = vdT + ((size_t)b * 64 + lane) * SEQ + c2 * 64;
            for (int k = 0; k < 64; ++k) { const float pk = __shfl(pr, k); o += pk * bf2f(vr[k]); } }
        odsa[(size_t)t * 512 + h * 64 + lane] = f2bf(o / fmaxf(l, 1e-30f));
    }
}
__device__ __forceinline__ void st_merge_naive(const Params& p) {
    const int tid = threadIdx.x; const bf16_t* Z = (const bf16_t*)(p.ws + WS_Z);
    const bf16_t* onsa = (const bf16_t*)(p.ws + WS_ONSA); const bf16_t* odsa = (const bf16_t*)(p.ws + WS_ODSA); bf16_t* mg = (bf16_t*)(p.ws + WS_MERGED);
    for (int it = blockIdx.x; it < (T / 8) * 2; it += gridDim.x) { const int t0 = (it >> 1) * 8, n = (it & 1) * 512 + tid;
        float a[8], d[8]; naive_dot8(onsa, 512, p.w_nsa, D, 512, t0, n, a); naive_dot8(odsa, 512, p.w_dsa, D, 512, t0, n, d);
#pragma unroll
        for (int i = 0; i < 8; ++i) { const float g1 = bf2f(Z[(size_t)(t0 + i) * NZ + ZC_GM + n]), g2 = bf2f(Z[(size_t)(t0 + i) * NZ + ZC_GM + 1024 + n]);
            mg[(size_t)(t0 + i) * D + n] = f2bf(g1 * a[i] + g2 * d[i]); } }
}
__device__ __forceinline__ void st_out_naive(const Params& p) {
    const int tid = threadIdx.x; const bf16_t* mg = (const bf16_t*)(p.ws + WS_MERGED); const float* mod = (const float*)(p.ws + WS_MOD);
    for (int it = blockIdx.x; it < (T / 8) * 2; it += gridDim.x) { const int t0 = (it >> 1) * 8, n = (it & 1) * 512 + tid;
        float a[8]; naive_dot8(mg, D, p.w_out, D, D, t0, n, a); const float g1 = mod[(t0 >> 11) * 6144 + 2048 + n];
#pragma unroll
        for (int i = 0; i < 8; ++i) p.out[(size_t)(t0 + i) * D + n] = p.x[(size_t)(t0 + i) * D + n] + g1 * a[i]; }
}
__device__ __forceinline__ void st_peerq_naive(const Params& p) {
    const int tid = threadIdx.x; const bf16_t* h2 = (const bf16_t*)(p.ws + WS_H2); bf16_t* q = (bf16_t*)(p.ws + WS_MERGED);
    for (int it = blockIdx.x; it < (T / 8) * 2; it += gridDim.x) { const int t0 = (it >> 1) * 8, n = (it & 1) * 512 + tid;
        float a[8]; naive_dot8(h2, D, p.wq, D, D, t0, n, a);
#pragma unroll
        for (int i = 0; i < 8; ++i) q[(size_t)(t0 + i) * D + n] = f2bf(a[i]); }
}
__device__ __forceinline__ void st_ssub_naive(const Params& p) {
    const int tid = threadIdx.x; const bf16_t* q = (const bf16_t*)(p.ws + WS_MERGED); float* ss = (float*)(p.ws + WS_SSUB);
    for (size_t it = (size_t)blockIdx.x * NTHR + tid; it < (size_t)T * 2048; it += (size_t)gridDim.x * NTHR) {
        const int t = (int)(it >> 11), col = (int)(it & 2047), hc = col >> 7, n = col & 127;
        const bf16_t* qr = q + (size_t)t * D + hc * 64; const float* sk = p.subkeys + ((size_t)hc * 128 + n) * 64;
        float acc = 0.f; for (int d = 0; d < 64; ++d) acc += bf2f(qr[d]) * sk[d];
        ss[it] = acc; }
}
__device__ __forceinline__ u32 ordf(float f);
__device__ __forceinline__ void ins16(u32 (&s)[16], u32 key) {
#pragma unroll
    for (int i = 0; i < 16; ++i) { const u32 mx = s[i] > key ? s[i] : key; key = s[i] > key ? key : s[i]; s[i] = mx; }
}
__device__ __forceinline__ void st_route(const Params& p) {
    const int tid = threadIdx.x; const float* ss = (const float*)(p.ws + WS_SSUB); int* eidx = (int*)(p.ws + WS_EIDX); float* gate = (float*)(p.ws + WS_GATE);
    for (int it = blockIdx.x * NTHR + tid; it < T * 8; it += gridDim.x * NTHR) {
        const float* s0 = ss + (size_t)it * 256;
        u32 a[16], b[16];
#pragma unroll
        for (int i = 0; i < 16; ++i) { a[i] = 0u; b[i] = 0u; }
        for (int n = 0; n < 128; n += 4) { const float4 x = *(const float4*)(s0 + n), y = *(const float4*)(s0 + 128 + n);
            ins16(a, (ordf(x.x) & ~127u) | (u32)(127 - n)); ins16(a, (ordf(x.y) & ~127u) | (u32)(126 - n)); ins16(a, (ordf(x.z) & ~127u) | (u32)(125 - n)); ins16(a, (ordf(x.w) & ~127u) | (u32)(124 - n));
            ins16(b, (ordf(y.x) & ~127u) | (u32)(127 - n)); ins16(b, (ordf(y.y) & ~127u) | (u32)(126 - n)); ins16(b, (ordf(y.z) & ~127u) | (u32)(125 - n)); ins16(b, (ordf(y.w) & ~127u) | (u32)(124 - n)); }
        float va[16], vb[16]; int na[16], nb[16];
#pragma unroll
        for (int i = 0; i < 16; ++i) { na[i] = 127 - (int)(a[i] & 127u); nb[i] = 127 - (int)(b[i] & 127u); va[i] = s0[na[i]]; vb[i] = s0[128 + nb[i]]; }
        u32 tk[16];
#pragma unroll
        for (int i = 0; i < 16; ++i) tk[i] = 0u;
#pragma unroll
        for (int i = 0; i < 16; ++i)
#pragma unroll
            for (int j = 0; j < 16; ++j) if ((i + 1) * (j + 1) <= 16) ins16(tk, (ordf(va[i] + vb[j]) & ~255u) | (u32)(255 - (i * 16 + j)));
        float ts[16]; int te[16];
#pragma unroll
        for (int r = 0; r < 16; ++r) { const int flat = 255 - (int)(tk[r] & 255u), i = flat >> 4, j = flat & 15; float x = 0.f, y = 0.f; int ni = 0, nj = 0;
#pragma unroll
            for (int q = 0; q < 16; ++q) { if (i == q) { x = va[q]; ni = na[q]; } if (j == q) { y = vb[q]; nj = nb[q]; } }
            ts[r] = x + y; te[r] = ni * 128 + nj; }
        float mx = ts[0];
#pragma unroll
        for (int r = 1; r < 16; ++r) mx = fmaxf(mx, ts[r]);
        float sum = 0.f, ex[16];
#pragma unroll
        for (int r = 0; r < 16; ++r) { ex[r] = __expf(ts[r] - mx); sum += ex[r]; }
        const float inv = 1.0f / sum;
#pragma unroll
        for (int r = 0; r < 16; ++r) { eidx[(size_t)it * 16 + r] = te[r]; gate[(size_t)it * 16 + r] = ex[r] * inv; }
    }
}
__device__ __forceinline__ void st_cvt_uv(const Params& p) {
    const int tid = threadIdx.x; bf16_t* u16 = (bf16_t*)(p.ws + WS_U16); bf16_t* v16 = (bf16_t*)(p.ws + WS_V16);
    const size_t n4 = (size_t)16384 * 1024 / 4;
    for (size_t i = (size_t)blockIdx.x * NTHR + tid; i < n4; i += (size_t)gridDim.x * NTHR) {
        const float4 a = ((const float4*)p.pu)[i], b = ((const float4*)p.pv)[i];
        uint2 o; o.x = pk2(a.x, a.y); o.y = pk2(a.z, a.w); ((uint2*)u16)[i] = o; o.x = pk2(b.x, b.y); o.y = pk2(b.z, b.w); ((uint2*)v16)[i] = o; }
}
__device__ __forceinline__ void st_expert(const Params& p, unsigned char* lds) {
    const int tid = threadIdx.x, lane = tid & 63, w = tid >> 6;
    const bf16_t* h2 = (const bf16_t*)(p.ws + WS_H2); const bf16_t* u16 = (const bf16_t*)(p.ws + WS_U16); const bf16_t* v16 = (const bf16_t*)(p.ws + WS_V16);
    const int* eidx = (const int*)(p.ws + WS_EIDX); const float* gate = (const float*)(p.ws + WS_GATE); const float* mod = (const float*)(p.ws + WS_MOD);
    float* wl = (float*)lds + w * 128;
    for (int t = blockIdx.x * 8 + w; t < T; t += gridDim.x * 8) {
        float xv[16]; { const uint4 a = *(const uint4*)(h2 + (size_t)t * D + lane * 16), b = *(const uint4*)(h2 + (size_t)t * D + lane * 16 + 8);
            xv[0] = bflo(a.x); xv[1] = bfhi(a.x); xv[2] = bflo(a.y); xv[3] = bfhi(a.y); xv[4] = bflo(a.z); xv[5] = bfhi(a.z); xv[6] = bflo(a.w); xv[7] = bfhi(a.w);
            xv[8] = bflo(b.x); xv[9] = bfhi(b.x); xv[10] = bflo(b.y); xv[11] = bfhi(b.y); xv[12] = bflo(b.z); xv[13] = bfhi(b.z); xv[14] = bflo(b.w); xv[15] = bfhi(b.w); }
        const int e0 = eidx[(size_t)t * 128 + lane], e1 = eidx[(size_t)t * 128 + 64 + lane];
        const float g0 = gate[(size_t)t * 128 + lane], g1 = gate[(size_t)t * 128 + 64 + lane];
        for (int k = 0; k < 128; ++k) { const int e = __shfl(k < 64 ? e0 : e1, k & 63);
            const bf16_t* ur = u16 + (size_t)e * D + lane * 16; const uint4 a = *(const uint4*)ur, b = *(const uint4*)(ur + 8);
            float s = xv[0] * bflo(a.x) + xv[1] * bfhi(a.x) + xv[2] * bflo(a.y) + xv[3] * bfhi(a.y) + xv[4] * bflo(a.z) + xv[5] * bfhi(a.z) + xv[6] * bflo(a.w) + xv[7] * bfhi(a.w)
                    + xv[8] * bflo(b.x) + xv[9] * bfhi(b.x) + xv[10] * bflo(b.y) + xv[11] * bfhi(b.y) + xv[12] * bflo(b.z) + xv[13] * bfhi(b.z) + xv[14] * bflo(b.w) + xv[15] * bfhi(b.w);
            s = wave_sum(s);
            if (lane == (k & 63)) { const float gg = k < 64 ? g0 : g1; wl[k] = gg * gelu_erf(s); } }
        __builtin_amdgcn_s_waitcnt(0);
        float acc[16];
#pragma unroll
        for (int i = 0; i < 16; ++i) acc[i] = 0.f;
        for (int k = 0; k < 128; ++k) { const int e = __shfl(k < 64 ? e0 : e1, k & 63); const float wk = wl[k];
            const bf16_t* vr = v16 + (size_t)e * D + lane * 16; const uint4 a = *(const uint4*)vr, b = *(const uint4*)(vr + 8);
            acc[0] += wk * bflo(a.x); acc[1] += wk * bfhi(a.x); acc[2] += wk * bflo(a.y); acc[3] += wk * bfhi(a.y); acc[4] += wk * bflo(a.z); acc[5] += wk * bfhi(a.z); acc[6] += wk * bflo(a.w); acc[7] += wk * bfhi(a.w);
            acc[8] += wk * bflo(b.x); acc[9] += wk * bfhi(b.x); acc[10] += wk * bflo(b.y); acc[11] += wk * bfhi(b.y); acc[12] += wk * bflo(b.z); acc[13] += wk * bfhi(b.z); acc[14] += wk * bflo(b.w); acc[15] += wk * bfhi(b.w); }
        const float* g2 = mod + (t >> 11) * 6144 + 5120 + lane * 16; float* xr = p.out + (size_t)t * D + lane * 16; float ss = 0.f;
#pragma unroll
        for (int i = 0; i < 16; ++i) { acc[i] = xr[i] + g2[i] * acc[i]; ss += acc[i] * acc[i]; }
        const float r = rsqrtf(wave_sum(ss) * (1.0f / D) + EPS);
#pragma unroll
        for (int i = 0; i < 16; ++i) xr[i] = acc[i] * r * p.final_g[lane * 16 + i];
    }
}


typedef short bf16x8 __attribute__((ext_vector_type(8)));
typedef float f32x16 __attribute__((ext_vector_type(16)));
typedef unsigned u32x2 __attribute__((ext_vector_type(2)));
typedef unsigned u32x4 __attribute__((ext_vector_type(4)));
typedef __bf16 hbf2_t __attribute__((ext_vector_type(2)));
typedef float f32x2_t __attribute__((ext_vector_type(2)));
#define MFMA32(a, b, c) __builtin_amdgcn_mfma_f32_32x32x16_bf16((a), (b), (c), 0, 0, 0)
__device__ __forceinline__ u32 pkbf(float a, float b) { const f32x2_t v = {a, b}; const hbf2_t r = __builtin_convertvector(v, hbf2_t); return __builtin_bit_cast(u32, r); }
__device__ __forceinline__ bf16x8 ld8(const bf16_t* q) { return *(const bf16x8*)q; }
__device__ __forceinline__ bf16x8 ld44(const bf16_t* q) { const u32x2 a = *(const u32x2*)q, b = *(const u32x2*)(q + 8); const u32x4 v = {a.x, a.y, b.x, b.y}; return __builtin_bit_cast(bf16x8, v); }
template <int H> __device__ __forceinline__ bf16x8 pack8(const f32x16& s) {
    const u32x4 v = {pkbf(s[8 * H], s[8 * H + 1]), pkbf(s[8 * H + 2], s[8 * H + 3]), pkbf(s[8 * H + 4], s[8 * H + 5]), pkbf(s[8 * H + 6], s[8 * H + 7])};
    return __builtin_bit_cast(bf16x8, v);
}
__device__ __forceinline__ float dpp_xor1(float v) { return __int_as_float(__builtin_amdgcn_update_dpp(0, __float_as_int(v), 0xB1, 0xF, 0xF, true)); }
__device__ __forceinline__ float dpp_xor2(float v) { return __int_as_float(__builtin_amdgcn_update_dpp(0, __float_as_int(v), 0x4E, 0xF, 0xF, true)); }
__device__ __forceinline__ f32x16 zero16() { f32x16 z;
#pragma unroll
    for (int i = 0; i < 16; ++i) z[i] = 0.f; return z; }
__device__ __forceinline__ void flash_tile(float& m, float& l, f32x16& o0, f32x16& o1, f32x16 s, u32 vm, const bf16_t* vb, size_t dbs) {
    const bf16x8 v00 = ld44(vb), v01 = ld44(vb + 16), v10 = ld44(vb + dbs), v11 = ld44(vb + dbs + 16);
    float mx = -1e30f;
#pragma unroll
    for (int R = 0; R < 16; ++R) { s[R] = ((vm >> R) & 1u) ? s[R] : -1e30f; mx = fmaxf(mx, s[R]); }
    mx = fmaxf(mx, __shfl_xor(mx, 32));
    const float mn = fmaxf(m, mx), al = __expf(m - mn);
    float ps = 0.f;
#pragma unroll
    for (int R = 0; R < 16; ++R) { const float pr = ((vm >> R) & 1u) ? __expf(s[R] - mn) : 0.f; s[R] = pr; ps += pr; }
    ps += __shfl_xor(ps, 32);
    l = l * al + ps; m = mn;
#pragma unroll
    for (int R = 0; R < 16; ++R) { o0[R] *= al; o1[R] *= al; }
    const bf16x8 p0 = pack8<0>(s), p1 = pack8<1>(s);
    o0 = MFMA32(v00, p0, o0); o0 = MFMA32(v01, p1, o0);
    o1 = MFMA32(v10, p0, o1); o1 = MFMA32(v11, p1, o1);
}
__device__ __forceinline__ u32 vm_le(int lim) { u32 vm = 0u;
#pragma unroll
    for (int R = 0; R < 16; ++R) vm |= (((R & 3) + 8 * (R >> 2)) <= lim) ? (1u << R) : 0u;
    return vm; }
__device__ __forceinline__ u32 vm_from_word(u32 word, int hl) { const u32 sh = word >> (4 * hl); return (sh & 0xFu) | (((sh >> 8) & 0xFu) << 4) | (((sh >> 16) & 0xFu) << 8) | (((sh >> 24) & 0xFu) << 12); }
__device__ __forceinline__ void store_ot(bf16_t* orow, const f32x16& o0, const f32x16& o1, int hl) {
#pragma unroll
    for (int q = 0; q < 4; ++q) {
        u32x2 a = {pkbf(o0[4 * q], o0[4 * q + 1]), pkbf(o0[4 * q + 2], o0[4 * q + 3])}; *(u32x2*)(orow + 8 * q + 4 * hl) = a;
        u32x2 b = {pkbf(o1[4 * q], o1[4 * q + 1]), pkbf(o1[4 * q + 2], o1[4 * q + 3])}; *(u32x2*)(orow + 32 + 8 * q + 4 * hl) = b;
    }
}
__device__ __forceinline__ u32 ordf(float f) { const u32 u = __float_as_uint(f); return (u & 0x80000000u) ? ~u : (u | 0x80000000u); }

__device__ __forceinline__ void st_nsa(const Params& p) {
    const int tid = threadIdx.x, lane = tid & 63, w = __builtin_amdgcn_readfirstlane(tid >> 6), c_ = lane & 31, hl_ = lane >> 5;
    const bf16_t* Z = (const bf16_t*)(p.ws + WS_Z); unsigned char* dob = (unsigned char*)p.out;
    const bf16_t* kcmp = (const bf16_t*)(dob + DO_KCMP); const bf16_t* vcmpT = (const bf16_t*)(dob + DO_VCMPT);
    const bf16_t* vsT = (const bf16_t*)(dob + DO_VST); const bf16_t* vwT = (const bf16_t*)(dob + DO_VWT);
    bf16_t* onsa = (bf16_t*)(p.ws + WS_ONSA);
    for (int ps = blockIdx.x; ps < 256; ps += gridDim.x)
    for (int which = 0; which < 2; ++which) {
        const int b = ps >> 5, g = (ps >> 4) & 1, jj = ps & 15, qb = which ? 31 - jj : jj, cur = qb;
        int c = c_, hl = hl_; asm volatile("" : "+v"(c), "+v"(hl));
        const int pmin = qb * 64 + 8 * w, pos = pmin + (c >> 2), head = 4 * g + (c & 3);
        const bf16_t* zr = Z + (size_t)(b * SEQ + pos) * NZ;
        bf16x8 qfr[4];
#pragma unroll
        for (int kk = 0; kk < 4; ++kk) qfr[kk] = ld8(zr + ZC_QN + head * 64 + 16 * kk + 8 * hl);
        const float gc = bf2f(zr[ZC_GN + head * 3]), gs = bf2f(zr[ZC_GN + head * 3 + 1]), gw = bf2f(zr[ZC_GN + head * 3 + 2]);
        f32x16 out0 = zero16(), out1 = zero16();
        u32 sel;
        {
            const int pmax = pmin + 7; const int nmax = pmax >= 31 ? ((pmax - 31) >> 4) : -1; const int ntile = nmax >= 0 ? (((nmax > 126 ? 126 : nmax) >> 5) + 1) : 0;
            const bf16_t* kb = kcmp + ((size_t)(b * 2 + g) * 128 + c) * 64 + 8 * hl;
            float mx = -1e30f, l = 0.f;
            const int nlim = (pos >= 31 ? (((pos - 31) >> 4) > 126 ? 126 : ((pos - 31) >> 4)) : -1) - 4 * hl;
            for (int kt = 0; kt < ntile; ++kt) {
                f32x16 s = zero16();
#pragma unroll
                for (int kk = 0; kk < 4; ++kk) s = MFMA32(ld8(kb + (size_t)kt * 32 * 64 + 16 * kk), qfr[kk], s);
                const u32 vm = vm_le(nlim - 32 * kt);
                float tm = -1e30f;
#pragma unroll
                for (int R = 0; R < 16; ++R) { s[R] = ((vm >> R) & 1u) ? s[R] : -1e30f; tm = fmaxf(tm, s[R]); }
                const float mn = fmaxf(mx, tm); float ps = 0.f;
#pragma unroll
                for (int R = 0; R < 16; ++R) ps += ((vm >> R) & 1u) ? __expf(s[R] - mn) : 0.f;
                l = l * __expf(mx - mn) + ps; mx = mn;
            }
            {
                const float mo = __shfl_xor(mx, 32), lo_ = __shfl_xor(l, 32); const float mn = fmaxf(mx, mo);
                l = l * __expf(mx - mn) + lo_ * __expf(mo - mn); mx = mn; }
            const float il = 1.0f / fmaxf(l, 1e-30f);
            __builtin_amdgcn_sched_barrier(0);
            f32x16 o0 = zero16(), o1 = zero16();
            const bf16_t* vb = vcmpT + ((size_t)(b * 2 + g) * 64 + c) * 128 + 4 * hl;
            float G[16], L[16];
#pragma unroll
            for (int kt = 0; kt < 4; ++kt) {
                if (kt < ntile) {
                    f32x16 s = zero16();
#pragma unroll
                    for (int kk = 0; kk < 4; ++kk) s = MFMA32(ld8(kb + (size_t)kt * 32 * 64 + 16 * kk), qfr[kk], s);
                    const u32 vm = vm_le(nlim - 32 * kt);
#pragma unroll
                    for (int R = 0; R < 16; ++R) s[R] = ((vm >> R) & 1u) ? __expf(s[R] - mx) * il : 0.f;
                    const bf16x8 p0 = pack8<0>(s), p1 = pack8<1>(s);
                    o0 = MFMA32(ld44(vb + 32 * kt), p0, o0); o0 = MFMA32(ld44(vb + 32 * kt + 16), p1, o0);
                    o1 = MFMA32(ld44(vb + 32 * 128 + 32 * kt), p0, o1); o1 = MFMA32(ld44(vb + 32 * 128 + 32 * kt + 16), p1, o1);
#pragma unroll
                    for (int rg = 0; rg < 4; ++rg) { float gsum = (s[4 * rg] + s[4 * rg + 1]) + (s[4 * rg + 2] + s[4 * rg + 3]); float last = s[4 * rg + 3];
                        gsum += dpp_xor1(gsum); gsum += dpp_xor2(gsum); last += dpp_xor1(last); last += dpp_xor2(last);
                        G[4 * kt + rg] = gsum; L[4 * kt + rg] = last; }
                } else {
#pragma unroll
                    for (int rg = 0; rg < 4; ++rg) { G[4 * kt + rg] = 0.f; L[4 * kt + rg] = 0.f; }
                }
                __builtin_amdgcn_sched_barrier(0);
            }
#pragma unroll
            for (int R = 0; R < 16; ++R) { out0[R] = gc * o0[R]; out1[R] = gc * o1[R]; }
            float v[16], vx[16];
            { float Lx[16];
#pragma unroll
              for (int i = 0; i < 16; ++i) Lx[i] = __shfl_xor(L[i], 32);
#pragma unroll
              for (int i = 0; i < 16; ++i) { const float prevL = hl ? Lx[i] : (i > 0 ? Lx[i > 0 ? i - 1 : 0] : 0.f); const float bl = prevL + 2.f * G[i] - L[i];
                const int j = 2 * i + hl; const bool forced = (j == 0) || (j == cur) || (j == cur - 1);
                v[i] = forced ? __builtin_inff() : (j <= cur ? bl : -__builtin_inff()); } }
#pragma unroll
            for (int i = 0; i < 16; ++i) vx[i] = __shfl_xor(v[i], 32);
            u32 own = 0u;
#pragma unroll
            for (int i = 0; i < 16; ++i) { int rank = 0;
#pragma unroll
                for (int i2 = 0; i2 < 16; ++i2) {
                    if (i2 != i) rank += (v[i2] > v[i] || (v[i2] == v[i] && i2 < i)) ? 1 : 0;
                    const bool xlt = (i2 < i) || (hl && i2 == i);
                    rank += (vx[i2] > v[i] || (vx[i2] == v[i] && xlt)) ? 1 : 0; }
                const int j = 2 * i + hl; own |= ((j <= cur) && rank < 16) ? (1u << j) : 0u; }
            sel = own | (u32)__shfl_xor((int)own, 32);
            __builtin_amdgcn_sched_barrier(0);
        }
        {
            float m = -1e30f, l = 0.f; f32x16 o0 = zero16(), o1 = zero16();
            const bf16_t* kb = Z + (size_t)(b * SEQ + c) * NZ + ZC_KS + g * 64 + 8 * hl;
            const bf16_t* vb = vsT + ((size_t)(b * 2 + g) * 64 + c) * SEQ + 4 * hl;
            for (int jb = 0; jb <= cur; ++jb) {
                const bool mine = (sel >> jb) & 1u;
                if (__ballot(mine) == 0ull) continue;
#pragma unroll
                for (int h2 = 0; h2 < 2; ++h2) { const int key0 = jb * 64 + h2 * 32;
                    f32x16 s = zero16();
#pragma unroll
                    for (int kk = 0; kk < 4; ++kk) s = MFMA32(ld8(kb + (size_t)key0 * NZ + 16 * kk), qfr[kk], s);
                    const u32 vm = mine ? vm_le(pos - key0 - 4 * hl) : 0u;
                    flash_tile(m, l, o0, o1, s, vm, vb + key0, (size_t)32 * SEQ); }
            }
            const float f = gs / fmaxf(l, 1e-30f);
#pragma unroll
            for (int R = 0; R < 16; ++R) { out0[R] += f * o0[R]; out1[R] += f * o1[R]; }
        }
        {
            float m = -1e30f, l = 0.f; f32x16 o0 = zero16(), o1 = zero16();
            const bf16_t* kb = Z + (size_t)(b * SEQ + c) * NZ + ZC_KW + g * 64 + 8 * hl;
            const bf16_t* vb = vwT + ((size_t)(b * 2 + g) * 64 + c) * SEQ + 4 * hl;
            const int kstart = pmin - 511 > 0 ? pmin - 511 : 0;
            for (int kt = kstart >> 5; kt <= (pmin + 7) >> 5; ++kt) { const int key0 = kt * 32;
                f32x16 s = zero16();
#pragma unroll
                for (int kk = 0; kk < 4; ++kk) s = MFMA32(ld8(kb + (size_t)key0 * NZ + 16 * kk), qfr[kk], s);
                const int d1 = pos - key0 - 4 * hl; const u32 vm = vm_le(d1) & ~vm_le(d1 - 512);
                flash_tile(m, l, o0, o1, s, vm, vb + key0, (size_t)32 * SEQ); }
            const float f = gw / fmaxf(l, 1e-30f);
#pragma unroll
            for (int R = 0; R < 16; ++R) { out0[R] += f * o0[R]; out1[R] += f * o1[R]; }
        }
        store_ot(onsa + (size_t)(b * SEQ + pos) * 512 + head * 64, out0, out1, hl);
    }
}

__device__ __forceinline__ void st_dsa(const Params& p, unsigned char* lds) {
    const int tid = threadIdx.x, lane = tid & 63, w = __builtin_amdgcn_readfirstlane(tid >> 6), c_ = lane & 31, hl_ = lane >> 5;
    const bf16_t* Z = (const bf16_t*)(p.ws + WS_Z); unsigned char* dob = (unsigned char*)p.out;
    const bf16_t* kd = (const bf16_t*)(dob + DO_KD); const bf16_t* vdT = (const bf16_t*)(dob + DO_VDT);
    bf16_t* odsa = (bf16_t*)(p.ws + WS_ODSA);
    u32* mk = (u32*)lds;
    for (int ps = blockIdx.x; ps < 256; ps += gridDim.x)
    for (int which = 0; which < 2; ++which) {
        const int b = ps >> 5, jj = ps & 31, qb = which ? 63 - jj : jj;
        const int tok0 = b * SEQ + qb * 32;
        int c = c_, hl = hl_; asm volatile("" : "+v"(c), "+v"(hl));
        __syncthreads();
        {
            const int r = c; const int qq_r = ((r >> 2) & 1) * 2 + (r >> 4), head_r = ((r >> 3) & 1) * 4 + (r & 3);
            bf16x8 afr[4];
#pragma unroll
            for (int kk = 0; kk < 4; ++kk) afr[kk] = ld8(Z + (size_t)(tok0 + 4 * w + qq_r) * NZ + ZC_QI + head_r * 64 + 16 * kk + 8 * hl);
            float wv[2][8]; int posq[2];
#pragma unroll
            for (int s = 0; s < 2; ++s) { posq[s] = qb * 32 + 4 * w + 2 * hl + s;
                const uint4 ww = *(const uint4*)(Z + (size_t)(tok0 + 4 * w + 2 * hl + s) * NZ + ZC_WI);
                wv[s][0] = bflo(ww.x) * 0.35355339059327373f; wv[s][1] = bfhi(ww.x) * 0.35355339059327373f; wv[s][2] = bflo(ww.y) * 0.35355339059327373f; wv[s][3] = bfhi(ww.y) * 0.35355339059327373f;
                wv[s][4] = bflo(ww.z) * 0.35355339059327373f; wv[s][5] = bfhi(ww.z) * 0.35355339059327373f; wv[s][6] = bflo(ww.w) * 0.35355339059327373f; wv[s][7] = bfhi(ww.w) * 0.35355339059327373f; }
            u32 key[64][2];
            const bf16_t* kib = Z + (size_t)(b * SEQ + c) * NZ + ZC_KI + 8 * hl;
            bf16x8 bc[4];
#pragma unroll
            for (int kk = 0; kk < 4; ++kk) bc[kk] = ld8(kib + 16 * kk);
            const bf16_t* kp = kib;
#pragma unroll
            for (int kt = 0; kt < 64; ++kt) {
                if (kt <= qb) {
                    bf16x8 bn[4];
                    if (kt + 1 <= qb) kp += (size_t)32 * NZ;
                    asm volatile("" : "+v"(kp));
#pragma unroll
                    for (int kk = 0; kk < 4; ++kk) bn[kk] = ld8(kp + 16 * kk);
                    f32x16 acc = zero16();
#pragma unroll
                    for (int kk = 0; kk < 4; ++kk) acc = MFMA32(afr[kk], bc[kk], acc);
#pragma unroll
                    for (int s = 0; s < 2; ++s) { float sc = 0.f;
#pragma unroll
                        for (int e = 0; e < 8; ++e) sc = fmaf(wv[s][e], fmaxf(acc[8 * s + e], 0.f), sc);
                        key[kt][s] = (c <= posq[s] - kt * 32) ? ordf(sc) : 0u; }
#pragma unroll
                    for (int kk = 0; kk < 4; ++kk) bc[kk] = bn[kk];
                } else { key[kt][0] = 0u; key[kt][1] = 0u; }
                __builtin_amdgcn_sched_barrier(0);
            }
            u32 lo[2], hi[2], thr[2]; bool done[2], exact[2];
#pragma unroll
            for (int s = 0; s < 2; ++s) { lo[s] = 0x00800000u; hi[s] = 0xFF800000u; thr[s] = 1u; exact[s] = true; done[s] = posq[s] < 256; }
            for (int iter = 0; iter < 40; ++iter) {
                if (__all(done[0] && done[1])) break;
                u32 mid[2]; int cnt[2];
#pragma unroll
                for (int s = 0; s < 2; ++s) { mid[s] = lo[s] + ((hi[s] - lo[s]) >> 1); cnt[s] = 0; }
#pragma unroll
                for (int kt = 0; kt < 64; ++kt) { cnt[0] += (key[kt][0] >= mid[0]) ? 1 : 0; cnt[1] += (key[kt][1] >= mid[1]) ? 1 : 0; }
#pragma unroll
                for (int s = 0; s < 2; ++s) {
#pragma unroll
                    for (int o = 1; o < 32; o <<= 1) cnt[s] += __shfl_xor(cnt[s], o);
                    if (!done[s]) { if (cnt[s] >= 256) lo[s] = mid[s]; else hi[s] = mid[s];
                        if (cnt[s] == 256) { thr[s] = mid[s]; exact[s] = true; done[s] = true; }
                        else if (hi[s] - lo[s] <= 1u) { thr[s] = lo[s]; exact[s] = false; done[s] = true; } } }
            }
            if (__all(exact[0] && exact[1])) {
#pragma unroll
                for (int kt = 0; kt < 64; ++kt) if (kt <= qb) {
#pragma unroll
                    for (int s = 0; s < 2; ++s) { const unsigned long long bal = __ballot(key[kt][s] >= thr[s]);
                        if (lane == 0) { mk[(4 * w + s) * 65 + kt] = (u32)bal; mk[(4 * w + 2 + s) * 65 + kt] = (u32)(bal >> 32); } } }
            } else {
#pragma unroll
                for (int s = 0; s < 2; ++s) {
                    int cgt = 0; const u32 lowk = exact[s] ? thr[s] : thr[s] + 1u;
#pragma unroll
                    for (int kt = 0; kt < 64; ++kt) cgt += (key[kt][s] >= lowk) ? 1 : 0;
#pragma unroll
                    for (int o = 1; o < 32; o <<= 1) cgt += __shfl_xor(cgt, o);
                    const int need = exact[s] ? 0 : 256 - cgt;
                    int rem0 = __shfl(need, 0), rem1 = __shfl(need, 32);
                    const u32 eqk = exact[s] ? 0xFFFFFFFFu : thr[s];
#pragma unroll
                    for (int kt = 0; kt < 64; ++kt) if (kt <= qb) {
                        const unsigned long long bg = __ballot(key[kt][s] >= lowk), be = __ballot(key[kt][s] == eqk);
                        u32 e0 = (u32)be, e1 = (u32)(be >> 32);
                        while (__popc(e0) > rem0) e0 &= ~(1u << (31 - __clz(e0)));
                        while (__popc(e1) > rem1) e1 &= ~(1u << (31 - __clz(e1)));
                        rem0 -= __popc(e0); rem1 -= __popc(e1);
                        if (lane == 0) { mk[(4 * w + s) * 65 + kt] = (u32)bg | e0; mk[(4 * w + 2 + s) * 65 + kt] = (u32)(bg >> 32) | e1; } }
                }
            }
        }
        __syncthreads();
        {
            bf16x8 qfr[4];
#pragma unroll
            for (int kk = 0; kk < 4; ++kk) qfr[kk] = ld8(Z + (size_t)(tok0 + c) * NZ + ZC_QD + w * 64 + 16 * kk + 8 * hl);
            float m = -1e30f, l = 0.f; f32x16 o0 = zero16(), o1 = zero16();
            const bf16_t* kb = kd + (size_t)(b * SEQ + c) * 64 + 8 * hl;
            const bf16_t* vb = vdT + ((size_t)b * 64 + c) * SEQ + 4 * hl;
            for (int kt = 0; kt <= qb; ++kt) {
                const u32 word = mk[c * 65 + kt];
                if (__ballot(word != 0u) == 0ull) continue;
                f32x16 s = zero16();
#pragma unroll
                for (int kk = 0; kk < 4; ++kk) s = MFMA32(ld8(kb + (size_t)kt * 32 * 64 + 16 * kk), qfr[kk], s);
                flash_tile(m, l, o0, o1, s, vm_from_word(word, hl), vb + kt * 32, (size_t)32 * SEQ);
            }
            const float f = 1.0f / fmaxf(l, 1e-30f);
#pragma unroll
            for (int R = 0; R < 16; ++R) { o0[R] *= f; o1[R] *= f; }
            store_ot(odsa + (size_t)(tok0 + c) * 512 + w * 64, o0, o1, hl);
        }
    }
}

namespace pg8 {
typedef short bf16x8 __attribute__((ext_vector_type(8)));
typedef float f32x4 __attribute__((ext_vector_type(4)));
typedef unsigned u32x4 __attribute__((ext_vector_type(4)));
constexpr int BM = 256, BK = 64, HALF = 128, HTB = HALF * BK * 2, STAGE_BYTES = 8 * HTB, NXCD = 8, WGM = 8;
__host__ __device__ __forceinline__ int lds_byte(int r, int c) { const int st = (r >> 4) * 2 + (c >> 5), rr = r & 15, cc = c & 31, ob = rr * 64 + cc * 2; return st * 1024 + (ob ^ (((ob >> 9) & 1) << 5)); }
__host__ __device__ __forceinline__ void stage_rc(int b, int& R, int& C) { const int st = b / 1024, sb = b % 1024, swz = sb ^ (((sb >> 9) & 1) << 5); R = (st >> 1) * 16 + swz / 64; C = (st & 1) * 32 + (swz % 64) / 2; }
__host__ __device__ __forceinline__ int perm32(int rho) { const int n = rho >> 4, i = rho & 15; return 8 * (i >> 2) + 4 * n + (i & 3); }
struct Unit { int pm, pn; };
struct Gemm { const bf16_t* A; const bf16_t* Bt; int M, N, K; };
struct StaticOrder {
    int nM, nN, nwg, G, c;
    __host__ __device__ void init(int M, int N, int G_, int c_) { nM = M / BM; nN = N / BM; nwg = nM * nN; G = G_; c = c_; }
    __host__ __device__ bool next(int i, Unit& u) const {
        const long L = (long)i * G + c; if (L >= nwg) return false;
        int wgid = (int)L; { const int q = nwg / NXCD, r = nwg % NXCD, xcd = wgid % NXCD, off = wgid / NXCD; wgid = (xcd < r ? xcd * (q + 1) : r * (q + 1) + (xcd - r) * q) + off; }
        const int nig = WGM * nN, gid = wgid / nig, fm = gid * WGM, gsz = (nM - fm) < WGM ? (nM - fm) : WGM;
        u.pm = fm + ((wgid % nig) % gsz); u.pn = (wgid % nig) / gsz; return true;
    }
    __device__ __forceinline__ void a_ready(const Unit&) const {}
    __device__ __forceinline__ void done(const Unit&) const {}
};
__device__ __forceinline__ unsigned cvt_pk_bf16(float lo, float hi) { unsigned r; asm volatile("v_cvt_pk_bf16_f32 %0, %1, %2" : "=v"(r) : "v"(lo), "v"(hi)); return r; }

template <class Epi, class Sched, bool ALIGN_EPI = false, bool SP2 = false>
__device__ __forceinline__ void gemm_phase(LAS unsigned char* lds, const Gemm g, const Sched& S, const Epi& E) {
    int tid = threadIdx.x; asm volatile("" : "+v"(tid));
    const int wid = __builtin_amdgcn_readfirstlane(tid >> 6), lane = tid & 63, wr = wid >> 2, wc = wid & 3, fr = lane & 15, fq = lane >> 4;
    const int K = g.K, nt = K / BK;
    unsigned voffA[2], voffB[2];
#pragma unroll
    for (int i = 0; i < 2; ++i) { int R, C; stage_rc(tid * 16 + i * 8192, R, C); const int Rb = Epi::PERM ? ((R & ~31) + perm32(R & 31)) : R;
        voffA[i] = (unsigned)(R * K + C) * 2u; voffB[i] = (unsigned)(Rb * K + C) * 2u; }
    const size_t kstep = (size_t)(BK * 2);
    const size_t hstep = (size_t)HALF * K * 2;
    const size_t tstep = 2 * hstep;
    const unsigned ldsw = (unsigned)wid * 1024u;
    const int aoff = lds_byte(wr * 64 + fr, fq * 8), boff = lds_byte(wc * 32 + fr, fq * 8);
#define PG8_SA(b, h) (((b) * 2 + (h)) * HTB)
#define PG8_SB(b, h) ((4 + (b) * 2 + (h)) * HTB)
#define PG8_STAGE(bufoff, gbase, voff) do { _Pragma("unroll") for (int _i = 0; _i < 2; ++_i) \
        __builtin_amdgcn_global_load_lds((const unsigned*)((const char*)(gbase) + (voff)[_i]), (LAS unsigned*)(lds + (bufoff) + ldsw + _i * 8192), 16, 0, 0); } while (0)
#define PG8_LDA(dst, b, h) do { _Pragma("unroll") for (int m = 0; m < 4; ++m) _Pragma("unroll") for (int k = 0; k < 2; ++k) dst[m][k] = *(const LAS bf16x8*)(lds + PG8_SA(b, h) + aoff + m * 2048 + k * 1024); } while (0)
#define PG8_LDB(dst, b, h) do { _Pragma("unroll") for (int n = 0; n < 2; ++n) _Pragma("unroll") for (int k = 0; k < 2; ++k) dst[n][k] = *(const LAS bf16x8*)(lds + PG8_SB(b, h) + boff + n * 2048 + k * 1024); } while (0)
#define PG8_MMA(ai, bj, At, Bt) do { __builtin_amdgcn_s_setprio(1); _Pragma("unroll") for (int m = 0; m < 4; ++m) _Pragma("unroll") for (int n = 0; n < 2; ++n) _Pragma("unroll") for (int k = 0; k < 2; ++k) \
        acc[ai][bj][m][n] = __builtin_amdgcn_mfma_f32_16x16x32_bf16(Bt[n][k], At[m][k], acc[ai][bj][m][n], 0, 0, 0); __builtin_amdgcn_s_setprio(0); } while (0)
#define PG8_WAIT_V(n) asm volatile("s_waitcnt vmcnt(" #n ")" ::: "memory")
#define PG8_WAIT_L(n) asm volatile("s_waitcnt lgkmcnt(" #n ")" ::: "memory")
#define PG8_BAR __builtin_amdgcn_s_barrier()
#define PG8_SCHED __builtin_amdgcn_sched_barrier(0)
    Unit cur, nxt; int ui = 0;
    if (!S.next(0, cur)) return;
    f32x4 acc[2][2][4][2];
#pragma unroll
    for (int a = 0; a < 2; ++a)
#pragma unroll
        for (int b = 0; b < 2; ++b)
#pragma unroll
            for (int m = 0; m < 4; ++m)
#pragma unroll
                for (int n = 0; n < 2; ++n) acc[a][b][m][n] = (f32x4){0.f, 0.f, 0.f, 0.f};
    bf16x8 At[4][2], B0[2][2], B1[2][2];
    const char* cA = (const char*)g.A + (size_t)cur.pm * tstep; const char* cB = (const char*)g.Bt + (size_t)cur.pn * tstep;
    S.a_ready(cur);
    if constexpr (SP2) {
        PG8_STAGE(PG8_SB(0, 0), cB, voffB); PG8_STAGE(PG8_SB(0, 1), cB + hstep, voffB); PG8_STAGE(PG8_SA(0, 0), cA, voffA); PG8_STAGE(PG8_SA(0, 1), cA + hstep, voffA);
        if (wr == 1) PG8_BAR;
        PG8_WAIT_V(2); PG8_BAR;
        PG8_STAGE(PG8_SB(1, 0), cB + kstep, voffB); PG8_STAGE(PG8_SA(1, 0), cA + kstep, voffA); PG8_STAGE(PG8_SB(1, 1), cB + hstep + kstep, voffB);
        PG8_WAIT_V(6); PG8_BAR;
    } else {
        PG8_STAGE(PG8_SB(0, 0), cB, voffB); PG8_STAGE(PG8_SA(0, 0), cA, voffA); PG8_STAGE(PG8_SB(0, 1), cB + hstep, voffB); PG8_STAGE(PG8_SA(0, 1), cA + hstep, voffA);
        if (wr == 1) PG8_BAR;
        PG8_WAIT_V(4); PG8_BAR;
        PG8_STAGE(PG8_SB(1, 0), cB + kstep, voffB); PG8_STAGE(PG8_SA(1, 0), cA + kstep, voffA); PG8_STAGE(PG8_SB(1, 1), cB + hstep + kstep, voffB);
        PG8_WAIT_V(6); PG8_BAR;
    }
    for (;;) {
        const bool has_next = S.next(ui + 1, nxt);
        const char* nA = has_next ? (const char*)g.A + (size_t)nxt.pm * tstep : cA; const char* nB = has_next ? (const char*)g.Bt + (size_t)nxt.pn * tstep : cB;
        for (int t = 0; t < nt; t += 2) {
            const bool last = (t == nt - 2);
            const char* a1 = cA + (size_t)(t + 1) * kstep;
            const char* a2 = last ? nA : cA + (size_t)(t + 2) * kstep; const char* b2 = last ? nB : cB + (size_t)(t + 2) * kstep;
            const char* a3 = a2 + kstep; const char* b3 = b2 + kstep;
            if (last && has_next) S.a_ready(nxt);
            if constexpr (SP2) {
            PG8_LDB(B0, 0, 0); PG8_LDB(B1, 0, 1); PG8_SCHED; PG8_LDA(At, 0, 0); PG8_STAGE(PG8_SA(1, 1), a1 + hstep, voffA);
            PG8_WAIT_V(8); PG8_WAIT_L(0); PG8_BAR; PG8_MMA(0, 0, At, B0); PG8_MMA(0, 1, At, B1); PG8_BAR; PG8_SCHED;
            PG8_LDA(At, 0, 1); PG8_STAGE(PG8_SB(0, 0), b2, voffB); PG8_STAGE(PG8_SB(0, 1), b2 + hstep, voffB); PG8_STAGE(PG8_SA(0, 0), a2, voffA);
            PG8_WAIT_V(8); PG8_WAIT_L(0); PG8_BAR; PG8_MMA(1, 0, At, B0); PG8_MMA(1, 1, At, B1); PG8_BAR; PG8_SCHED;
            PG8_LDB(B0, 1, 0); PG8_LDB(B1, 1, 1); PG8_SCHED; PG8_LDA(At, 1, 0); PG8_STAGE(PG8_SA(0, 1), a2 + hstep, voffA);
            PG8_WAIT_V(8); PG8_WAIT_L(0); PG8_BAR; PG8_MMA(0, 0, At, B0); PG8_MMA(0, 1, At, B1); PG8_BAR; PG8_SCHED;
            PG8_LDA(At, 1, 1); PG8_STAGE(PG8_SB(1, 0), b3, voffB); PG8_STAGE(PG8_SB(1, 1), b3 + hstep, voffB); PG8_STAGE(PG8_SA(1, 0), a3, voffA);
            PG8_WAIT_V(8); PG8_WAIT_L(0); PG8_BAR; PG8_MMA(1, 0, At, B0); PG8_MMA(1, 1, At, B1); PG8_BAR; PG8_SCHED;
            } else {
            PG8_LDB(B0, 0, 0); PG8_SCHED; PG8_LDA(At, 0, 0); PG8_STAGE(PG8_SA(1, 1), a1 + hstep, voffA);
            PG8_WAIT_L(8); PG8_BAR; PG8_WAIT_L(0); PG8_MMA(0, 0, At, B0); PG8_BAR; PG8_SCHED;
            PG8_LDB(B1, 0, 1); PG8_STAGE(PG8_SB(0, 0), b2, voffB);
            PG8_BAR; PG8_WAIT_L(0); PG8_MMA(0, 1, At, B1); PG8_BAR;
            PG8_LDA(At, 0, 1); PG8_STAGE(PG8_SA(0, 0), a2, voffA);
            PG8_BAR; PG8_WAIT_L(0); PG8_MMA(1, 0, At, B0); PG8_BAR; PG8_SCHED;
            PG8_STAGE(PG8_SB(0, 1), b2 + hstep, voffB);
            PG8_WAIT_V(6); PG8_BAR; PG8_MMA(1, 1, At, B1); PG8_BAR;
            PG8_LDB(B0, 1, 0); PG8_SCHED; PG8_LDA(At, 1, 0); PG8_STAGE(PG8_SA(0, 1), a2 + hstep, voffA);
            PG8_WAIT_L(8); PG8_BAR; PG8_WAIT_L(0); PG8_MMA(0, 0, At, B0); PG8_BAR; PG8_SCHED;
            PG8_LDB(B1, 1, 1); PG8_STAGE(PG8_SB(1, 0), b3, voffB);
            PG8_BAR; PG8_WAIT_L(0); PG8_MMA(0, 1, At, B1); PG8_BAR;
            PG8_LDA(At, 1, 1); PG8_STAGE(PG8_SA(1, 0), a3, voffA);
            PG8_BAR; PG8_WAIT_L(0); PG8_MMA(1, 0, At, B0); PG8_BAR; PG8_SCHED;
            PG8_STAGE(PG8_SB(1, 1), b3 + hstep, voffB);
            PG8_WAIT_V(6); PG8_BAR; PG8_MMA(1, 1, At, B1); PG8_BAR;
            }
        }
        if constexpr (ALIGN_EPI) { if (wr == 0) PG8_BAR; }
        if constexpr (!Epi::AFTER_DRAIN) { E(acc, cur, wr, wc, fr, fq); S.done(cur); }
        if (!has_next) break;
#pragma unroll
        for (int a = 0; a < 2; ++a)
#pragma unroll
            for (int b = 0; b < 2; ++b)
#pragma unroll
                for (int m = 0; m < 4; ++m)
#pragma unroll
                    for (int n = 0; n < 2; ++n) acc[a][b][m][n] = (f32x4){0.f, 0.f, 0.f, 0.f};
        cur = nxt; cA = nA; cB = nB; ++ui;
        if constexpr (ALIGN_EPI) { if (wr == 1) PG8_BAR; }
    }
    PG8_WAIT_V(0);
    if constexpr (!ALIGN_EPI) { if (wr == 0) PG8_BAR; }
    PG8_BAR;
#undef PG8_SA
#undef PG8_SB
#undef PG8_STAGE
#undef PG8_LDA
#undef PG8_LDB
#undef PG8_MMA
#undef PG8_WAIT_V
#undef PG8_WAIT_L
#undef PG8_BAR
#undef PG8_SCHED
}
struct EpiZ {
    static constexpr bool PERM = true, AFTER_DRAIN = false;
    bf16_t* Z; const float* cosT; const float* sinT;
    __device__ __forceinline__ void operator()(const f32x4 (&acc)[2][2][4][2], const Unit& u, int wr, int wc, int fr, int fq) const {
#pragma unroll
        for (int bj = 0; bj < 2; ++bj) {
            const int cb = u.pn * BM + bj * HALF + wc * 32;
            const int g64 = cb >> 6; const int c0 = cb + 8 * fq;
            const bool roped = (g64 < 64) && ((ROPE_MASK >> g64) & 1ull);
            const bool sig = (cb >= ZC_GM) || (c0 >= ZC_GN && c0 < ZC_WI);
            const float sc = ((g64 < 64) && ((SCALE_MASK >> g64) & 1ull)) ? 0.125f : 1.0f;
#pragma unroll
            for (int ai = 0; ai < 2; ++ai)
#pragma unroll
                for (int m = 0; m < 4; ++m) {
                    const int row = u.pm * BM + ai * HALF + wr * 64 + m * 16 + fr;
                    f32x4 v0 = acc[ai][bj][m][0], v1 = acc[ai][bj][m][1];
                    if (roped) {
                        const int pos = row & (SEQ - 1), i0 = (c0 & 63) >> 1;
                        const f32x4 cs = *(const f32x4*)(cosT + pos * 32 + i0), sn = *(const f32x4*)(sinT + pos * 32 + i0);
                        const f32x4 a = v0, b = v1;
                        v0[0] = (a[0] * cs[0] - a[1] * sn[0]) * sc; v0[1] = (a[1] * cs[0] + a[0] * sn[0]) * sc;
                        v0[2] = (a[2] * cs[1] - a[3] * sn[1]) * sc; v0[3] = (a[3] * cs[1] + a[2] * sn[1]) * sc;
                        v1[0] = (b[0] * cs[2] - b[1] * sn[2]) * sc; v1[1] = (b[1] * cs[2] + b[0] * sn[2]) * sc;
                        v1[2] = (b[2] * cs[3] - b[3] * sn[3]) * sc; v1[3] = (b[3] * cs[3] + b[2] * sn[3]) * sc;
                    } else if (sig) {
#pragma unroll
                        for (int e = 0; e < 4; ++e) { v0[e] = sigmoidf_(v0[e]); v1[e] = sigmoidf_(v1[e]); }
                    }
                    u32x4 w; w.x = cvt_pk_bf16(v0[0], v0[1]); w.y = cvt_pk_bf16(v0[2], v0[3]); w.z = cvt_pk_bf16(v1[0], v1[1]); w.w = cvt_pk_bf16(v1[2], v1[3]);
                    *(u32x4*)(Z + (size_t)row * NZ + c0) = w;
                }
        }
    }
};
struct EpiMerge {
    static constexpr bool PERM = true, AFTER_DRAIN = false;
    bf16_t* O; const bf16_t* Zg; int mode;
    __device__ __forceinline__ void operator()(const f32x4 (&acc)[2][2][4][2], const Unit& u, int wr, int wc, int fr, int fq) const {
#pragma unroll
        for (int ai = 0; ai < 2; ++ai)
#pragma unroll
            for (int m = 0; m < 4; ++m) { const int row = u.pm * BM + ai * HALF + wr * 64 + m * 16 + fr;
#pragma unroll
                for (int bj = 0; bj < 2; ++bj) { const int c0 = u.pn * BM + bj * HALF + wc * 32 + 8 * fq;
                    const u32x4 gz = *(const u32x4*)(Zg + (size_t)row * NZ + c0);
                    f32x4 v0 = acc[ai][bj][m][0], v1 = acc[ai][bj][m][1];
                    v0[0] *= bflo(gz.x); v0[1] *= bfhi(gz.x); v0[2] *= bflo(gz.y); v0[3] *= bfhi(gz.y); v1[0] *= bflo(gz.z); v1[1] *= bfhi(gz.z); v1[2] *= bflo(gz.w); v1[3] *= bfhi(gz.w);
                    bf16_t* op = O + (size_t)row * D + c0;
                    if (mode) { const u32x4 o = *(const u32x4*)op;
                        v0[0] += bflo(o.x); v0[1] += bfhi(o.x); v0[2] += bflo(o.y); v0[3] += bfhi(o.y); v1[0] += bflo(o.z); v1[1] += bfhi(o.z); v1[2] += bflo(o.w); v1[3] += bfhi(o.w); }
                    u32x4 w; w.x = cvt_pk_bf16(v0[0], v0[1]); w.y = cvt_pk_bf16(v0[2], v0[3]); w.z = cvt_pk_bf16(v1[0], v1[1]); w.w = cvt_pk_bf16(v1[2], v1[3]);
                    *(u32x4*)op = w; } }
    }
};
struct EpiOut {
    static constexpr bool PERM = true, AFTER_DRAIN = false;
    const float* x; float* o; const float* mod;
    __device__ __forceinline__ void operator()(const f32x4 (&acc)[2][2][4][2], const Unit& u, int wr, int wc, int fr, int fq) const {
#pragma unroll
        for (int ai = 0; ai < 2; ++ai)
#pragma unroll
            for (int m = 0; m < 4; ++m) { const int row = u.pm * BM + ai * HALF + wr * 64 + m * 16 + fr; const float* g1 = mod + (row >> 11) * 6144 + 2048;
#pragma unroll
                for (int bj = 0; bj < 2; ++bj) { const int c0 = u.pn * BM + bj * HALF + wc * 32 + 8 * fq;
#pragma unroll
                    for (int n = 0; n < 2; ++n) { const f32x4 gg = *(const f32x4*)(g1 + c0 + 4 * n), xx = *(const f32x4*)(x + (size_t)row * D + c0 + 4 * n);
                        *(f32x4*)(o + (size_t)row * D + c0 + 4 * n) = xx + gg * acc[ai][bj][m][n]; } } }
    }
};
struct EpiF32 {
    static constexpr bool PERM = true, AFTER_DRAIN = false;
    float* O; int ldc;
    __device__ __forceinline__ void operator()(const f32x4 (&acc)[2][2][4][2], const Unit& u, int wr, int wc, int fr, int fq) const {
#pragma unroll
        for (int ai = 0; ai < 2; ++ai)
#pragma unroll
            for (int m = 0; m < 4; ++m) { const int row = u.pm * BM + ai * HALF + wr * 64 + m * 16 + fr;
#pragma unroll
                for (int bj = 0; bj < 2; ++bj) { const int c0 = u.pn * BM + bj * HALF + wc * 32 + 8 * fq;
                    *(f32x4*)(O + (size_t)row * ldc + c0) = acc[ai][bj][m][0]; *(f32x4*)(O + (size_t)row * ldc + c0 + 4) = acc[ai][bj][m][1]; } }
    }
};
}

template <bool ZMAP>
__device__ __forceinline__ void transpose_item(const float* W, int K, int Nsrc, bf16_t* WT, LAS float* scr, int item, int nblk, int lane) {
    const int kb = item / nblk, nb = item % nblk, k0 = 64 * kb, n0 = 32 * nb;
    int sc = n0 + (lane & 31); if (ZMAP) sc = z_logical_col(sc);
#pragma unroll 8
    for (int i = 0; i < 32; ++i) { const int kk = 2 * i + (lane >> 5); scr[kk * 33 + (lane & 31)] = (sc >= 0) ? W[(size_t)(k0 + kk) * Nsrc + sc] : 0.f; }
    asm volatile("s_waitcnt lgkmcnt(0)" ::: "memory");
    const int c = lane & 7;
#pragma unroll
    for (int j = 0; j < 4; ++j) { const int n = (lane >> 3) + 8 * j; const LAS float* s = scr + (8 * c) * 33 + n;
        uint4 o; o.x = pk2(s[0 * 33], s[1 * 33]); o.y = pk2(s[2 * 33], s[3 * 33]); o.z = pk2(s[4 * 33], s[5 * 33]); o.w = pk2(s[6 * 33], s[7 * 33]);
        *(uint4*)(WT + (size_t)(n0 + n) * K + k0 + 8 * c) = o; }
    asm volatile("s_waitcnt lgkmcnt(0)" ::: "memory");
}
__device__ __forceinline__ void st_convert(const Params& p, unsigned char* lds) {
    const int tid = threadIdx.x, lane = tid & 63, w = __builtin_amdgcn_readfirstlane(tid >> 6);
    LAS float* scr = (LAS float*)((LAS unsigned char*)lds + 49152 + w * 8704);
    const int gw = blockIdx.x * 8 + w, NGW = gridDim.x * 8;
    constexpr int I_IN = 16 * 144, I_BR = 8 * 32, I_OUT = 16 * 32;
    for (int it = gw; it < I_IN + 2 * I_BR + I_OUT; it += NGW) {
        int r = it;
        if (r < I_IN) { transpose_item<true>(p.w_in, D, DIN, (bf16_t*)(p.ws + WS_WINT), scr, r, 144, lane); continue; } r -= I_IN;
        if (r < I_BR) { transpose_item<false>(p.w_nsa, 512, D, (bf16_t*)(p.ws + WS_WNSAT), scr, r, 32, lane); continue; } r -= I_BR;
        if (r < I_BR) { transpose_item<false>(p.w_dsa, 512, D, (bf16_t*)(p.ws + WS_WDSAT), scr, r, 32, lane); continue; } r -= I_BR;
        transpose_item<false>(p.w_out, D, D, (bf16_t*)(p.ws + WS_WOUTT), scr, r, 32, lane);
    }
    bf16_t* wf = (bf16_t*)(p.ws + WS_WFOLDT);
    for (int it = blockIdx.x * NTHR + tid; it < 2048 * 1024 / 2; it += gridDim.x * NTHR) {
        const int k = (it & 511) * 2, col = it >> 9, hc = col >> 7;
        const float* sk = p.subkeys + (size_t)col * 64; const float* q0 = p.wq + (size_t)k * D + hc * 64; const float* q1 = q0 + D;
        float a0 = 0.f, a1 = 0.f;
#pragma unroll 8
        for (int d = 0; d < 64; d += 4) { const float4 s4 = *(const float4*)(sk + d), x0 = *(const float4*)(q0 + d), x1 = *(const float4*)(q1 + d);
            a0 += s4.x * x0.x + s4.y * x0.y + s4.z * x0.z + s4.w * x0.w; a1 += s4.x * x1.x + s4.y * x1.y + s4.z * x1.z + s4.w * x1.w; }
        *(u32*)(wf + (size_t)col * D + k) = pk2(a0, a1);
    }
}
__device__ __forceinline__ void st_z_gemm(const Params& p, unsigned char* lds) {
    pg8::Gemm g{(const bf16_t*)(p.ws + WS_HB), (const bf16_t*)(p.ws + WS_WINT), T, NZ, D}; pg8::StaticOrder S; S.init(T, NZ, gridDim.x, blockIdx.x);
    pg8::EpiZ E{(bf16_t*)(p.ws + WS_Z), (const float*)(p.ws + WS_COS), (const float*)(p.ws + WS_SIN)};
    pg8::gemm_phase<pg8::EpiZ, pg8::StaticOrder, true, true>((LAS unsigned char*)lds, g, S, E);
}
__device__ __forceinline__ void st_merge_gemm(const Params& p, unsigned char* lds) {
    pg8::StaticOrder S; S.init(T, D, gridDim.x, blockIdx.x);
    { pg8::Gemm g{(const bf16_t*)(p.ws + WS_ONSA), (const bf16_t*)(p.ws + WS_WNSAT), T, D, 512};
      pg8::EpiMerge E{(bf16_t*)(p.ws + WS_MERGED), (const bf16_t*)(p.ws + WS_Z) + ZC_GM, 0};
      pg8::gemm_phase<pg8::EpiMerge, pg8::StaticOrder, true, true>((LAS unsigned char*)lds, g, S, E); }
    asm volatile("s_waitcnt vmcnt(0)" ::: "memory"); __syncthreads();
    { pg8::Gemm g{(const bf16_t*)(p.ws + WS_ODSA), (const bf16_t*)(p.ws + WS_WDSAT), T, D, 512};
      pg8::EpiMerge E{(bf16_t*)(p.ws + WS_MERGED), (const bf16_t*)(p.ws + WS_Z) + ZC_GM + 1024, 1};
      pg8::gemm_phase<pg8::EpiMerge, pg8::StaticOrder, true, true>((LAS unsigned char*)lds, g, S, E); }
}
__device__ __forceinline__ void st_out_gemm(const Params& p, unsigned char* lds) {
    pg8::Gemm g{(const bf16_t*)(p.ws + WS_MERGED), (const bf16_t*)(p.ws + WS_WOUTT), T, D, D}; pg8::StaticOrder S; S.init(T, D, gridDim.x, blockIdx.x);
    pg8::EpiOut E{p.x, p.out, (const float*)(p.ws + WS_MOD)};
    pg8::gemm_phase<pg8::EpiOut, pg8::StaticOrder, true, true>((LAS unsigned char*)lds, g, S, E);
}
__device__ __forceinline__ void st_ssub_gemm(const Params& p, unsigned char* lds) {
    pg8::Gemm g{(const bf16_t*)(p.ws + WS_H2), (const bf16_t*)(p.ws + WS_WFOLDT), T, 2048, D}; pg8::StaticOrder S; S.init(T, 2048, gridDim.x, blockIdx.x);
    pg8::EpiF32 E{(float*)(p.ws + WS_SSUB), 2048};
    pg8::gemm_phase<pg8::EpiF32, pg8::StaticOrder, true, true>((LAS unsigned char*)lds, g, S, E);
}

#define XB_TMO      128
#define XB_XCNT(j)  (256  + 64 * (j))
#define XB_XSUB(j)  (1280 + 64 * (j))
#define XB_XGEN(j)  (2304 + 64 * (j))
#define XB_TOP      3328
#define XB_TOPGEN   3392
#define XCD_BAR_WORDS 3456
#define XB_SPIN_CAP (1u << 22)
__device__ __forceinline__ unsigned xb_ld(unsigned* p)              { return __hip_atomic_load(p, __ATOMIC_RELAXED, __HIP_MEMORY_SCOPE_AGENT); }
__device__ __forceinline__ unsigned xb_add(unsigned* p, unsigned v) { return __hip_atomic_fetch_add(p, v, __ATOMIC_RELAXED, __HIP_MEMORY_SCOPE_AGENT); }
__device__ __forceinline__ unsigned xb_xcc_id() { return (unsigned)__builtin_amdgcn_s_getreg((3 << 11) | 20) & 0xFu; }
#define XB_SPIN(cond, bar) do { unsigned _sp = 0; while (cond) { __builtin_amdgcn_s_sleep(1); \
    if ((++_sp & 255u) == 0u) { if (xb_ld(&(bar)[XB_TMO])) break; if (_sp > XB_SPIN_CAP) { atomicAdd(&(bar)[XB_TMO], 1u); break; } } } } while (0)
struct XcdBarrier { unsigned* bar; unsigned x; volatile LAS unsigned* st; };
__device__ __forceinline__ XcdBarrier xcd_barrier_post(unsigned* bar, volatile LAS unsigned* st) {
    XcdBarrier b; b.bar = bar; b.x = xb_xcc_id(); b.st = st;
    if (threadIdx.x == 0) (void)xb_add(&bar[XB_XCNT(b.x)], 1u);
    return b;
}
__device__ __forceinline__ void xcd_barrier_complete(unsigned* bar, unsigned x, unsigned& nloc, unsigned& nx) {
    const unsigned G = gridDim.x * gridDim.y * gridDim.z;
    unsigned sum, cnt, mine, sp = 0u;
    for (;;) {
        sum = 0u; cnt = 0u; mine = 0u;
#pragma unroll
        for (unsigned j = 0; j < 16; ++j) { const unsigned c = xb_ld(&bar[XB_XCNT(j)]); sum += c; cnt += (c > 0u) ? 1u : 0u; mine = (j == x) ? c : mine; }
        if (sum == G) break;
        __builtin_amdgcn_s_sleep(1);
        if ((++sp & 255u) == 0u) { if (xb_ld(&bar[XB_TMO])) break; if (sp > XB_SPIN_CAP) { atomicAdd(&bar[XB_TMO], 1u); break; } }
    }
    nloc = mine > 0u ? mine : 1u; nx = cnt > 0u ? cnt : 1u;
}
__device__ __forceinline__ void xcd_barrier(const XcdBarrier& b) {
    asm volatile("s_waitcnt vmcnt(0)" ::: "memory");
    __syncthreads();
    if (threadIdx.x == 0) {
        unsigned* bar = b.bar;
        __builtin_amdgcn_s_waitcnt(0);
        unsigned nloc = b.st[0], nx = b.st[1];
        if (nloc == 0u) { xcd_barrier_complete(bar, b.x, nloc, nx); b.st[0] = nloc; b.st[1] = nx; }
        const unsigned old = xb_add(&bar[XB_XSUB(b.x)], 1u);
        const unsigned gen = old / nloc;
        if (old + 1u == (gen + 1u) * nloc) {
            __builtin_amdgcn_fence(__ATOMIC_RELEASE, "agent");
            asm volatile("s_waitcnt vmcnt(0)" ::: "memory");
            const unsigned og = xb_add(&bar[XB_TOP], 1u);
            const unsigned tg = og / nx;
            if (og + 1u == (tg + 1u) * nx) xb_add(&bar[XB_TOPGEN], 1u);
            else XB_SPIN(xb_ld(&bar[XB_TOPGEN]) == tg, bar);
            __builtin_amdgcn_fence(__ATOMIC_ACQUIRE, "agent");
            xb_add(&bar[XB_XGEN(b.x)], 1u);
            asm volatile("s_waitcnt vmcnt(0)" ::: "memory");
        } else {
            XB_SPIN(xb_ld(&bar[XB_XGEN(b.x)]) == gen, bar);
            __builtin_amdgcn_fence(__ATOMIC_ACQUIRE, "agent");
            asm volatile("s_waitcnt vmcnt(0)" ::: "memory");
        }
    }
    __syncthreads();
}

constexpr int LDS_BYTES = 131072 + 1024;
constexpr int LDS_CTL = 131072;
__global__ void __launch_bounds__(NTHR, 2) k_mega(Params p) {
    extern __shared__ __attribute__((aligned(16))) unsigned char smem[];
    if (threadIdx.x < 4) ((volatile LAS unsigned*)(smem + LDS_CTL))[threadIdx.x] = 0u;
    __syncthreads();
    XcdBarrier bar = xcd_barrier_post((unsigned*)(p.ws + WS_BAR), (volatile LAS unsigned*)(smem + LDS_CTL));
#define GBAR() xcd_barrier(bar)
    st_adaln(p, smem);
    st_convert(p, smem);      GBAR();
    st_norm_rows(p, 0);       GBAR();
    st_z_gemm(p, smem);       GBAR();
    st_prep_a_naive(p);       GBAR();
    st_prep_b_naive(p);       GBAR();
    st_nsa(p);                __syncthreads();
    st_dsa(p, smem);          GBAR();
    st_merge_gemm(p, smem);   GBAR();
    st_out_gemm(p, smem);     GBAR();
    st_norm_rows(p, 1);       GBAR();
    st_ssub_gemm(p, smem);    GBAR();
    st_route(p);
    st_cvt_uv(p);             GBAR();
    st_expert(p, smem);
}

extern "C" void kernel_launch(void* const* d_in, const int* in_sizes, int n_in, void* d_out, int out_size, void* d_ws, size_t ws_size, hipStream_t stream) {
    static int grid = 0;
    if (grid == 0) {
        int dev = 0, cus = 0, per_cu = 0;
        hipGetDevice(&dev); hipDeviceGetAttribute(&cus, hipDeviceAttributeMultiprocessorCount, dev);
        hipFuncSetAttribute((const void*)k_mega, hipFuncAttributeMaxDynamicSharedMemorySize, LDS_BYTES);
        hipOccupancyMaxActiveBlocksPerMultiprocessor(&per_cu, (const void*)k_mega, NTHR, LDS_BYTES);
        if (per_cu < 1) { fprintf(stderr, "kernel_launch: occupancy query says %d blocks/CU\n", per_cu); per_cu = 1; }
        (void)hipGetLastError();
        grid = cus;
    }
    Params p{};
    const float** f = (const float**)&p;
    for (int i = 0; i < 23; ++i) f[i] = (const float*)d_in[i];
    p.out = (float*)d_out; p.ws = (unsigned char*)d_ws;
    hipMemsetAsync((unsigned char*)d_ws + WS_BAR, 0, 16384, stream);
    hipLaunchKernelGGL(k_mega, dim3(grid), dim3(NTHR), LDS_BYTES, stream, p);
}
#ifdef TESTK
__global__ void __launch_bounds__(NTHR, 2) k_t_nsa(Params p) { st_nsa(p); }
__global__ void __launch_bounds__(NTHR, 2) k_t_dsa(Params p) { extern __shared__ __attribute__((aligned(16))) unsigned char smem[]; st_dsa(p, smem); }
#endif
```

```cpp
#include <hip/hip_runtime.h>
#include <stdint.h>
#include <stdio.h>

#define LAS __attribute__((address_space(3)))
typedef unsigned short bf16_t;
typedef unsigned int u32;

constexpr int T = 16384, SEQ = 2048, NB = 8, D = 1024, NZ = 4608, DIN = 4576;
constexpr int NTHR = 512;
constexpr float EPS = 1e-6f;
constexpr int ZC_QN = 0, ZC_KC = 512, ZC_VC = 640, ZC_KS = 768, ZC_VS = 896, ZC_KW = 1024, ZC_VW = 1152, ZC_QD = 1280, ZC_CKV = 1792,
              ZC_QI = 1920, ZC_KI = 2432, ZC_GN = 2496, ZC_WI = 2520, ZC_GM = 2560;
constexpr unsigned long long ROPE_MASK = 0xFFull | (3ull << 8) | (3ull << 12) | (3ull << 16) | (0xFFull << 20) | (0xFFull << 30) | (1ull << 38);
constexpr unsigned long long SCALE_MASK = 0xFFull | (0xFFull << 20) | (0xFFull << 30);

constexpr size_t WS_Z = 0;
constexpr size_t WS_SSUB = 0;
constexpr size_t WS_EIDX = 134217728;
constexpr size_t WS_GATE = 142606336;
constexpr size_t WS_MERGED = 150994944;
constexpr size_t WS_U16 = WS_MERGED;
constexpr size_t WS_HB = 184549376;
constexpr size_t WS_ONSA = WS_HB;
constexpr size_t WS_ODSA = WS_HB + 16777216;
constexpr size_t WS_V16 = WS_HB;
constexpr size_t WS_H2 = 218103808;
constexpr size_t WS_W = 251658240;
constexpr size_t WS_WINT = WS_H2;
constexpr size_t WS_WNSAT = WS_W;
constexpr size_t WS_WDSAT = WS_WNSAT + 1048576;
constexpr size_t WS_WOUTT = WS_WDSAT + 1048576;
constexpr size_t WS_WFOLDT = WS_WOUTT + 2097152;
constexpr size_t WS_SMALL = WS_WFOLDT + 4194304;
constexpr size_t WS_MOD = WS_SMALL;
constexpr size_t WS_COS = WS_MOD + 196608;
constexpr size_t WS_SIN = WS_COS + 262144;
constexpr size_t WS_BAR = WS_SIN + 262144;
constexpr size_t WS_W1T = WS_BAR + 16384;
constexpr size_t WS_BPOS = WS_W1T + 524288;
constexpr size_t WS_END_SMALL = WS_BPOS + 512;
static_assert(WS_END_SMALL <= 268435456, "ws overflow");
constexpr size_t DO_KD = 0;
constexpr size_t DO_VDT = 2097152;
constexpr size_t DO_VST = 4194304;
constexpr size_t DO_VWT = 8388608;
constexpr size_t DO_KCMP = 12582912;
constexpr size_t DO_VCMPT = 12845056;
constexpr size_t DO_HID = 13107200;
constexpr size_t DO_MASK = 14680064;
constexpr size_t DO_END = DO_MASK + 4194304;

struct Params {
    const float *x, *c, *ada_w, *ada_b, *norm1_g, *w_in, *cmp_pos, *w1k, *w2k, *w1v, *w2v, *kvg, *w_uk, *w_uv, *w_nsa, *w_dsa, *w_out, *norm2_g, *wq,
        *subkeys, *pu, *pv, *final_g;
    float* out;
    unsigned char* ws;
};

__device__ __forceinline__ bf16_t f2bf(float f) { u32 u = __float_as_uint(f); u += 0x7fffu + ((u >> 16) & 1u); return (bf16_t)(u >> 16); }
__device__ __forceinline__ float bf2f(bf16_t h) { return __uint_as_float((u32)h << 16); }
__device__ __forceinline__ float bflo(u32 w) { return __uint_as_float(w << 16); }
__device__ __forceinline__ float bfhi(u32 w) { return __uint_as_float(w & 0xffff0000u); }
__device__ __forceinline__ u32 pk2(float lo, float hi) { return (u32)f2bf(lo) | ((u32)f2bf(hi) << 16); }
__device__ __forceinline__ float wave_sum(float v) {
#pragma unroll
    for (int o = 1; o < 64; o <<= 1) v += __shfl_xor(v, o);
    return v;
}
__device__ __forceinline__ float wave_max(float v) {
#pragma unroll
    for (int o = 1; o < 64; o <<= 1) v = fmaxf(v, __shfl_xor(v, o));
    return v;
}
__device__ __forceinline__ float sigmoidf_(float v) { return 1.0f / (1.0f + __expf(-v)); }
__device__ __forceinline__ float gelu_tanh(float v) { const float u = 0.7978845608028654f * (v + 0.044715f * v * v * v); return 0.5f * v * (1.0f + tanhf(u)); }
__device__ __forceinline__ float gelu_erf(float v) { return 0.5f * v * (1.0f + erff(v * 0.7071067811865476f)); }
__device__ __forceinline__ int z_logical_col(int pc) {
    const int g64 = pc >> 6; const int o = pc & 63;
    const int po = (g64 < 64 && ((ROPE_MASK >> g64) & 1ull)) ? ((o >> 1) + 32 * (o & 1)) : o;
    const int pp = (pc & ~63) + po;
    if (pc < 1280) return pp;
    if (pc < 1792) return 1304 + (pp - 1280);
    if (pc < 1920) return 1816 + (pp - 1792);
    if (pc < 2432) return 1944 + (pp - 1920);
    if (pc < 2496) return 2456 + (pp - 2432);
    if (pc < 2520) return 1280 + (pc - 2496);
    if (pc < 2528) return 2520 + (pc - 2520);
    if (pc < 2560) return -1;
    return 2528 + (pc - 2560);
}
__device__ __forceinline__ void z_post(int t, int pc, float& v0, float& v1, const float* cosT, const float* sinT) {
    const int g64 = pc >> 6;
    if (g64 < 64 && ((ROPE_MASK >> g64) & 1ull)) {
        const int i = (pc & 63) >> 1, pos = t & (SEQ - 1);
        const float c = cosT[pos * 32 + i], s = sinT[pos * 32 + i];
        const float a = v0 * c - v1 * s, b = v1 * c + v0 * s;
        const float sc = ((SCALE_MASK >> g64) & 1ull) ? 0.125f : 1.0f;
        v0 = a * sc; v1 = b * sc;
    } else if (pc >= ZC_GM || (pc >= ZC_GN && pc < ZC_WI)) { v0 = sigmoidf_(v0); v1 = sigmoidf_(v1); }
}
__device__ __forceinline__ void sincos_tab(float ang, float& s, float& c) {
    const double a = (double)ang; const double k = rint(a * 0.63661977236758134308);
    const float r = (float)(a - k * 1.57079632679489661923); const float z = r * r;
    const float sp = ((-1.9515295891e-4f * z + 8.3321608736e-3f) * z - 1.6666654611e-1f) * z * r + r;
    const float cp = ((2.443315711809948e-5f * z - 1.388731625493765e-3f) * z + 4.166664568298827e-2f) * z * z - 0.5f * z + 1.0f;
    const int q = ((int)k) & 3;
    s = (q == 0) ? sp : (q == 1) ? cp : (q == 2) ? -sp : -cp;
    c = (q == 0) ? cp : (q == 1) ? -sp : (q == 2) ? -cp : sp;
}

__device__ __forceinline__ void st_adaln(const Params& p, unsigned char* lds) {
    const int tid = threadIdx.x, lane = tid & 63, w = tid >> 6;
    float* cosT = (float*)(p.ws + WS_COS); float* sinT = (float*)(p.ws + WS_SIN);
    for (int i = blockIdx.x * NTHR + tid; i < SEQ * 32; i += gridDim.x * NTHR) {
        const int pos = i >> 5, f = i & 31; const float inv = powf(10000.0f, -(float)f / 32.0f);
        float s, c; sincos_tab((float)pos * inv, s, c); cosT[i] = c; sinT[i] = s;
    }
    float* sc = (float*)lds;
    float* red = sc + 8192;
    for (int i = tid; i < 8192; i += NTHR) { const float v = p.c[i]; sc[i] = v / (1.0f + __expf(-v)); }
    __syncthreads();
    float* mod = (float*)(p.ws + WS_MOD);
    for (int unit = blockIdx.x; unit < 192; unit += gridDim.x) {
        float acc[8];
#pragma unroll
        for (int b = 0; b < 8; ++b) acc[b] = 0.f;
        const int col = unit * 32 + (lane & 31), ks = lane >> 5;
        for (int kk = 0; kk < 64; ++kk) {
            const int k = w * 128 + kk * 2 + ks; const float wv = p.ada_w[(size_t)k * 6144 + col];
#pragma unroll
            for (int b = 0; b < 8; ++b) acc[b] += sc[b * 1024 + k] * wv;
        }
#pragma unroll
        for (int b = 0; b < 8; ++b) red[((w * 2 + ks) * 8 + b) * 32 + (lane & 31)] = acc[b];
        __syncthreads();
        if (tid < 256) { const int b = tid >> 5, c = tid & 31; float s = 0.f;
            for (int j = 0; j < 16; ++j) s += red[(j * 8 + b) * 32 + c];
            mod[b * 6144 + unit * 32 + c] = s + p.ada_b[unit * 32 + c]; }
        __syncthreads();
    }
}
__device__ __forceinline__ void st_norm_rows(const Params& p, int which) {
    const int tid = threadIdx.x, lane = tid & 63, w = tid >> 6;
    const float* src = which ? p.out : p.x; const float* g = which ? p.norm2_g : p.norm1_g;
    bf16_t* dst = (bf16_t*)(p.ws + (which ? WS_H2 : WS_HB));
    const float* mod = (const float*)(p.ws + WS_MOD);
    for (int t = blockIdx.x * 8 + w; t < T; t += gridDim.x * 8) {
        const int b = t >> 11; const float* sh = mod + b * 6144 + (which ? 3072 : 0); const float* scl = sh + 1024;
        const float4* xr = (const float4*)(src + (size_t)t * D);
        float4 v[4]; float ss = 0.f;
#pragma unroll
        for (int j = 0; j < 4; ++j) { v[j] = xr[lane + 64 * j]; ss += v[j].x * v[j].x + v[j].y * v[j].y + v[j].z * v[j].z + v[j].w * v[j].w; }
        const float r = rsqrtf(wave_sum(ss) * (1.0f / D) + EPS);
#pragma unroll
        for (int j = 0; j < 4; ++j) { const int d0 = (lane + 64 * j) * 4;
            const float4 gg = *(const float4*)(g + d0), s4 = *(const float4*)(scl + d0), h4 = *(const float4*)(sh + d0);
            const float o0 = v[j].x * r * gg.x * (1.f + s4.x) + h4.x, o1 = v[j].y * r * gg.y * (1.f + s4.y) + h4.y;
            const float o2 = v[j].z * r * gg.z * (1.f + s4.z) + h4.z, o3 = v[j].w * r * gg.w * (1.f + s4.w) + h4.w;
            uint2 o; o.x = pk2(o0, o1); o.y = pk2(o2, o3); *(uint2*)(dst + (size_t)t * D + d0) = o; }
    }
}
__device__ __forceinline__ void naive_dot8(const bf16_t* A, int lda, const float* W, int ldw, int K, int t0, int col, float (&acc)[8]) {
#pragma unroll
    for (int i = 0; i < 8; ++i) acc[i] = 0.f;
    for (int k = 0; k < K; k += 2) {
        const float w0 = W[(size_t)k * ldw + col], w1 = W[(size_t)(k + 1) * ldw + col];
#pragma unroll
        for (int i = 0; i < 8; ++i) { const u32 a = *(const u32*)(A + (size_t)(t0 + i) * lda + k); acc[i] += bflo(a) * w0 + bfhi(a) * w1; }
    }
}
__device__ __forceinline__ void st_z_naive(const Params& p) {
    const int tid = threadIdx.x; const bf16_t* hb = (const bf16_t*)(p.ws + WS_HB); bf16_t* Z = (bf16_t*)(p.ws + WS_Z);
    const float* cosT = (const float*)(p.ws + WS_COS); const float* sinT = (const float*)(p.ws + WS_SIN);
    const int nitems = (T / 8) * 9;
    for (int it = blockIdx.x * 2 + (tid >> 8); it < nitems; it += gridDim.x * 2) {
        const int tt = it / 9, ch = it % 9; const int t0 = tt * 8; const int pc = (ch * 256 + (tid & 255)) * 2;
        const int l0 = z_logical_col(pc), l1 = z_logical_col(pc + 1);
        float a0[8], a1[8];
        if (l0 >= 0) { naive_dot8(hb, D, p.w_in, DIN, D, t0, l0, a0); naive_dot8(hb, D, p.w_in, DIN, D, t0, l1, a1); }
        else {
#pragma unroll
            for (int i = 0; i < 8; ++i) { a0[i] = 0.f; a1[i] = 0.f; } }
#pragma unroll
        for (int i = 0; i < 8; ++i) { float v0 = a0[i], v1 = a1[i]; z_post(t0 + i, pc, v0, v1, cosT, sinT); *(u32*)(Z + (size_t)(t0 + i) * NZ + pc) = pk2(v0, v1); }
    }
}
__device__ __forceinline__ void st_prep_a_naive(const Params& p) {
    const int tid = threadIdx.x; const bf16_t* Z = (const bf16_t*)(p.ws + WS_Z);
    const float* cosT = (const float*)(p.ws + WS_COS); const float* sinT = (const float*)(p.ws + WS_SIN);
    unsigned char* dob = (unsigned char*)p.out;
    bf16_t* kd = (bf16_t*)(dob + DO_KD); bf16_t* vdT = (bf16_t*)(dob + DO_VDT); bf16_t* vsT = (bf16_t*)(dob + DO_VST); bf16_t* vwT = (bf16_t*)(dob + DO_VWT);
    float* hid = (float*)(dob + DO_HID);
    for (int it = blockIdx.x * NTHR + tid; it < T * 32; it += gridDim.x * NTHR) {
        const int t = it >> 5, i = it & 31; const bf16_t* cr = Z + (size_t)t * NZ + ZC_CKV;
        float ss = 0.f; for (int r = 0; r < 128; ++r) { const float v = bf2f(cr[r]); ss += v * v; }
        const float rn = rsqrtf(ss * (1.0f / 128.0f) + EPS);
        float k1 = 0.f, k2 = 0.f, v1 = 0.f, v2 = 0.f;
        for (int r = 0; r < 128; ++r) { const float cn = bf2f(cr[r]) * rn * p.kvg[r];
            k1 += cn * p.w_uk[r * 64 + i]; k2 += cn * p.w_uk[r * 64 + i + 32]; v1 += cn * p.w_uv[r * 64 + i]; v2 += cn * p.w_uv[r * 64 + i + 32]; }
        const int pos = t & (SEQ - 1), b = t >> 11; const float c = cosT[pos * 32 + i], s = sinT[pos * 32 + i];
        *(u32*)(kd + (size_t)t * 64 + 2 * i) = pk2(k1 * c - k2 * s, k2 * c + k1 * s);
        vdT[((size_t)b * 64 + i) * SEQ + pos] = f2bf(v1); vdT[((size_t)b * 64 + i + 32) * SEQ + pos] = f2bf(v2);
    }
    for (int it = blockIdx.x * NTHR + tid; it < T * 128; it += gridDim.x * NTHR) {
        const int t = it >> 7, gd = it & 127, b = t >> 11, pos = t & (SEQ - 1);
        vsT[((size_t)b * 128 + gd) * SEQ + pos] = Z[(size_t)t * NZ + ZC_VS + gd];
        vwT[((size_t)b * 128 + gd) * SEQ + pos] = Z[(size_t)t * NZ + ZC_VW + gd];
    }
    for (int it = blockIdx.x * NTHR + tid; it < 2 * 8 * 2 * 128 * 64; it += gridDim.x * NTHR) {
        const int e = it & 63, n = (it >> 6) & 127, g = (it >> 13) & 1, b = (it >> 14) & 7, kv = it >> 17;
        float acc = 0.f;
        if (n < 127) {
            const float* w1 = kv ? p.w1v : p.w1k;
            for (int l = 0; l < 32; ++l) { const bf16_t* xr = Z + (size_t)(b * SEQ + 16 * n + l) * NZ + (kv ? ZC_VC : ZC_KC) + g * 64;
                for (int d = 0; d < 64; ++d) { const int pd = kv ? d : (2 * (d & 31) + (d >> 5));
                    acc += (bf2f(xr[pd]) + p.cmp_pos[l * 64 + d]) * w1[(l * 64 + d) * 64 + e]; } }
            acc = gelu_tanh(acc);
        }
        hid[it] = acc;
    }
}
__device__ __forceinline__ void st_prep_b_naive(const Params& p) {
    const int tid = threadIdx.x; unsigned char* dob = (unsigned char*)p.out;
    const float* hid = (const float*)(dob + DO_HID); bf16_t* kcmp = (bf16_t*)(dob + DO_KCMP); bf16_t* vcmpT = (bf16_t*)(dob + DO_VCMPT);
    for (int it = blockIdx.x * NTHR + tid; it < 2 * 8 * 2 * 128 * 64; it += gridDim.x * NTHR) {
        const int f = it & 63, n = (it >> 6) & 127, g = (it >> 13) & 1, b = (it >> 14) & 7, kv = it >> 17;
        const float* w2 = kv ? p.w2v : p.w2k; const float* h = hid + (size_t)(it & ~63);
        float acc = 0.f;
        if (n < 127) for (int e = 0; e < 64; ++e) acc += h[e] * w2[e * 64 + f];
        if (kv == 0) kcmp[(((size_t)b * 2 + g) * 128 + n) * 64 + (2 * (f & 31) + (f >> 5))] = f2bf(acc);
        else vcmpT[(((size_t)b * 2 + g) * 64 + f) * 128 + n] = f2bf(acc);
    }
}
__device__ __forceinline__ float dot64(const float* q, const bf16_t* kr) {
    float s = 0.f;
#pragma unroll
    for (int j = 0; j < 8; ++j) { const uint4 v = *(const uint4*)(kr + 8 * j); const float* qq = q + 8 * j;
        s += qq[0] * bflo(v.x) + qq[1] * bfhi(v.x) + qq[2] * bflo(v.y) + qq[3] * bfhi(v.y) + qq[4] * bflo(v.z) + qq[5] * bfhi(v.z) + qq[6] * bflo(v.w) + qq[7] * bfhi(v.w); }
    return s;
}
__device__ __forceinline__ void st_nsa_naive(const Params& p, unsigned char* lds) {
    const int tid = threadIdx.x, lane = tid & 63, h = tid >> 6, g = h >> 2;
    const bf16_t* Z = (const bf16_t*)(p.ws + WS_Z); unsigned char* dob = (unsigned char*)p.out;
    const bf16_t* kcmp = (const bf16_t*)(dob + DO_KCMP); const bf16_t* vcmpT = (const bf16_t*)(dob + DO_VCMPT);
    bf16_t* onsa = (bf16_t*)(p.ws + WS_ONSA);
    float* qs = (float*)lds;
    float* pc = qs + 512;
    float* vals = pc + 1024;
    u32* selm = (u32*)(vals + 64);
    for (int t = blockIdx.x; t < T; t += gridDim.x) {
        const int b = t >> 11, pos = t & (SEQ - 1); const bf16_t* zr = Z + (size_t)t * NZ;
        __syncthreads();
        qs[h * 64 + lane] = bf2f(zr[ZC_QN + h * 64 + lane]);
        __syncthreads();
        const float* q = qs + h * 64;
        float sc[2]; float m = -1e30f;
#pragma unroll
        for (int c2 = 0; c2 < 2; ++c2) { const int n = c2 * 64 + lane; const bool valid = (n < 127) && (16 * n + 31 <= pos);
            const float s = dot64(q, kcmp + (((size_t)b * 2 + g) * 128 + n) * 64); sc[c2] = valid ? s : -1e30f; m = fmaxf(m, sc[c2]); }
        m = wave_max(m); float l = 0.f;
#pragma unroll
        for (int c2 = 0; c2 < 2; ++c2) { const int n = c2 * 64 + lane; const bool valid = (n < 127) && (16 * n + 31 <= pos); sc[c2] = valid ? __expf(sc[c2] - m) : 0.f; l += sc[c2]; }
        l = wave_sum(l); const float il = 1.0f / fmaxf(l, 1e-30f);
        pc[h * 128 + lane] = sc[0] * il; pc[h * 128 + 64 + lane] = sc[1] * il;
        __syncthreads();
        float ocmp = 0.f; { const bf16_t* vr = vcmpT + (((size_t)b * 2 + g) * 64 + lane) * 128; const float* pp = pc + h * 128;
            for (int n = 0; n < 128; ++n) ocmp += pp[n] * bf2f(vr[n]); }
        if (tid < 64) { const int gg = tid >> 5, j = tid & 31; const float* p0 = pc + gg * 512;
            auto imp = [&](int n) -> float { return (n < 0 || n > 126) ? 0.f : (p0[n] + p0[128 + n] + p0[256 + n] + p0[384 + n]); };
            const float bl = imp(4 * j - 1) + 2.f * imp(4 * j) + 2.f * imp(4 * j + 1) + 2.f * imp(4 * j + 2) + imp(4 * j + 3);
            const int cur = pos >> 6; const bool forced = (j == 0) || (j == cur) || (j == cur - 1); const bool adm = (j * 64 <= pos);
            vals[tid] = forced ? __builtin_inff() : (adm ? bl : -__builtin_inff()); }
        __syncthreads();
        if (tid < 64) { const int gg = tid >> 5, j = tid & 31; const float v = vals[tid]; int rank = 0;
            for (int j2 = 0; j2 < 32; ++j2) { const float v2 = vals[gg * 32 + j2]; rank += (v2 > v || (v2 == v && j2 < j)) ? 1 : 0; }
            const unsigned long long bal = __ballot(rank < 16);
            if (tid == 0) { selm[0] = (u32)bal; selm[1] = (u32)(bal >> 32); } }
        __syncthreads();
        const u32 sel = selm[g];
        float ms = -1e30f, ls = 0.f, os = 0.f;
        for (int j = 0; j * 64 <= pos; ++j) { if (!((sel >> j) & 1u)) continue;
            const int kp = j * 64 + lane; const bool valid = kp <= pos;
            float s = dot64(q, Z + (size_t)(b * SEQ + kp) * NZ + ZC_KS + g * 64); s = valid ? s : -1e30f;
            const float mn = fmaxf(ms, wave_max(s)); const float al = __expf(ms - mn); const float pr = valid ? __expf(s - mn) : 0.f;
            ls = ls * al + wave_sum(pr); os *= al; ms = mn;
            for (int k = 0; k < 64; ++k) { const float pk = __shfl(pr, k); os += pk * bf2f(Z[(size_t)(b * SEQ + j * 64 + k) * NZ + ZC_VS + g * 64 + lane]); } }
        os = os / fmaxf(ls, 1e-30f);
        float mw = -1e30f, lw = 0.f, ow = 0.f;
        for (int c2 = 0; c2 < 8; ++c2) { const int kp = pos - 511 + c2 * 64 + lane; const bool valid = kp >= 0; if (pos - 511 + c2 * 64 + 63 < 0) continue;
            float s = valid ? dot64(q, Z + (size_t)(b * SEQ + kp) * NZ + ZC_KW + g * 64) : -1e30f;
            const float mn = fmaxf(mw, wave_max(s)); const float al = __expf(mw - mn); const float pr = valid ? __expf(s - mn) : 0.f;
            lw = lw * al + wave_sum(pr); ow *= al; mw = mn;
            for (int k = 0; k < 64; ++k) { const float pk = __shfl(pr, k); const int kk = pos - 511 + c2 * 64 + k;
                if (kk >= 0) ow += pk * bf2f(Z[(size_t)(b * SEQ + kk) * NZ + ZC_VW + g * 64 + lane]); } }
        ow = ow / fmaxf(lw, 1e-30f);
        const float gc = bf2f(zr[ZC_GN + h * 3 + 0]), gs = bf2f(zr[ZC_GN + h * 3 + 1]), gw = bf2f(zr[ZC_GN + h * 3 + 2]);
        onsa[(size_t)t * 512 + h * 64 + lane] = f2bf(gc * ocmp + gs * os + gw * ow);
    }
}
__device__ __forceinline__ void st_dsa_naive(const Params& p, unsigned char* lds) {
    const int tid = threadIdx.x, lane = tid & 63, h = tid >> 6;
    const bf16_t* Z = (const bf16_t*)(p.ws + WS_Z); unsigned char* dob = (unsigned char*)p.out;
    const bf16_t* kd = (const bf16_t*)(dob + DO_KD); const bf16_t* vdT = (const bf16_t*)(dob + DO_VDT); u32* maskg = (u32*)(dob + DO_MASK);
    bf16_t* odsa = (bf16_t*)(p.ws + WS_ODSA);
    float* qi = (float*)lds;
    float* qd = qi + 512;
    float* wv = qd + 512;
    float* scv = wv + 8;
    u32* mk = (u32*)(scv + 2048);
    for (int t = blockIdx.x; t < T; t += gridDim.x) {
        const int b = t >> 11, pos = t & (SEQ - 1); const bf16_t* zr = Z + (size_t)t * NZ;
        __syncthreads();
        qi[tid] = bf2f(zr[ZC_QI + tid]); qd[tid] = bf2f(zr[ZC_QD + tid]);
        if (tid < 8) wv[tid] = bf2f(zr[ZC_WI + tid]) * 0.35355339059327373f;
        __syncthreads();
        for (int i = 0; i < 4; ++i) { const int k = tid + 512 * i; float s = -__builtin_inff();
            if (k <= pos) { s = 0.f; const bf16_t* kr = Z + (size_t)(b * SEQ + k) * NZ + ZC_KI;
                for (int hh = 0; hh < 8; ++hh) { const float lg = dot64(qi + hh * 64, kr); s = fmaf(wv[hh], fmaxf(lg, 0.f), s); } }
            scv[k] = s; }
        __syncthreads();
        for (int i = 0; i < 4; ++i) { const int k = tid + 512 * i; bool selb = false;
            if (k <= pos) { if (pos < 256) selb = true; else { const float v = scv[k]; int rank = 0;
                    for (int j = 0; j <= pos; ++j) { const float v2 = scv[j]; rank += (v2 > v || (v2 == v && j < k)) ? 1 : 0; } selb = rank < 256; } }
            const unsigned long long bal = __ballot(selb);
            if (lane == 0) { const int wi = 16 * i + 2 * h; mk[wi] = (u32)bal; mk[wi + 1] = (u32)(bal >> 32); } }
        __syncthreads();
        if (tid < 64) maskg[(size_t)t * 64 + tid] = mk[tid];
        float m = -1e30f, l = 0.f, o = 0.f; const float* q = qd + h * 64;
        for (int c2 = 0; c2 * 64 <= pos; ++c2) { const int kp = c2 * 64 + lane; const bool valid = (mk[kp >> 5] >> (kp & 31)) & 1u;
            if (__ballot(valid) == 0ull) continue;
            float s = valid ? dot64(q, kd + (size_t)(b * SEQ + kp) * 64) : -1e30f;
            const float mn = fmaxf(m, wave_max(s)); const float al = __expf(m - mn); const float pr = valid ? __expf(s - mn) : 0.f;
            l = l * al + wave_sum(pr); o *= al; m = mn;
            const bf16_t* vr = vdT + ((size_t)b * 64 + lane) * SEQ + c2 * 64;
            for (int k = 0; k < 64; ++k) { const float pk = __shfl(pr, k); o += pk * bf2f(vr[k]); } }
        odsa[(size_t)t * 512 + h * 64 + lane] = f2bf(o / fmaxf(l, 1e-30f));
    }
}
__device__ __forceinline__ void st_merge_naive(const Params& p) {
    const int tid = threadIdx.x; const bf16_t* Z = (const bf16_t*)(p.ws + WS_Z);
    const bf16_t* onsa = (const bf16_t*)(p.ws + WS_ONSA); const bf16_t* odsa = (const bf16_t*)(p.ws + WS_ODSA); bf16_t* mg = (bf16_t*)(p.ws + WS_MERGED);
    for (int it = blockIdx.x; it < (T / 8) * 2; it += gridDim.x) { const int t0 = (it >> 1) * 8, n = (it & 1) * 512 + tid;
        float a[8], d[8]; naive_dot8(onsa, 512, p.w_nsa, D, 512, t0, n, a); naive_dot8(odsa, 512, p.w_dsa, D, 512, t0, n, d);
#pragma unroll
        for (int i = 0; i < 8; ++i) { const float g1 = bf2f(Z[(size_t)(t0 + i) * NZ + ZC_GM + n]), g2 = bf2f(Z[(size_t)(t0 + i) * NZ + ZC_GM + 1024 + n]);
            mg[(size_t)(t0 + i) * D + n] = f2bf(g1 * a[i] + g2 * d[i]); } }
}
__device__ __forceinline__ void st_out_naive(const Params& p) {
    const int tid = threadIdx.x; const bf16_t* mg = (const bf16_t*)(p.ws + WS_MERGED); const float* mod = (const float*)(p.ws + WS_MOD);
    for (int it = blockIdx.x; it < (T / 8) * 2; it += gridDim.x) { const int t0 = (it >> 1) * 8, n = (it & 1) * 512 + tid;
        float a[8]; naive_dot8(mg, D, p.w_out, D, D, t0, n, a); const float g1 = mod[(t0 >> 11) * 6144 + 2048 + n];
#pragma unroll
        for (int i = 0; i < 8; ++i) p.out[(size_t)(t0 + i) * D + n] = p.x[(size_t)(t0 + i) * D + n] + g1 * a[i]; }
}
__device__ __forceinline__ void st_peerq_naive(const Params& p) {
    const int tid = threadIdx.x; const bf16_t* h2 = (const bf16_t*)(p.ws + WS_H2); bf16_t* q = (bf16_t*)(p.ws + WS_MERGED);
    for (int it = blockIdx.x; it < (T / 8) * 2; it += gridDim.x) { const int t0 = (it >> 1) * 8, n = (it & 1) * 512 + tid;
        float a[8]; naive_dot8(h2, D, p.wq, D, D, t0, n, a);
#pragma unroll
        for (int i = 0; i < 8; ++i) q[(size_t)(t0 + i) * D + n] = f2bf(a[i]); }
}
__device__ __forceinline__ void st_ssub_naive(const Params& p) {
    const int tid = threadIdx.x; const bf16_t* q = (const bf16_t*)(p.ws + WS_MERGED); float* ss = (float*)(p.ws + WS_SSUB);
    for (size_t it = (size_t)blockIdx.x * NTHR + tid; it < (size_t)T * 2048; it += (size_t)gridDim.x * NTHR) {
        const int t = (int)(it >> 11), col = (int)(it & 2047), hc = col >> 7, n = col & 127;
        const bf16_t* qr = q + (size_t)t * D + hc * 64; const float* sk = p.subkeys + ((size_t)hc * 128 + n) * 64;
        float acc = 0.f; for (int d = 0; d < 64; ++d) acc += bf2f(qr[d]) * sk[d];
        ss[it] = acc; }
}
__device__ __forceinline__ u32 ordf(float f);
__device__ __forceinline__ void ins16(u32 (&s)[16], u32 key) {
#pragma unroll
    for (int i = 0; i < 16; ++i) { const u32 mx = s[i] > key ? s[i] : key; key = s[i] > key ? key : s[i]; s[i] = mx; }
}
__device__ __forceinline__ void st_route(const Params& p) {
    const int tid = threadIdx.x; const float* ss = (const float*)(p.ws + WS_SSUB); int* eidx = (int*)(p.ws + WS_EIDX); float* gate = (float*)(p.ws + WS_GATE);
    for (int it = blockIdx.x * NTHR + tid; it < T * 8; it += gridDim.x * NTHR) {
        const float* s0 = ss + (size_t)it * 256;
        u32 a[16], b[16];
#pragma unroll
        for (int i = 0; i < 16; ++i) { a[i] = 0u; b[i] = 0u; }
        for (int n = 0; n < 128; n += 4) { const float4 x = *(const float4*)(s0 + n), y = *(const float4*)(s0 + 128 + n);
            ins16(a, (ordf(x.x) & ~127u) | (u32)(127 - n)); ins16(a, (ordf(x.y) & ~127u) | (u32)(126 - n)); ins16(a, (ordf(x.z) & ~127u) | (u32)(125 - n)); ins16(a, (ordf(x.w) & ~127u) | (u32)(124 - n));
            ins16(b, (ordf(y.x) & ~127u) | (u32)(127 - n)); ins16(b, (ordf(y.y) & ~127u) | (u32)(126 - n)); ins16(b, (ordf(y.z) & ~127u) | (u32)(125 - n)); ins16(b, (ordf(y.w) & ~127u) | (u32)(124 - n)); }
        float va[16], vb[16]; int na[16], nb[16];
#pragma unroll
        for (int i = 0; i < 16; ++i) { na[i] = 127 - (int)(a[i] & 127u); nb[i] = 127 - (int)(b[i] & 127u); va[i] = s0[na[i]]; vb[i] = s0[128 + nb[i]]; }
        u32 tk[16];
#pragma unroll
        for (int i = 0; i < 16; ++i) tk[i] = 0u;
#pragma unroll
        for (int i = 0; i < 16; ++i)
#pragma unroll
            for (int j = 0; j < 16; ++j) if ((i + 1) * (j + 1) <= 16) ins16(tk, (ordf(va[i] + vb[j]) & ~255u) | (u32)(255 - (i * 16 + j)));
        float ts[16]; int te[16];
#pragma unroll
        for (int r = 0; r < 16; ++r) { const int flat = 255 - (int)(tk[r] & 255u), i = flat >> 4, j = flat & 15; float x = 0.f, y = 0.f; int ni = 0, nj = 0;
#pragma unroll
            for (int q = 0; q < 16; ++q) { if (i == q) { x = va[q]; ni = na[q]; } if (j == q) { y = vb[q]; nj = nb[q]; } }
            ts[r] = x + y; te[r] = ni * 128 + nj; }
        float mx = ts[0];
#pragma unroll
        for (int r = 1; r < 16; ++r) mx = fmaxf(mx, ts[r]);
        float sum = 0.f, ex[16];
#pragma unroll
        for (int r = 0; r < 16; ++r) { ex[r] = __expf(ts[r] - mx); sum += ex[r]; }
        const float inv = 1.0f / sum;
#pragma unroll
        for (int r = 0; r < 16; ++r) { eidx[(size_t)it * 16 + r] = te[r]; gate[(size_t)it * 16 + r] = ex[r] * inv; }
    }
}
__device__ __forceinline__ void st_cvt_uv(const Params& p) {
    const int tid = threadIdx.x; bf16_t* u16 = (bf16_t*)(p.ws + WS_U16); bf16_t* v16 = (bf16_t*)(p.ws + WS_V16);
    const size_t n4 = (size_t)16384 * 1024 / 4;
    for (size_t i = (size_t)blockIdx.x * NTHR + tid; i < n4; i += (size_t)gridDim.x * NTHR) {
        const float4 a = ((const float4*)p.pu)[i], b = ((const float4*)p.pv)[i];
        uint2 o; o.x = pk2(a.x, a.y); o.y = pk2(a.z, a.w); ((uint2*)u16)[i] = o; o.x = pk2(b.x, b.y); o.y = pk2(b.z, b.w); ((uint2*)v16)[i] = o; }
}
__device__ __forceinline__ void st_expert(const Params& p, unsigned char* lds) {
    const int tid = threadIdx.x, lane = tid & 63, w = tid >> 6;
    const bf16_t* h2 = (const bf16_t*)(p.ws + WS_H2); const bf16_t* u16 = (const bf16_t*)(p.ws + WS_U16); const bf16_t* v16 = (const bf16_t*)(p.ws + WS_V16);
    const int* eidx = (const int*)(p.ws + WS_EIDX); const float* gate = (const float*)(p.ws + WS_GATE); const float* mod = (const float*)(p.ws + WS_MOD);
    float* wl = (float*)lds + w * 128;
    for (int t = blockIdx.x * 8 + w; t < T; t += gridDim.x * 8) {
        float xv[16]; { const uint4 a = *(const uint4*)(h2 + (size_t)t * D + lane * 16), b = *(const uint4*)(h2 + (size_t)t * D + lane * 16 + 8);
            xv[0] = bflo(a.x); xv[1] = bfhi(a.x); xv[2] = bflo(a.y); xv[3] = bfhi(a.y); xv[4] = bflo(a.z); xv[5] = bfhi(a.z); xv[6] = bflo(a.w); xv[7] = bfhi(a.w);
            xv[8] = bflo(b.x); xv[9] = bfhi(b.x); xv[10] = bflo(b.y); xv[11] = bfhi(b.y); xv[12] = bflo(b.z); xv[13] = bfhi(b.z); xv[14] = bflo(b.w); xv[15] = bfhi(b.w); }
        const int e0 = eidx[(size_t)t * 128 + lane], e1 = eidx[(size_t)t * 128 + 64 + lane];
        const float g0 = gate[(size_t)t * 128 + lane], g1 = gate[(size_t)t * 128 + 64 + lane];
        for (int k = 0; k < 128; ++k) { const int e = __shfl(k < 64 ? e0 : e1, k & 63);
            const bf16_t* ur = u16 + (size_t)e * D + lane * 16; const uint4 a = *(const uint4*)ur, b = *(const uint4*)(ur + 8);
            float s = xv[0] * bflo(a.x) + xv[1] * bfhi(a.x) + xv[2] * bflo(a.y) + xv[3] * bfhi(a.y) + xv[4] * bflo(a.z) + xv[5] * bfhi(a.z) + xv[6] * bflo(a.w) + xv[7] * bfhi(a.w)
                    + xv[8] * bflo(b.x) + xv[9] * bfhi(b.x) + xv[10] * bflo(b.y) + xv[11] * bfhi(b.y) + xv[12] * bflo(b.z) + xv[13] * bfhi(b.z) + xv[14] * bflo(b.w) + xv[15] * bfhi(b.w);
            s = wave_sum(s);
            if (lane == (k & 63)) { const float gg = k < 64 ? g0 : g1; wl[k] = gg * gelu_erf(s); } }
        __builtin_amdgcn_s_waitcnt(0);
        float acc[16];
#pragma unroll
        for (int i = 0; i < 16; ++i) acc[i] = 0.f;
        for (int k = 0; k < 128; ++k) { const int e = __shfl(k < 64 ? e0 : e1, k & 63); const float wk = wl[k];
            const bf16_t* vr = v16 + (size_t)e * D + lane * 16; const uint4 a = *(const uint4*)vr, b = *(const uint4*)(vr + 8);
            acc[0] += wk * bflo(a.x); acc[1] += wk * bfhi(a.x); acc[2] += wk * bflo(a.y); acc[3] += wk * bfhi(a.y); acc[4] += wk * bflo(a.z); acc[5] += wk * bfhi(a.z); acc[6] += wk * bflo(a.w); acc[7] += wk * bfhi(a.w);
            acc[8] += wk * bflo(b.x); acc[9] += wk * bfhi(b.x); acc[10] += wk * bflo(b.y); acc[11] += wk * bfhi(b.y); acc[12] += wk * bflo(b.z); acc[13] += wk * bfhi(b.z); acc[14] += wk * bflo(b.w); acc[15] += wk * bfhi(b.w); }
        const float* g2 = mod + (t >> 11) * 6144 + 5120 + lane * 16; float* xr = p.out + (size_t)t * D + lane * 16; float ss = 0.f;
#pragma unroll
        for (int i = 0; i < 16; ++i) { acc[i] = xr[i] + g2[i] * acc[i]; ss += acc[i] * acc[i]; }
        const float r = rsqrtf(wave_sum(ss) * (1.0f / D) + EPS);
#pragma unroll
        for (int i = 0; i < 16; ++i) xr[i] = acc[i] * r * p.final_g[lane * 16 + i];
    }
}


typedef short bf16x8 __attribute__((ext_vector_type(8)));
typedef float f32x16 __attribute__((ext_vector_type(16)));
typedef unsigned u32x2 __attribute__((ext_vector_type(2)));
typedef unsigned u32x4 __attribute__((ext_vector_type(4)));
typedef __bf16 hbf2_t __attribute__((ext_vector_type(2)));
typedef float f32x2_t __attribute__((ext_vector_type(2)));
#define MFMA32(a, b, c) __builtin_amdgcn_mfma_f32_32x32x16_bf16((a), (b), (c), 0, 0, 0)
__device__ __forceinline__ u32 pkbf(float a, float b) { const f32x2_t v = {a, b}; const hbf2_t r = __builtin_convertvector(v, hbf2_t); return __builtin_bit_cast(u32, r); }
__device__ __forceinline__ bf16x8 ld8(const bf16_t* q) { return *(const bf16x8*)q; }
__device__ __forceinline__ bf16x8 ld44(const bf16_t* q) { const u32x2 a = *(const u32x2*)q, b = *(const u32x2*)(q + 8); const u32x4 v = {a.x, a.y, b.x, b.y}; return __builtin_bit_cast(bf16x8, v); }
template <int H> __device__ __forceinline__ bf16x8 pack8(const f32x16& s) {
    const u32x4 v = {pkbf(s[8 * H], s[8 * H + 1]), pkbf(s[8 * H + 2], s[8 * H + 3]), pkbf(s[8 * H + 4], s[8 * H + 5]), pkbf(s[8 * H + 6], s[8 * H + 7])};
    return __builtin_bit_cast(bf16x8, v);
}
__device__ __forceinline__ float dpp_xor1(float v) { return __int_as_float(__builtin_amdgcn_update_dpp(0, __float_as_int(v), 0xB1, 0xF, 0xF, true)); }
__device__ __forceinline__ float dpp_xor2(float v) { return __int_as_float(__builtin_amdgcn_update_dpp(0, __float_as_int(v), 0x4E, 0xF, 0xF, true)); }
__device__ __forceinline__ f32x16 zero16() { f32x16 z;
#pragma unroll
    for (int i = 0; i < 16; ++i) z[i] = 0.f; return z; }
__device__ __forceinline__ void flash_tile(float& m, float& l, f32x16& o0, f32x16& o1, f32x16 s, u32 vm, const bf16_t* vb, size_t dbs) {
    const bf16x8 v00 = ld44(vb), v01 = ld44(vb + 16), v10 = ld44(vb + dbs), v11 = ld44(vb + dbs + 16);
    float mx = -1e30f;
#pragma unroll
    for (int R = 0; R < 16; ++R) { s[R] = ((vm >> R) & 1u) ? s[R] : -1e30f; mx = fmaxf(mx, s[R]); }
    mx = fmaxf(mx, __shfl_xor(mx, 32));
    const float mn = fmaxf(m, mx), al = __expf(m - mn);
    float ps = 0.f;
#pragma unroll
    for (int R = 0; R < 16; ++R) { const float pr = ((vm >> R) & 1u) ? __expf(s[R] - mn) : 0.f; s[R] = pr; ps += pr; }
    ps += __shfl_xor(ps, 32);
    l = l * al + ps; m = mn;
#pragma unroll
    for (int R = 0; R < 16; ++R) { o0[R] *= al; o1[R] *= al; }
    const bf16x8 p0 = pack8<0>(s), p1 = pack8<1>(s);
    o0 = MFMA32(v00, p0, o0); o0 = MFMA32(v01, p1, o0);
    o1 = MFMA32(v10, p0, o1); o1 = MFMA32(v11, p1, o1);
}
__device__ __forceinline__ u32 vm_le(int lim) { u32 vm = 0u;
#pragma unroll
    for (int R = 0; R < 16; ++R) vm |= (((R & 3) + 8 * (R >> 2)) <= lim) ? (1u << R) : 0u;
    return vm; }
__device__ __forceinline__ u32 vm_from_word(u32 word, int hl) { const u32 sh = word >> (4 * hl); return (sh & 0xFu) | (((sh >> 8) & 0xFu) << 4) | (((sh >> 16) & 0xFu) << 8) | (((sh >> 24) & 0xFu) << 12); }
__device__ __forceinline__ void store_ot(bf16_t* orow, const f32x16& o0, const f32x16& o1, int hl) {
#pragma unroll
    for (int q = 0; q < 4; ++q) {
        u32x2 a = {pkbf(o0[4 * q], o0[4 * q + 1]), pkbf(o0[4 * q + 2], o0[4 * q + 3])}; *(u32x2*)(orow + 8 * q + 4 * hl) = a;
        u32x2 b = {pkbf(o1[4 * q], o1[4 * q + 1]), pkbf(o1[4 * q + 2], o1[4 * q + 3])}; *(u32x2*)(orow + 32 + 8 * q + 4 * hl) = b;
    }
}
__device__ __forceinline__ u32 ordf(float f) { const u32 u = __float_as_uint(f); return (u & 0x80000000u) ? ~u : (u | 0x80000000u); }

__device__ __forceinline__ void st_nsa(const Params& p) {
    const int tid = threadIdx.x, lane = tid & 63, w = __builtin_amdgcn_readfirstlane(tid >> 6), c_ = lane & 31, hl_ = lane >> 5;
    const bf16_t* Z = (const bf16_t*)(p.ws + WS_Z); unsigned char* dob = (unsigned char*)p.out;
    const bf16_t* kcmp = (const bf16_t*)(dob + DO_KCMP); const bf16_t* vcmpT = (const bf16_t*)(dob + DO_VCMPT);
    const bf16_t* vsT = (const bf16_t*)(dob + DO_VST); const bf16_t* vwT = (const bf16_t*)(dob + DO_VWT);
    bf16_t* onsa = (bf16_t*)(p.ws + WS_ONSA);
    for (int ps = blockIdx.x; ps < 256; ps += gridDim.x)
    for (int which = 0; which < 2; ++which) {
        const int b = ps >> 5, g = (ps >> 4) & 1, jj = ps & 15, qb = which ? 31 - jj : jj, cur = qb;
        int c = c_, hl = hl_; asm volatile("" : "+v"(c), "+v"(hl));
        const int pmin = qb * 64 + 8 * w, pos = pmin + (c >> 2), head = 4 * g + (c & 3);
        const bf16_t* zr = Z + (size_t)(b * SEQ + pos) * NZ;
        bf16x8 qfr[4];
#pragma unroll
        for (int kk = 0; kk < 4; ++kk) qfr[kk] = ld8(zr + ZC_QN + head * 64 + 16 * kk + 8 * hl);
        const float gc = bf2f(zr[ZC_GN + head * 3]), gs = bf2f(zr[ZC_GN + head * 3 + 1]), gw = bf2f(zr[ZC_GN + head * 3 + 2]);
        f32x16 out0 = zero16(), out1 = zero16();
        u32 sel;
        {
            const int pmax = pmin + 7; const int nmax = pmax >= 31 ? ((pmax - 31) >> 4) : -1; const int ntile = nmax >= 0 ? (((nmax > 126 ? 126 : nmax) >> 5) + 1) : 0;
            const bf16_t* kb = kcmp + ((size_t)(b * 2 + g) * 128 + c) * 64 + 8 * hl;
            float mx = -1e30f, l = 0.f;
            const int nlim = (pos >= 31 ? (((pos - 31) >> 4) > 126 ? 126 : ((pos - 31) >> 4)) : -1) - 4 * hl;
            for (int kt = 0; kt < ntile; ++kt) {
                f32x16 s = zero16();
#pragma unroll
                for (int kk = 0; kk < 4; ++kk) s = MFMA32(ld8(kb + (size_t)kt * 32 * 64 + 16 * kk), qfr[kk], s);
                const u32 vm = vm_le(nlim - 32 * kt);
                float tm = -1e30f;
#pragma unroll
                for (int R = 0; R < 16; ++R) { s[R] = ((vm >> R) & 1u) ? s[R] : -1e30f; tm = fmaxf(tm, s[R]); }
                const float mn = fmaxf(mx, tm); float ps = 0.f;
#pragma unroll
                for (int R = 0; R < 16; ++R) ps += ((vm >> R) & 1u) ? __expf(s[R] - mn) : 0.f;
                l = l * __expf(mx - mn) + ps; mx = mn;
            }
            {
                const float mo = __shfl_xor(mx, 32), lo_ = __shfl_xor(l, 32); const float mn = fmaxf(mx, mo);
                l = l * __expf(mx - mn) + lo_ * __expf(mo - mn); mx = mn; }
            const float il = 1.0f / fmaxf(l, 1e-30f);
            __builtin_amdgcn_sched_barrier(0);
            f32x16 o0 = zero16(), o1 = zero16();
            const bf16_t* vb = vcmpT + ((size_t)(b * 2 + g) * 64 + c) * 128 + 4 * hl;
            float G[16], L[16];
#pragma unroll
            for (int kt = 0; kt < 4; ++kt) {
                if (kt < ntile) {
                    f32x16 s = zero16();
#pragma unroll
                    for (int kk = 0; kk < 4; ++kk) s = MFMA32(ld8(kb + (size_t)kt * 32 * 64 + 16 * kk), qfr[kk], s);
                    const u32 vm = vm_le(nlim - 32 * kt);
#pragma unroll
                    for (int R = 0; R < 16; ++R) s[R] = ((vm >> R) & 1u) ? __expf(s[R] - mx) * il : 0.f;
                    const bf16x8 p0 = pack8<0>(s), p1 = pack8<1>(s);
                    o0 = MFMA32(ld44(vb + 32 * kt), p0, o0); o0 = MFMA32(ld44(vb + 32 * kt + 16), p1, o0);
                    o1 = MFMA32(ld44(vb + 32 * 128 + 32 * kt), p0, o1); o1 = MFMA32(ld44(vb + 32 * 128 + 32 * kt + 16), p1, o1);
#pragma unroll
                    for (int rg = 0; rg < 4; ++rg) { float gsum = (s[4 * rg] + s[4 * rg + 1]) + (s[4 * rg + 2] + s[4 * rg + 3]); float last = s[4 * rg + 3];
                        gsum += dpp_xor1(gsum); gsum += dpp_xor2(gsum); last += dpp_xor1(last); last += dpp_xor2(last);
                        G[4 * kt + rg] = gsum; L[4 * kt + rg] = last; }
                } else {
#pragma unroll
                    for (int rg = 0; rg < 4; ++rg) { G[4 * kt + rg] = 0.f; L[4 * kt + rg] = 0.f; }
                }
                __builtin_amdgcn_sched_barrier(0);
            }
#pragma unroll
            for (int R = 0; R < 16; ++R) { out0[R] = gc * o0[R]; out1[R] = gc * o1[R]; }
            float v[16], vx[16];
            { float Lx[16];
#pragma unroll
              for (int i = 0; i < 16; ++i) Lx[i] = __shfl_xor(L[i], 32);
#pragma unroll
              for (int i = 0; i < 16; ++i) { const float prevL = hl ? Lx[i] : (i > 0 ? Lx[i > 0 ? i - 1 : 0] : 0.f); const float bl = prevL + 2.f * G[i] - L[i];
                const int j = 2 * i + hl; const bool forced = (j == 0) || (j == cur) || (j == cur - 1);
                v[i] = forced ? __builtin_inff() : (j <= cur ? bl : -__builtin_inff()); } }
#pragma unroll
            for (int i = 0; i < 16; ++i) vx[i] = __shfl_xor(v[i], 32);
            u32 own = 0u;
#pragma unroll
            for (int i = 0; i < 16; ++i) { int rank = 0;
#pragma unroll
                for (int i2 = 0; i2 < 16; ++i2) {
                    if (i2 != i) rank += (v[i2] > v[i] || (v[i2] == v[i] && i2 < i)) ? 1 : 0;
                    const bool xlt = (i2 < i) || (hl && i2 == i);
                    rank += (vx[i2] > v[i] || (vx[i2] == v[i] && xlt)) ? 1 : 0; }
                const int j = 2 * i + hl; own |= ((j <= cur) && rank < 16) ? (1u << j) : 0u; }
            sel = own | (u32)__shfl_xor((int)own, 32);
            __builtin_amdgcn_sched_barrier(0);
        }
        {
            float m = -1e30f, l = 0.f; f32x16 o0 = zero16(), o1 = zero16();
            const bf16_t* kb = Z + (size_t)(b * SEQ + c) * NZ + ZC_KS + g * 64 + 8 * hl;
            const bf16_t* vb = vsT + ((size_t)(b * 2 + g) * 64 + c) * SEQ + 4 * hl;
            for (int jb = 0; jb <= cur; ++jb) {
                const bool mine = (sel >> jb) & 1u;
                if (__ballot(mine) == 0ull) continue;
#pragma unroll
                for (int h2 = 0; h2 < 2; ++h2) { const int key0 = jb * 64 + h2 * 32;
                    f32x16 s = zero16();
#pragma unroll
                    for (int kk = 0; kk < 4; ++kk) s = MFMA32(ld8(kb + (size_t)key0 * NZ + 16 * kk), qfr[kk], s);
                    const u32 vm = mine ? vm_le(pos - key0 - 4 * hl) : 0u;
                    flash_tile(m, l, o0, o1, s, vm, vb + key0, (size_t)32 * SEQ); }
            }
            const float f = gs / fmaxf(l, 1e-30f);
#pragma unroll
            for (int R = 0; R < 16; ++R) { out0[R] += f * o0[R]; out1[R] += f * o1[R]; }
        }
        {
            float m = -1e30f, l = 0.f; f32x16 o0 = zero16(), o1 = zero16();
            const bf16_t* kb = Z + (size_t)(b * SEQ + c) * NZ + ZC_KW + g * 64 + 8 * hl;
            const bf16_t* vb = vwT + ((size_t)(b * 2 + g) * 64 + c) * SEQ + 4 * hl;
            const int kstart = pmin - 511 > 0 ? pmin - 511 : 0;
            for (int kt = kstart >> 5; kt <= (pmin + 7) >> 5; ++kt) { const int key0 = kt * 32;
                f32x16 s = zero16();
#pragma unroll
                for (int kk = 0; kk < 4; ++kk) s = MFMA32(ld8(kb + (size_t)key0 * NZ + 16 * kk), qfr[kk], s);
                const int d1 = pos - key0 - 4 * hl; const u32 vm = vm_le(d1) & ~vm_le(d1 - 512);
                flash_tile(m, l, o0, o1, s, vm, vb + key0, (size_t)32 * SEQ); }
            const float f = gw / fmaxf(l, 1e-30f);
#pragma unroll
            for (int R = 0; R < 16; ++R) { out0[R] += f * o0[R]; out1[R] += f * o1[R]; }
        }
        store_ot(onsa + (size_t)(b * SEQ + pos) * 512 + head * 64, out0, out1, hl);
    }
}

__device__ __forceinline__ void st_dsa(const Params& p, unsigned char* lds) {
    const int tid = threadIdx.x, lane = tid & 63, w = __builtin_amdgcn_readfirstlane(tid >> 6), c_ = lane & 31, hl_ = lane >> 5;
    const bf16_t* Z = (const bf16_t*)(p.ws + WS_Z); unsigned char* dob = (unsigned char*)p.out;
    const bf16_t* kd = (const bf16_t*)(dob + DO_KD); const bf16_t* vdT = (const bf16_t*)(dob + DO_VDT);
    bf16_t* odsa = (bf16_t*)(p.ws + WS_ODSA);
    u32* mk = (u32*)lds;
    for (int ps = blockIdx.x; ps < 256; ps += gridDim.x)
    for (int which = 0; which < 2; ++which) {
        const int b = ps >> 5, jj = ps & 31, qb = which ? 63 - jj : jj;
        const int tok0 = b * SEQ + qb * 32;
        int c = c_, hl = hl_; asm volatile("" : "+v"(c), "+v"(hl));
        __syncthreads();
        {
            const int r = c; const int qq_r = ((r >> 2) & 1) * 2 + (r >> 4), head_r = ((r >> 3) & 1) * 4 + (r & 3);
            bf16x8 afr[4];
#pragma unroll
            for (int kk = 0; kk < 4; ++kk) afr[kk] = ld8(Z + (size_t)(tok0 + 4 * w + qq_r) * NZ + ZC_QI + head_r * 64 + 16 * kk + 8 * hl);
            float wv[2][8]; int posq[2];
#pragma unroll
            for (int s = 0; s < 2; ++s) { posq[s] = qb * 32 + 4 * w + 2 * hl + s;
                const uint4 ww = *(const uint4*)(Z + (size_t)(tok0 + 4 * w + 2 * hl + s) * NZ + ZC_WI);
                wv[s][0] = bflo(ww.x) * 0.35355339059327373f; wv[s][1] = bfhi(ww.x) * 0.35355339059327373f; wv[s][2] = bflo(ww.y) * 0.35355339059327373f; wv[s][3] = bfhi(ww.y) * 0.35355339059327373f;
                wv[s][4] = bflo(ww.z) * 0.35355339059327373f; wv[s][5] = bfhi(ww.z) * 0.35355339059327373f; wv[s][6] = bflo(ww.w) * 0.35355339059327373f; wv[s][7] = bfhi(ww.w) * 0.35355339059327373f; }
            u32 key[64][2];
            const bf16_t* kib = Z + (size_t)(b * SEQ + c) * NZ + ZC_KI + 8 * hl;
            bf16x8 bc[4];
#pragma unroll
            for (int kk = 0; kk < 4; ++kk) bc[kk] = ld8(kib + 16 * kk);
            const bf16_t* kp = kib;
#pragma unroll
            for (int kt = 0; kt < 64; ++kt) {
                if (kt <= qb) {
                    bf16x8 bn[4];
                    if (kt + 1 <= qb) kp += (size_t)32 * NZ;
                    asm volatile("" : "+v"(kp));
#pragma unroll
                    for (int kk = 0; kk < 4; ++kk) bn[kk] = ld8(kp + 16 * kk);
                    f32x16 acc = zero16();
#pragma unroll
                    for (int kk = 0; kk < 4; ++kk) acc = MFMA32(afr[kk], bc[kk], acc);
#pragma unroll
                    for (int s = 0; s < 2; ++s) { float sc = 0.f;
#pragma unroll
                        for (int e = 0; e < 8; ++e) sc = fmaf(wv[s][e], fmaxf(acc[8 * s + e], 0.f), sc);
                        key[kt][s] = (c <= posq[s] - kt * 32) ? ordf(sc) : 0u; }
#pragma unroll
                    for (int kk = 0; kk < 4; ++kk) bc[kk] = bn[kk];
                } else { key[kt][0] = 0u; key[kt][1] = 0u; }
                __builtin_amdgcn_sched_barrier(0);
            }
            u32 lo[2], hi[2], thr[2]; bool done[2], exact[2];
#pragma unroll
            for (int s = 0; s < 2; ++s) { lo[s] = 0x00800000u; hi[s] = 0xFF800000u; thr[s] = 1u; exact[s] = true; done[s] = posq[s] < 256; }
            for (int iter = 0; iter < 40; ++iter) {
                if (__all(done[0] && done[1])) break;
                u32 mid[2]; int cnt[2];
#pragma unroll
                for (int s = 0; s < 2; ++s) { mid[s] = lo[s] + ((hi[s] - lo[s]) >> 1); cnt[s] = 0; }
#pragma unroll
                for (int kt = 0; kt < 64; ++kt) { cnt[0] += (key[kt][0] >= mid[0]) ? 1 : 0; cnt[1] += (key[kt][1] >= mid[1]) ? 1 : 0; }
#pragma unroll
                for (int s = 0; s < 2; ++s) {
#pragma unroll
                    for (int o = 1; o < 32; o <<= 1) cnt[s] += __shfl_xor(cnt[s], o);
                    if (!done[s]) { if (cnt[s] >= 256) lo[s] = mid[s]; else hi[s] = mid[s];
                        if (cnt[s] == 256) { thr[s] = mid[s]; exact[s] = true; done[s] = true; }
                        else if (hi[s] - lo[s] <= 1u) { thr[s] = lo[s]; exact[s] = false; done[s] = true; } } }
            }
            if (__all(exact[0] && exact[1])) {
#pragma unroll
                for (int kt = 0; kt < 64; ++kt) if (kt <= qb) {
#pragma unroll
                    for (int s = 0; s < 2; ++s) { const unsigned long long bal = __ballot(key[kt][s] >= thr[s]);
                        if (lane == 0) { mk[(4 * w + s) * 65 + kt] = (u32)bal; mk[(4 * w + 2 + s) * 65 + kt] = (u32)(bal >> 32); } } }
            } else {
#pragma unroll
                for (int s = 0; s < 2; ++s) {
                    int cgt = 0; const u32 lowk = exact[s] ? thr[s] : thr[s] + 1u;
#pragma unroll
                    for (int kt = 0; kt < 64; ++kt) cgt += (key[kt][s] >= lowk) ? 1 : 0;
#pragma unroll
                    for (int o = 1; o < 32; o <<= 1) cgt += __shfl_xor(cgt, o);
                    const int need = exact[s] ? 0 : 256 - cgt;
                    int rem0 = __shfl(need, 0), rem1 = __shfl(need, 32);
                    const u32 eqk = exact[s] ? 0xFFFFFFFFu : thr[s];
#pragma unroll
                    for (int kt = 0; kt < 64; ++kt) if (kt <= qb) {
                        const unsigned long long bg = __ballot(key[kt][s] >= lowk), be = __ballot(key[kt][s] == eqk);
                        u32 e0 = (u32)be, e1 = (u32)(be >> 32);
                        while (__popc(e0) > rem0) e0 &= ~(1u << (31 - __clz(e0)));
                        while (__popc(e1) > rem1) e1 &= ~(1u << (31 - __clz(e1)));
                        rem0 -= __popc(e0); rem1 -= __popc(e1);
                        if (lane == 0) { mk[(4 * w + s) * 65 + kt] = (u32)bg | e0; mk[(4 * w + 2 + s) * 65 + kt] = (u32)(bg >> 32) | e1; } }
                }
            }
        }
        __syncthreads();
        {
            bf16x8 qfr[4];
#pragma unroll
            for (int kk = 0; kk < 4; ++kk) qfr[kk] = ld8(Z + (size_t)(tok0 + c) * NZ + ZC_QD + w * 64 + 16 * kk + 8 * hl);
            float m = -1e30f, l = 0.f; f32x16 o0 = zero16(), o1 = zero16();
            const bf16_t* kb = kd + (size_t)(b * SEQ + c) * 64 + 8 * hl;
            const bf16_t* vb = vdT + ((size_t)b * 64 + c) * SEQ + 4 * hl;
            for (int kt = 0; kt <= qb; ++kt) {
                const u32 word = mk[c * 65 + kt];
                if (__ballot(word != 0u) == 0ull) continue;
                f32x16 s = zero16();
#pragma unroll
                for (int kk = 0; kk < 4; ++kk) s = MFMA32(ld8(kb + (size_t)kt * 32 * 64 + 16 * kk), qfr[kk], s);
                flash_tile(m, l, o0, o1, s, vm_from_word(word, hl), vb + kt * 32, (size_t)32 * SEQ);
            }
            const float f = 1.0f / fmaxf(l, 1e-30f);
#pragma unroll
            for (int R = 0; R < 16; ++R) { o0[R] *= f; o1[R] *= f; }
            store_ot(odsa + (size_t)(tok0 + c) * 512 + w * 64, o0, o1, hl);
        }
    }
}

typedef __bf16 v2bf_t __attribute__((ext_vector_type(2)));
__device__ __forceinline__ float dot2bf(u32 a, u32 b, float c) { return __builtin_amdgcn_fdot2_f32_bf16(__builtin_bit_cast(v2bf_t, a), __builtin_bit_cast(v2bf_t, b), c, false); }
__device__ __forceinline__ float dpp_hmirror(float v) { return __int_as_float(__builtin_amdgcn_update_dpp(0, __float_as_int(v), 0x141, 0xF, 0xF, true)); }
__device__ __forceinline__ void st_expert2(const Params& p, unsigned char* lds) {
    int tid = threadIdx.x; asm volatile("" : "+v"(tid));
    const int lane = tid & 63, w = __builtin_amdgcn_readfirstlane(tid >> 6), rs = lane >> 3, ch = lane & 7;
    const bf16_t* h2 = (const bf16_t*)(p.ws + WS_H2); const bf16_t* u16 = (const bf16_t*)(p.ws + WS_U16); const bf16_t* v16 = (const bf16_t*)(p.ws + WS_V16);
    const int* eidx = (const int*)(p.ws + WS_EIDX); const float* gate = (const float*)(p.ws + WS_GATE); const float* mod = (const float*)(p.ws + WS_MOD);
    float* wl = (float*)lds + w * 256;
    int* el = (int*)(wl + 128);
    for (int t = blockIdx.x * 8 + w; t < T; t += gridDim.x * 8) {
        u32x4 xq[16];
#pragma unroll
        for (int i = 0; i < 16; ++i) xq[i] = *(const u32x4*)(h2 + (size_t)t * D + (ch + 8 * i) * 8);
        { const int e0 = eidx[(size_t)t * 128 + lane], e1 = eidx[(size_t)t * 128 + 64 + lane]; el[lane] = e0; el[64 + lane] = e1; }
#pragma unroll
        for (int rg = 0; rg < 16; ++rg) {
            const int e = eidx[(size_t)t * 128 + 8 * rg + rs]; const float gt = gate[(size_t)t * 128 + 8 * rg + rs];
            const bf16_t* ur = u16 + (size_t)e * D + ch * 8;
            float s0 = 0.f, s1 = 0.f;
#pragma unroll
            for (int i = 0; i < 16; ++i) { const u32x4 uv = *(const u32x4*)(ur + 64 * i);
                s0 = dot2bf(uv.x, xq[i].x, s0); s1 = dot2bf(uv.y, xq[i].y, s1); s0 = dot2bf(uv.z, xq[i].z, s0); s1 = dot2bf(uv.w, xq[i].w, s1); }
            float s = s0 + s1; s += dpp_hmirror(s); s += dpp_xor1(s); s += dpp_xor2(s);
            if (ch == 0) wl[8 * rg + rs] = gt * gelu_erf(s);
        }
        asm volatile("s_waitcnt lgkmcnt(0)" ::: "memory");
        float acc[16];
#pragma unroll
        for (int i = 0; i < 16; ++i) acc[i] = 0.f;
        for (int k0 = 0; k0 < 128; k0 += 8) {
            u32x4 va[8], vb[8]; float wk[8];
#pragma unroll
            for (int j = 0; j < 8; ++j) { const int e = __builtin_amdgcn_readfirstlane(el[k0 + j]); wk[j] = wl[k0 + j];
                const bf16_t* vr = v16 + (size_t)e * D + lane * 8; va[j] = *(const u32x4*)vr; vb[j] = *(const u32x4*)(vr + 512); }
#pragma unroll
            for (int j = 0; j < 8; ++j) {
                acc[0] += wk[j] * bflo(va[j].x); acc[1] += wk[j] * bfhi(va[j].x); acc[2] += wk[j] * bflo(va[j].y); acc[3] += wk[j] * bfhi(va[j].y);
                acc[4] += wk[j] * bflo(va[j].z); acc[5] += wk[j] * bfhi(va[j].z); acc[6] += wk[j] * bflo(va[j].w); acc[7] += wk[j] * bfhi(va[j].w);
                acc[8] += wk[j] * bflo(vb[j].x); acc[9] += wk[j] * bfhi(vb[j].x); acc[10] += wk[j] * bflo(vb[j].y); acc[11] += wk[j] * bfhi(vb[j].y);
                acc[12] += wk[j] * bflo(vb[j].z); acc[13] += wk[j] * bfhi(vb[j].z); acc[14] += wk[j] * bflo(vb[j].w); acc[15] += wk[j] * bfhi(vb[j].w); }
        }
        const float* g2 = mod + (t >> 11) * 6144 + 5120; float* xr = p.out + (size_t)t * D; float ss = 0.f;
#pragma unroll
        for (int hlf = 0; hlf < 2; ++hlf)
#pragma unroll
            for (int q = 0; q < 2; ++q) { const int d0 = hlf * 512 + lane * 8 + 4 * q; const float4 xv = *(const float4*)(xr + d0), gv = *(const float4*)(g2 + d0);
                float* a = acc + hlf * 8 + 4 * q; a[0] = xv.x + gv.x * a[0]; a[1] = xv.y + gv.y * a[1]; a[2] = xv.z + gv.z * a[2]; a[3] = xv.w + gv.w * a[3];
                ss += a[0] * a[0] + a[1] * a[1] + a[2] * a[2] + a[3] * a[3]; }
        const float r = rsqrtf(wave_sum(ss) * (1.0f / D) + EPS);
#pragma unroll
        for (int hlf = 0; hlf < 2; ++hlf)
#pragma unroll
            for (int q = 0; q < 2; ++q) { const int d0 = hlf * 512 + lane * 8 + 4 * q; const float4 fg = *(const float4*)(p.final_g + d0); const float* a = acc + hlf * 8 + 4 * q;
                float4 o; o.x = a[0] * r * fg.x; o.y = a[1] * r * fg.y; o.z = a[2] * r * fg.z; o.w = a[3] * r * fg.w; *(float4*)(xr + d0) = o; }
        asm volatile("s_waitcnt lgkmcnt(0)" ::: "memory");
    }
}

namespace pg8 {
typedef short bf16x8 __attribute__((ext_vector_type(8)));
typedef float f32x4 __attribute__((ext_vector_type(4)));
typedef unsigned u32x4 __attribute__((ext_vector_type(4)));
constexpr int BM = 256, BK = 64, HALF = 128, HTB = HALF * BK * 2, STAGE_BYTES = 8 * HTB, NXCD = 8, WGM = 8;
__host__ __device__ __forceinline__ int lds_byte(int r, int c) { const int st = (r >> 4) * 2 + (c >> 5), rr = r & 15, cc = c & 31, ob = rr * 64 + cc * 2; return st * 1024 + (ob ^ (((ob >> 9) & 1) << 5)); }
__host__ __device__ __forceinline__ void stage_rc(int b, int& R, int& C) { const int st = b / 1024, sb = b % 1024, swz = sb ^ (((sb >> 9) & 1) << 5); R = (st >> 1) * 16 + swz / 64; C = (st & 1) * 32 + (swz % 64) / 2; }
__host__ __device__ __forceinline__ int perm32(int rho) { const int n = rho >> 4, i = rho & 15; return 8 * (i >> 2) + 4 * n + (i & 3); }
struct Unit { int pm, pn; };
struct Gemm { const bf16_t* A; const bf16_t* Bt; int M, N, K; };
struct StaticOrder {
    int nM, nN, nwg, G, c;
    __host__ __device__ void init(int M, int N, int G_, int c_) { nM = M / BM; nN = N / BM; nwg = nM * nN; G = G_; c = c_; }
    __host__ __device__ bool next(int i, Unit& u) const {
        const long L = (long)i * G + c; if (L >= nwg) return false;
        int wgid = (int)L; { const int q = nwg / NXCD, r = nwg % NXCD, xcd = wgid % NXCD, off = wgid / NXCD; wgid = (xcd < r ? xcd * (q + 1) : r * (q + 1) + (xcd - r) * q) + off; }
        const int nig = WGM * nN, gid = wgid / nig, fm = gid * WGM, gsz = (nM - fm) < WGM ? (nM - fm) : WGM;
        u.pm = fm + ((wgid % nig) % gsz); u.pn = (wgid % nig) / gsz; return true;
    }
    __device__ __forceinline__ void a_ready(const Unit&) const {}
    __device__ __forceinline__ void done(const Unit&) const {}
};
__device__ __forceinline__ unsigned cvt_pk_bf16(float lo, float hi) { unsigned r; asm volatile("v_cvt_pk_bf16_f32 %0, %1, %2" : "=v"(r) : "v"(lo), "v"(hi)); return r; }

template <class Epi, class Sched, bool ALIGN_EPI = false, bool SP2 = false>
__device__ __forceinline__ void gemm_phase(LAS unsigned char* lds, const Gemm g, const Sched& S, const Epi& E) {
    int tid = threadIdx.x; asm volatile("" : "+v"(tid));
    const int wid = __builtin_amdgcn_readfirstlane(tid >> 6), lane = tid & 63, wr = wid >> 2, wc = wid & 3, fr = lane & 15, fq = lane >> 4;
    const int K = g.K, nt = K / BK;
    unsigned voffA[2], voffB[2];
#pragma unroll
    for (int i = 0; i < 2; ++i) { int R, C; stage_rc(tid * 16 + i * 8192, R, C); const int Rb = Epi::PERM ? ((R & ~31) + perm32(R & 31)) : R;
        voffA[i] = (unsigned)(R * K + C) * 2u; voffB[i] = (unsigned)(Rb * K + C) * 2u; }
    const size_t kstep = (size_t)(BK * 2);
    const size_t hstep = (size_t)HALF * K * 2;
    const size_t tstep = 2 * hstep;
    const unsigned ldsw = (unsigned)wid * 1024u;
    const int aoff = lds_byte(wr * 64 + fr, fq * 8), boff = lds_byte(wc * 32 + fr, fq * 8);
#define PG8_SA(b, h) (((b) * 2 + (h)) * HTB)
#define PG8_SB(b, h) ((4 + (b) * 2 + (h)) * HTB)
#define PG8_STAGE(bufoff, gbase, voff) do { _Pragma("unroll") for (int _i = 0; _i < 2; ++_i) \
        __builtin_amdgcn_global_load_lds((const unsigned*)((const char*)(gbase) + (voff)[_i]), (LAS unsigned*)(lds + (bufoff) + ldsw + _i * 8192), 16, 0, 0); } while (0)
#define PG8_LDA(dst, b, h) do { _Pragma("unroll") for (int m = 0; m < 4; ++m) _Pragma("unroll") for (int k = 0; k < 2; ++k) dst[m][k] = *(const LAS bf16x8*)(lds + PG8_SA(b, h) + aoff + m * 2048 + k * 1024); } while (0)
#define PG8_LDB(dst, b, h) do { _Pragma("unroll") for (int n = 0; n < 2; ++n) _Pragma("unroll") for (int k = 0; k < 2; ++k) dst[n][k] = *(const LAS bf16x8*)(lds + PG8_SB(b, h) + boff + n * 2048 + k * 1024); } while (0)
#define PG8_MMA(ai, bj, At, Bt) do { __builtin_amdgcn_s_setprio(1); _Pragma("unroll") for (int m = 0; m < 4; ++m) _Pragma("unroll") for (int n = 0; n < 2; ++n) _Pragma("unroll") for (int k = 0; k < 2; ++k) \
        acc[ai][bj][m][n] = __builtin_amdgcn_mfma_f32_16x16x32_bf16(Bt[n][k], At[m][k], acc[ai][bj][m][n], 0, 0, 0); __builtin_amdgcn_s_setprio(0); } while (0)
#define PG8_WAIT_V(n) asm volatile("s_waitcnt vmcnt(" #n ")" ::: "memory")
#define PG8_WAIT_L(n) asm volatile("s_waitcnt lgkmcnt(" #n ")" ::: "memory")
#define PG8_BAR __builtin_amdgcn_s_barrier()
#define PG8_SCHED __builtin_amdgcn_sched_barrier(0)
    Unit cur, nxt; int ui = 0;
    if (!S.next(0, cur)) return;
    f32x4 acc[2][2][4][2];
#pragma unroll
    for (int a = 0; a < 2; ++a)
#pragma unroll
        for (int b = 0; b < 2; ++b)
#pragma unroll
            for (int m = 0; m < 4; ++m)
#pragma unroll
                for (int n = 0; n < 2; ++n) acc[a][b][m][n] = (f32x4){0.f, 0.f, 0.f, 0.f};
    bf16x8 At[4][2], B0[2][2], B1[2][2];
    const char* cA = (const char*)g.A + (size_t)cur.pm * tstep; const char* cB = (const char*)g.Bt + (size_t)cur.pn * tstep;
    S.a_ready(cur);
    if constexpr (SP2) {
        PG8_STAGE(PG8_SB(0, 0), cB, voffB); PG8_STAGE(PG8_SB(0, 1), cB + hstep, voffB); PG8_STAGE(PG8_SA(0, 0), cA, voffA); PG8_STAGE(PG8_SA(0, 1), cA + hstep, voffA);
        if (wr == 1) PG8_BAR;
        PG8_WAIT_V(2); PG8_BAR;
        PG8_STAGE(PG8_SB(1, 0), cB + kstep, voffB); PG8_STAGE(PG8_SA(1, 0), cA + kstep, voffA); PG8_STAGE(PG8_SB(1, 1), cB + hstep + kstep, voffB);
        PG8_WAIT_V(6); PG8_BAR;
    } else {
        PG8_STAGE(PG8_SB(0, 0), cB, voffB); PG8_STAGE(PG8_SA(0, 0), cA, voffA); PG8_STAGE(PG8_SB(0, 1), cB + hstep, voffB); PG8_STAGE(PG8_SA(0, 1), cA + hstep, voffA);
        if (wr == 1) PG8_BAR;
        PG8_WAIT_V(4); PG8_BAR;
        PG8_STAGE(PG8_SB(1, 0), cB + kstep, voffB); PG8_STAGE(PG8_SA(1, 0), cA + kstep, voffA); PG8_STAGE(PG8_SB(1, 1), cB + hstep + kstep, voffB);
        PG8_WAIT_V(6); PG8_BAR;
    }
    for (;;) {
        const bool has_next = S.next(ui + 1, nxt);
        const char* nA = has_next ? (const char*)g.A + (size_t)nxt.pm * tstep : cA; const char* nB = has_next ? (const char*)g.Bt + (size_t)nxt.pn * tstep : cB;
        for (int t = 0; t < nt; t += 2) {
            const bool last = (t == nt - 2);
            const char* a1 = cA + (size_t)(t + 1) * kstep;
            const char* a2 = last ? nA : cA + (size_t)(t + 2) * kstep; const char* b2 = last ? nB : cB + (size_t)(t + 2) * kstep;
            const char* a3 = a2 + kstep; const char* b3 = b2 + kstep;
            if (last && has_next) S.a_ready(nxt);
            if constexpr (SP2) {
            PG8_LDB(B0, 0, 0); PG8_LDB(B1, 0, 1); PG8_SCHED; PG8_LDA(At, 0, 0); PG8_STAGE(PG8_SA(1, 1), a1 + hstep, voffA);
            PG8_WAIT_V(8); PG8_WAIT_L(0); PG8_BAR; PG8_MMA(0, 0, At, B0); PG8_MMA(0, 1, At, B1); PG8_BAR; PG8_SCHED;
            PG8_LDA(At, 0, 1); PG8_STAGE(PG8_SB(0, 0), b2, voffB); PG8_STAGE(PG8_SB(0, 1), b2 + hstep, voffB); PG8_STAGE(PG8_SA(0, 0), a2, voffA);
            PG8_WAIT_V(8); PG8_WAIT_L(0); PG8_BAR; PG8_MMA(1, 0, At, B0); PG8_MMA(1, 1, At, B1); PG8_BAR; PG8_SCHED;
            PG8_LDB(B0, 1, 0); PG8_LDB(B1, 1, 1); PG8_SCHED; PG8_LDA(At, 1, 0); PG8_STAGE(PG8_SA(0, 1), a2 + hstep, voffA);
            PG8_WAIT_V(8); PG8_WAIT_L(0); PG8_BAR; PG8_MMA(0, 0, At, B0); PG8_MMA(0, 1, At, B1); PG8_BAR; PG8_SCHED;
            PG8_LDA(At, 1, 1); PG8_STAGE(PG8_SB(1, 0), b3, voffB); PG8_STAGE(PG8_SB(1, 1), b3 + hstep, voffB); PG8_STAGE(PG8_SA(1, 0), a3, voffA);
            PG8_WAIT_V(8); PG8_WAIT_L(0); PG8_BAR; PG8_MMA(1, 0, At, B0); PG8_MMA(1, 1, At, B1); PG8_BAR; PG8_SCHED;
            } else {
            PG8_LDB(B0, 0, 0); PG8_SCHED; PG8_LDA(At, 0, 0); PG8_STAGE(PG8_SA(1, 1), a1 + hstep, voffA);
            PG8_WAIT_L(8); PG8_BAR; PG8_WAIT_L(0); PG8_MMA(0, 0, At, B0); PG8_BAR; PG8_SCHED;
            PG8_LDB(B1, 0, 1); PG8_STAGE(PG8_SB(0, 0), b2, voffB);
            PG8_BAR; PG8_WAIT_L(0); PG8_MMA(0, 1, At, B1); PG8_BAR;
            PG8_LDA(At, 0, 1); PG8_STAGE(PG8_SA(0, 0), a2, voffA);
            PG8_BAR; PG8_WAIT_L(0); PG8_MMA(1, 0, At, B0); PG8_BAR; PG8_SCHED;
            PG8_STAGE(PG8_SB(0, 1), b2 + hstep, voffB);
            PG8_WAIT_V(6); PG8_BAR; PG8_MMA(1, 1, At, B1); PG8_BAR;
            PG8_LDB(B0, 1, 0); PG8_SCHED; PG8_LDA(At, 1, 0); PG8_STAGE(PG8_SA(0, 1), a2 + hstep, voffA);
            PG8_WAIT_L(8); PG8_BAR; PG8_WAIT_L(0); PG8_MMA(0, 0, At, B0); PG8_BAR; PG8_SCHED;
            PG8_LDB(B1, 1, 1); PG8_STAGE(PG8_SB(1, 0), b3, voffB);
            PG8_BAR; PG8_WAIT_L(0); PG8_MMA(0, 1, At, B1); PG8_BAR;
            PG8_LDA(At, 1, 1); PG8_STAGE(PG8_SA(1, 0), a3, voffA);
            PG8_BAR; PG8_WAIT_L(0); PG8_MMA(1, 0, At, B0); PG8_BAR; PG8_SCHED;
            PG8_STAGE(PG8_SB(1, 1), b3 + hstep, voffB);
            PG8_WAIT_V(6); PG8_BAR; PG8_MMA(1, 1, At, B1); PG8_BAR;
            }
        }
        if constexpr (ALIGN_EPI) { if (wr == 0) PG8_BAR; }
        if constexpr (!Epi::AFTER_DRAIN) { E(acc, cur, wr, wc, fr, fq); S.done(cur); }
        if (!has_next) break;
#pragma unroll
        for (int a = 0; a < 2; ++a)
#pragma unroll
            for (int b = 0; b < 2; ++b)
#pragma unroll
                for (int m = 0; m < 4; ++m)
#pragma unroll
                    for (int n = 0; n < 2; ++n) acc[a][b][m][n] = (f32x4){0.f, 0.f, 0.f, 0.f};
        cur = nxt; cA = nA; cB = nB; ++ui;
        if constexpr (ALIGN_EPI) { if (wr == 1) PG8_BAR; }
    }
    PG8_WAIT_V(0);
    if constexpr (!ALIGN_EPI) { if (wr == 0) PG8_BAR; }
    PG8_BAR;
#undef PG8_SA
#undef PG8_SB
#undef PG8_STAGE
#undef PG8_LDA
#undef PG8_LDB
#undef PG8_MMA
#undef PG8_WAIT_V
#undef PG8_WAIT_L
#undef PG8_BAR
#undef PG8_SCHED
}
struct EpiZ {
    static constexpr bool PERM = true, AFTER_DRAIN = false;
    bf16_t* Z; const float* cosT; const float* sinT;
    __device__ __forceinline__ void operator()(const f32x4 (&acc)[2][2][4][2], const Unit& u, int wr, int wc, int fr, int fq) const {
#pragma unroll
        for (int bj = 0; bj < 2; ++bj) {
            const int cb = u.pn * BM + bj * HALF + wc * 32;
            const int g64 = cb >> 6; const int c0 = cb + 8 * fq;
            const bool roped = (g64 < 64) && ((ROPE_MASK >> g64) & 1ull);
            const bool sig = (cb >= ZC_GM) || (c0 >= ZC_GN && c0 < ZC_WI);
            const float sc = ((g64 < 64) && ((SCALE_MASK >> g64) & 1ull)) ? 0.125f : 1.0f;
#pragma unroll
            for (int ai = 0; ai < 2; ++ai)
#pragma unroll
                for (int m = 0; m < 4; ++m) {
                    const int row = u.pm * BM + ai * HALF + wr * 64 + m * 16 + fr;
                    f32x4 v0 = acc[ai][bj][m][0], v1 = acc[ai][bj][m][1];
                    if (roped) {
                        const int pos = row & (SEQ - 1), i0 = (c0 & 63) >> 1;
                        const f32x4 cs = *(const f32x4*)(cosT + pos * 32 + i0), sn = *(const f32x4*)(sinT + pos * 32 + i0);
                        const f32x4 a = v0, b = v1;
                        v0[0] = (a[0] * cs[0] - a[1] * sn[0]) * sc; v0[1] = (a[1] * cs[0] + a[0] * sn[0]) * sc;
                        v0[2] = (a[2] * cs[1] - a[3] * sn[1]) * sc; v0[3] = (a[3] * cs[1] + a[2] * sn[1]) * sc;
                        v1[0] = (b[0] * cs[2] - b[1] * sn[2]) * sc; v1[1] = (b[1] * cs[2] + b[0] * sn[2]) * sc;
                        v1[2] = (b[2] * cs[3] - b[3] * sn[3]) * sc; v1[3] = (b[3] * cs[3] + b[2] * sn[3]) * sc;
                    } else if (sig) {
#pragma unroll
                        for (int e = 0; e < 4; ++e) { v0[e] = sigmoidf_(v0[e]); v1[e] = sigmoidf_(v1[e]); }
                    }
                    u32x4 w; w.x = cvt_pk_bf16(v0[0], v0[1]); w.y = cvt_pk_bf16(v0[2], v0[3]); w.z = cvt_pk_bf16(v1[0], v1[1]); w.w = cvt_pk_bf16(v1[2], v1[3]);
                    *(u32x4*)(Z + (size_t)row * NZ + c0) = w;
                }
        }
    }
};
struct EpiMerge {
    static constexpr bool PERM = true, AFTER_DRAIN = false;
    bf16_t* O; const bf16_t* Zg; int mode;
    __device__ __forceinline__ void operator()(const f32x4 (&acc)[2][2][4][2], const Unit& u, int wr, int wc, int fr, int fq) const {
#pragma unroll
        for (int ai = 0; ai < 2; ++ai)
#pragma unroll
            for (int m = 0; m < 4; ++m) { const int row = u.pm * BM + ai * HALF + wr * 64 + m * 16 + fr;
#pragma unroll
                for (int bj = 0; bj < 2; ++bj) { const int c0 = u.pn * BM + bj * HALF + wc * 32 + 8 * fq;
                    const u32x4 gz = *(const u32x4*)(Zg + (size_t)row * NZ + c0);
                    f32x4 v0 = acc[ai][bj][m][0], v1 = acc[ai][bj][m][1];
                    v0[0] *= bflo(gz.x); v0[1] *= bfhi(gz.x); v0[2] *= bflo(gz.y); v0[3] *= bfhi(gz.y); v1[0] *= bflo(gz.z); v1[1] *= bfhi(gz.z); v1[2] *= bflo(gz.w); v1[3] *= bfhi(gz.w);
                    bf16_t* op = O + (size_t)row * D + c0;
                    if (mode) { const u32x4 o = *(const u32x4*)op;
                        v0[0] += bflo(o.x); v0[1] += bfhi(o.x); v0[2] += bflo(o.y); v0[3] += bfhi(o.y); v1[0] += bflo(o.z); v1[1] += bfhi(o.z); v1[2] += bflo(o.w); v1[3] += bfhi(o.w); }
                    u32x4 w; w.x = cvt_pk_bf16(v0[0], v0[1]); w.y = cvt_pk_bf16(v0[2], v0[3]); w.z = cvt_pk_bf16(v1[0], v1[1]); w.w = cvt_pk_bf16(v1[2], v1[3]);
                    *(u32x4*)op = w; } }
    }
};
struct EpiOut {
    static constexpr bool PERM = true, AFTER_DRAIN = false;
    const float* x; float* o; const float* mod;
    __device__ __forceinline__ void operator()(const f32x4 (&acc)[2][2][4][2], const Unit& u, int wr, int wc, int fr, int fq) const {
#pragma unroll
        for (int ai = 0; ai < 2; ++ai)
#pragma unroll
            for (int m = 0; m < 4; ++m) { const int row = u.pm * BM + ai * HALF + wr * 64 + m * 16 + fr; const float* g1 = mod + (row >> 11) * 6144 + 2048;
#pragma unroll
                for (int bj = 0; bj < 2; ++bj) { const int c0 = u.pn * BM + bj * HALF + wc * 32 + 8 * fq;
#pragma unroll
                    for (int n = 0; n < 2; ++n) { const f32x4 gg = *(const f32x4*)(g1 + c0 + 4 * n), xx = *(const f32x4*)(x + (size_t)row * D + c0 + 4 * n);
                        *(f32x4*)(o + (size_t)row * D + c0 + 4 * n) = xx + gg * acc[ai][bj][m][n]; } } }
    }
};
struct EpiF32 {
    static constexpr bool PERM = true, AFTER_DRAIN = false;
    float* O; int ldc;
    __device__ __forceinline__ void operator()(const f32x4 (&acc)[2][2][4][2], const Unit& u, int wr, int wc, int fr, int fq) const {
#pragma unroll
        for (int ai = 0; ai < 2; ++ai)
#pragma unroll
            for (int m = 0; m < 4; ++m) { const int row = u.pm * BM + ai * HALF + wr * 64 + m * 16 + fr;
#pragma unroll
                for (int bj = 0; bj < 2; ++bj) { const int c0 = u.pn * BM + bj * HALF + wc * 32 + 8 * fq;
                    *(f32x4*)(O + (size_t)row * ldc + c0) = acc[ai][bj][m][0]; *(f32x4*)(O + (size_t)row * ldc + c0 + 4) = acc[ai][bj][m][1]; } }
    }
};
}

template <bool ZMAP>
__device__ __forceinline__ void transpose_item(const float* W, int K, int Nsrc, bf16_t* WT, LAS float* scr, int item, int nblk, int lane) {
    const int kb = item / nblk, nb = item % nblk, k0 = 64 * kb, n0 = 32 * nb;
    int sc = n0 + (lane & 31); if (ZMAP) sc = z_logical_col(sc);
#pragma unroll 8
    for (int i = 0; i < 32; ++i) { const int kk = 2 * i + (lane >> 5); scr[kk * 33 + (lane & 31)] = (sc >= 0) ? W[(size_t)(k0 + kk) * Nsrc + sc] : 0.f; }
    asm volatile("s_waitcnt lgkmcnt(0)" ::: "memory");
    const int c = lane & 7;
#pragma unroll
    for (int j = 0; j < 4; ++j) { const int n = (lane >> 3) + 8 * j; const LAS float* s = scr + (8 * c) * 33 + n;
        uint4 o; o.x = pk2(s[0 * 33], s[1 * 33]); o.y = pk2(s[2 * 33], s[3 * 33]); o.z = pk2(s[4 * 33], s[5 * 33]); o.w = pk2(s[6 * 33], s[7 * 33]);
        *(uint4*)(WT + (size_t)(n0 + n) * K + k0 + 8 * c) = o; }
    asm volatile("s_waitcnt lgkmcnt(0)" ::: "memory");
}
__device__ __forceinline__ void st_convert(const Params& p, unsigned char* lds) {
    const int tid = threadIdx.x, lane = tid & 63, w = __builtin_amdgcn_readfirstlane(tid >> 6);
    LAS float* scr = (LAS float*)((LAS unsigned char*)lds + 49152 + w * 8704);
    const int gw = blockIdx.x * 8 + w, NGW = gridDim.x * 8;
    constexpr int I_IN = 16 * 144, I_BR = 8 * 32, I_OUT = 16 * 32;
    for (int it = gw; it < I_IN + 2 * I_BR + I_OUT; it += NGW) {
        int r = it;
        if (r < I_IN) { transpose_item<true>(p.w_in, D, DIN, (bf16_t*)(p.ws + WS_WINT), scr, r, 144, lane); continue; } r -= I_IN;
        if (r < I_BR) { transpose_item<false>(p.w_nsa, 512, D, (bf16_t*)(p.ws + WS_WNSAT), scr, r, 32, lane); continue; } r -= I_BR;
        if (r < I_BR) { transpose_item<false>(p.w_dsa, 512, D, (bf16_t*)(p.ws + WS_WDSAT), scr, r, 32, lane); continue; } r -= I_BR;
        transpose_item<false>(p.w_out, D, D, (bf16_t*)(p.ws + WS_WOUTT), scr, r, 32, lane);
    }
    { bf16_t* w1t = (bf16_t*)(p.ws + WS_W1T); float* bpos = (float*)(p.ws + WS_BPOS);
      for (int it = blockIdx.x * NTHR + tid; it < 2 * 64 * 2048; it += gridDim.x * NTHR) {
          const int e = it & 63, kidx = (it >> 6) & 2047, kv = it >> 17; const int l = kidx >> 6, dp = kidx & 63; const int d = kv ? dp : ((dp >> 1) + 32 * (dp & 1));
          w1t[((size_t)kv * 64 + e) * 2048 + kidx] = f2bf((kv ? p.w1v : p.w1k)[(l * 64 + d) * 64 + e]); }
      for (int o = gw; o < 128; o += NGW) { const int kv = o >> 6, e = o & 63; const float* w1 = kv ? p.w1v : p.w1k; float s = 0.f;
          for (int i = lane; i < 2048; i += 64) s += p.cmp_pos[i] * w1[i * 64 + e];
          s = wave_sum(s); if (lane == 0) bpos[o] = s; } }
    bf16_t* wf = (bf16_t*)(p.ws + WS_WFOLDT);
    for (int it = blockIdx.x * NTHR + tid; it < 2048 * 1024 / 2; it += gridDim.x * NTHR) {
        const int k = (it & 511) * 2, col = it >> 9, hc = col >> 7;
        const float* sk = p.subkeys + (size_t)col * 64; const float* q0 = p.wq + (size_t)k * D + hc * 64; const float* q1 = q0 + D;
        float a0 = 0.f, a1 = 0.f;
#pragma unroll 8
        for (int d = 0; d < 64; d += 4) { const float4 s4 = *(const float4*)(sk + d), x0 = *(const float4*)(q0 + d), x1 = *(const float4*)(q1 + d);
            a0 += s4.x * x0.x + s4.y * x0.y + s4.z * x0.z + s4.w * x0.w; a1 += s4.x * x1.x + s4.y * x1.y + s4.z * x1.z + s4.w * x1.w; }
        *(u32*)(wf + (size_t)col * D + k) = pk2(a0, a1);
    }
}
__device__ __forceinline__ void st_z_gemm(const Params& p, unsigned char* lds) {
    pg8::Gemm g{(const bf16_t*)(p.ws + WS_HB), (const bf16_t*)(p.ws + WS_WINT), T, NZ, D}; pg8::StaticOrder S; S.init(T, NZ, gridDim.x, blockIdx.x);
    pg8::EpiZ E{(bf16_t*)(p.ws + WS_Z), (const float*)(p.ws + WS_COS), (const float*)(p.ws + WS_SIN)};
    pg8::gemm_phase<pg8::EpiZ, pg8::StaticOrder, true, true>((LAS unsigned char*)lds, g, S, E);
}
__device__ __forceinline__ void st_merge_gemm(const Params& p, unsigned char* lds) {
    pg8::StaticOrder S; S.init(T, D, gridDim.x, blockIdx.x);
    { pg8::Gemm g{(const bf16_t*)(p.ws + WS_ONSA), (const bf16_t*)(p.ws + WS_WNSAT), T, D, 512};
      pg8::EpiMerge E{(bf16_t*)(p.ws + WS_MERGED), (const bf16_t*)(p.ws + WS_Z) + ZC_GM, 0};
      pg8::gemm_phase<pg8::EpiMerge, pg8::StaticOrder, true, true>((LAS unsigned char*)lds, g, S, E); }
    asm volatile("s_waitcnt vmcnt(0)" ::: "memory"); __syncthreads();
    { pg8::Gemm g{(const bf16_t*)(p.ws + WS_ODSA), (const bf16_t*)(p.ws + WS_WDSAT), T, D, 512};
      pg8::EpiMerge E{(bf16_t*)(p.ws + WS_MERGED), (const bf16_t*)(p.ws + WS_Z) + ZC_GM + 1024, 1};
      pg8::gemm_phase<pg8::EpiMerge, pg8::StaticOrder, true, true>((LAS unsigned char*)lds, g, S, E); }
}
__device__ __forceinline__ void st_out_gemm(const Params& p, unsigned char* lds) {
    pg8::Gemm g{(const bf16_t*)(p.ws + WS_MERGED), (const bf16_t*)(p.ws + WS_WOUTT), T, D, D}; pg8::StaticOrder S; S.init(T, D, gridDim.x, blockIdx.x);
    pg8::EpiOut E{p.x, p.out, (const float*)(p.ws + WS_MOD)};
    pg8::gemm_phase<pg8::EpiOut, pg8::StaticOrder, true, true>((LAS unsigned char*)lds, g, S, E);
}
__device__ __forceinline__ void st_ssub_gemm(const Params& p, unsigned char* lds) {
    pg8::Gemm g{(const bf16_t*)(p.ws + WS_H2), (const bf16_t*)(p.ws + WS_WFOLDT), T, 2048, D}; pg8::StaticOrder S; S.init(T, 2048, gridDim.x, blockIdx.x);
    pg8::EpiF32 E{(float*)(p.ws + WS_SSUB), 2048};
    pg8::gemm_phase<pg8::EpiF32, pg8::StaticOrder, true, true>((LAS unsigned char*)lds, g, S, E);
}

typedef float f32x4_t __attribute__((ext_vector_type(4)));
__device__ __forceinline__ void st_prep(const Params& p, unsigned char* lds) {
    int tid = threadIdx.x; asm volatile("" : "+v"(tid));
    const int lane = tid & 63, w = __builtin_amdgcn_readfirstlane(tid >> 6);
    const bf16_t* Z = (const bf16_t*)(p.ws + WS_Z);
    const float* cosT = (const float*)(p.ws + WS_COS); const float* sinT = (const float*)(p.ws + WS_SIN);
    unsigned char* dob = (unsigned char*)p.out;
    bf16_t* kd = (bf16_t*)(dob + DO_KD); bf16_t* vdT = (bf16_t*)(dob + DO_VDT); bf16_t* vsT = (bf16_t*)(dob + DO_VST); bf16_t* vwT = (bf16_t*)(dob + DO_VWT);
    bf16_t* kcmp = (bf16_t*)(dob + DO_KCMP); bf16_t* vcmpT = (bf16_t*)(dob + DO_VCMPT);
    {   float* red = (float*)lds;
        float* hid = red + 8 * 16 * 64;
        const bf16_t* w1t = (const bf16_t*)(p.ws + WS_W1T); const float* bpos = (const float*)(p.ws + WS_BPOS);
        for (int u = blockIdx.x; u < 256; u += gridDim.x) {
            const int kv = u >> 7, b = (u >> 4) & 7, g = (u >> 3) & 1, n0 = (u & 7) * 16;
            const int nl = lane & 15, kq = lane >> 4; int n = n0 + nl; if (n > 126) n = 126;
            pg8::f32x4 acc[4];
#pragma unroll
            for (int ec = 0; ec < 4; ++ec) acc[ec] = (pg8::f32x4){0.f, 0.f, 0.f, 0.f};
            const bf16_t* ab = Z + (size_t)(b * SEQ + 16 * n) * NZ + (kv ? ZC_VC : ZC_KC) + g * 64 + 8 * kq;
            const bf16_t* bb = w1t + ((size_t)kv * 64 + nl) * 2048 + 8 * kq;
#pragma unroll
            for (int i = 0; i < 8; ++i) { const int kk = 8 * w + i;
                const pg8::bf16x8 a = *(const pg8::bf16x8*)(ab + (size_t)(kk >> 1) * NZ + (kk & 1) * 32);
#pragma unroll
                for (int ec = 0; ec < 4; ++ec) { const pg8::bf16x8 bv = *(const pg8::bf16x8*)(bb + (size_t)ec * 16 * 2048 + 32 * kk);
                    acc[ec] = __builtin_amdgcn_mfma_f32_16x16x32_bf16(a, bv, acc[ec], 0, 0, 0); } }
            __syncthreads();
#pragma unroll
            for (int ec = 0; ec < 4; ++ec)
#pragma unroll
                for (int r = 0; r < 4; ++r) red[(w * 16 + 4 * kq + r) * 64 + 16 * ec + nl] = acc[ec][r];
            __syncthreads();
#pragma unroll
            for (int q = 0; q < 2; ++q) { const int o = tid + 512 * q; float s = bpos[kv * 64 + (o & 63)];
#pragma unroll
                for (int ww = 0; ww < 8; ++ww) s += red[ww * 1024 + o];
                hid[o] = gelu_tanh(s); }
            __syncthreads();
            { const int nn = tid >> 5, f0 = (tid & 31) * 2; const float* w2 = kv ? p.w2v : p.w2k; float a0 = 0.f, a1 = 0.f;
              for (int e = 0; e < 64; ++e) { const float h = hid[nn * 64 + e]; const float2 ww = *(const float2*)(w2 + e * 64 + f0); a0 += h * ww.x; a1 += h * ww.y; }
              const int nglob = n0 + nn; if (nglob > 126) { a0 = 0.f; a1 = 0.f; }
              if (kv == 0) { bf16_t* o = kcmp + (((size_t)b * 2 + g) * 128 + nglob) * 64; o[2 * (f0 & 31) + (f0 >> 5)] = f2bf(a0); o[2 * ((f0 + 1) & 31) + ((f0 + 1) >> 5)] = f2bf(a1); }
              else { bf16_t* o = vcmpT + (((size_t)b * 2 + g) * 64 + f0) * 128 + nglob; o[0] = f2bf(a0); o[128] = f2bf(a1); } }
        }
        __syncthreads();
    }
    {   bf16_t* tl = (bf16_t*)lds;
        for (int it = blockIdx.x; it < 512; it += gridDim.x) {
            const int which = it & 1, tt = (it >> 1) & 31, b = it >> 6; const int t0 = b * SEQ + tt * 64;
            __syncthreads();
#pragma unroll
            for (int q = 0; q < 2; ++q) { const int idx = tid + 512 * q, tok = idx >> 4, ch = idx & 15;
                const uint4 v = *(const uint4*)(Z + (size_t)(t0 + tok) * NZ + (which ? ZC_VW : ZC_VS) + ch * 8); bf16_t* d = tl + tok * 130 + ch * 8;
                d[0] = (bf16_t)v.x; d[1] = (bf16_t)(v.x >> 16); d[2] = (bf16_t)v.y; d[3] = (bf16_t)(v.y >> 16); d[4] = (bf16_t)v.z; d[5] = (bf16_t)(v.z >> 16); d[6] = (bf16_t)v.w; d[7] = (bf16_t)(v.w >> 16); }
            __syncthreads();
#pragma unroll
            for (int q = 0; q < 2; ++q) { const int idx = tid + 512 * q, gd = idx >> 3, c8 = idx & 7; const bf16_t* s = tl + (c8 * 8) * 130 + gd;
                uint4 o; o.x = (u32)s[0] | ((u32)s[130] << 16); o.y = (u32)s[260] | ((u32)s[390] << 16); o.z = (u32)s[520] | ((u32)s[650] << 16); o.w = (u32)s[780] | ((u32)s[910] << 16);
                *(uint4*)((which ? vwT : vsT) + ((size_t)b * 128 + gd) * SEQ + tt * 64 + c8 * 8) = o; }
        }
    }
    for (int it = blockIdx.x * NTHR + tid; it < T * 32; it += gridDim.x * NTHR) {
        const int t = it >> 5, i = it & 31; const bf16_t* cr = Z + (size_t)t * NZ + ZC_CKV;
        float ss = 0.f;
#pragma unroll 4
        for (int r = 0; r < 128; r += 8) { const uint4 v = *(const uint4*)(cr + r);
            ss += bflo(v.x) * bflo(v.x) + bfhi(v.x) * bfhi(v.x) + bflo(v.y) * bflo(v.y) + bfhi(v.y) * bfhi(v.y) + bflo(v.z) * bflo(v.z) + bfhi(v.z) * bfhi(v.z) + bflo(v.w) * bflo(v.w) + bfhi(v.w) * bfhi(v.w); }
        const float rn = rsqrtf(ss * (1.0f / 128.0f) + EPS);
        float k1 = 0.f, k2 = 0.f, v1 = 0.f, v2 = 0.f;
#pragma unroll 4
        for (int r = 0; r < 128; ++r) { const float cn = bf2f(cr[r]) * rn * p.kvg[r];
            k1 += cn * p.w_uk[r * 64 + i]; k2 += cn * p.w_uk[r * 64 + i + 32]; v1 += cn * p.w_uv[r * 64 + i]; v2 += cn * p.w_uv[r * 64 + i + 32]; }
        const int pos = t & (SEQ - 1), b = t >> 11; const float c = cosT[pos * 32 + i], s = sinT[pos * 32 + i];
        *(u32*)(kd + (size_t)t * 64 + 2 * i) = pk2(k1 * c - k2 * s, k2 * c + k1 * s);
        vdT[((size_t)b * 64 + i) * SEQ + pos] = f2bf(v1); vdT[((size_t)b * 64 + i + 32) * SEQ + pos] = f2bf(v2);
    }
}

#define XB_TMO      128
#define XB_XCNT(j)  (256  + 64 * (j))
#define XB_XSUB(j)  (1280 + 64 * (j))
#define XB_XGEN(j)  (2304 + 64 * (j))
#define XB_TOP      3328
#define XB_TOPGEN   3392
#define XCD_BAR_WORDS 3456
#define XB_SPIN_CAP (1u << 22)
__device__ __forceinline__ unsigned xb_ld(unsigned* p)              { return __hip_atomic_load(p, __ATOMIC_RELAXED, __HIP_MEMORY_SCOPE_AGENT); }
__device__ __forceinline__ unsigned xb_add(unsigned* p, unsigned v) { return __hip_atomic_fetch_add(p, v, __ATOMIC_RELAXED, __HIP_MEMORY_SCOPE_AGENT); }
__device__ __forceinline__ unsigned xb_xcc_id() { return (unsigned)__builtin_amdgcn_s_getreg((3 << 11) | 20) & 0xFu; }
#define XB_SPIN(cond, bar) do { unsigned _sp = 0; while (cond) { __builtin_amdgcn_s_sleep(1); \
    if ((++_sp & 255u) == 0u) { if (xb_ld(&(bar)[XB_TMO])) break; if (_sp > XB_SPIN_CAP) { atomicAdd(&(bar)[XB_TMO], 1u); break; } } } } while (0)
struct XcdBarrier { unsigned* bar; unsigned x; volatile LAS unsigned* st; };
__device__ __forceinline__ XcdBarrier xcd_barrier_post(unsigned* bar, volatile LAS unsigned* st) {
    XcdBarrier b; b.bar = bar; b.x = xb_xcc_id(); b.st = st;
    if (threadIdx.x == 0) (void)xb_add(&bar[XB_XCNT(b.x)], 1u);
    return b;
}
__device__ __forceinline__ void xcd_barrier_complete(unsigned* bar, unsigned x, unsigned& nloc, unsigned& nx) {
    const unsigned G = gridDim.x * gridDim.y * gridDim.z;
    unsigned sum, cnt, mine, sp = 0u;
    for (;;) {
        sum = 0u; cnt = 0u; mine = 0u;
#pragma unroll
        for (unsigned j = 0; j < 16; ++j) { const unsigned c = xb_ld(&bar[XB_XCNT(j)]); sum += c; cnt += (c > 0u) ? 1u : 0u; mine = (j == x) ? c : mine; }
        if (sum == G) break;
        __builtin_amdgcn_s_sleep(1);
        if ((++sp & 255u) == 0u) { if (xb_ld(&bar[XB_TMO])) break; if (sp > XB_SPIN_CAP) { atomicAdd(&bar[XB_TMO], 1u); break; } }
    }
    nloc = mine > 0u ? mine : 1u; nx = cnt > 0u ? cnt : 1u;
}
__device__ __forceinline__ void xcd_barrier(const XcdBarrier& b) {
    asm volatile("s_waitcnt vmcnt(0)" ::: "memory");
    __syncthreads();
    if (threadIdx.x == 0) {
        unsigned* bar = b.bar;
        __builtin_amdgcn_s_waitcnt(0);
        unsigned nloc = b.st[0], nx = b.st[1];
        if (nloc == 0u) { xcd_barrier_complete(bar, b.x, nloc, nx); b.st[0] = nloc; b.st[1] = nx; }
        const unsigned old = xb_add(&bar[XB_XSUB(b.x)], 1u);
        const unsigned gen = old / nloc;
        if (old + 1u == (gen + 1u) * nloc) {
            __builtin_amdgcn_fence(__ATOMIC_RELEASE, "agent");
            asm volatile("s_waitcnt vmcnt(0)" ::: "memory");
            const unsigned og = xb_add(&bar[XB_TOP], 1u);
            const unsigned tg = og / nx;
            if (og + 1u == (tg + 1u) * nx) xb_add(&bar[XB_TOPGEN], 1u);
            else XB_SPIN(xb_ld(&bar[XB_TOPGEN]) == tg, bar);
            __builtin_amdgcn_fence(__ATOMIC_ACQUIRE, "agent");
            xb_add(&bar[XB_XGEN(b.x)], 1u);
            asm volatile("s_waitcnt vmcnt(0)" ::: "memory");
        } else {
            XB_SPIN(xb_ld(&bar[XB_XGEN(b.x)]) == gen, bar);
            __builtin_amdgcn_fence(__ATOMIC_ACQUIRE, "agent");
            asm volatile("s_waitcnt vmcnt(0)" ::: "memory");
        }
    }
    __syncthreads();
}

constexpr int LDS_BYTES = 131072 + 1024;
constexpr int LDS_CTL = 131072;
__global__ void __launch_bounds__(NTHR, 2) k_mega(Params p) {
    extern __shared__ __attribute__((aligned(16))) unsigned char smem[];
    if (threadIdx.x < 4) ((volatile LAS unsigned*)(smem + LDS_CTL))[threadIdx.x] = 0u;
    __syncthreads();
    XcdBarrier bar = xcd_barrier_post((unsigned*)(p.ws + WS_BAR), (volatile LAS unsigned*)(smem + LDS_CTL));
#define GBAR() xcd_barrier(bar)
    st_adaln(p, smem);
    st_convert(p, smem);      GBAR();
    st_norm_rows(p, 0);       GBAR();
    st_z_gemm(p, smem);       GBAR();
    st_prep(p, smem);         GBAR();
    st_nsa(p);                __syncthreads();
    st_dsa(p, smem);          GBAR();
    st_merge_gemm(p, smem);   GBAR();
    st_out_gemm(p, smem);     GBAR();
    st_norm_rows(p, 1);       GBAR();
    st_ssub_gemm(p, smem);    GBAR();
    st_route(p);
    st_cvt_uv(p);             GBAR();
    st_expert2(p, smem);
}

extern "C" void kernel_launch(void* const* d_in, const int* in_sizes, int n_in, void* d_out, int out_size, void* d_ws, size_t ws_size, hipStream_t stream) {
    static int grid = 0;
    if (grid == 0) {
        int dev = 0, cus = 0, per_cu = 0;
        hipGetDevice(&dev); hipDeviceGetAttribute(&cus, hipDeviceAttributeMultiprocessorCount, dev);
        hipFuncSetAttribute((const void*)k_mega, hipFuncAttributeMaxDynamicSharedMemorySize, LDS_BYTES);
        hipOccupancyMaxActiveBlocksPerMultiprocessor(&per_cu, (const void*)k_mega, NTHR, LDS_BYTES);
        if (per_cu < 1) { fprintf(stderr, "kernel_launch: occupancy query says %d blocks/CU\n", per_cu); per_cu = 1; }
        (void)hipGetLastError();
        grid = cus;
    }
    Params p{};
    const float** f = (const float**)&p;
    for (int i = 0; i < 23; ++i) f[i] = (const float*)d_in[i];
    p.out = (float*)d_out; p.ws = (unsigned char*)d_ws;
    hipMemsetAsync((unsigned char*)d_ws + WS_BAR, 0, 16384, stream);
    hipLaunchKernelGGL(k_mega, dim3(grid), dim3(NTHR), LDS_BYTES, stream, p);
}
#ifdef TESTK
__global__ void __launch_bounds__(NTHR, 2) k_t_nsa(Params p) { st_nsa(p); }
__global__ void __launch_bounds__(NTHR, 2) k_t_dsa(Params p) { extern __shared__ __attribute__((aligned(16))) unsigned char smem[]; st_dsa(p, smem); }
#endif
```

```cpp
#include <hip/hip_runtime.h>
#include <stdint.h>
#include <stdio.h>

#define LAS __attribute__((address_space(3)))
typedef unsigned short bf16_t;
typedef unsigned int u32;

constexpr int T = 16384, SEQ = 2048, NB = 8, D = 1024, NZ = 4608, DIN = 4576;
constexpr int NTHR = 512;
constexpr float EPS = 1e-6f;
constexpr int ZC_QN = 0, ZC_KC = 512, ZC_VC = 640, ZC_KS = 768, ZC_VS = 896, ZC_KW = 1024, ZC_VW = 1152, ZC_QD = 1280, ZC_CKV = 1792,
              ZC_QI = 1920, ZC_KI = 2432, ZC_GN = 2496, ZC_WI = 2520, ZC_GM = 2560;
constexpr unsigned long long ROPE_MASK = 0xFFull | (3ull << 8) | (3ull << 12) | (3ull << 16) | (0xFFull << 20) | (0xFFull << 30) | (1ull << 38);
constexpr unsigned long long SCALE_MASK = 0xFFull | (0xFFull << 20) | (0xFFull << 30);

constexpr size_t WS_Z = 0;
constexpr size_t WS_SSUB = 0;
constexpr size_t WS_EIDX = 134217728;
constexpr size_t WS_GATE = 142606336;
constexpr size_t WS_MERGED = 150994944;
constexpr size_t WS_U16 = WS_MERGED;
constexpr size_t WS_HB = 184549376;
constexpr size_t WS_ONSA = WS_HB;
constexpr size_t WS_ODSA = WS_HB + 16777216;
constexpr size_t WS_V16 = WS_HB;
constexpr size_t WS_H2 = 218103808;
constexpr size_t WS_W = 251658240;
constexpr size_t WS_WINT = WS_H2;
constexpr size_t WS_WNSAT = WS_W;
constexpr size_t WS_WDSAT = WS_WNSAT + 1048576;
constexpr size_t WS_WOUTT = WS_WDSAT + 1048576;
constexpr size_t WS_WFOLDT = WS_WOUTT + 2097152;
constexpr size_t WS_SMALL = WS_WFOLDT + 4194304;
constexpr size_t WS_MOD = WS_SMALL;
constexpr size_t WS_COS = WS_MOD + 196608;
constexpr size_t WS_SIN = WS_COS + 262144;
constexpr size_t WS_BAR = WS_SIN + 262144;
constexpr size_t WS_W1T = WS_BAR + 16384;
constexpr size_t WS_BPOS = WS_W1T + 524288;
constexpr size_t WS_END_SMALL = WS_BPOS + 512;
static_assert(WS_END_SMALL <= 268435456, "ws overflow");
constexpr size_t DO_KD = 0;
constexpr size_t DO_VDT = 2097152;
constexpr size_t DO_VST = 4194304;
constexpr size_t DO_VWT = 8388608;
constexpr size_t DO_KCMP = 12582912;
constexpr size_t DO_VCMPT = 12845056;
constexpr size_t DO_HID = 13107200;
constexpr size_t DO_MASK = 14680064;
constexpr size_t DO_END = DO_MASK + 4194304;

struct Params {
    const float *x, *c, *ada_w, *ada_b, *norm1_g, *w_in, *cmp_pos, *w1k, *w2k, *w1v, *w2v, *kvg, *w_uk, *w_uv, *w_nsa, *w_dsa, *w_out, *norm2_g, *wq,
        *subkeys, *pu, *pv, *final_g;
    float* out;
    unsigned char* ws;
};

__device__ __forceinline__ bf16_t f2bf(float f) { u32 u = __float_as_uint(f); u += 0x7fffu + ((u >> 16) & 1u); return (bf16_t)(u >> 16); }
__device__ __forceinline__ float bf2f(bf16_t h) { return __uint_as_float((u32)h << 16); }
__device__ __forceinline__ float bflo(u32 w) { return __uint_as_float(w << 16); }
__device__ __forceinline__ float bfhi(u32 w) { return __uint_as_float(w & 0xffff0000u); }
__device__ __forceinline__ u32 pk2(float lo, float hi) { return (u32)f2bf(lo) | ((u32)f2bf(hi) << 16); }
__device__ __forceinline__ float wave_sum(float v) {
#pragma unroll
    for (int o = 1; o < 64; o <<= 1) v += __shfl_xor(v, o);
    return v;
}
__device__ __forceinline__ float wave_max(float v) {
#pragma unroll
    for (int o = 1; o < 64; o <<= 1) v = fmaxf(v, __shfl_xor(v, o));
    return v;
}
__device__ __forceinline__ float sigmoidf_(float v) { return 1.0f / (1.0f + __expf(-v)); }
__device__ __forceinline__ float gelu_tanh(float v) { const float u = 0.7978845608028654f * (v + 0.044715f * v * v * v); return 0.5f * v * (1.0f + tanhf(u)); }
__device__ __forceinline__ float gelu_erf(float v) { return 0.5f * v * (1.0f + erff(v * 0.7071067811865476f)); }
__device__ __forceinline__ int z_logical_col(int pc) {
    const int g64 = pc >> 6; const int o = pc & 63;
    const int po = (g64 < 64 && ((ROPE_MASK >> g64) & 1ull)) ? ((o >> 1) + 32 * (o & 1)) : o;
    const int pp = (pc & ~63) + po;
    if (pc < 1280) return pp;
    if (pc < 1792) return 1304 + (pp - 1280);
    if (pc < 1920) return 1816 + (pp - 1792);
    if (pc < 2432) return 1944 + (pp - 1920);
    if (pc < 2496) return 2456 + (pp - 2432);
    if (pc < 2520) return 1280 + (pc - 2496);
    if (pc < 2528) return 2520 + (pc - 2520);
    if (pc < 2560) return -1;
    return 2528 + (pc - 2560);
}
__device__ __forceinline__ void z_post(int t, int pc, float& v0, float& v1, const float* cosT, const float* sinT) {
    const int g64 = pc >> 6;
    if (g64 < 64 && ((ROPE_MASK >> g64) & 1ull)) {
        const int i = (pc & 63) >> 1, pos = t & (SEQ - 1);
        const float c = cosT[pos * 32 + i], s = sinT[pos * 32 + i];
        const float a = v0 * c - v1 * s, b = v1 * c + v0 * s;
        const float sc = ((SCALE_MASK >> g64) & 1ull) ? 0.125f : 1.0f;
        v0 = a * sc; v1 = b * sc;
    } else if (pc >= ZC_GM || (pc >= ZC_GN && pc < ZC_WI)) { v0 = sigmoidf_(v0); v1 = sigmoidf_(v1); }
}
__device__ __forceinline__ void sincos_tab(float ang, float& s, float& c) {
    const double a = (double)ang; const double k = rint(a * 0.63661977236758134308);
    const float r = (float)(a - k * 1.57079632679489661923); const float z = r * r;
    const float sp = ((-1.9515295891e-4f * z + 8.3321608736e-3f) * z - 1.6666654611e-1f) * z * r + r;
    const float cp = ((2.443315711809948e-5f * z - 1.388731625493765e-3f) * z + 4.166664568298827e-2f) * z * z - 0.5f * z + 1.0f;
    const int q = ((int)k) & 3;
    s = (q == 0) ? sp : (q == 1) ? cp : (q == 2) ? -sp : -cp;
    c = (q == 0) ? cp : (q == 1) ? -sp : (q == 2) ? -cp : sp;
}

__device__ __forceinline__ void st_adaln(const Params& p, unsigned char* lds) {
    int tid_ = threadIdx.x; asm volatile("" : "+v"(tid_)); const int tid = tid_, lane = tid & 63, w = tid >> 6;
    float* cosT = (float*)(p.ws + WS_COS); float* sinT = (float*)(p.ws + WS_SIN);
    for (int i = blockIdx.x * NTHR + tid; i < SEQ * 32; i += gridDim.x * NTHR) {
        const int pos = i >> 5, f = i & 31; const float inv = powf(10000.0f, -(float)f / 32.0f);
        float s, c; sincos_tab((float)pos * inv, s, c); cosT[i] = c; sinT[i] = s;
    }
    float* sc = (float*)lds;
    float* red = sc + 8192;
    for (int i = tid; i < 8192; i += NTHR) { const float v = p.c[i]; sc[i] = v / (1.0f + __expf(-v)); }
    __syncthreads();
    float* mod = (float*)(p.ws + WS_MOD);
    for (int unit = blockIdx.x; unit < 192; unit += gridDim.x) {
        float acc[8];
#pragma unroll
        for (int b = 0; b < 8; ++b) acc[b] = 0.f;
        const int col = unit * 32 + (lane & 31), ks = lane >> 5;
        for (int kk = 0; kk < 64; ++kk) {
            const int k = w * 128 + kk * 2 + ks; const float wv = p.ada_w[(size_t)k * 6144 + col];
#pragma unroll
            for (int b = 0; b < 8; ++b) acc[b] += sc[b * 1024 + k] * wv;
        }
#pragma unroll
        for (int b = 0; b < 8; ++b) red[((w * 2 + ks) * 8 + b) * 32 + (lane & 31)] = acc[b];
        __syncthreads();
        if (tid < 256) { const int b = tid >> 5, c = tid & 31; float s = 0.f;
            for (int j = 0; j < 16; ++j) s += red[(j * 8 + b) * 32 + c];
            mod[b * 6144 + unit * 32 + c] = s + p.ada_b[unit * 32 + c]; }
        __syncthreads();
    }
}
__device__ __forceinline__ void st_norm_rows(const Params& p, int which) {
    int tid_ = threadIdx.x; asm volatile("" : "+v"(tid_)); const int tid = tid_, lane = tid & 63, w = tid >> 6;
    const float* src = which ? p.out : p.x; const float* g = which ? p.norm2_g : p.norm1_g;
    bf16_t* dst = (bf16_t*)(p.ws + (which ? WS_H2 : WS_HB));
    const float* mod = (const float*)(p.ws + WS_MOD);
    for (int t = blockIdx.x * 8 + w; t < T; t += gridDim.x * 8) {
        const int b = t >> 11; const float* sh = mod + b * 6144 + (which ? 3072 : 0); const float* scl = sh + 1024;
        const float4* xr = (const float4*)(src + (size_t)t * D);
        float4 v[4]; float ss = 0.f;
#pragma unroll
        for (int j = 0; j < 4; ++j) { v[j] = xr[lane + 64 * j]; ss += v[j].x * v[j].x + v[j].y * v[j].y + v[j].z * v[j].z + v[j].w * v[j].w; }
        const float r = rsqrtf(wave_sum(ss) * (1.0f / D) + EPS);
#pragma unroll
        for (int j = 0; j < 4; ++j) { const int d0 = (lane + 64 * j) * 4;
            const float4 gg = *(const float4*)(g + d0), s4 = *(const float4*)(scl + d0), h4 = *(const float4*)(sh + d0);
            const float o0 = v[j].x * r * gg.x * (1.f + s4.x) + h4.x, o1 = v[j].y * r * gg.y * (1.f + s4.y) + h4.y;
            const float o2 = v[j].z * r * gg.z * (1.f + s4.z) + h4.z, o3 = v[j].w * r * gg.w * (1.f + s4.w) + h4.w;
            uint2 o; o.x = pk2(o0, o1); o.y = pk2(o2, o3); *(uint2*)(dst + (size_t)t * D + d0) = o; }
    }
}
__device__ __forceinline__ void naive_dot8(const bf16_t* A, int lda, const float* W, int ldw, int K, int t0, int col, float (&acc)[8]) {
#pragma unroll
    for (int i = 0; i < 8; ++i) acc[i] = 0.f;
    for (int k = 0; k < K; k += 2) {
        const float w0 = W[(size_t)k * ldw + col], w1 = W[(size_t)(k + 1) * ldw + col];
#pragma unroll
        for (int i = 0; i < 8; ++i) { const u32 a = *(const u32*)(A + (size_t)(t0 + i) * lda + k); acc[i] += bflo(a) * w0 + bfhi(a) * w1; }
    }
}
__device__ __forceinline__ void st_z_naive(const Params& p) {
    int tid_ = threadIdx.x; asm volatile("" : "+v"(tid_)); const int tid = tid_; const bf16_t* hb = (const bf16_t*)(p.ws + WS_HB); bf16_t* Z = (bf16_t*)(p.ws + WS_Z);
    const float* cosT = (const float*)(p.ws + WS_COS); const float* sinT = (const float*)(p.ws + WS_SIN);
    const int nitems = (T / 8) * 9;
    for (int it = blockIdx.x * 2 + (tid >> 8); it < nitems; it += gridDim.x * 2) {
        const int tt = it / 9, ch = it % 9; const int t0 = tt * 8; const int pc = (ch * 256 + (tid & 255)) * 2;
        const int l0 = z_logical_col(pc), l1 = z_logical_col(pc + 1);
        float a0[8], a1[8];
        if (l0 >= 0) { naive_dot8(hb, D, p.w_in, DIN, D, t0, l0, a0); naive_dot8(hb, D, p.w_in, DIN, D, t0, l1, a1); }
        else {
#pragma unroll
            for (int i = 0; i < 8; ++i) { a0[i] = 0.f; a1[i] = 0.f; } }
#pragma unroll
        for (int i = 0; i < 8; ++i) { float v0 = a0[i], v1 = a1[i]; z_post(t0 + i, pc, v0, v1, cosT, sinT); *(u32*)(Z + (size_t)(t0 + i) * NZ + pc) = pk2(v0, v1); }
    }
}
__device__ __forceinline__ void st_prep_a_naive(const Params& p) {
    int tid_ = threadIdx.x; asm volatile("" : "+v"(tid_)); const int tid = tid_; const bf16_t* Z = (const bf16_t*)(p.ws + WS_Z);
    const float* cosT = (const float*)(p.ws + WS_COS); const float* sinT = (const float*)(p.ws + WS_SIN);
    unsigned char* dob = (unsigned char*)p.out;
    bf16_t* kd = (bf16_t*)(dob + DO_KD); bf16_t* vdT = (bf16_t*)(dob + DO_VDT); bf16_t* vsT = (bf16_t*)(dob + DO_VST); bf16_t* vwT = (bf16_t*)(dob + DO_VWT);
    float* hid = (float*)(dob + DO_HID);
    for (int it = blockIdx.x * NTHR + tid; it < T * 32; it += gridDim.x * NTHR) {
        const int t = it >> 5, i = it & 31; const bf16_t* cr = Z + (size_t)t * NZ + ZC_CKV;
        float ss = 0.f; for (int r = 0; r < 128; ++r) { const float v = bf2f(cr[r]); ss += v * v; }
        const float rn = rsqrtf(ss * (1.0f / 128.0f) + EPS);
        float k1 = 0.f, k2 = 0.f, v1 = 0.f, v2 = 0.f;
        for (int r = 0; r < 128; ++r) { const float cn = bf2f(cr[r]) * rn * p.kvg[r];
            k1 += cn * p.w_uk[r * 64 + i]; k2 += cn * p.w_uk[r * 64 + i + 32]; v1 += cn * p.w_uv[r * 64 + i]; v2 += cn * p.w_uv[r * 64 + i + 32]; }
        const int pos = t & (SEQ - 1), b = t >> 11; const float c = cosT[pos * 32 + i], s = sinT[pos * 32 + i];
        *(u32*)(kd + (size_t)t * 64 + 2 * i) = pk2(k1 * c - k2 * s, k2 * c + k1 * s);
        vdT[((size_t)b * 64 + i) * SEQ + pos] = f2bf(v1); vdT[((size_t)b * 64 + i + 32) * SEQ + pos] = f2bf(v2);
    }
    for (int it = blockIdx.x * NTHR + tid; it < T * 128; it += gridDim.x * NTHR) {
        const int t = it >> 7, gd = it & 127, b = t >> 11, pos = t & (SEQ - 1);
        vsT[((size_t)b * 128 + gd) * SEQ + pos] = Z[(size_t)t * NZ + ZC_VS + gd];
        vwT[((size_t)b * 128 + gd) * SEQ + pos] = Z[(size_t)t * NZ + ZC_VW + gd];
    }
    for (int it = blockIdx.x * NTHR + tid; it < 2 * 8 * 2 * 128 * 64; it += gridDim.x * NTHR) {
        const int e = it & 63, n = (it >> 6) & 127, g = (it >> 13) & 1, b = (it >> 14) & 7, kv = it >> 17;
        float acc = 0.f;
        if (n < 127) {
            const float* w1 = kv ? p.w1v : p.w1k;
            for (int l = 0; l < 32; ++l) { const bf16_t* xr = Z + (size_t)(b * SEQ + 16 * n + l) * NZ + (kv ? ZC_VC : ZC_KC) + g * 64;
                for (int d = 0; d < 64; ++d) { const int pd = kv ? d : (2 * (d & 31) + (d >> 5));
                    acc += (bf2f(xr[pd]) + p.cmp_pos[l * 64 + d]) * w1[(l * 64 + d) * 64 + e]; } }
            acc = gelu_tanh(acc);
        }
        hid[it] = acc;
    }
}
__device__ __forceinline__ void st_prep_b_naive(const Params& p) {
    int tid_ = threadIdx.x; asm volatile("" : "+v"(tid_)); const int tid = tid_; unsigned char* dob = (unsigned char*)p.out;
    const float* hid = (const float*)(dob + DO_HID); bf16_t* kcmp = (bf16_t*)(dob + DO_KCMP); bf16_t* vcmpT = (bf16_t*)(dob + DO_VCMPT);
    for (int it = blockIdx.x * NTHR + tid; it < 2 * 8 * 2 * 128 * 64; it += gridDim.x * NTHR) {
        const int f = it & 63, n = (it >> 6) & 127, g = (it >> 13) & 1, b = (it >> 14) & 7, kv = it >> 17;
        const float* w2 = kv ? p.w2v : p.w2k; const float* h = hid + (size_t)(it & ~63);
        float acc = 0.f;
        if (n < 127) for (int e = 0; e < 64; ++e) acc += h[e] * w2[e * 64 + f];
        if (kv == 0) kcmp[(((size_t)b * 2 + g) * 128 + n) * 64 + (2 * (f & 31) + (f >> 5))] = f2bf(acc);
        else vcmpT[(((size_t)b * 2 + g) * 64 + f) * 128 + n] = f2bf(acc);
    }
}
__device__ __forceinline__ float dot64(const float* q, const bf16_t* kr) {
    float s = 0.f;
#pragma unroll
    for (int j = 0; j < 8; ++j) { const uint4 v = *(const uint4*)(kr + 8 * j); const float* qq = q + 8 * j;
        s += qq[0] * bflo(v.x) + qq[1] * bfhi(v.x) + qq[2] * bflo(v.y) + qq[3] * bfhi(v.y) + qq[4] * bflo(v.z) + qq[5] * bfhi(v.z) + qq[6] * bflo(v.w) + qq[7] * bfhi(v.w); }
    return s;
}
__device__ __forceinline__ void st_nsa_naive(const Params& p, unsigned char* lds) {
    int tid_ = threadIdx.x; asm volatile("" : "+v"(tid_)); const int tid = tid_, lane = tid & 63, h = tid >> 6, g = h >> 2;
    const bf16_t* Z = (const bf16_t*)(p.ws + WS_Z); unsigned char* dob = (unsigned char*)p.out;
    const bf16_t* kcmp = (const bf16_t*)(dob + DO_KCMP); const bf16_t* vcmpT = (const bf16_t*)(dob + DO_VCMPT);
    bf16_t* onsa = (bf16_t*)(p.ws + WS_ONSA);
    float* qs = (float*)lds;
    float* pc = qs + 512;
    float* vals = pc + 1024;
    u32* selm = (u32*)(vals + 64);
    for (int t = blockIdx.x; t < T; t += gridDim.x) {
        const int b = t >> 11, pos = t & (SEQ - 1); const bf16_t* zr = Z + (size_t)t * NZ;
        __syncthreads();
        qs[h * 64 + lane] = bf2f(zr[ZC_QN + h * 64 + lane]);
        __syncthreads();
        const float* q = qs + h * 64;
        float sc[2]; float m = -1e30f;
#pragma unroll
        for (int c2 = 0; c2 < 2; ++c2) { const int n = c2 * 64 + lane; const bool valid = (n < 127) && (16 * n + 31 <= pos);
            const float s = dot64(q, kcmp + (((size_t)b * 2 + g) * 128 + n) * 64); sc[c2] = valid ? s : -1e30f; m = fmaxf(m, sc[c2]); }
        m = wave_max(m); float l = 0.f;
#pragma unroll
        for (int c2 = 0; c2 < 2; ++c2) { const int n = c2 * 64 + lane; const bool valid = (n < 127) && (16 * n + 31 <= pos); sc[c2] = valid ? __expf(sc[c2] - m) : 0.f; l += sc[c2]; }
        l = wave_sum(l); const float il = 1.0f / fmaxf(l, 1e-30f);
        pc[h * 128 + lane] = sc[0] * il; pc[h * 128 + 64 + lane] = sc[1] * il;
        __syncthreads();
        float ocmp = 0.f; { const bf16_t* vr = vcmpT + (((size_t)b * 2 + g) * 64 + lane) * 128; const float* pp = pc + h * 128;
            for (int n = 0; n < 128; ++n) ocmp += pp[n] * bf2f(vr[n]); }
        if (tid < 64) { const int gg = tid >> 5, j = tid & 31; const float* p0 = pc + gg * 512;
            auto imp = [&](int n) -> float { return (n < 0 || n > 126) ? 0.f : (p0[n] + p0[128 + n] + p0[256 + n] + p0[384 + n]); };
            const float bl = imp(4 * j - 1) + 2.f * imp(4 * j) + 2.f * imp(4 * j + 1) + 2.f * imp(4 * j + 2) + imp(4 * j + 3);
            const int cur = pos >> 6; const bool forced = (j == 0) || (j == cur) || (j == cur - 1); const bool adm = (j * 64 <= pos);
            vals[tid] = forced ? __builtin_inff() : (adm ? bl : -__builtin_inff()); }
        __syncthreads();
        if (tid < 64) { const int gg = tid >> 5, j = tid & 31; const float v = vals[tid]; int rank = 0;
            for (int j2 = 0; j2 < 32; ++j2) { const float v2 = vals[gg * 32 + j2]; rank += (v2 > v || (v2 == v && j2 < j)) ? 1 : 0; }
            const unsigned long long bal = __ballot(rank < 16);
            if (tid == 0) { selm[0] = (u32)bal; selm[1] = (u32)(bal >> 32); } }
        __syncthreads();
        const u32 sel = selm[g];
        float ms = -1e30f, ls = 0.f, os = 0.f;
        for (int j = 0; j * 64 <= pos; ++j) { if (!((sel >> j) & 1u)) continue;
            const int kp = j * 64 + lane; const bool valid = kp <= pos;
            float s = dot64(q, Z + (size_t)(b * SEQ + kp) * NZ + ZC_KS + g * 64); s = valid ? s : -1e30f;
            const float mn = fmaxf(ms, wave_max(s)); const float al = __expf(ms - mn); const float pr = valid ? __expf(s - mn) : 0.f;
            ls = ls * al + wave_sum(pr); os *= al; ms = mn;
            for (int k = 0; k < 64; ++k) { const float pk = __shfl(pr, k); os += pk * bf2f(Z[(size_t)(b * SEQ + j * 64 + k) * NZ + ZC_VS + g * 64 + lane]); } }
        os = os / fmaxf(ls, 1e-30f);
        float mw = -1e30f, lw = 0.f, ow = 0.f;
        for (int c2 = 0; c2 < 8; ++c2) { const int kp = pos - 511 + c2 * 64 + lane; const bool valid = kp >= 0; if (pos - 511 + c2 * 64 + 63 < 0) continue;
            float s = valid ? dot64(q, Z + (size_t)(b * SEQ + kp) * NZ + ZC_KW + g * 64) : -1e30f;
            const float mn = fmaxf(mw, wave_max(s)); const float al = __expf(mw - mn); const float pr = valid ? __expf(s - mn) : 0.f;
            lw = lw * al + wave_sum(pr); ow *= al; mw = mn;
            for (int k = 0; k < 64; ++k) { const float pk = __shfl(pr, k); const int kk = pos - 511 + c2 * 64 + k;
                if (kk >= 0) ow += pk * bf2f(Z[(size_t)(b * SEQ + kk) * NZ + ZC_VW + g * 64 + lane]); } }
        ow = ow / fmaxf(lw, 1e-30f);
        const float gc = bf2f(zr[ZC_GN + h * 3 + 0]), gs = bf2f(zr[ZC_GN + h * 3 + 1]), gw = bf2f(zr[ZC_GN + h * 3 + 2]);
        onsa[(size_t)t * 512 + h * 64 + lane] = f2bf(gc * ocmp + gs * os + gw * ow);
    }
}
__device__ __forceinline__ void st_dsa_naive(const Params& p, unsigned char* lds) {
    int tid_ = threadIdx.x; asm volatile("" : "+v"(tid_)); const int tid = tid_, lane = tid & 63, h = tid >> 6;
    const bf16_t* Z = (const bf16_t*)(p.ws + WS_Z); unsigned char* dob = (unsigned char*)p.out;
    const bf16_t* kd = (const bf16_t*)(dob + DO_KD); const bf16_t* vdT = (const bf16_t*)(dob + DO_VDT); u32* maskg = (u32*)(dob + DO_MASK);
    bf16_t* odsa = (bf16_t*)(p.ws + WS_ODSA);
    float* qi = (float*)lds;
    float* qd = qi + 512;
    float* wv = qd + 512;
    float* scv = wv + 8;
    u32* mk = (u32*)(scv + 2048);
    for (int t = blockIdx.x; t < T; t += gridDim.x) {
        const int b = t >> 11, pos = t & (SEQ - 1); const bf16_t* zr = Z + (size_t)t * NZ;
        __syncthreads();
        qi[tid] = bf2f(zr[ZC_QI + tid]); qd[tid] = bf2f(zr[ZC_QD + tid]);
        if (tid < 8) wv[tid] = bf2f(zr[ZC_WI + tid]) * 0.35355339059327373f;
        __syncthreads();
        for (int i = 0; i < 4; ++i) { const int k = tid + 512 * i; float s = -__builtin_inff();
            if (k <= pos) { s = 0.f; const bf16_t* kr = Z + (size_t)(b * SEQ + k) * NZ + ZC_KI;
                for (int hh = 0; hh < 8; ++hh) { const float lg = dot64(qi + hh * 64, kr); s = fmaf(wv[hh], fmaxf(lg, 0.f), s); } }
            scv[k] = s; }
        __syncthreads();
        for (int i = 0; i < 4; ++i) { const int k = tid + 512 * i; bool selb = false;
            if (k <= pos) { if (pos < 256) selb = true; else { const float v = scv[k]; int rank = 0;
                    for (int j = 0; j <= pos; ++j) { const float v2 = scv[j]; rank += (v2 > v || (v2 == v && j < k)) ? 1 : 0; } selb = rank < 256; } }
            const unsigned long long bal = __ballot(selb);
            if (lane == 0) { const int wi = 16 * i + 2 * h; mk[wi] = (u32)bal; mk[wi + 1] = (u32)(bal >> 32); } }
        __syncthreads();
        if (tid < 64) maskg[(size_t)t * 64 + tid] = mk[tid];
        float m = -1e30f, l = 0.f, o = 0.f; const float* q = qd + h * 64;
        for (int c2 = 0; c2 * 64 <= pos; ++c2) { const int kp = c2 * 64 + lane; const bool valid = (mk[kp >> 5] >> (kp & 31)) & 1u;
            if (__ballot(valid) == 0ull) continue;
            float s = valid ? dot64(q, kd + (size_t)(b * SEQ + kp) * 64) : -1e30f;
            const float mn = fmaxf(m, wave_max(s)); const float al = __expf(m - mn); const float pr = valid ? __expf(s - mn) : 0.f;
            l = l * al + wave_sum(pr); o *= al; m = mn;
            const bf16_t* vr = vdT + ((size_t)b * 64 + lane) * SEQ + c2 * 64;
            for (int k = 0; k < 64; ++k) { const float pk = __shfl(pr, k); o += pk * bf2f(vr[k]); } }
        odsa[(size_t)t * 512 + h * 64 + lane] = f2bf(o / fmaxf(l, 1e-30f));
    }
}
__device__ __forceinline__ void st_merge_naive(const Params& p) {
    int tid_ = threadIdx.x; asm volatile("" : "+v"(tid_)); const int tid = tid_; const bf16_t* Z = (const bf16_t*)(p.ws + WS_Z);
    const bf16_t* onsa = (const bf16_t*)(p.ws + WS_ONSA); const bf16_t* odsa = (const bf16_t*)(p.ws + WS_ODSA); bf16_t* mg = (bf16_t*)(p.ws + WS_MERGED);
    for (int it = blockIdx.x; it < (T / 8) * 2; it += gridDim.x) { const int t0 = (it >> 1) * 8, n = (it & 1) * 512 + tid;
        float a[8], d[8]; naive_dot8(onsa, 512, p.w_nsa, D, 512, t0, n, a); naive_dot8(odsa, 512, p.w_dsa, D, 512, t0, n, d);
#pragma unroll
        for (int i = 0; i < 8; ++i) { const float g1 = bf2f(Z[(size_t)(t0 + i) * NZ + ZC_GM + n]), g2 = bf2f(Z[(size_t)(t0 + i) * NZ + ZC_GM + 1024 + n]);
            mg[(size_t)(t0 + i) * D + n] = f2bf(g1 * a[i] + g2 * d[i]); } }
}
__device__ __forceinline__ void st_out_naive(const Params& p) {
    int tid_ = threadIdx.x; asm volatile("" : "+v"(tid_)); const int tid = tid_; const bf16_t* mg = (const bf16_t*)(p.ws + WS_MERGED); const float* mod = (const float*)(p.ws + WS_MOD);
    for (int it = blockIdx.x; it < (T / 8) * 2; it += gridDim.x) { const int t0 = (it >> 1) * 8, n = (it & 1) * 512 + tid;
        float a[8]; naive_dot8(mg, D, p.w_out, D, D, t0, n, a); const float g1 = mod[(t0 >> 11) * 6144 + 2048 + n];
#pragma unroll
        for (int i = 0; i < 8; ++i) p.out[(size_t)(t0 + i) * D + n] = p.x[(size_t)(t0 + i) * D + n] + g1 * a[i]; }
}
__device__ __forceinline__ void st_peerq_naive(const Params& p) {
    int tid_ = threadIdx.x; asm volatile("" : "+v"(tid_)); const int tid = tid_; const bf16_t* h2 = (const bf16_t*)(p.ws + WS_H2); bf16_t* q = (bf16_t*)(p.ws + WS_MERGED);
    for (int it = blockIdx.x; it < (T / 8) * 2; it += gridDim.x) { const int t0 = (it >> 1) * 8, n = (it & 1) * 512 + tid;
        float a[8]; naive_dot8(h2, D, p.wq, D, D, t0, n, a);
#pragma unroll
        for (int i = 0; i < 8; ++i) q[(size_t)(t0 + i) * D + n] = f2bf(a[i]); }
}
__device__ __forceinline__ void st_ssub_naive(const Params& p) {
    int tid_ = threadIdx.x; asm volatile("" : "+v"(tid_)); const int tid = tid_; const bf16_t* q = (const bf16_t*)(p.ws + WS_MERGED); float* ss = (float*)(p.ws + WS_SSUB);
    for (size_t it = (size_t)blockIdx.x * NTHR + tid; it < (size_t)T * 2048; it += (size_t)gridDim.x * NTHR) {
        const int t = (int)(it >> 11), col = (int)(it & 2047), hc = col >> 7, n = col & 127;
        const bf16_t* qr = q + (size_t)t * D + hc * 64; const float* sk = p.subkeys + ((size_t)hc * 128 + n) * 64;
        float acc = 0.f; for (int d = 0; d < 64; ++d) acc += bf2f(qr[d]) * sk[d];
        ss[it] = acc; }
}
__device__ __forceinline__ u32 ordf(float f);
__device__ __forceinline__ void ins16(u32 (&s)[16], u32 key) {
#pragma unroll
    for (int i = 0; i < 16; ++i) { const u32 mx = s[i] > key ? s[i] : key; key = s[i] > key ? key : s[i]; s[i] = mx; }
}
__device__ __forceinline__ void st_route(const Params& p) {
    int tid_ = threadIdx.x; asm volatile("" : "+v"(tid_)); const int tid = tid_; const float* ss = (const float*)(p.ws + WS_SSUB); int* eidx = (int*)(p.ws + WS_EIDX); float* gate = (float*)(p.ws + WS_GATE);
    for (int it = blockIdx.x * NTHR + tid; it < T * 8; it += gridDim.x * NTHR) {
        const float* s0 = ss + (size_t)it * 256;
        u32 a[16], b[16];
#pragma unroll
        for (int i = 0; i < 16; ++i) { a[i] = 0u; b[i] = 0u; }
        for (int n = 0; n < 128; n += 4) { const float4 x = *(const float4*)(s0 + n), y = *(const float4*)(s0 + 128 + n);
            ins16(a, (ordf(x.x) & ~127u) | (u32)(127 - n)); ins16(a, (ordf(x.y) & ~127u) | (u32)(126 - n)); ins16(a, (ordf(x.z) & ~127u) | (u32)(125 - n)); ins16(a, (ordf(x.w) & ~127u) | (u32)(124 - n));
            ins16(b, (ordf(y.x) & ~127u) | (u32)(127 - n)); ins16(b, (ordf(y.y) & ~127u) | (u32)(126 - n)); ins16(b, (ordf(y.z) & ~127u) | (u32)(125 - n)); ins16(b, (ordf(y.w) & ~127u) | (u32)(124 - n)); }
        float va[16], vb[16]; int na[16], nb[16];
#pragma unroll
        for (int i = 0; i < 16; ++i) { na[i] = 127 - (int)(a[i] & 127u); nb[i] = 127 - (int)(b[i] & 127u); va[i] = s0[na[i]]; vb[i] = s0[128 + nb[i]]; }
        u32 tk[16];
#pragma unroll
        for (int i = 0; i < 16; ++i) tk[i] = 0u;
#pragma unroll
        for (int i = 0; i < 16; ++i)
#pragma unroll
            for (int j = 0; j < 16; ++j) if ((i + 1) * (j + 1) <= 16) ins16(tk, (ordf(va[i] + vb[j]) & ~255u) | (u32)(255 - (i * 16 + j)));
        float ts[16]; int te[16];
#pragma unroll
        for (int r = 0; r < 16; ++r) { const int flat = 255 - (int)(tk[r] & 255u), i = flat >> 4, j = flat & 15; float x = 0.f, y = 0.f; int ni = 0, nj = 0;
#pragma unroll
            for (int q = 0; q < 16; ++q) { if (i == q) { x = va[q]; ni = na[q]; } if (j == q) { y = vb[q]; nj = nb[q]; } }
            ts[r] = x + y; te[r] = ni * 128 + nj; }
        float mx = ts[0];
#pragma unroll
        for (int r = 1; r < 16; ++r) mx = fmaxf(mx, ts[r]);
        float sum = 0.f, ex[16];
#pragma unroll
        for (int r = 0; r < 16; ++r) { ex[r] = __expf(ts[r] - mx); sum += ex[r]; }
        const float inv = 1.0f / sum;
#pragma unroll
        for (int r = 0; r < 16; ++r) { eidx[(size_t)it * 16 + r] = te[r]; gate[(size_t)it * 16 + r] = ex[r] * inv; }
    }
}
__device__ __forceinline__ void st_cvt_uv(const Params& p) {
    int tid_ = threadIdx.x; asm volatile("" : "+v"(tid_)); const int tid = tid_; bf16_t* u16 = (bf16_t*)(p.ws + WS_U16); bf16_t* v16 = (bf16_t*)(p.ws + WS_V16);
    const size_t n4 = (size_t)16384 * 1024 / 4;
    for (size_t i = (size_t)blockIdx.x * NTHR + tid; i < n4; i += (size_t)gridDim.x * NTHR) {
        const float4 a = ((const float4*)p.pu)[i], b = ((const float4*)p.pv)[i];
        uint2 o; o.x = pk2(a.x, a.y); o.y = pk2(a.z, a.w); ((uint2*)u16)[i] = o; o.x = pk2(b.x, b.y); o.y = pk2(b.z, b.w); ((uint2*)v16)[i] = o; }
}
__device__ __forceinline__ void st_expert(const Params& p, unsigned char* lds) {
    int tid_ = threadIdx.x; asm volatile("" : "+v"(tid_)); const int tid = tid_, lane = tid & 63, w = tid >> 6;
    const bf16_t* h2 = (const bf16_t*)(p.ws + WS_H2); const bf16_t* u16 = (const bf16_t*)(p.ws + WS_U16); const bf16_t* v16 = (const bf16_t*)(p.ws + WS_V16);
    const int* eidx = (const int*)(p.ws + WS_EIDX); const float* gate = (const float*)(p.ws + WS_GATE); const float* mod = (const float*)(p.ws + WS_MOD);
    float* wl = (float*)lds + w * 128;
    for (int t = blockIdx.x * 8 + w; t < T; t += gridDim.x * 8) {
        float xv[16]; { const uint4 a = *(const uint4*)(h2 + (size_t)t * D + lane * 16), b = *(const uint4*)(h2 + (size_t)t * D + lane * 16 + 8);
            xv[0] = bflo(a.x); xv[1] = bfhi(a.x); xv[2] = bflo(a.y); xv[3] = bfhi(a.y); xv[4] = bflo(a.z); xv[5] = bfhi(a.z); xv[6] = bflo(a.w); xv[7] = bfhi(a.w);
            xv[8] = bflo(b.x); xv[9] = bfhi(b.x); xv[10] = bflo(b.y); xv[11] = bfhi(b.y); xv[12] = bflo(b.z); xv[13] = bfhi(b.z); xv[14] = bflo(b.w); xv[15] = bfhi(b.w); }
        const int e0 = eidx[(size_t)t * 128 + lane], e1 = eidx[(size_t)t * 128 + 64 + lane];
        const float g0 = gate[(size_t)t * 128 + lane], g1 = gate[(size_t)t * 128 + 64 + lane];
        for (int k = 0; k < 128; ++k) { const int e = __shfl(k < 64 ? e0 : e1, k & 63);
            const bf16_t* ur = u16 + (size_t)e * D + lane * 16; const uint4 a = *(const uint4*)ur, b = *(const uint4*)(ur + 8);
            float s = xv[0] * bflo(a.x) + xv[1] * bfhi(a.x) + xv[2] * bflo(a.y) + xv[3] * bfhi(a.y) + xv[4] * bflo(a.z) + xv[5] * bfhi(a.z) + xv[6] * bflo(a.w) + xv[7] * bfhi(a.w)
                    + xv[8] * bflo(b.x) + xv[9] * bfhi(b.x) + xv[10] * bflo(b.y) + xv[11] * bfhi(b.y) + xv[12] * bflo(b.z) + xv[13] * bfhi(b.z) + xv[14] * bflo(b.w) + xv[15] * bfhi(b.w);
            s = wave_sum(s);
            if (lane == (k & 63)) { const float gg = k < 64 ? g0 : g1; wl[k] = gg * gelu_erf(s); } }
        __builtin_amdgcn_s_waitcnt(0);
        float acc[16];
#pragma unroll
        for (int i = 0; i < 16; ++i) acc[i] = 0.f;
        for (int k = 0; k < 128; ++k) { const int e = __shfl(k < 64 ? e0 : e1, k & 63); const float wk = wl[k];
            const bf16_t* vr = v16 + (size_t)e * D + lane * 16; const uint4 a = *(const uint4*)vr, b = *(const uint4*)(vr + 8);
            acc[0] += wk * bflo(a.x); acc[1] += wk * bfhi(a.x); acc[2] += wk * bflo(a.y); acc[3] += wk * bfhi(a.y); acc[4] += wk * bflo(a.z); acc[5] += wk * bfhi(a.z); acc[6] += wk * bflo(a.w); acc[7] += wk * bfhi(a.w);
            acc[8] += wk * bflo(b.x); acc[9] += wk * bfhi(b.x); acc[10] += wk * bflo(b.y); acc[11] += wk * bfhi(b.y); acc[12] += wk * bflo(b.z); acc[13] += wk * bfhi(b.z); acc[14] += wk * bflo(b.w); acc[15] += wk * bfhi(b.w); }
        const float* g2 = mod + (t >> 11) * 6144 + 5120 + lane * 16; float* xr = p.out + (size_t)t * D + lane * 16; float ss = 0.f;
#pragma unroll
        for (int i = 0; i < 16; ++i) { acc[i] = xr[i] + g2[i] * acc[i]; ss += acc[i] * acc[i]; }
        const float r = rsqrtf(wave_sum(ss) * (1.0f / D) + EPS);
#pragma unroll
        for (int i = 0; i < 16; ++i) xr[i] = acc[i] * r * p.final_g[lane * 16 + i];
    }
}


typedef short bf16x8 __attribute__((ext_vector_type(8)));
typedef float f32x16 __attribute__((ext_vector_type(16)));
typedef unsigned u32x2 __attribute__((ext_vector_type(2)));
typedef unsigned u32x4 __attribute__((ext_vector_type(4)));
typedef __bf16 hbf2_t __attribute__((ext_vector_type(2)));
typedef float f32x2_t __attribute__((ext_vector_type(2)));
#define MFMA32(a, b, c) __builtin_amdgcn_mfma_f32_32x32x16_bf16((a), (b), (c), 0, 0, 0)
__device__ __forceinline__ u32 pkbf(float a, float b) { const f32x2_t v = {a, b}; const hbf2_t r = __builtin_convertvector(v, hbf2_t); return __builtin_bit_cast(u32, r); }
__device__ __forceinline__ bf16x8 ld8(const bf16_t* q) { return *(const bf16x8*)q; }
__device__ __forceinline__ bf16x8 ld44(const bf16_t* q) { const u32x2 a = *(const u32x2*)q, b = *(const u32x2*)(q + 8); const u32x4 v = {a.x, a.y, b.x, b.y}; return __builtin_bit_cast(bf16x8, v); }
template <int H> __device__ __forceinline__ bf16x8 pack8(const f32x16& s) {
    const u32x4 v = {pkbf(s[8 * H], s[8 * H + 1]), pkbf(s[8 * H + 2], s[8 * H + 3]), pkbf(s[8 * H + 4], s[8 * H + 5]), pkbf(s[8 * H + 6], s[8 * H + 7])};
    return __builtin_bit_cast(bf16x8, v);
}
__device__ __forceinline__ float dpp_xor1(float v) { return __int_as_float(__builtin_amdgcn_update_dpp(0, __float_as_int(v), 0xB1, 0xF, 0xF, true)); }
__device__ __forceinline__ float dpp_xor2(float v) { return __int_as_float(__builtin_amdgcn_update_dpp(0, __float_as_int(v), 0x4E, 0xF, 0xF, true)); }
__device__ __forceinline__ f32x16 zero16() { f32x16 z;
#pragma unroll
    for (int i = 0; i < 16; ++i) z[i] = 0.f; return z; }
__device__ __forceinline__ void flash_tile(float& m, float& l, f32x16& o0, f32x16& o1, f32x16 s, u32 vm, const bf16_t* vb, size_t dbs) {
    const bf16x8 v00 = ld44(vb), v01 = ld44(vb + 16), v10 = ld44(vb + dbs), v11 = ld44(vb + dbs + 16);
    float mx = -1e30f;
#pragma unroll
    for (int R = 0; R < 16; ++R) { s[R] = ((vm >> R) & 1u) ? s[R] : -1e30f; mx = fmaxf(mx, s[R]); }
    mx = fmaxf(mx, __shfl_xor(mx, 32));
    const float mn = fmaxf(m, mx), al = __expf(m - mn);
    float ps = 0.f;
#pragma unroll
    for (int R = 0; R < 16; ++R) { const float pr = ((vm >> R) & 1u) ? __expf(s[R] - mn) : 0.f; s[R] = pr; ps += pr; }
    ps += __shfl_xor(ps, 32);
    l = l * al + ps; m = mn;
#pragma unroll
    for (int R = 0; R < 16; ++R) { o0[R] *= al; o1[R] *= al; }
    const bf16x8 p0 = pack8<0>(s), p1 = pack8<1>(s);
    o0 = MFMA32(v00, p0, o0); o0 = MFMA32(v01, p1, o0);
    o1 = MFMA32(v10, p0, o1); o1 = MFMA32(v11, p1, o1);
}
__device__ __forceinline__ u32 vm_le(int lim) { u32 vm = 0u;
#pragma unroll
    for (int R = 0; R < 16; ++R) vm |= (((R & 3) + 8 * (R >> 2)) <= lim) ? (1u << R) : 0u;
    return vm; }
__device__ __forceinline__ u32 vm_from_word(u32 word, int hl) { const u32 sh = word >> (4 * hl); return (sh & 0xFu) | (((sh >> 8) & 0xFu) << 4) | (((sh >> 16) & 0xFu) << 8) | (((sh >> 24) & 0xFu) << 12); }
__device__ __forceinline__ void store_ot(bf16_t* orow, const f32x16& o0, const f32x16& o1, int hl) {
#pragma unroll
    for (int q = 0; q < 4; ++q) {
        u32x2 a = {pkbf(o0[4 * q], o0[4 * q + 1]), pkbf(o0[4 * q + 2], o0[4 * q + 3])}; *(u32x2*)(orow + 8 * q + 4 * hl) = a;
        u32x2 b = {pkbf(o1[4 * q], o1[4 * q + 1]), pkbf(o1[4 * q + 2], o1[4 * q + 3])}; *(u32x2*)(orow + 32 + 8 * q + 4 * hl) = b;
    }
}
__device__ __forceinline__ u32 ordf(float f) { const u32 u = __float_as_uint(f); return (u & 0x80000000u) ? ~u : (u | 0x80000000u); }

__device__ __forceinline__ void st_nsa(const Params& p) {
    int tid_ = threadIdx.x; asm volatile("" : "+v"(tid_)); const int tid = tid_, lane = tid & 63, w = __builtin_amdgcn_readfirstlane(tid >> 6), c_ = lane & 31, hl_ = lane >> 5;
    const bf16_t* Z = (const bf16_t*)(p.ws + WS_Z); unsigned char* dob = (unsigned char*)p.out;
    const bf16_t* kcmp = (const bf16_t*)(dob + DO_KCMP); const bf16_t* vcmpT = (const bf16_t*)(dob + DO_VCMPT);
    const bf16_t* vsT = (const bf16_t*)(dob + DO_VST); const bf16_t* vwT = (const bf16_t*)(dob + DO_VWT);
    bf16_t* onsa = (bf16_t*)(p.ws + WS_ONSA);
    for (int ps = blockIdx.x; ps < 256; ps += gridDim.x)
    for (int which = 0; which < 2; ++which) {
        const int b = ps >> 5, g = (ps >> 4) & 1, jj = ps & 15, qb = which ? 31 - jj : jj, cur = qb;
        int c = c_, hl = hl_; asm volatile("" : "+v"(c), "+v"(hl));
        const int pmin = qb * 64 + 8 * w, pos = pmin + (c >> 2), head = 4 * g + (c & 3);
        const bf16_t* zr = Z + (size_t)(b * SEQ + pos) * NZ;
        bf16x8 qfr[4];
#pragma unroll
        for (int kk = 0; kk < 4; ++kk) qfr[kk] = ld8(zr + ZC_QN + head * 64 + 16 * kk + 8 * hl);
        const float gc = bf2f(zr[ZC_GN + head * 3]), gs = bf2f(zr[ZC_GN + head * 3 + 1]), gw = bf2f(zr[ZC_GN + head * 3 + 2]);
        f32x16 out0 = zero16(), out1 = zero16();
        u32 sel;
        {
            const int pmax = pmin + 7; const int nmax = pmax >= 31 ? ((pmax - 31) >> 4) : -1; const int ntile = nmax >= 0 ? (((nmax > 126 ? 126 : nmax) >> 5) + 1) : 0;
            const bf16_t* kb = kcmp + ((size_t)(b * 2 + g) * 128 + c) * 64 + 8 * hl;
            float mx = -1e30f, l = 0.f;
            const int nlim = (pos >= 31 ? (((pos - 31) >> 4) > 126 ? 126 : ((pos - 31) >> 4)) : -1) - 4 * hl;
            for (int kt = 0; kt < ntile; ++kt) {
                f32x16 s = zero16();
#pragma unroll
                for (int kk = 0; kk < 4; ++kk) s = MFMA32(ld8(kb + (size_t)kt * 32 * 64 + 16 * kk), qfr[kk], s);
                const u32 vm = vm_le(nlim - 32 * kt);
                float tm = -1e30f;
#pragma unroll
                for (int R = 0; R < 16; ++R) { s[R] = ((vm >> R) & 1u) ? s[R] : -1e30f; tm = fmaxf(tm, s[R]); }
                const float mn = fmaxf(mx, tm); float ps = 0.f;
#pragma unroll
                for (int R = 0; R < 16; ++R) ps += ((vm >> R) & 1u) ? __expf(s[R] - mn) : 0.f;
                l = l * __expf(mx - mn) + ps; mx = mn;
            }
            {
                const float mo = __shfl_xor(mx, 32), lo_ = __shfl_xor(l, 32); const float mn = fmaxf(mx, mo);
                l = l * __expf(mx - mn) + lo_ * __expf(mo - mn); mx = mn; }
            const float il = 1.0f / fmaxf(l, 1e-30f);
            __builtin_amdgcn_sched_barrier(0);
            f32x16 o0 = zero16(), o1 = zero16();
            const bf16_t* vb = vcmpT + ((size_t)(b * 2 + g) * 64 + c) * 128 + 4 * hl;
            float G[16], L[16];
#pragma unroll
            for (int kt = 0; kt < 4; ++kt) {
                if (kt < ntile) {
                    f32x16 s = zero16();
#pragma unroll
                    for (int kk = 0; kk < 4; ++kk) s = MFMA32(ld8(kb + (size_t)kt * 32 * 64 + 16 * kk), qfr[kk], s);
                    const u32 vm = vm_le(nlim - 32 * kt);
#pragma unroll
                    for (int R = 0; R < 16; ++R) s[R] = ((vm >> R) & 1u) ? __expf(s[R] - mx) * il : 0.f;
                    const bf16x8 p0 = pack8<0>(s), p1 = pack8<1>(s);
                    o0 = MFMA32(ld44(vb + 32 * kt), p0, o0); o0 = MFMA32(ld44(vb + 32 * kt + 16), p1, o0);
                    o1 = MFMA32(ld44(vb + 32 * 128 + 32 * kt), p0, o1); o1 = MFMA32(ld44(vb + 32 * 128 + 32 * kt + 16), p1, o1);
#pragma unroll
                    for (int rg = 0; rg < 4; ++rg) { float gsum = (s[4 * rg] + s[4 * rg + 1]) + (s[4 * rg + 2] + s[4 * rg + 3]); float last = s[4 * rg + 3];
                        gsum += dpp_xor1(gsum); gsum += dpp_xor2(gsum); last += dpp_xor1(last); last += dpp_xor2(last);
                        G[4 * kt + rg] = gsum; L[4 * kt + rg] = last; }
                } else {
#pragma unroll
                    for (int rg = 0; rg < 4; ++rg) { G[4 * kt + rg] = 0.f; L[4 * kt + rg] = 0.f; }
                }
                __builtin_amdgcn_sched_barrier(0);
            }
#pragma unroll
            for (int R = 0; R < 16; ++R) { out0[R] = gc * o0[R]; out1[R] = gc * o1[R]; }
            float v[16], vx[16];
            { float Lx[16];
#pragma unroll
              for (int i = 0; i < 16; ++i) Lx[i] = __shfl_xor(L[i], 32);
#pragma unroll
              for (int i = 0; i < 16; ++i) { const float prevL = hl ? Lx[i] : (i > 0 ? Lx[i > 0 ? i - 1 : 0] : 0.f); const float bl = prevL + 2.f * G[i] - L[i];
                const int j = 2 * i + hl; const bool forced = (j == 0) || (j == cur) || (j == cur - 1);
                v[i] = forced ? __builtin_inff() : (j <= cur ? bl : -__builtin_inff()); } }
#pragma unroll
            for (int i = 0; i < 16; ++i) vx[i] = __shfl_xor(v[i], 32);
            u32 own = 0u;
#pragma unroll
            for (int i = 0; i < 16; ++i) { int rank = 0;
#pragma unroll
                for (int i2 = 0; i2 < 16; ++i2) {
                    if (i2 != i) rank += (v[i2] > v[i] || (v[i2] == v[i] && i2 < i)) ? 1 : 0;
                    const bool xlt = (i2 < i) || (hl && i2 == i);
                    rank += (vx[i2] > v[i] || (vx[i2] == v[i] && xlt)) ? 1 : 0; }
                const int j = 2 * i + hl; own |= ((j <= cur) && rank < 16) ? (1u << j) : 0u; }
            sel = own | (u32)__shfl_xor((int)own, 32);
            __builtin_amdgcn_sched_barrier(0);
        }
        {
            float m = -1e30f, l = 0.f; f32x16 o0 = zero16(), o1 = zero16();
            const bf16_t* kb = Z + (size_t)(b * SEQ + c) * NZ + ZC_KS + g * 64 + 8 * hl;
            const bf16_t* vb = vsT + ((size_t)(b * 2 + g) * 64 + c) * SEQ + 4 * hl;
            for (int jb = 0; jb <= cur; ++jb) {
                const bool mine = (sel >> jb) & 1u;
                if (__ballot(mine) == 0ull) continue;
#pragma unroll
                for (int h2 = 0; h2 < 2; ++h2) { const int key0 = jb * 64 + h2 * 32;
                    f32x16 s = zero16();
#pragma unroll
                    for (int kk = 0; kk < 4; ++kk) s = MFMA32(ld8(kb + (size_t)key0 * NZ + 16 * kk), qfr[kk], s);
                    const u32 vm = mine ? vm_le(pos - key0 - 4 * hl) : 0u;
                    flash_tile(m, l, o0, o1, s, vm, vb + key0, (size_t)32 * SEQ); }
            }
            const float f = gs / fmaxf(l, 1e-30f);
#pragma unroll
            for (int R = 0; R < 16; ++R) { out0[R] += f * o0[R]; out1[R] += f * o1[R]; }
        }
        {
            float m = -1e30f, l = 0.f; f32x16 o0 = zero16(), o1 = zero16();
            const bf16_t* kb = Z + (size_t)(b * SEQ + c) * NZ + ZC_KW + g * 64 + 8 * hl;
            const bf16_t* vb = vwT + ((size_t)(b * 2 + g) * 64 + c) * SEQ + 4 * hl;
            const int kstart = pmin - 511 > 0 ? pmin - 511 : 0;
            for (int kt = kstart >> 5; kt <= (pmin + 7) >> 5; ++kt) { const int key0 = kt * 32;
                f32x16 s = zero16();
#pragma unroll
                for (int kk = 0; kk < 4; ++kk) s = MFMA32(ld8(kb + (size_t)key0 * NZ + 16 * kk), qfr[kk], s);
                const int d1 = pos - key0 - 4 * hl; const u32 vm = vm_le(d1) & ~vm_le(d1 - 512);
                flash_tile(m, l, o0, o1, s, vm, vb + key0, (size_t)32 * SEQ); }
            const float f = gw / fmaxf(l, 1e-30f);
#pragma unroll
            for (int R = 0; R < 16; ++R) { out0[R] += f * o0[R]; out1[R] += f * o1[R]; }
        }
        store_ot(onsa + (size_t)(b * SEQ + pos) * 512 + head * 64, out0, out1, hl);
    }
}

__device__ __forceinline__ void st_dsa(const Params& p, unsigned char* lds) {
    int tid_ = threadIdx.x; asm volatile("" : "+v"(tid_)); const int tid = tid_, lane = tid & 63, w = __builtin_amdgcn_readfirstlane(tid >> 6), c_ = lane & 31, hl_ = lane >> 5;
    const bf16_t* Z = (const bf16_t*)(p.ws + WS_Z); unsigned char* dob = (unsigned char*)p.out;
    const bf16_t* kd = (const bf16_t*)(dob + DO_KD); const bf16_t* vdT = (const bf16_t*)(dob + DO_VDT);
    bf16_t* odsa = (bf16_t*)(p.ws + WS_ODSA);
    u32* mk = (u32*)lds;
    for (int ps = blockIdx.x; ps < 256; ps += gridDim.x)
    for (int which = 0; which < 2; ++which) {
        const int b = ps >> 5, jj = ps & 31, qb = which ? 63 - jj : jj;
        const int tok0 = b * SEQ + qb * 32;
        int c = c_, hl = hl_; asm volatile("" : "+v"(c), "+v"(hl));
        __syncthreads();
        {
            const int r = c; const int qq_r = ((r >> 2) & 1) * 2 + (r >> 4), head_r = ((r >> 3) & 1) * 4 + (r & 3);
            bf16x8 afr[4];
#pragma unroll
            for (int kk = 0; kk < 4; ++kk) afr[kk] = ld8(Z + (size_t)(tok0 + 4 * w + qq_r) * NZ + ZC_QI + head_r * 64 + 16 * kk + 8 * hl);
            float wv[2][8]; int posq[2];
#pragma unroll
            for (int s = 0; s < 2; ++s) { posq[s] = qb * 32 + 4 * w + 2 * hl + s;
                const uint4 ww = *(const uint4*)(Z + (size_t)(tok0 + 4 * w + 2 * hl + s) * NZ + ZC_WI);
                wv[s][0] = bflo(ww.x) * 0.35355339059327373f; wv[s][1] = bfhi(ww.x) * 0.35355339059327373f; wv[s][2] = bflo(ww.y) * 0.35355339059327373f; wv[s][3] = bfhi(ww.y) * 0.35355339059327373f;
                wv[s][4] = bflo(ww.z) * 0.35355339059327373f; wv[s][5] = bfhi(ww.z) * 0.35355339059327373f; wv[s][6] = bflo(ww.w) * 0.35355339059327373f; wv[s][7] = bfhi(ww.w) * 0.35355339059327373f; }
            u32 key[64][2];
            const bf16_t* kib = Z + (size_t)(b * SEQ + c) * NZ + ZC_KI + 8 * hl;
            bf16x8 bc[4];
#pragma unroll
            for (int kk = 0; kk < 4; ++kk) bc[kk] = ld8(kib + 16 * kk);
            const bf16_t* kp = kib;
#pragma unroll
            for (int kt = 0; kt < 64; ++kt) {
                if (kt <= qb) {
                    bf16x8 bn[4];
                    if (kt + 1 <= qb) kp += (size_t)32 * NZ;
                    asm volatile("" : "+v"(kp));
#pragma unroll
                    for (int kk = 0; kk < 4; ++kk) bn[kk] = ld8(kp + 16 * kk);
                    f32x16 acc = zero16();
#pragma unroll
                    for (int kk = 0; kk < 4; ++kk) acc = MFMA32(afr[kk], bc[kk], acc);
#pragma unroll
                    for (int s = 0; s < 2; ++s) { float sc = 0.f;
#pragma unroll
                        for (int e = 0; e < 8; ++e) sc = fmaf(wv[s][e], fmaxf(acc[8 * s + e], 0.f), sc);
                        key[kt][s] = (c <= posq[s] - kt * 32) ? ordf(sc) : 0u; }
#pragma unroll
                    for (int kk = 0; kk < 4; ++kk) bc[kk] = bn[kk];
                } else { key[kt][0] = 0u; key[kt][1] = 0u; }
                __builtin_amdgcn_sched_barrier(0);
            }
            u32 lo[2], hi[2], thr[2]; bool done[2], exact[2];
#pragma unroll
            for (int s = 0; s < 2; ++s) { lo[s] = 0x00800000u; hi[s] = 0xFF800000u; thr[s] = 1u; exact[s] = true; done[s] = posq[s] < 256; }
            for (int iter = 0; iter < 40; ++iter) {
                if (__all(done[0] && done[1])) break;
                u32 mid[2]; int cnt[2];
#pragma unroll
                for (int s = 0; s < 2; ++s) { mid[s] = lo[s] + ((hi[s] - lo[s]) >> 1); cnt[s] = 0; }
#pragma unroll
                for (int kt = 0; kt < 64; ++kt) { cnt[0] += (key[kt][0] >= mid[0]) ? 1 : 0; cnt[1] += (key[kt][1] >= mid[1]) ? 1 : 0; }
#pragma unroll
                for (int s = 0; s < 2; ++s) {
#pragma unroll
                    for (int o = 1; o < 32; o <<= 1) cnt[s] += __shfl_xor(cnt[s], o);
                    if (!done[s]) { if (cnt[s] >= 256) lo[s] = mid[s]; else hi[s] = mid[s];
                        if (cnt[s] == 256) { thr[s] = mid[s]; exact[s] = true; done[s] = true; }
                        else if (hi[s] - lo[s] <= 1u) { thr[s] = lo[s]; exact[s] = false; done[s] = true; } } }
            }
            if (__all(exact[0] && exact[1])) {
#pragma unroll
                for (int kt = 0; kt < 64; ++kt) if (kt <= qb) {
#pragma unroll
                    for (int s = 0; s < 2; ++s) { const unsigned long long bal = __ballot(key[kt][s] >= thr[s]);
                        if (lane == 0) { mk[(4 * w + s) * 65 + kt] = (u32)bal; mk[(4 * w + 2 + s) * 65 + kt] = (u32)(bal >> 32); } } }
            } else {
#pragma unroll
                for (int s = 0; s < 2; ++s) {
                    int cgt = 0; const u32 lowk = exact[s] ? thr[s] : thr[s] + 1u;
#pragma unroll
                    for (int kt = 0; kt < 64; ++kt) cgt += (key[kt][s] >= lowk) ? 1 : 0;
#pragma unroll
                    for (int o = 1; o < 32; o <<= 1) cgt += __shfl_xor(cgt, o);
                    const int need = exact[s] ? 0 : 256 - cgt;
                    int rem0 = __shfl(need, 0), rem1 = __shfl(need, 32);
                    const u32 eqk = exact[s] ? 0xFFFFFFFFu : thr[s];
#pragma unroll
                    for (int kt = 0; kt < 64; ++kt) if (kt <= qb) {
                        const unsigned long long bg = __ballot(key[kt][s] >= lowk), be = __ballot(key[kt][s] == eqk);
                        u32 e0 = (u32)be, e1 = (u32)(be >> 32);
                        while (__popc(e0) > rem0) e0 &= ~(1u << (31 - __clz(e0)));
                        while (__popc(e1) > rem1) e1 &= ~(1u << (31 - __clz(e1)));
                        rem0 -= __popc(e0); rem1 -= __popc(e1);
                        if (lane == 0) { mk[(4 * w + s) * 65 + kt] = (u32)bg | e0; mk[(4 * w + 2 + s) * 65 + kt] = (u32)(bg >> 32) | e1; } }
                }
            }
        }
        __syncthreads();
        {
            bf16x8 qfr[4];
#pragma unroll
            for (int kk = 0; kk < 4; ++kk) qfr[kk] = ld8(Z + (size_t)(tok0 + c) * NZ + ZC_QD + w * 64 + 16 * kk + 8 * hl);
            float m = -1e30f, l = 0.f; f32x16 o0 = zero16(), o1 = zero16();
            const bf16_t* kb = kd + (size_t)(b * SEQ + c) * 64 + 8 * hl;
            const bf16_t* vb = vdT + ((size_t)b * 64 + c) * SEQ + 4 * hl;
            for (int kt = 0; kt <= qb; ++kt) {
                const u32 word = mk[c * 65 + kt];
                if (__ballot(word != 0u) == 0ull) continue;
                f32x16 s = zero16();
#pragma unroll
                for (int kk = 0; kk < 4; ++kk) s = MFMA32(ld8(kb + (size_t)kt * 32 * 64 + 16 * kk), qfr[kk], s);
                flash_tile(m, l, o0, o1, s, vm_from_word(word, hl), vb + kt * 32, (size_t)32 * SEQ);
            }
            const float f = 1.0f / fmaxf(l, 1e-30f);
#pragma unroll
            for (int R = 0; R < 16; ++R) { o0[R] *= f; o1[R] *= f; }
            store_ot(odsa + (size_t)(tok0 + c) * 512 + w * 64, o0, o1, hl);
        }
    }
}

constexpr int TILE_B = 4608;
template <int NT> __device__ __forceinline__ void sk_gload(uint4 (&rk)[NT / 2], const bf16_t* kbase, size_t kstride, int t0c, int tlast, int tid) {
#pragma unroll
    for (int q = 0; q < NT / 2; ++q) { const int idx = tid + 512 * q, tile = idx >> 8, r = (idx >> 3) & 31, ch = idx & 7; int tg = t0c + tile; tg = tg > tlast ? tlast : tg;
        rk[q] = *(const uint4*)(kbase + (size_t)(32 * tg + r) * kstride + 8 * ch); }
}
template <int NT> __device__ __forceinline__ void sk_lwrite(const uint4 (&rk)[NT / 2], LAS unsigned char* kb, int tid) {
#pragma unroll
    for (int q = 0; q < NT / 2; ++q) { const int idx = tid + 512 * q, tile = idx >> 8, r = (idx >> 3) & 31, ch = idx & 7; const u32x4 v = {rk[q].x, rk[q].y, rk[q].z, rk[q].w}; *(LAS u32x4*)(kb + tile * TILE_B + r * 144 + ch * 16) = v; }
}
template <int NT> __device__ __forceinline__ void sv_gload(uint4 (&rv)[NT / 2], const bf16_t* vbase, size_t vstride, int t0c, int tlast, int tid) {
#pragma unroll
    for (int q = 0; q < NT / 2; ++q) { const int idx = tid + 512 * q, tile = idx >> 8, d = (idx >> 2) & 63, sg = idx & 3; int tg = t0c + tile; tg = tg > tlast ? tlast : tg;
        rv[q] = *(const uint4*)(vbase + (size_t)d * vstride + 32 * tg + 8 * sg); }
}
template <int NT> __device__ __forceinline__ void sv_lwrite(const uint4 (&rv)[NT / 2], LAS unsigned char* vb, int tid) {
#pragma unroll
    for (int q = 0; q < NT / 2; ++q) { const int idx = tid + 512 * q, tile = idx >> 8, d = (idx >> 2) & 63, sg = idx & 3; LAS unsigned char* a = vb + tile * TILE_B + d * 72 + sg * 16;
        const u32x2 v0 = {rv[q].x, rv[q].y}, v1 = {rv[q].z, rv[q].w}; *(LAS u32x2*)a = v0; *(LAS u32x2*)(a + 8) = v1; }
}
__device__ __forceinline__ bf16x8 lds_k(const LAS unsigned char* kt, int c, int hl, int kk) { return *(const LAS bf16x8*)(kt + c * 144 + kk * 32 + hl * 16); }
__device__ __forceinline__ bf16x8 lds_v(const LAS unsigned char* vt, int d, int hl, int s) { const LAS unsigned char* q = vt + d * 72 + s * 32 + hl * 8;
    const u32x2 a = *(const LAS u32x2*)q, b = *(const LAS u32x2*)(q + 16); const u32x4 v = {a.x, a.y, b.x, b.y}; return __builtin_bit_cast(bf16x8, v); }
__device__ __forceinline__ void flash_tile_lds(float& m, float& l, f32x16& o0, f32x16& o1, f32x16 s, u32 vm, const LAS unsigned char* vt, int c, int hl) {
    const bf16x8 v00 = lds_v(vt, c, hl, 0), v01 = lds_v(vt, c, hl, 1), v10 = lds_v(vt, c + 32, hl, 0), v11 = lds_v(vt, c + 32, hl, 1);
    float mx = -1e30f;
#pragma unroll
    for (int R = 0; R < 16; ++R) { s[R] = ((vm >> R) & 1u) ? s[R] : -1e30f; mx = fmaxf(mx, s[R]); }
    mx = fmaxf(mx, __shfl_xor(mx, 32));
    const float mn = fmaxf(m, mx), al = __expf(m - mn);
    float ps = 0.f;
#pragma unroll
    for (int R = 0; R < 16; ++R) { const float pr = ((vm >> R) & 1u) ? __expf(s[R] - mn) : 0.f; s[R] = pr; ps += pr; }
    ps += __shfl_xor(ps, 32);
    l = l * al + ps; m = mn;
#pragma unroll
    for (int R = 0; R < 16; ++R) { o0[R] *= al; o1[R] *= al; }
    const bf16x8 p0 = pack8<0>(s), p1 = pack8<1>(s);
    o0 = MFMA32(v00, p0, o0); o0 = MFMA32(v01, p1, o0);
    o1 = MFMA32(v10, p0, o1); o1 = MFMA32(v11, p1, o1);
}
constexpr int ATT_CHUNK = 8 * TILE_B;
constexpr int ATT_MK_OFF = 2 * ATT_CHUNK;

#define ATT_STREAM_KV(kbase, kstride, vbase, vstride, tfirst, tlast, BODY) do { \
    const int _tf = (tfirst), _tl = (tlast); const int _nch = (_tl - _tf + 4) >> 2; \
    uint4 _rk[2], _rv[2]; \
    __syncthreads(); \
    sk_gload<4>(_rk, (kbase), (kstride), _tf, _tl, tid); sv_gload<4>(_rv, (vbase), (vstride), _tf, _tl, tid); \
    sk_lwrite<4>(_rk, sm, tid); sv_lwrite<4>(_rv, sm + 4 * TILE_B, tid); \
    if (_nch > 1) { sk_gload<4>(_rk, (kbase), (kstride), _tf + 4, _tl, tid); sv_gload<4>(_rv, (vbase), (vstride), _tf + 4, _tl, tid); } \
    for (int _c = 0; _c < _nch; ++_c) { \
        __syncthreads(); \
        if (_c + 1 < _nch) { LAS unsigned char* _nb = sm + ((_c + 1) & 1) * ATT_CHUNK; sk_lwrite<4>(_rk, _nb, tid); sv_lwrite<4>(_rv, _nb + 4 * TILE_B, tid); \
            if (_c + 2 < _nch) { sk_gload<4>(_rk, (kbase), (kstride), _tf + 4 * (_c + 2), _tl, tid); sv_gload<4>(_rv, (vbase), (vstride), _tf + 4 * (_c + 2), _tl, tid); } } \
        const LAS unsigned char* _cb = sm + (_c & 1) * ATT_CHUNK; \
        _Pragma("unroll") for (int _i = 0; _i < 4; ++_i) { const int tg = _tf + 4 * _c + _i; if (tg <= _tl) { const LAS unsigned char* kt = _cb + _i * TILE_B; const LAS unsigned char* vt = _cb + (4 + _i) * TILE_B; BODY } } \
    } } while (0)

__device__ __forceinline__ void st_nsa2(const Params& p, unsigned char* lds) {
    LAS unsigned char* sm = (LAS unsigned char*)lds;
    const bf16_t* Z = (const bf16_t*)(p.ws + WS_Z); unsigned char* dob = (unsigned char*)p.out;
    const bf16_t* kcmp = (const bf16_t*)(dob + DO_KCMP); const bf16_t* vcmpT = (const bf16_t*)(dob + DO_VCMPT);
    const bf16_t* vsT = (const bf16_t*)(dob + DO_VST); const bf16_t* vwT = (const bf16_t*)(dob + DO_VWT);
    bf16_t* onsa = (bf16_t*)(p.ws + WS_ONSA);
    for (int ps = blockIdx.x; ps < 256; ps += gridDim.x)
    for (int which = 0; which < 2; ++which) {
        const int b = ps >> 5, g = (ps >> 4) & 1, jj = ps & 15, qb = which ? 31 - jj : jj, cur = qb;
        int tid = threadIdx.x; asm volatile("" : "+v"(tid));
        const int lane = tid & 63, w = __builtin_amdgcn_readfirstlane(tid >> 6), c = lane & 31, hl = lane >> 5;
        const int t0 = qb * 64, pmin = t0 + 8 * w, pos = pmin + (c >> 2), head = 4 * g + (c & 3);
        const bf16_t* zr = Z + (size_t)(b * SEQ + pos) * NZ;
        bf16x8 qfr[4];
#pragma unroll
        for (int kk = 0; kk < 4; ++kk) qfr[kk] = ld8(zr + ZC_QN + head * 64 + 16 * kk + 8 * hl);
        const float gc = bf2f(zr[ZC_GN + head * 3]), gs = bf2f(zr[ZC_GN + head * 3 + 1]), gw = bf2f(zr[ZC_GN + head * 3 + 2]);
        f32x16 out0 = zero16(), out1 = zero16();
        u32 sel;
        {
            const int pmax = pmin + 7; const int nmax = pmax >= 31 ? ((pmax - 31) >> 4) : -1; const int ntile = nmax >= 0 ? (((nmax > 126 ? 126 : nmax) >> 5) + 1) : 0;
            const bf16_t* kb = kcmp + ((size_t)(b * 2 + g) * 128 + c) * 64 + 8 * hl;
            float mx = -1e30f, l = 0.f;
            const int nlim = (pos >= 31 ? (((pos - 31) >> 4) > 126 ? 126 : ((pos - 31) >> 4)) : -1) - 4 * hl;
            for (int kt = 0; kt < ntile; ++kt) {
                f32x16 s = zero16();
#pragma unroll
                for (int kk = 0; kk < 4; ++kk) s = MFMA32(ld8(kb + (size_t)kt * 32 * 64 + 16 * kk), qfr[kk], s);
                const u32 vm = vm_le(nlim - 32 * kt);
                float tm = -1e30f;
#pragma unroll
                for (int R = 0; R < 16; ++R) { s[R] = ((vm >> R) & 1u) ? s[R] : -1e30f; tm = fmaxf(tm, s[R]); }
                const float mn = fmaxf(mx, tm); float ps2 = 0.f;
#pragma unroll
                for (int R = 0; R < 16; ++R) ps2 += ((vm >> R) & 1u) ? __expf(s[R] - mn) : 0.f;
                l = l * __expf(mx - mn) + ps2; mx = mn;
            }
            { const float mo = __shfl_xor(mx, 32), lo_ = __shfl_xor(l, 32); const float mn = fmaxf(mx, mo);
              l = l * __expf(mx - mn) + lo_ * __expf(mo - mn); mx = mn; }
            const float il = 1.0f / fmaxf(l, 1e-30f);
            __builtin_amdgcn_sched_barrier(0);
            f32x16 o0 = zero16(), o1 = zero16();
            const bf16_t* vb = vcmpT + ((size_t)(b * 2 + g) * 64 + c) * 128 + 4 * hl;
            float G[16], L[16];
#pragma unroll
            for (int kt = 0; kt < 4; ++kt) {
                if (kt < ntile) {
                    f32x16 s = zero16();
#pragma unroll
                    for (int kk = 0; kk < 4; ++kk) s = MFMA32(ld8(kb + (size_t)kt * 32 * 64 + 16 * kk), qfr[kk], s);
                    const u32 vm = vm_le(nlim - 32 * kt);
#pragma unroll
                    for (int R = 0; R < 16; ++R) s[R] = ((vm >> R) & 1u) ? __expf(s[R] - mx) * il : 0.f;
                    const bf16x8 p0 = pack8<0>(s), p1 = pack8<1>(s);
                    o0 = MFMA32(ld44(vb + 32 * kt), p0, o0); o0 = MFMA32(ld44(vb + 32 * kt + 16), p1, o0);
                    o1 = MFMA32(ld44(vb + 32 * 128 + 32 * kt), p0, o1); o1 = MFMA32(ld44(vb + 32 * 128 + 32 * kt + 16), p1, o1);
#pragma unroll
                    for (int rg = 0; rg < 4; ++rg) { float gsum = (s[4 * rg] + s[4 * rg + 1]) + (s[4 * rg + 2] + s[4 * rg + 3]); float last = s[4 * rg + 3];
                        gsum += dpp_xor1(gsum); gsum += dpp_xor2(gsum); last += dpp_xor1(last); last += dpp_xor2(last);
                        G[4 * kt + rg] = gsum; L[4 * kt + rg] = last; }
                } else {
#pragma unroll
                    for (int rg = 0; rg < 4; ++rg) { G[4 * kt + rg] = 0.f; L[4 * kt + rg] = 0.f; }
                }
                __builtin_amdgcn_sched_barrier(0);
            }
#pragma unroll
            for (int R = 0; R < 16; ++R) { out0[R] = gc * o0[R]; out1[R] = gc * o1[R]; }
            float v[16], vx[16];
            { float Lx[16];
#pragma unroll
              for (int i = 0; i < 16; ++i) Lx[i] = __shfl_xor(L[i], 32);
#pragma unroll
              for (int i = 0; i < 16; ++i) { const float prevL = hl ? Lx[i] : (i > 0 ? Lx[i > 0 ? i - 1 : 0] : 0.f); const float bl = prevL + 2.f * G[i] - L[i];
                const int j = 2 * i + hl; const bool forced = (j == 0) || (j == cur) || (j == cur - 1);
                v[i] = forced ? __builtin_inff() : (j <= cur ? bl : -__builtin_inff()); } }
#pragma unroll
            for (int i = 0; i < 16; ++i) vx[i] = __shfl_xor(v[i], 32);
            u32 own = 0u;
#pragma unroll
            for (int i = 0; i < 16; ++i) { int rank = 0;
#pragma unroll
                for (int i2 = 0; i2 < 16; ++i2) {
                    if (i2 != i) rank += (v[i2] > v[i] || (v[i2] == v[i] && i2 < i)) ? 1 : 0;
                    const bool xlt = (i2 < i) || (hl && i2 == i);
                    rank += (vx[i2] > v[i] || (vx[i2] == v[i] && xlt)) ? 1 : 0; }
                const int j = 2 * i + hl; own |= ((j <= cur) && rank < 16) ? (1u << j) : 0u; }
            sel = own | (u32)__shfl_xor((int)own, 32);
            __builtin_amdgcn_sched_barrier(0);
        }
        {
            float m = -1e30f, l = 0.f; f32x16 o0 = zero16(), o1 = zero16();
            ATT_STREAM_KV(Z + (size_t)(b * SEQ) * NZ + ZC_KS + g * 64, (size_t)NZ, vsT + (size_t)(b * 2 + g) * 64 * SEQ, (size_t)SEQ, 0, 2 * cur + 1, {
                const bool mine = (sel >> (tg >> 1)) & 1u;
                if (__ballot(mine) != 0ull) {
                    f32x16 s = zero16();
                    _Pragma("unroll") for (int kk = 0; kk < 4; ++kk) s = MFMA32(lds_k(kt, c, hl, kk), qfr[kk], s);
                    const u32 vm = mine ? vm_le(pos - tg * 32 - 4 * hl) : 0u;
                    flash_tile_lds(m, l, o0, o1, s, vm, vt, c, hl); } });
            const float f = gs / fmaxf(l, 1e-30f);
#pragma unroll
            for (int R = 0; R < 16; ++R) { out0[R] += f * o0[R]; out1[R] += f * o1[R]; }
        }
        {
            float m = -1e30f, l = 0.f; f32x16 o0 = zero16(), o1 = zero16();
            const int wfirst = (t0 - 511 > 0 ? t0 - 511 : 0) >> 5, wlast = (t0 + 63) >> 5;
            const int myfirst = (pmin - 511 > 0 ? pmin - 511 : 0) >> 5, mylast = (pmin + 7) >> 5;
            ATT_STREAM_KV(Z + (size_t)(b * SEQ) * NZ + ZC_KW + g * 64, (size_t)NZ, vwT + (size_t)(b * 2 + g) * 64 * SEQ, (size_t)SEQ, wfirst, wlast, {
                if (tg >= myfirst && tg <= mylast) {
                    f32x16 s = zero16();
                    _Pragma("unroll") for (int kk = 0; kk < 4; ++kk) s = MFMA32(lds_k(kt, c, hl, kk), qfr[kk], s);
                    const int d1 = pos - tg * 32 - 4 * hl; const u32 vm = vm_le(d1) & ~vm_le(d1 - 512);
                    flash_tile_lds(m, l, o0, o1, s, vm, vt, c, hl); } });
            const float f = gw / fmaxf(l, 1e-30f);
#pragma unroll
            for (int R = 0; R < 16; ++R) { out0[R] += f * o0[R]; out1[R] += f * o1[R]; }
        }
        store_ot(onsa + (size_t)(b * SEQ + pos) * 512 + head * 64, out0, out1, hl);
    }
    __syncthreads();
}

__device__ __forceinline__ void st_dsa2(const Params& p, unsigned char* lds) {
    LAS unsigned char* sm = (LAS unsigned char*)lds;
    const bf16_t* Z = (const bf16_t*)(p.ws + WS_Z); unsigned char* dob = (unsigned char*)p.out;
    const bf16_t* kd = (const bf16_t*)(dob + DO_KD); const bf16_t* vdT = (const bf16_t*)(dob + DO_VDT);
    bf16_t* odsa = (bf16_t*)(p.ws + WS_ODSA);
    u32* mk = (u32*)(lds + ATT_MK_OFF);
    for (int ps = blockIdx.x; ps < 256; ps += gridDim.x)
    for (int which = 0; which < 2; ++which) {
        const int b = ps >> 5, jj = ps & 31, qb = which ? 63 - jj : jj;
        const int tok0 = b * SEQ + qb * 32;
        int tid = threadIdx.x; asm volatile("" : "+v"(tid));
        const int lane = tid & 63, w = __builtin_amdgcn_readfirstlane(tid >> 6), c = lane & 31, hl = lane >> 5;
        {
            const int r = c; const int qq_r = ((r >> 2) & 1) * 2 + (r >> 4), head_r = ((r >> 3) & 1) * 4 + (r & 3);
            bf16x8 afr[4];
#pragma unroll
            for (int kk = 0; kk < 4; ++kk) afr[kk] = ld8(Z + (size_t)(tok0 + 4 * w + qq_r) * NZ + ZC_QI + head_r * 64 + 16 * kk + 8 * hl);
            float wv[2][8]; int posq[2];
#pragma unroll
            for (int s = 0; s < 2; ++s) { posq[s] = qb * 32 + 4 * w + 2 * hl + s;
                const uint4 ww = *(const uint4*)(Z + (size_t)(tok0 + 4 * w + 2 * hl + s) * NZ + ZC_WI);
                wv[s][0] = bflo(ww.x) * 0.35355339059327373f; wv[s][1] = bfhi(ww.x) * 0.35355339059327373f; wv[s][2] = bflo(ww.y) * 0.35355339059327373f; wv[s][3] = bfhi(ww.y) * 0.35355339059327373f;
                wv[s][4] = bflo(ww.z) * 0.35355339059327373f; wv[s][5] = bfhi(ww.z) * 0.35355339059327373f; wv[s][6] = bflo(ww.w) * 0.35355339059327373f; wv[s][7] = bfhi(ww.w) * 0.35355339059327373f; }
            u32 key[64][2];
            const bf16_t* kib = Z + (size_t)(b * SEQ) * NZ + ZC_KI;
            uint4 rk[4];
            __syncthreads();
            sk_gload<8>(rk, kib, (size_t)NZ, 0, qb, tid); sk_lwrite<8>(rk, sm, tid);
            if (qb >= 8) sk_gload<8>(rk, kib, (size_t)NZ, 8, qb, tid);
#pragma unroll
            for (int ch = 0; ch < 8; ++ch) {
                if (ch * 8 <= qb) {
                    __syncthreads();
                    if ((ch + 1) * 8 <= qb) { sk_lwrite<8>(rk, sm + ((ch + 1) & 1) * ATT_CHUNK, tid);
                        if ((ch + 2) * 8 <= qb) sk_gload<8>(rk, kib, (size_t)NZ, (ch + 2) * 8, qb, tid); }
                    const LAS unsigned char* cb = sm + (ch & 1) * ATT_CHUNK;
#pragma unroll
                    for (int i = 0; i < 8; ++i) { const int kt = ch * 8 + i;
                        if (kt <= qb) {
                            f32x16 acc = zero16();
#pragma unroll
                            for (int kk = 0; kk < 4; ++kk) acc = MFMA32(afr[kk], lds_k(cb + i * TILE_B, c, hl, kk), acc);
#pragma unroll
                            for (int s = 0; s < 2; ++s) { float sc = 0.f;
#pragma unroll
                                for (int e = 0; e < 8; ++e) sc = fmaf(wv[s][e], fmaxf(acc[8 * s + e], 0.f), sc);
                                key[kt][s] = (c <= posq[s] - kt * 32) ? ordf(sc) : 0u; }
                        } else { key[kt][0] = 0u; key[kt][1] = 0u; }
                        __builtin_amdgcn_sched_barrier(0);
                    }
                } else {
#pragma unroll
                    for (int i = 0; i < 8; ++i) { key[ch * 8 + i][0] = 0u; key[ch * 8 + i][1] = 0u; }
                }
            }
            u32 lo[2], hi[2], thr[2]; bool done[2], exact[2];
#pragma unroll
            for (int s = 0; s < 2; ++s) { lo[s] = 0x00800000u; hi[s] = 0xFF800000u; thr[s] = 1u; exact[s] = true; done[s] = posq[s] < 256; }
            for (int iter = 0; iter < 40; ++iter) {
                if (__all(done[0] && done[1])) break;
                u32 mid[2]; int cnt[2];
#pragma unroll
                for (int s = 0; s < 2; ++s) { mid[s] = lo[s] + ((hi[s] - lo[s]) >> 1); cnt[s] = 0; }
#pragma unroll
                for (int kt = 0; kt < 64; ++kt) { cnt[0] += (key[kt][0] >= mid[0]) ? 1 : 0; cnt[1] += (key[kt][1] >= mid[1]) ? 1 : 0; }
#pragma unroll
                for (int s = 0; s < 2; ++s) {
#pragma unroll
                    for (int o = 1; o < 32; o <<= 1) cnt[s] += __shfl_xor(cnt[s], o);
                    if (!done[s]) { if (cnt[s] >= 256) lo[s] = mid[s]; else hi[s] = mid[s];
                        if (cnt[s] == 256) { thr[s] = mid[s]; exact[s] = true; done[s] = true; }
                        else if (hi[s] - lo[s] <= 1u) { thr[s] = lo[s]; exact[s] = false; done[s] = true; } } }
            }
            if (__all(exact[0] && exact[1])) {
#pragma unroll
                for (int kt = 0; kt < 64; ++kt) if (kt <= qb) {
#pragma unroll
                    for (int s = 0; s < 2; ++s) { const unsigned long long bal = __ballot(key[kt][s] >= thr[s]);
                        if (lane == 0) { mk[(4 * w + s) * 65 + kt] = (u32)bal; mk[(4 * w + 2 + s) * 65 + kt] = (u32)(bal >> 32); } } }
            } else {
#pragma unroll
                for (int s = 0; s < 2; ++s) {
                    int cgt = 0; const u32 lowk = exact[s] ? thr[s] : thr[s] + 1u;
#pragma unroll
                    for (int kt = 0; kt < 64; ++kt) cgt += (key[kt][s] >= lowk) ? 1 : 0;
#pragma unroll
                    for (int o = 1; o < 32; o <<= 1) cgt += __shfl_xor(cgt, o);
                    const int need = exact[s] ? 0 : 256 - cgt;
                    int rem0 = __shfl(need, 0), rem1 = __shfl(need, 32);
                    const u32 eqk = exact[s] ? 0xFFFFFFFFu : thr[s];
#pragma unroll
                    for (int kt = 0; kt < 64; ++kt) if (kt <= qb) {
                        const unsigned long long bg = __ballot(key[kt][s] >= lowk), be = __ballot(key[kt][s] == eqk);
                        u32 e0 = (u32)be, e1 = (u32)(be >> 32);
                        while (__popc(e0) > rem0) e0 &= ~(1u << (31 - __clz(e0)));
                        while (__popc(e1) > rem1) e1 &= ~(1u << (31 - __clz(e1)));
                        rem0 -= __popc(e0); rem1 -= __popc(e1);
                        if (lane == 0) { mk[(4 * w + s) * 65 + kt] = (u32)bg | e0; mk[(4 * w + 2 + s) * 65 + kt] = (u32)(bg >> 32) | e1; } }
                }
            }
        }
        {
            bf16x8 qfr[4];
#pragma unroll
            for (int kk = 0; kk < 4; ++kk) qfr[kk] = ld8(Z + (size_t)(tok0 + c) * NZ + ZC_QD + w * 64 + 16 * kk + 8 * hl);
            float m = -1e30f, l = 0.f; f32x16 o0 = zero16(), o1 = zero16();
            ATT_STREAM_KV(kd + (size_t)(b * SEQ) * 64, (size_t)64, vdT + (size_t)b * 64 * SEQ, (size_t)SEQ, 0, qb, {
                const u32 word = mk[c * 65 + tg];
                if (__ballot(word != 0u) != 0ull) {
                    f32x16 s = zero16();
                    _Pragma("unroll") for (int kk = 0; kk < 4; ++kk) s = MFMA32(lds_k(kt, c, hl, kk), qfr[kk], s);
                    flash_tile_lds(m, l, o0, o1, s, vm_from_word(word, hl), vt, c, hl); } });
            const float f = 1.0f / fmaxf(l, 1e-30f);
#pragma unroll
            for (int R = 0; R < 16; ++R) { o0[R] *= f; o1[R] *= f; }
            store_ot(odsa + (size_t)(tok0 + c) * 512 + w * 64, o0, o1, hl);
        }
    }
    __syncthreads();
}

typedef __bf16 v2bf_t __attribute__((ext_vector_type(2)));
__device__ __forceinline__ float dot2bf(u32 a, u32 b, float c) { return __builtin_amdgcn_fdot2_f32_bf16(__builtin_bit_cast(v2bf_t, a), __builtin_bit_cast(v2bf_t, b), c, false); }
__device__ __forceinline__ float dpp_hmirror(float v) { return __int_as_float(__builtin_amdgcn_update_dpp(0, __float_as_int(v), 0x141, 0xF, 0xF, true)); }
__device__ __forceinline__ void st_expert2(const Params& p, unsigned char* lds) {
    int tid = threadIdx.x; asm volatile("" : "+v"(tid));
    const int lane = tid & 63, w = __builtin_amdgcn_readfirstlane(tid >> 6), rs = lane >> 3, ch = lane & 7;
    const bf16_t* h2 = (const bf16_t*)(p.ws + WS_H2); const bf16_t* u16 = (const bf16_t*)(p.ws + WS_U16); const bf16_t* v16 = (const bf16_t*)(p.ws + WS_V16);
    const int* eidx = (const int*)(p.ws + WS_EIDX); const float* gate = (const float*)(p.ws + WS_GATE); const float* mod = (const float*)(p.ws + WS_MOD);
    float* wl = (float*)lds + w * 256;
    int* el = (int*)(wl + 128);
    for (int t = blockIdx.x * 8 + w; t < T; t += gridDim.x * 8) {
        u32x4 xq[16];
#pragma unroll
        for (int i = 0; i < 16; ++i) xq[i] = *(const u32x4*)(h2 + (size_t)t * D + (ch + 8 * i) * 8);
        { const int e0 = eidx[(size_t)t * 128 + lane], e1 = eidx[(size_t)t * 128 + 64 + lane]; el[lane] = e0; el[64 + lane] = e1; }
#pragma unroll
        for (int rg = 0; rg < 16; ++rg) {
            const int e = eidx[(size_t)t * 128 + 8 * rg + rs]; const float gt = gate[(size_t)t * 128 + 8 * rg + rs];
            const bf16_t* ur = u16 + (size_t)e * D + ch * 8;
            float s0 = 0.f, s1 = 0.f;
#pragma unroll
            for (int i = 0; i < 16; ++i) { const u32x4 uv = *(const u32x4*)(ur + 64 * i);
                s0 = dot2bf(uv.x, xq[i].x, s0); s1 = dot2bf(uv.y, xq[i].y, s1); s0 = dot2bf(uv.z, xq[i].z, s0); s1 = dot2bf(uv.w, xq[i].w, s1); }
            float s = s0 + s1; s += dpp_hmirror(s); s += dpp_xor1(s); s += dpp_xor2(s);
            if (ch == 0) wl[8 * rg + rs] = gt * gelu_erf(s);
        }
        asm volatile("s_waitcnt lgkmcnt(0)" ::: "memory");
        float acc[16];
#pragma unroll
        for (int i = 0; i < 16; ++i) acc[i] = 0.f;
        for (int k0 = 0; k0 < 128; k0 += 8) {
            u32x4 va[8], vb[8]; float wk[8];
#pragma unroll
            for (int j = 0; j < 8; ++j) { const int e = __builtin_amdgcn_readfirstlane(el[k0 + j]); wk[j] = wl[k0 + j];
                const bf16_t* vr = v16 + (size_t)e * D + lane * 8; va[j] = *(const u32x4*)vr; vb[j] = *(const u32x4*)(vr + 512); }
#pragma unroll
            for (int j = 0; j < 8; ++j) {
                acc[0] += wk[j] * bflo(va[j].x); acc[1] += wk[j] * bfhi(va[j].x); acc[2] += wk[j] * bflo(va[j].y); acc[3] += wk[j] * bfhi(va[j].y);
                acc[4] += wk[j] * bflo(va[j].z); acc[5] += wk[j] * bfhi(va[j].z); acc[6] += wk[j] * bflo(va[j].w); acc[7] += wk[j] * bfhi(va[j].w);
                acc[8] += wk[j] * bflo(vb[j].x); acc[9] += wk[j] * bfhi(vb[j].x); acc[10] += wk[j] * bflo(vb[j].y); acc[11] += wk[j] * bfhi(vb[j].y);
                acc[12] += wk[j] * bflo(vb[j].z); acc[13] += wk[j] * bfhi(vb[j].z); acc[14] += wk[j] * bflo(vb[j].w); acc[15] += wk[j] * bfhi(vb[j].w); }
        }
        const float* g2 = mod + (t >> 11) * 6144 + 5120; float* xr = p.out + (size_t)t * D; float ss = 0.f;
#pragma unroll
        for (int hlf = 0; hlf < 2; ++hlf)
#pragma unroll
            for (int q = 0; q < 2; ++q) { const int d0 = hlf * 512 + lane * 8 + 4 * q; const float4 xv = *(const float4*)(xr + d0), gv = *(const float4*)(g2 + d0);
                float* a = acc + hlf * 8 + 4 * q; a[0] = xv.x + gv.x * a[0]; a[1] = xv.y + gv.y * a[1]; a[2] = xv.z + gv.z * a[2]; a[3] = xv.w + gv.w * a[3];
                ss += a[0] * a[0] + a[1] * a[1] + a[2] * a[2] + a[3] * a[3]; }
        const float r = rsqrtf(wave_sum(ss) * (1.0f / D) + EPS);
#pragma unroll
        for (int hlf = 0; hlf < 2; ++hlf)
#pragma unroll
            for (int q = 0; q < 2; ++q) { const int d0 = hlf * 512 + lane * 8 + 4 * q; const float4 fg = *(const float4*)(p.final_g + d0); const float* a = acc + hlf * 8 + 4 * q;
                float4 o; o.x = a[0] * r * fg.x; o.y = a[1] * r * fg.y; o.z = a[2] * r * fg.z; o.w = a[3] * r * fg.w; *(float4*)(xr + d0) = o; }
        asm volatile("s_waitcnt lgkmcnt(0)" ::: "memory");
    }
}

namespace pg8 {
typedef short bf16x8 __attribute__((ext_vector_type(8)));
typedef float f32x4 __attribute__((ext_vector_type(4)));
typedef unsigned u32x4 __attribute__((ext_vector_type(4)));
constexpr int BM = 256, BK = 64, HALF = 128, HTB = HALF * BK * 2, STAGE_BYTES = 8 * HTB, NXCD = 8, WGM = 8;
__host__ __device__ __forceinline__ int lds_byte(int r, int c) { const int st = (r >> 4) * 2 + (c >> 5), rr = r & 15, cc = c & 31, ob = rr * 64 + cc * 2; return st * 1024 + (ob ^ (((ob >> 9) & 1) << 5)); }
__host__ __device__ __forceinline__ void stage_rc(int b, int& R, int& C) { const int st = b / 1024, sb = b % 1024, swz = sb ^ (((sb >> 9) & 1) << 5); R = (st >> 1) * 16 + swz / 64; C = (st & 1) * 32 + (swz % 64) / 2; }
__host__ __device__ __forceinline__ int perm32(int rho) { const int n = rho >> 4, i = rho & 15; return 8 * (i >> 2) + 4 * n + (i & 3); }
struct Unit { int pm, pn; };
struct Gemm { const bf16_t* A; const bf16_t* Bt; int M, N, K; };
struct StaticOrder {
    int nM, nN, nwg, G, c;
    __host__ __device__ void init(int M, int N, int G_, int c_) { nM = M / BM; nN = N / BM; nwg = nM * nN; G = G_; c = c_; }
    __host__ __device__ bool next(int i, Unit& u) const {
        const long L = (long)i * G + c; if (L >= nwg) return false;
        int wgid = (int)L; { const int q = nwg / NXCD, r = nwg % NXCD, xcd = wgid % NXCD, off = wgid / NXCD; wgid = (xcd < r ? xcd * (q + 1) : r * (q + 1) + (xcd - r) * q) + off; }
        const int nig = WGM * nN, gid = wgid / nig, fm = gid * WGM, gsz = (nM - fm) < WGM ? (nM - fm) : WGM;
        u.pm = fm + ((wgid % nig) % gsz); u.pn = (wgid % nig) / gsz; return true;
    }
    __device__ __forceinline__ void a_ready(const Unit&) const {}
    __device__ __forceinline__ void done(const Unit&) const {}
};
__device__ __forceinline__ unsigned cvt_pk_bf16(float lo, float hi) { unsigned r; asm volatile("v_cvt_pk_bf16_f32 %0, %1, %2" : "=v"(r) : "v"(lo), "v"(hi)); return r; }

template <class Epi, class Sched, bool ALIGN_EPI = false, bool SP2 = false>
__device__ __forceinline__ void gemm_phase(LAS unsigned char* lds, const Gemm g, const Sched& S, const Epi& E) {
    int tid = threadIdx.x; asm volatile("" : "+v"(tid));
    const int wid = __builtin_amdgcn_readfirstlane(tid >> 6), lane = tid & 63, wr = wid >> 2, wc = wid & 3, fr = lane & 15, fq = lane >> 4;
    const int K = g.K, nt = K / BK;
    unsigned voffA[2], voffB[2];
#pragma unroll
    for (int i = 0; i < 2; ++i) { int R, C; stage_rc(tid * 16 + i * 8192, R, C); const int Rb = Epi::PERM ? ((R & ~31) + perm32(R & 31)) : R;
        voffA[i] = (unsigned)(R * K + C) * 2u; voffB[i] = (unsigned)(Rb * K + C) * 2u; }
    const size_t kstep = (size_t)(BK * 2);
    const size_t hstep = (size_t)HALF * K * 2;
    const size_t tstep = 2 * hstep;
    const unsigned ldsw = (unsigned)wid * 1024u;
    const int aoff = lds_byte(wr * 64 + fr, fq * 8), boff = lds_byte(wc * 32 + fr, fq * 8);
#define PG8_SA(b, h) (((b) * 2 + (h)) * HTB)
#define PG8_SB(b, h) ((4 + (b) * 2 + (h)) * HTB)
#define PG8_STAGE(bufoff, gbase, voff) do { _Pragma("unroll") for (int _i = 0; _i < 2; ++_i) \
        __builtin_amdgcn_global_load_lds((const unsigned*)((const char*)(gbase) + (voff)[_i]), (LAS unsigned*)(lds + (bufoff) + ldsw + _i * 8192), 16, 0, 0); } while (0)
#define PG8_LDA(dst, b, h) do { _Pragma("unroll") for (int m = 0; m < 4; ++m) _Pragma("unroll") for (int k = 0; k < 2; ++k) dst[m][k] = *(const LAS bf16x8*)(lds + PG8_SA(b, h) + aoff + m * 2048 + k * 1024); } while (0)
#define PG8_LDB(dst, b, h) do { _Pragma("unroll") for (int n = 0; n < 2; ++n) _Pragma("unroll") for (int k = 0; k < 2; ++k) dst[n][k] = *(const LAS bf16x8*)(lds + PG8_SB(b, h) + boff + n * 2048 + k * 1024); } while (0)
#define PG8_MMA(ai, bj, At, Bt) do { __builtin_amdgcn_s_setprio(1); _Pragma("unroll") for (int m = 0; m < 4; ++m) _Pragma("unroll") for (int n = 0; n < 2; ++n) _Pragma("unroll") for (int k = 0; k < 2; ++k) \
        acc[ai][bj][m][n] = __builtin_amdgcn_mfma_f32_16x16x32_bf16(Bt[n][k], At[m][k], acc[ai][bj][m][n], 0, 0, 0); __builtin_amdgcn_s_setprio(0); } while (0)
#define PG8_WAIT_V(n) asm volatile("s_waitcnt vmcnt(" #n ")" ::: "memory")
#define PG8_WAIT_L(n) asm volatile("s_waitcnt lgkmcnt(" #n ")" ::: "memory")
#define PG8_BAR __builtin_amdgcn_s_barrier()
#define PG8_SCHED __builtin_amdgcn_sched_barrier(0)
    Unit cur, nxt; int ui = 0;
    if (!S.next(0, cur)) return;
    f32x4 acc[2][2][4][2];
#pragma unroll
    for (int a = 0; a < 2; ++a)
#pragma unroll
        for (int b = 0; b < 2; ++b)
#pragma unroll
            for (int m = 0; m < 4; ++m)
#pragma unroll
                for (int n = 0; n < 2; ++n) acc[a][b][m][n] = (f32x4){0.f, 0.f, 0.f, 0.f};
    bf16x8 At[4][2], B0[2][2], B1[2][2];
    const char* cA = (const char*)g.A + (size_t)cur.pm * tstep; const char* cB = (const char*)g.Bt + (size_t)cur.pn * tstep;
    S.a_ready(cur);
    if constexpr (SP2) {
        PG8_STAGE(PG8_SB(0, 0), cB, voffB); PG8_STAGE(PG8_SB(0, 1), cB + hstep, voffB); PG8_STAGE(PG8_SA(0, 0), cA, voffA); PG8_STAGE(PG8_SA(0, 1), cA + hstep, voffA);
        if (wr == 1) PG8_BAR;
        PG8_WAIT_V(2); PG8_BAR;
        PG8_STAGE(PG8_SB(1, 0), cB + kstep, voffB); PG8_STAGE(PG8_SA(1, 0), cA + kstep, voffA); PG8_STAGE(PG8_SB(1, 1), cB + hstep + kstep, voffB);
        PG8_WAIT_V(6); PG8_BAR;
    } else {
        PG8_STAGE(PG8_SB(0, 0), cB, voffB); PG8_STAGE(PG8_SA(0, 0), cA, voffA); PG8_STAGE(PG8_SB(0, 1), cB + hstep, voffB); PG8_STAGE(PG8_SA(0, 1), cA + hstep, voffA);
        if (wr == 1) PG8_BAR;
        PG8_WAIT_V(4); PG8_BAR;
        PG8_STAGE(PG8_SB(1, 0), cB + kstep, voffB); PG8_STAGE(PG8_SA(1, 0), cA + kstep, voffA); PG8_STAGE(PG8_SB(1, 1), cB + hstep + kstep, voffB);
        PG8_WAIT_V(6); PG8_BAR;
    }
    for (;;) {
        const bool has_next = S.next(ui + 1, nxt);
        const char* nA = has_next ? (const char*)g.A + (size_t)nxt.pm * tstep : cA; const char* nB = has_next ? (const char*)g.Bt + (size_t)nxt.pn * tstep : cB;
        for (int t = 0; t < nt; t += 2) {
            const bool last = (t == nt - 2);
            const char* a1 = cA + (size_t)(t + 1) * kstep;
            const char* a2 = last ? nA : cA + (size_t)(t + 2) * kstep; const char* b2 = last ? nB : cB + (size_t)(t + 2) * kstep;
            const char* a3 = a2 + kstep; const char* b3 = b2 + kstep;
            if (last && has_next) S.a_ready(nxt);
            if constexpr (SP2) {
            PG8_LDB(B0, 0, 0); PG8_LDB(B1, 0, 1); PG8_SCHED; PG8_LDA(At, 0, 0); PG8_STAGE(PG8_SA(1, 1), a1 + hstep, voffA);
            PG8_WAIT_V(8); PG8_WAIT_L(0); PG8_BAR; PG8_MMA(0, 0, At, B0); PG8_MMA(0, 1, At, B1); PG8_BAR; PG8_SCHED;
            PG8_LDA(At, 0, 1); PG8_STAGE(PG8_SB(0, 0), b2, voffB); PG8_STAGE(PG8_SB(0, 1), b2 + hstep, voffB); PG8_STAGE(PG8_SA(0, 0), a2, voffA);
            PG8_WAIT_V(8); PG8_WAIT_L(0); PG8_BAR; PG8_MMA(1, 0, At, B0); PG8_MMA(1, 1, At, B1); PG8_BAR; PG8_SCHED;
            PG8_LDB(B0, 1, 0); PG8_LDB(B1, 1, 1); PG8_SCHED; PG8_LDA(At, 1, 0); PG8_STAGE(PG8_SA(0, 1), a2 + hstep, voffA);
            PG8_WAIT_V(8); PG8_WAIT_L(0); PG8_BAR; PG8_MMA(0, 0, At, B0); PG8_MMA(0, 1, At, B1); PG8_BAR; PG8_SCHED;
            PG8_LDA(At, 1, 1); PG8_STAGE(PG8_SB(1, 0), b3, voffB); PG8_STAGE(PG8_SB(1, 1), b3 + hstep, voffB); PG8_STAGE(PG8_SA(1, 0), a3, voffA);
            PG8_WAIT_V(8); PG8_WAIT_L(0); PG8_BAR; PG8_MMA(1, 0, At, B0); PG8_MMA(1, 1, At, B1); PG8_BAR; PG8_SCHED;
            } else {
            PG8_LDB(B0, 0, 0); PG8_SCHED; PG8_LDA(At, 0, 0); PG8_STAGE(PG8_SA(1, 1), a1 + hstep, voffA);
            PG8_WAIT_L(8); PG8_BAR; PG8_WAIT_L(0); PG8_MMA(0, 0, At, B0); PG8_BAR; PG8_SCHED;
            PG8_LDB(B1, 0, 1); PG8_STAGE(PG8_SB(0, 0), b2, voffB);
            PG8_BAR; PG8_WAIT_L(0); PG8_MMA(0, 1, At, B1); PG8_BAR;
            PG8_LDA(At, 0, 1); PG8_STAGE(PG8_SA(0, 0), a2, voffA);
            PG8_BAR; PG8_WAIT_L(0); PG8_MMA(1, 0, At, B0); PG8_BAR; PG8_SCHED;
            PG8_STAGE(PG8_SB(0, 1), b2 + hstep, voffB);
            PG8_WAIT_V(6); PG8_BAR; PG8_MMA(1, 1, At, B1); PG8_BAR;
            PG8_LDB(B0, 1, 0); PG8_SCHED; PG8_LDA(At, 1, 0); PG8_STAGE(PG8_SA(0, 1), a2 + hstep, voffA);
            PG8_WAIT_L(8); PG8_BAR; PG8_WAIT_L(0); PG8_MMA(0, 0, At, B0); PG8_BAR; PG8_SCHED;
            PG8_LDB(B1, 1, 1); PG8_STAGE(PG8_SB(1, 0), b3, voffB);
            PG8_BAR; PG8_WAIT_L(0); PG8_MMA(0, 1, At, B1); PG8_BAR;
            PG8_LDA(At, 1, 1); PG8_STAGE(PG8_SA(1, 0), a3, voffA);
            PG8_BAR; PG8_WAIT_L(0); PG8_MMA(1, 0, At, B0); PG8_BAR; PG8_SCHED;
            PG8_STAGE(PG8_SB(1, 1), b3 + hstep, voffB);
            PG8_WAIT_V(6); PG8_BAR; PG8_MMA(1, 1, At, B1); PG8_BAR;
            }
        }
        if constexpr (ALIGN_EPI) { if (wr == 0) PG8_BAR; }
        if constexpr (!Epi::AFTER_DRAIN) { E(acc, cur, wr, wc, fr, fq); S.done(cur); }
        if (!has_next) break;
#pragma unroll
        for (int a = 0; a < 2; ++a)
#pragma unroll
            for (int b = 0; b < 2; ++b)
#pragma unroll
                for (int m = 0; m < 4; ++m)
#pragma unroll
                    for (int n = 0; n < 2; ++n) acc[a][b][m][n] = (f32x4){0.f, 0.f, 0.f, 0.f};
        cur = nxt; cA = nA; cB = nB; ++ui;
        if constexpr (ALIGN_EPI) { if (wr == 1) PG8_BAR; }
    }
    PG8_WAIT_V(0);
    if constexpr (!ALIGN_EPI) { if (wr == 0) PG8_BAR; }
    PG8_BAR;
#undef PG8_SA
#undef PG8_SB
#undef PG8_STAGE
#undef PG8_LDA
#undef PG8_LDB
#undef PG8_MMA
#undef PG8_WAIT_V
#undef PG8_WAIT_L
#undef PG8_BAR
#undef PG8_SCHED
}
struct EpiZ {
    static constexpr bool PERM = true, AFTER_DRAIN = false;
    bf16_t* Z; const float* cosT; const float* sinT;
    __device__ __forceinline__ void operator()(const f32x4 (&acc)[2][2][4][2], const Unit& u, int wr, int wc, int fr, int fq) const {
#pragma unroll
        for (int bj = 0; bj < 2; ++bj) {
            const int cb = u.pn * BM + bj * HALF + wc * 32;
            const int g64 = cb >> 6; const int c0 = cb + 8 * fq;
            const bool roped = (g64 < 64) && ((ROPE_MASK >> g64) & 1ull);
            const bool sig = (cb >= ZC_GM) || (c0 >= ZC_GN && c0 < ZC_WI);
            const float sc = ((g64 < 64) && ((SCALE_MASK >> g64) & 1ull)) ? 0.125f : 1.0f;
#pragma unroll
            for (int ai = 0; ai < 2; ++ai)
#pragma unroll
                for (int m = 0; m < 4; ++m) {
                    const int row = u.pm * BM + ai * HALF + wr * 64 + m * 16 + fr;
                    f32x4 v0 = acc[ai][bj][m][0], v1 = acc[ai][bj][m][1];
                    if (roped) {
                        const int pos = row & (SEQ - 1), i0 = (c0 & 63) >> 1;
                        const f32x4 cs = *(const f32x4*)(cosT + pos * 32 + i0), sn = *(const f32x4*)(sinT + pos * 32 + i0);
                        const f32x4 a = v0, b = v1;
                        v0[0] = (a[0] * cs[0] - a[1] * sn[0]) * sc; v0[1] = (a[1] * cs[0] + a[0] * sn[0]) * sc;
                        v0[2] = (a[2] * cs[1] - a[3] * sn[1]) * sc; v0[3] = (a[3] * cs[1] + a[2] * sn[1]) * sc;
                        v1[0] = (b[0] * cs[2] - b[1] * sn[2]) * sc; v1[1] = (b[1] * cs[2] + b[0] * sn[2]) * sc;
                        v1[2] = (b[2] * cs[3] - b[3] * sn[3]) * sc; v1[3] = (b[3] * cs[3] + b[2] * sn[3]) * sc;
                    } else if (sig) {
#pragma unroll
                        for (int e = 0; e < 4; ++e) { v0[e] = sigmoidf_(v0[e]); v1[e] = sigmoidf_(v1[e]); }
                    }
                    u32x4 w; w.x = cvt_pk_bf16(v0[0], v0[1]); w.y = cvt_pk_bf16(v0[2], v0[3]); w.z = cvt_pk_bf16(v1[0], v1[1]); w.w = cvt_pk_bf16(v1[2], v1[3]);
                    *(u32x4*)(Z + (size_t)row * NZ + c0) = w;
                }
        }
    }
};
struct EpiMerge {
    static constexpr bool PERM = true, AFTER_DRAIN = false;
    bf16_t* O; const bf16_t* Zg; int mode;
    __device__ __forceinline__ void operator()(const f32x4 (&acc)[2][2][4][2], const Unit& u, int wr, int wc, int fr, int fq) const {
#pragma unroll
        for (int ai = 0; ai < 2; ++ai)
#pragma unroll
            for (int m = 0; m < 4; ++m) { const int row = u.pm * BM + ai * HALF + wr * 64 + m * 16 + fr;
#pragma unroll
                for (int bj = 0; bj < 2; ++bj) { const int c0 = u.pn * BM + bj * HALF + wc * 32 + 8 * fq;
                    const u32x4 gz = *(const u32x4*)(Zg + (size_t)row * NZ + c0);
                    f32x4 v0 = acc[ai][bj][m][0], v1 = acc[ai][bj][m][1];
                    v0[0] *= bflo(gz.x); v0[1] *= bfhi(gz.x); v0[2] *= bflo(gz.y); v0[3] *= bfhi(gz.y); v1[0] *= bflo(gz.z); v1[1] *= bfhi(gz.z); v1[2] *= bflo(gz.w); v1[3] *= bfhi(gz.w);
                    bf16_t* op = O + (size_t)row * D + c0;
                    if (mode) { const u32x4 o = *(const u32x4*)op;
                        v0[0] += bflo(o.x); v0[1] += bfhi(o.x); v0[2] += bflo(o.y); v0[3] += bfhi(o.y); v1[0] += bflo(o.z); v1[1] += bfhi(o.z); v1[2] += bflo(o.w); v1[3] += bfhi(o.w); }
                    u32x4 w; w.x = cvt_pk_bf16(v0[0], v0[1]); w.y = cvt_pk_bf16(v0[2], v0[3]); w.z = cvt_pk_bf16(v1[0], v1[1]); w.w = cvt_pk_bf16(v1[2], v1[3]);
                    *(u32x4*)op = w; } }
    }
};
struct EpiOut {
    static constexpr bool PERM = true, AFTER_DRAIN = false;
    const float* x; float* o; const float* mod;
    __device__ __forceinline__ void operator()(const f32x4 (&acc)[2][2][4][2], const Unit& u, int wr, int wc, int fr, int fq) const {
#pragma unroll
        for (int ai = 0; ai < 2; ++ai)
#pragma unroll
            for (int m = 0; m < 4; ++m) { const int row = u.pm * BM + ai * HALF + wr * 64 + m * 16 + fr; const float* g1 = mod + (row >> 11) * 6144 + 2048;
#pragma unroll
                for (int bj = 0; bj < 2; ++bj) { const int c0 = u.pn * BM + bj * HALF + wc * 32 + 8 * fq;
#pragma unroll
                    for (int n = 0; n < 2; ++n) { const f32x4 gg = *(const f32x4*)(g1 + c0 + 4 * n), xx = *(const f32x4*)(x + (size_t)row * D + c0 + 4 * n);
                        *(f32x4*)(o + (size_t)row * D + c0 + 4 * n) = xx + gg * acc[ai][bj][m][n]; } } }
    }
};
struct EpiF32 {
    static constexpr bool PERM = true, AFTER_DRAIN = false;
    float* O; int ldc;
    __device__ __forceinline__ void operator()(const f32x4 (&acc)[2][2][4][2], const Unit& u, int wr, int wc, int fr, int fq) const {
#pragma unroll
        for (int ai = 0; ai < 2; ++ai)
#pragma unroll
            for (int m = 0; m < 4; ++m) { const int row = u.pm * BM + ai * HALF + wr * 64 + m * 16 + fr;
#pragma unroll
                for (int bj = 0; bj < 2; ++bj) { const int c0 = u.pn * BM + bj * HALF + wc * 32 + 8 * fq;
                    *(f32x4*)(O + (size_t)row * ldc + c0) = acc[ai][bj][m][0]; *(f32x4*)(O + (size_t)row * ldc + c0 + 4) = acc[ai][bj][m][1]; } }
    }
};
}

template <bool ZMAP>
__device__ __forceinline__ void transpose_item(const float* W, int K, int Nsrc, bf16_t* WT, LAS float* scr, int item, int nblk, int lane) {
    const int kb = item / nblk, nb = item % nblk, k0 = 64 * kb, n0 = 32 * nb;
    int sc = n0 + (lane & 31); if (ZMAP) sc = z_logical_col(sc);
#pragma unroll 8
    for (int i = 0; i < 32; ++i) { const int kk = 2 * i + (lane >> 5); scr[kk * 33 + (lane & 31)] = (sc >= 0) ? W[(size_t)(k0 + kk) * Nsrc + sc] : 0.f; }
    asm volatile("s_waitcnt lgkmcnt(0)" ::: "memory");
    const int c = lane & 7;
#pragma unroll
    for (int j = 0; j < 4; ++j) { const int n = (lane >> 3) + 8 * j; const LAS float* s = scr + (8 * c) * 33 + n;
        uint4 o; o.x = pk2(s[0 * 33], s[1 * 33]); o.y = pk2(s[2 * 33], s[3 * 33]); o.z = pk2(s[4 * 33], s[5 * 33]); o.w = pk2(s[6 * 33], s[7 * 33]);
        *(uint4*)(WT + (size_t)(n0 + n) * K + k0 + 8 * c) = o; }
    asm volatile("s_waitcnt lgkmcnt(0)" ::: "memory");
}
__device__ __forceinline__ void st_convert(const Params& p, unsigned char* lds) {
    int tid_ = threadIdx.x; asm volatile("" : "+v"(tid_)); const int tid = tid_, lane = tid & 63, w = __builtin_amdgcn_readfirstlane(tid >> 6);
    LAS float* scr = (LAS float*)((LAS unsigned char*)lds + 49152 + w * 8704);
    const int gw = blockIdx.x * 8 + w, NGW = gridDim.x * 8;
    constexpr int I_IN = 16 * 144, I_BR = 8 * 32, I_OUT = 16 * 32;
    for (int it = gw; it < I_IN + 2 * I_BR + I_OUT; it += NGW) {
        int r = it;
        if (r < I_IN) { transpose_item<true>(p.w_in, D, DIN, (bf16_t*)(p.ws + WS_WINT), scr, r, 144, lane); continue; } r -= I_IN;
        if (r < I_BR) { transpose_item<false>(p.w_nsa, 512, D, (bf16_t*)(p.ws + WS_WNSAT), scr, r, 32, lane); continue; } r -= I_BR;
        if (r < I_BR) { transpose_item<false>(p.w_dsa, 512, D, (bf16_t*)(p.ws + WS_WDSAT), scr, r, 32, lane); continue; } r -= I_BR;
        transpose_item<false>(p.w_out, D, D, (bf16_t*)(p.ws + WS_WOUTT), scr, r, 32, lane);
    }
    { bf16_t* w1t = (bf16_t*)(p.ws + WS_W1T); float* bpos = (float*)(p.ws + WS_BPOS);
      for (int it = blockIdx.x * NTHR + tid; it < 2 * 64 * 2048; it += gridDim.x * NTHR) {
          const int e = it & 63, kidx = (it >> 6) & 2047, kv = it >> 17; const int l = kidx >> 6, dp = kidx & 63; const int d = kv ? dp : ((dp >> 1) + 32 * (dp & 1));
          w1t[((size_t)kv * 64 + e) * 2048 + kidx] = f2bf((kv ? p.w1v : p.w1k)[(l * 64 + d) * 64 + e]); }
      for (int o = gw; o < 128; o += NGW) { const int kv = o >> 6, e = o & 63; const float* w1 = kv ? p.w1v : p.w1k; float s = 0.f;
          for (int i = lane; i < 2048; i += 64) s += p.cmp_pos[i] * w1[i * 64 + e];
          s = wave_sum(s); if (lane == 0) bpos[o] = s; } }
    bf16_t* wf = (bf16_t*)(p.ws + WS_WFOLDT);
    for (int it = blockIdx.x * NTHR + tid; it < 2048 * 1024 / 2; it += gridDim.x * NTHR) {
        const int k = (it & 511) * 2, col = it >> 9, hc = col >> 7;
        const float* sk = p.subkeys + (size_t)col * 64; const float* q0 = p.wq + (size_t)k * D + hc * 64; const float* q1 = q0 + D;
        float a0 = 0.f, a1 = 0.f;
#pragma unroll 8
        for (int d = 0; d < 64; d += 4) { const float4 s4 = *(const float4*)(sk + d), x0 = *(const float4*)(q0 + d), x1 = *(const float4*)(q1 + d);
            a0 += s4.x * x0.x + s4.y * x0.y + s4.z * x0.z + s4.w * x0.w; a1 += s4.x * x1.x + s4.y * x1.y + s4.z * x1.z + s4.w * x1.w; }
        *(u32*)(wf + (size_t)col * D + k) = pk2(a0, a1);
    }
}
__device__ __forceinline__ void st_z_gemm(const Params& p, unsigned char* lds) {
    pg8::Gemm g{(const bf16_t*)(p.ws + WS_HB), (const bf16_t*)(p.ws + WS_WINT), T, NZ, D}; pg8::StaticOrder S; S.init(T, NZ, gridDim.x, blockIdx.x);
    pg8::EpiZ E{(bf16_t*)(p.ws + WS_Z), (const float*)(p.ws + WS_COS), (const float*)(p.ws + WS_SIN)};
    pg8::gemm_phase<pg8::EpiZ, pg8::StaticOrder, true, true>((LAS unsigned char*)lds, g, S, E);
}
__device__ __forceinline__ void st_merge_gemm(const Params& p, unsigned char* lds) {
    pg8::StaticOrder S; S.init(T, D, gridDim.x, blockIdx.x);
    { pg8::Gemm g{(const bf16_t*)(p.ws + WS_ONSA), (const bf16_t*)(p.ws + WS_WNSAT), T, D, 512};
      pg8::EpiMerge E{(bf16_t*)(p.ws + WS_MERGED), (const bf16_t*)(p.ws + WS_Z) + ZC_GM, 0};
      pg8::gemm_phase<pg8::EpiMerge, pg8::StaticOrder, true, true>((LAS unsigned char*)lds, g, S, E); }
    asm volatile("s_waitcnt vmcnt(0)" ::: "memory"); __syncthreads();
    { pg8::Gemm g{(const bf16_t*)(p.ws + WS_ODSA), (const bf16_t*)(p.ws + WS_WDSAT), T, D, 512};
      pg8::EpiMerge E{(bf16_t*)(p.ws + WS_MERGED), (const bf16_t*)(p.ws + WS_Z) + ZC_GM + 1024, 1};
      pg8::gemm_phase<pg8::EpiMerge, pg8::StaticOrder, true, true>((LAS unsigned char*)lds, g, S, E); }
}
__device__ __forceinline__ void st_out_gemm(const Params& p, unsigned char* lds) {
    pg8::Gemm g{(const bf16_t*)(p.ws + WS_MERGED), (const bf16_t*)(p.ws + WS_WOUTT), T, D, D}; pg8::StaticOrder S; S.init(T, D, gridDim.x, blockIdx.x);
    pg8::EpiOut E{p.x, p.out, (const float*)(p.ws + WS_MOD)};
    pg8::gemm_phase<pg8::EpiOut, pg8::StaticOrder, true, true>((LAS unsigned char*)lds, g, S, E);
}
__device__ __forceinline__ void st_ssub_gemm(const Params& p, unsigned char* lds) {
    pg8::Gemm g{(const bf16_t*)(p.ws + WS_H2), (const bf16_t*)(p.ws + WS_WFOLDT), T, 2048, D}; pg8::StaticOrder S; S.init(T, 2048, gridDim.x, blockIdx.x);
    pg8::EpiF32 E{(float*)(p.ws + WS_SSUB), 2048};
    pg8::gemm_phase<pg8::EpiF32, pg8::StaticOrder, true, true>((LAS unsigned char*)lds, g, S, E);
}

typedef float f32x4_t __attribute__((ext_vector_type(4)));
__device__ __forceinline__ void st_prep(const Params& p, unsigned char* lds) {
    int tid = threadIdx.x; asm volatile("" : "+v"(tid));
    const int lane = tid & 63, w = __builtin_amdgcn_readfirstlane(tid >> 6);
    const bf16_t* Z = (const bf16_t*)(p.ws + WS_Z);
    const float* cosT = (const float*)(p.ws + WS_COS); const float* sinT = (const float*)(p.ws + WS_SIN);
    unsigned char* dob = (unsigned char*)p.out;
    bf16_t* kd = (bf16_t*)(dob + DO_KD); bf16_t* vdT = (bf16_t*)(dob + DO_VDT); bf16_t* vsT = (bf16_t*)(dob + DO_VST); bf16_t* vwT = (bf16_t*)(dob + DO_VWT);
    bf16_t* kcmp = (bf16_t*)(dob + DO_KCMP); bf16_t* vcmpT = (bf16_t*)(dob + DO_VCMPT);
    {   float* red = (float*)lds;
        float* hid = red + 8 * 16 * 64;
        const bf16_t* w1t = (const bf16_t*)(p.ws + WS_W1T); const float* bpos = (const float*)(p.ws + WS_BPOS);
        for (int u = blockIdx.x; u < 256; u += gridDim.x) {
            const int kv = u >> 7, b = (u >> 4) & 7, g = (u >> 3) & 1, n0 = (u & 7) * 16;
            const int nl = lane & 15, kq = lane >> 4; int n = n0 + nl; if (n > 126) n = 126;
            pg8::f32x4 acc[4];
#pragma unroll
            for (int ec = 0; ec < 4; ++ec) acc[ec] = (pg8::f32x4){0.f, 0.f, 0.f, 0.f};
            const bf16_t* ab = Z + (size_t)(b * SEQ + 16 * n) * NZ + (kv ? ZC_VC : ZC_KC) + g * 64 + 8 * kq;
            const bf16_t* bb = w1t + ((size_t)kv * 64 + nl) * 2048 + 8 * kq;
#pragma unroll
            for (int i = 0; i < 8; ++i) { const int kk = 8 * w + i;
                const pg8::bf16x8 a = *(const pg8::bf16x8*)(ab + (size_t)(kk >> 1) * NZ + (kk & 1) * 32);
#pragma unroll
                for (int ec = 0; ec < 4; ++ec) { const pg8::bf16x8 bv = *(const pg8::bf16x8*)(bb + (size_t)ec * 16 * 2048 + 32 * kk);
                    acc[ec] = __builtin_amdgcn_mfma_f32_16x16x32_bf16(a, bv, acc[ec], 0, 0, 0); } }
            __syncthreads();
#pragma unroll
            for (int ec = 0; ec < 4; ++ec)
#pragma unroll
                for (int r = 0; r < 4; ++r) red[(w * 16 + 4 * kq + r) * 64 + 16 * ec + nl] = acc[ec][r];
            __syncthreads();
#pragma unroll
            for (int q = 0; q < 2; ++q) { const int o = tid + 512 * q; float s = bpos[kv * 64 + (o & 63)];
#pragma unroll
                for (int ww = 0; ww < 8; ++ww) s += red[ww * 1024 + o];
                hid[o] = gelu_tanh(s); }
            __syncthreads();
            { const int nn = tid >> 5, f0 = (tid & 31) * 2; const float* w2 = kv ? p.w2v : p.w2k; float a0 = 0.f, a1 = 0.f;
              for (int e = 0; e < 64; ++e) { const float h = hid[nn * 64 + e]; const float2 ww = *(const float2*)(w2 + e * 64 + f0); a0 += h * ww.x; a1 += h * ww.y; }
              const int nglob = n0 + nn; if (nglob > 126) { a0 = 0.f; a1 = 0.f; }
              if (kv == 0) { bf16_t* o = kcmp + (((size_t)b * 2 + g) * 128 + nglob) * 64; o[2 * (f0 & 31) + (f0 >> 5)] = f2bf(a0); o[2 * ((f0 + 1) & 31) + ((f0 + 1) >> 5)] = f2bf(a1); }
              else { bf16_t* o = vcmpT + (((size_t)b * 2 + g) * 64 + f0) * 128 + nglob; o[0] = f2bf(a0); o[128] = f2bf(a1); } }
        }
        __syncthreads();
    }
    {   bf16_t* tl = (bf16_t*)lds;
        for (int it = blockIdx.x; it < 512; it += gridDim.x) {
            const int which = it & 1, tt = (it >> 1) & 31, b = it >> 6; const int t0 = b * SEQ + tt * 64;
            __syncthreads();
#pragma unroll
            for (int q = 0; q < 2; ++q) { const int idx = tid + 512 * q, tok = idx >> 4, ch = idx & 15;
                const uint4 v = *(const uint4*)(Z + (size_t)(t0 + tok) * NZ + (which ? ZC_VW : ZC_VS) + ch * 8); bf16_t* d = tl + tok * 130 + ch * 8;
                d[0] = (bf16_t)v.x; d[1] = (bf16_t)(v.x >> 16); d[2] = (bf16_t)v.y; d[3] = (bf16_t)(v.y >> 16); d[4] = (bf16_t)v.z; d[5] = (bf16_t)(v.z >> 16); d[6] = (bf16_t)v.w; d[7] = (bf16_t)(v.w >> 16); }
            __syncthreads();
#pragma unroll
            for (int q = 0; q < 2; ++q) { const int idx = tid + 512 * q, gd = idx >> 3, c8 = idx & 7; const bf16_t* s = tl + (c8 * 8) * 130 + gd;
                uint4 o; o.x = (u32)s[0] | ((u32)s[130] << 16); o.y = (u32)s[260] | ((u32)s[390] << 16); o.z = (u32)s[520] | ((u32)s[650] << 16); o.w = (u32)s[780] | ((u32)s[910] << 16);
                *(uint4*)((which ? vwT : vsT) + ((size_t)b * 128 + gd) * SEQ + tt * 64 + c8 * 8) = o; }
        }
    }
    for (int it = blockIdx.x * NTHR + tid; it < T * 32; it += gridDim.x * NTHR) {
        const int t = it >> 5, i = it & 31; const bf16_t* cr = Z + (size_t)t * NZ + ZC_CKV;
        float ss = 0.f;
#pragma unroll 4
        for (int r = 0; r < 128; r += 8) { const uint4 v = *(const uint4*)(cr + r);
            ss += bflo(v.x) * bflo(v.x) + bfhi(v.x) * bfhi(v.x) + bflo(v.y) * bflo(v.y) + bfhi(v.y) * bfhi(v.y) + bflo(v.z) * bflo(v.z) + bfhi(v.z) * bfhi(v.z) + bflo(v.w) * bflo(v.w) + bfhi(v.w) * bfhi(v.w); }
        const float rn = rsqrtf(ss * (1.0f / 128.0f) + EPS);
        float k1 = 0.f, k2 = 0.f, v1 = 0.f, v2 = 0.f;
#pragma unroll 4
        for (int r = 0; r < 128; ++r) { const float cn = bf2f(cr[r]) * rn * p.kvg[r];
            k1 += cn * p.w_uk[r * 64 + i]; k2 += cn * p.w_uk[r * 64 + i + 32]; v1 += cn * p.w_uv[r * 64 + i]; v2 += cn * p.w_uv[r * 64 + i + 32]; }
        const int pos = t & (SEQ - 1), b = t >> 11; const float c = cosT[pos * 32 + i], s = sinT[pos * 32 + i];
        *(u32*)(kd + (size_t)t * 64 + 2 * i) = pk2(k1 * c - k2 * s, k2 * c + k1 * s);
        vdT[((size_t)b * 64 + i) * SEQ + pos] = f2bf(v1); vdT[((size_t)b * 64 + i + 32) * SEQ + pos] = f2bf(v2);
    }
}

#define XB_TMO      128
#define XB_XCNT(j)  (256  + 64 * (j))
#define XB_XSUB(j)  (1280 + 64 * (j))
#define XB_XGEN(j)  (2304 + 64 * (j))
#define XB_TOP      3328
#define XB_TOPGEN   3392
#define XCD_BAR_WORDS 3456
#define XB_SPIN_CAP (1u << 22)
__device__ __forceinline__ unsigned xb_ld(unsigned* p)              { return __hip_atomic_load(p, __ATOMIC_RELAXED, __HIP_MEMORY_SCOPE_AGENT); }
__device__ __forceinline__ unsigned xb_add(unsigned* p, unsigned v) { return __hip_atomic_fetch_add(p, v, __ATOMIC_RELAXED, __HIP_MEMORY_SCOPE_AGENT); }
__device__ __forceinline__ unsigned xb_xcc_id() { return (unsigned)__builtin_amdgcn_s_getreg((3 << 11) | 20) & 0xFu; }
#define XB_SPIN(cond, bar) do { unsigned _sp = 0; while (cond) { __builtin_amdgcn_s_sleep(1); \
    if ((++_sp & 255u) == 0u) { if (xb_ld(&(bar)[XB_TMO])) break; if (_sp > XB_SPIN_CAP) { atomicAdd(&(bar)[XB_TMO], 1u); break; } } } } while (0)
struct XcdBarrier { unsigned* bar; unsigned x; volatile LAS unsigned* st; };
__device__ __forceinline__ XcdBarrier xcd_barrier_post(unsigned* bar, volatile LAS unsigned* st) {
    XcdBarrier b; b.bar = bar; b.x = xb_xcc_id(); b.st = st;
    if (threadIdx.x == 0) (void)xb_add(&bar[XB_XCNT(b.x)], 1u);
    return b;
}
__device__ __forceinline__ void xcd_barrier_complete(unsigned* bar, unsigned x, unsigned& nloc, unsigned& nx) {
    const unsigned G = gridDim.x * gridDim.y * gridDim.z;
    unsigned sum, cnt, mine, sp = 0u;
    for (;;) {
        sum = 0u; cnt = 0u; mine = 0u;
#pragma unroll
        for (unsigned j = 0; j < 16; ++j) { const unsigned c = xb_ld(&bar[XB_XCNT(j)]); sum += c; cnt += (c > 0u) ? 1u : 0u; mine = (j == x) ? c : mine; }
        if (sum == G) break;
        __builtin_amdgcn_s_sleep(1);
        if ((++sp & 255u) == 0u) { if (xb_ld(&bar[XB_TMO])) break; if (sp > XB_SPIN_CAP) { atomicAdd(&bar[XB_TMO], 1u); break; } }
    }
    nloc = mine > 0u ? mine : 1u; nx = cnt > 0u ? cnt : 1u;
}
__device__ __forceinline__ void xcd_barrier(const XcdBarrier& b) {
    asm volatile("s_waitcnt vmcnt(0)" ::: "memory");
    __syncthreads();
    if (threadIdx.x == 0) {
        unsigned* bar = b.bar;
        __builtin_amdgcn_s_waitcnt(0);
        unsigned nloc = b.st[0], nx = b.st[1];
        if (nloc == 0u) { xcd_barrier_complete(bar, b.x, nloc, nx); b.st[0] = nloc; b.st[1] = nx; }
        const unsigned old = xb_add(&bar[XB_XSUB(b.x)], 1u);
        const unsigned gen = old / nloc;
        if (old + 1u == (gen + 1u) * nloc) {
            __builtin_amdgcn_fence(__ATOMIC_RELEASE, "agent");
            asm volatile("s_waitcnt vmcnt(0)" ::: "memory");
            const unsigned og = xb_add(&bar[XB_TOP], 1u);
            const unsigned tg = og / nx;
            if (og + 1u == (tg + 1u) * nx) xb_add(&bar[XB_TOPGEN], 1u);
            else XB_SPIN(xb_ld(&bar[XB_TOPGEN]) == tg, bar);
            __builtin_amdgcn_fence(__ATOMIC_ACQUIRE, "agent");
            xb_add(&bar[XB_XGEN(b.x)], 1u);
            asm volatile("s_waitcnt vmcnt(0)" ::: "memory");
        } else {
            XB_SPIN(xb_ld(&bar[XB_XGEN(b.x)]) == gen, bar);
            __builtin_amdgcn_fence(__ATOMIC_ACQUIRE, "agent");
            asm volatile("s_waitcnt vmcnt(0)" ::: "memory");
        }
    }
    __syncthreads();
}

constexpr int LDS_BYTES = 131072 + 1024;
constexpr int LDS_CTL = 131072;
__global__ void __launch_bounds__(NTHR, 2) k_mega(Params p) {
    extern __shared__ __attribute__((aligned(16))) unsigned char smem[];
    if (threadIdx.x < 4) ((volatile LAS unsigned*)(smem + LDS_CTL))[threadIdx.x] = 0u;
    __syncthreads();
    XcdBarrier bar = xcd_barrier_post((unsigned*)(p.ws + WS_BAR), (volatile LAS unsigned*)(smem + LDS_CTL));
#define GBAR() xcd_barrier(bar)
#ifndef PROBE_STAGE
#define PROBE_STAGE 0
#endif
#define REP(n, body) do { body; if (PROBE_STAGE == (n)) { __syncthreads(); body; } } while (0)
    REP(1, st_adaln(p, smem); st_convert(p, smem));      GBAR();
    REP(2, st_norm_rows(p, 0));       GBAR();
    REP(3, st_z_gemm(p, smem));       GBAR();
    REP(4, st_prep(p, smem));         GBAR();
    REP(5, st_nsa2(p, smem));         __syncthreads();
    REP(6, st_dsa2(p, smem));         GBAR();
    REP(7, st_merge_gemm(p, smem));   GBAR();
    REP(8, st_out_gemm(p, smem));     GBAR();
    st_norm_rows(p, 1);       GBAR();
    REP(9, st_ssub_gemm(p, smem));    GBAR();
    REP(10, st_route(p));
    REP(11, st_cvt_uv(p));             GBAR();
    st_expert2(p, smem);
}

extern "C" void kernel_launch(void* const* d_in, const int* in_sizes, int n_in, void* d_out, int out_size, void* d_ws, size_t ws_size, hipStream_t stream) {
    static int grid = 0;
    if (grid == 0) {
        int dev = 0, cus = 0, per_cu = 0;
        hipGetDevice(&dev); hipDeviceGetAttribute(&cus, hipDeviceAttributeMultiprocessorCount, dev);
        hipFuncSetAttribute((const void*)k_mega, hipFuncAttributeMaxDynamicSharedMemorySize, LDS_BYTES);
        hipOccupancyMaxActiveBlocksPerMultiprocessor(&per_cu, (const void*)k_mega, NTHR, LDS_BYTES);
        if (per_cu < 1) { fprintf(stderr, "kernel_launch: occupancy query says %d blocks/CU\n", per_cu); per_cu = 1; }
        (void)hipGetLastError();
        grid = cus;
    }
    Params p{};
    const float** f = (const float**)&p;
    for (int i = 0; i < 23; ++i) f[i] = (const float*)d_in[i];
    p.out = (float*)d_out; p.ws = (unsigned char*)d_ws;
    hipMemsetAsync((unsigned char*)d_ws + WS_BAR, 0, 16384, stream);
    hipLaunchKernelGGL(k_mega, dim3(grid), dim3(NTHR), LDS_BYTES, stream, p);
}
#ifdef TESTK
__global__ void __launch_bounds__(NTHR, 2) k_t_nsa(Params p) { st_nsa(p); }
__global__ void __launch_bounds__(NTHR, 2) k_t_dsa(Params p) { extern __shared__ __attribute__((aligned(16))) unsigned char smem[]; st_dsa(p, smem); }
#endif
#ifdef TESTK2
__global__ void __launch_bounds__(NTHR, 2) k_t_nsa2(Params p) { extern __shared__ __attribute__((aligned(16))) unsigned char smem[]; st_nsa2(p, smem); }
__global__ void __launch_bounds__(NTHR, 2) k_t_dsa2(Params p) { extern __shared__ __attribute__((aligned(16))) unsigned char smem[]; st_dsa2(p, smem); }
#endif
```

```cpp
#include <hip/hip_runtime.h>
#include <stdint.h>
#include <stdio.h>

#ifndef PROBE_STAGE
#define PROBE_STAGE 0
#endif
#define LAS __attribute__((address_space(3)))
typedef unsigned short bf16_t;
typedef unsigned int u32;

constexpr int T = 16384, SEQ = 2048, NB = 8, D = 1024, NZ = 4608, DIN = 4576;
constexpr int NTHR = 512;
constexpr float EPS = 1e-6f;
constexpr int ZC_QN = 0, ZC_KC = 512, ZC_VC = 640, ZC_KS = 768, ZC_VS = 896, ZC_KW = 1024, ZC_VW = 1152, ZC_QD = 1280, ZC_CKV = 1792,
              ZC_QI = 1920, ZC_KI = 2432, ZC_GN = 2496, ZC_WI = 2520, ZC_GM = 2560;
constexpr unsigned long long ROPE_MASK = 0xFFull | (3ull << 8) | (3ull << 12) | (3ull << 16) | (0xFFull << 20) | (0xFFull << 30) | (1ull << 38);
constexpr unsigned long long SCALE_MASK = 0xFFull | (0xFFull << 20) | (0xFFull << 30);

constexpr size_t WS_Z = 0;
constexpr size_t WS_SSUB = 0;
constexpr size_t WS_EIDX = 134217728;
constexpr size_t WS_GATE = 142606336;
constexpr size_t WS_MERGED = 150994944;
constexpr size_t WS_U16 = WS_MERGED;
constexpr size_t WS_HB = 184549376;
constexpr size_t WS_ONSA = WS_HB;
constexpr size_t WS_ODSA = WS_HB + 16777216;
constexpr size_t WS_V16 = WS_HB;
constexpr size_t WS_H2 = 218103808;
constexpr size_t WS_W = 251658240;
constexpr size_t WS_WINT = WS_H2;
constexpr size_t WS_WNSAT = WS_W;
constexpr size_t WS_WDSAT = WS_WNSAT + 1048576;
constexpr size_t WS_WOUTT = WS_WDSAT + 1048576;
constexpr size_t WS_WFOLDT = WS_WOUTT + 2097152;
constexpr size_t WS_SMALL = WS_WFOLDT + 4194304;
constexpr size_t WS_MOD = WS_SMALL;
constexpr size_t WS_COS = WS_MOD + 196608;
constexpr size_t WS_SIN = WS_COS + 262144;
constexpr size_t WS_BAR = WS_SIN + 262144;
constexpr size_t WS_W1T = WS_BAR + 16384;
constexpr size_t WS_BPOS = WS_W1T + 524288;
constexpr size_t WS_END_SMALL = WS_BPOS + 512;
static_assert(WS_END_SMALL <= 268435456, "ws overflow");
constexpr size_t DO_KD = 0;
constexpr size_t DO_VDT = 2097152;
constexpr size_t DO_VST = 4194304;
constexpr size_t DO_VWT = 8388608;
constexpr size_t DO_KCMP = 12582912;
constexpr size_t DO_VCMPT = 12845056;
constexpr size_t DO_HID = 13107200;
constexpr size_t DO_MASK = 14680064;
constexpr size_t DO_END = DO_MASK + 4194304;

struct Params {
    const float *x, *c, *ada_w, *ada_b, *norm1_g, *w_in, *cmp_pos, *w1k, *w2k, *w1v, *w2v, *kvg, *w_uk, *w_uv, *w_nsa, *w_dsa, *w_out, *norm2_g, *wq,
        *subkeys, *pu, *pv, *final_g;
    float* out;
    unsigned char* ws;
};

__device__ __forceinline__ bf16_t f2bf(float f) { u32 u = __float_as_uint(f); u += 0x7fffu + ((u >> 16) & 1u); return (bf16_t)(u >> 16); }
__device__ __forceinline__ float bf2f(bf16_t h) { return __uint_as_float((u32)h << 16); }
__device__ __forceinline__ float bflo(u32 w) { return __uint_as_float(w << 16); }
__device__ __forceinline__ float bfhi(u32 w) { return __uint_as_float(w & 0xffff0000u); }
__device__ __forceinline__ u32 pk2(float lo, float hi) { return (u32)f2bf(lo) | ((u32)f2bf(hi) << 16); }
__device__ __forceinline__ float wave_sum(float v) {
#pragma unroll
    for (int o = 1; o < 64; o <<= 1) v += __shfl_xor(v, o);
    return v;
}
__device__ __forceinline__ float wave_max(float v) {
#pragma unroll
    for (int o = 1; o < 64; o <<= 1) v = fmaxf(v, __shfl_xor(v, o));
    return v;
}
__device__ __forceinline__ float sigmoidf_(float v) { return 1.0f / (1.0f + __expf(-v)); }
__device__ __forceinline__ float gelu_tanh(float v) { const float u = 0.7978845608028654f * (v + 0.044715f * v * v * v); return 0.5f * v * (1.0f + tanhf(u)); }
__device__ __forceinline__ float gelu_erf(float v) { return 0.5f * v * (1.0f + erff(v * 0.7071067811865476f)); }
__device__ __forceinline__ int z_logical_col(int pc) {
    const int g64 = pc >> 6; const int o = pc & 63;
    const int po = (g64 < 64 && ((ROPE_MASK >> g64) & 1ull)) ? ((o >> 1) + 32 * (o & 1)) : o;
    const int pp = (pc & ~63) + po;
    if (pc < 1280) return pp;
    if (pc < 1792) return 1304 + (pp - 1280);
    if (pc < 1920) return 1816 + (pp - 1792);
    if (pc < 2432) return 1944 + (pp - 1920);
    if (pc < 2496) return 2456 + (pp - 2432);
    if (pc < 2520) return 1280 + (pc - 2496);
    if (pc < 2528) return 2520 + (pc - 2520);
    if (pc < 2560) return -1;
    return 2528 + (pc - 2560);
}
__device__ __forceinline__ void z_post(int t, int pc, float& v0, float& v1, const float* cosT, const float* sinT) {
    const int g64 = pc >> 6;
    if (g64 < 64 && ((ROPE_MASK >> g64) & 1ull)) {
        const int i = (pc & 63) >> 1, pos = t & (SEQ - 1);
        const float c = cosT[pos * 32 + i], s = sinT[pos * 32 + i];
        const float a = v0 * c - v1 * s, b = v1 * c + v0 * s;
        const float sc = ((SCALE_MASK >> g64) & 1ull) ? 0.125f : 1.0f;
        v0 = a * sc; v1 = b * sc;
    } else if (pc >= ZC_GM || (pc >= ZC_GN && pc < ZC_WI)) { v0 = sigmoidf_(v0); v1 = sigmoidf_(v1); }
}
__device__ __forceinline__ void sincos_tab(float ang, float& s, float& c) {
    const double a = (double)ang; const double k = rint(a * 0.63661977236758134308);
    const float r = (float)(a - k * 1.57079632679489661923); const float z = r * r;
    const float sp = ((-1.9515295891e-4f * z + 8.3321608736e-3f) * z - 1.6666654611e-1f) * z * r + r;
    const float cp = ((2.443315711809948e-5f * z - 1.388731625493765e-3f) * z + 4.166664568298827e-2f) * z * z - 0.5f * z + 1.0f;
    const int q = ((int)k) & 3;
    s = (q == 0) ? sp : (q == 1) ? cp : (q == 2) ? -sp : -cp;
    c = (q == 0) ? cp : (q == 1) ? -sp : (q == 2) ? -cp : sp;
}

__device__ __forceinline__ void st_adaln(const Params& p, unsigned char* lds) {
    int tid_ = threadIdx.x; asm volatile("" : "+v"(tid_)); const int tid = tid_, lane = tid & 63, w = tid >> 6;
    float* cosT = (float*)(p.ws + WS_COS); float* sinT = (float*)(p.ws + WS_SIN);
    for (int i = blockIdx.x * NTHR + tid; i < SEQ * 32; i += gridDim.x * NTHR) {
        const int pos = i >> 5, f = i & 31; const float inv = powf(10000.0f, -(float)f / 32.0f);
        float s, c; sincos_tab((float)pos * inv, s, c); cosT[i] = c; sinT[i] = s;
    }
    float* sc = (float*)lds;
    float* red = sc + 8192;
    for (int i = tid; i < 8192; i += NTHR) { const float v = p.c[i]; sc[i] = v / (1.0f + __expf(-v)); }
    __syncthreads();
    float* mod = (float*)(p.ws + WS_MOD);
    for (int unit = blockIdx.x; unit < 192; unit += gridDim.x) {
        float acc[8];
#pragma unroll
        for (int b = 0; b < 8; ++b) acc[b] = 0.f;
        const int col = unit * 32 + (lane & 31), ks = lane >> 5;
        for (int kk = 0; kk < 64; ++kk) {
            const int k = w * 128 + kk * 2 + ks; const float wv = p.ada_w[(size_t)k * 6144 + col];
#pragma unroll
            for (int b = 0; b < 8; ++b) acc[b] += sc[b * 1024 + k] * wv;
        }
#pragma unroll
        for (int b = 0; b < 8; ++b) red[((w * 2 + ks) * 8 + b) * 32 + (lane & 31)] = acc[b];
        __syncthreads();
        if (tid < 256) { const int b = tid >> 5, c = tid & 31; float s = 0.f;
            for (int j = 0; j < 16; ++j) s += red[(j * 8 + b) * 32 + c];
            mod[b * 6144 + unit * 32 + c] = s + p.ada_b[unit * 32 + c]; }
        __syncthreads();
    }
}
__device__ __forceinline__ void st_norm_rows(const Params& p, int which) {
    int tid_ = threadIdx.x; asm volatile("" : "+v"(tid_)); const int tid = tid_, lane = tid & 63, w = tid >> 6;
    const float* src = which ? p.out : p.x; const float* g = which ? p.norm2_g : p.norm1_g;
    bf16_t* dst = (bf16_t*)(p.ws + (which ? WS_H2 : WS_HB));
    const float* mod = (const float*)(p.ws + WS_MOD);
    for (int t = blockIdx.x * 8 + w; t < T; t += gridDim.x * 8) {
        const int b = t >> 11; const float* sh = mod + b * 6144 + (which ? 3072 : 0); const float* scl = sh + 1024;
        const float4* xr = (const float4*)(src + (size_t)t * D);
        float4 v[4]; float ss = 0.f;
#pragma unroll
        for (int j = 0; j < 4; ++j) { v[j] = xr[lane + 64 * j]; ss += v[j].x * v[j].x + v[j].y * v[j].y + v[j].z * v[j].z + v[j].w * v[j].w; }
        const float r = rsqrtf(wave_sum(ss) * (1.0f / D) + EPS);
#pragma unroll
        for (int j = 0; j < 4; ++j) { const int d0 = (lane + 64 * j) * 4;
            const float4 gg = *(const float4*)(g + d0), s4 = *(const float4*)(scl + d0), h4 = *(const float4*)(sh + d0);
            const float o0 = v[j].x * r * gg.x * (1.f + s4.x) + h4.x, o1 = v[j].y * r * gg.y * (1.f + s4.y) + h4.y;
            const float o2 = v[j].z * r * gg.z * (1.f + s4.z) + h4.z, o3 = v[j].w * r * gg.w * (1.f + s4.w) + h4.w;
            uint2 o; o.x = pk2(o0, o1); o.y = pk2(o2, o3); *(uint2*)(dst + (size_t)t * D + d0) = o; }
    }
}
__device__ __forceinline__ void naive_dot8(const bf16_t* A, int lda, const float* W, int ldw, int K, int t0, int col, float (&acc)[8]) {
#pragma unroll
    for (int i = 0; i < 8; ++i) acc[i] = 0.f;
    for (int k = 0; k < K; k += 2) {
        const float w0 = W[(size_t)k * ldw + col], w1 = W[(size_t)(k + 1) * ldw + col];
#pragma unroll
        for (int i = 0; i < 8; ++i) { const u32 a = *(const u32*)(A + (size_t)(t0 + i) * lda + k); acc[i] += bflo(a) * w0 + bfhi(a) * w1; }
    }
}
__device__ __forceinline__ void st_z_naive(const Params& p) {
    int tid_ = threadIdx.x; asm volatile("" : "+v"(tid_)); const int tid = tid_; const bf16_t* hb = (const bf16_t*)(p.ws + WS_HB); bf16_t* Z = (bf16_t*)(p.ws + WS_Z);
    const float* cosT = (const float*)(p.ws + WS_COS); const float* sinT = (const float*)(p.ws + WS_SIN);
    const int nitems = (T / 8) * 9;
    for (int it = blockIdx.x * 2 + (tid >> 8); it < nitems; it += gridDim.x * 2) {
        const int tt = it / 9, ch = it % 9; const int t0 = tt * 8; const int pc = (ch * 256 + (tid & 255)) * 2;
        const int l0 = z_logical_col(pc), l1 = z_logical_col(pc + 1);
        float a0[8], a1[8];
        if (l0 >= 0) { naive_dot8(hb, D, p.w_in, DIN, D, t0, l0, a0); naive_dot8(hb, D, p.w_in, DIN, D, t0, l1, a1); }
        else {
#pragma unroll
            for (int i = 0; i < 8; ++i) { a0[i] = 0.f; a1[i] = 0.f; } }
#pragma unroll
        for (int i = 0; i < 8; ++i) { float v0 = a0[i], v1 = a1[i]; z_post(t0 + i, pc, v0, v1, cosT, sinT); *(u32*)(Z + (size_t)(t0 + i) * NZ + pc) = pk2(v0, v1); }
    }
}
__device__ __forceinline__ void st_prep_a_naive(const Params& p) {
    int tid_ = threadIdx.x; asm volatile("" : "+v"(tid_)); const int tid = tid_; const bf16_t* Z = (const bf16_t*)(p.ws + WS_Z);
    const float* cosT = (const float*)(p.ws + WS_COS); const float* sinT = (const float*)(p.ws + WS_SIN);
    unsigned char* dob = (unsigned char*)p.out;
    bf16_t* kd = (bf16_t*)(dob + DO_KD); bf16_t* vdT = (bf16_t*)(dob + DO_VDT); bf16_t* vsT = (bf16_t*)(dob + DO_VST); bf16_t* vwT = (bf16_t*)(dob + DO_VWT);
    float* hid = (float*)(dob + DO_HID);
    for (int it = blockIdx.x * NTHR + tid; it < T * 32; it += gridDim.x * NTHR) {
        const int t = it >> 5, i = it & 31; const bf16_t* cr = Z + (size_t)t * NZ + ZC_CKV;
        float ss = 0.f; for (int r = 0; r < 128; ++r) { const float v = bf2f(cr[r]); ss += v * v; }
        const float rn = rsqrtf(ss * (1.0f / 128.0f) + EPS);
        float k1 = 0.f, k2 = 0.f, v1 = 0.f, v2 = 0.f;
        for (int r = 0; r < 128; ++r) { const float cn = bf2f(cr[r]) * rn * p.kvg[r];
            k1 += cn * p.w_uk[r * 64 + i]; k2 += cn * p.w_uk[r * 64 + i + 32]; v1 += cn * p.w_uv[r * 64 + i]; v2 += cn * p.w_uv[r * 64 + i + 32]; }
        const int pos = t & (SEQ - 1), b = t >> 11; const float c = cosT[pos * 32 + i], s = sinT[pos * 32 + i];
        *(u32*)(kd + (size_t)t * 64 + 2 * i) = pk2(k1 * c - k2 * s, k2 * c + k1 * s);
        vdT[((size_t)b * 64 + i) * SEQ + pos] = f2bf(v1); vdT[((size_t)b * 64 + i + 32) * SEQ + pos] = f2bf(v2);
    }
    for (int it = blockIdx.x * NTHR + tid; it < T * 128; it += gridDim.x * NTHR) {
        const int t = it >> 7, gd = it & 127, b = t >> 11, pos = t & (SEQ - 1);
        vsT[((size_t)b * 128 + gd) * SEQ + pos] = Z[(size_t)t * NZ + ZC_VS + gd];
        vwT[((size_t)b * 128 + gd) * SEQ + pos] = Z[(size_t)t * NZ + ZC_VW + gd];
    }
    for (int it = blockIdx.x * NTHR + tid; it < 2 * 8 * 2 * 128 * 64; it += gridDim.x * NTHR) {
        const int e = it & 63, n = (it >> 6) & 127, g = (it >> 13) & 1, b = (it >> 14) & 7, kv = it >> 17;
        float acc = 0.f;
        if (n < 127) {
            const float* w1 = kv ? p.w1v : p.w1k;
            for (int l = 0; l < 32; ++l) { const bf16_t* xr = Z + (size_t)(b * SEQ + 16 * n + l) * NZ + (kv ? ZC_VC : ZC_KC) + g * 64;
                for (int d = 0; d < 64; ++d) { const int pd = kv ? d : (2 * (d & 31) + (d >> 5));
                    acc += (bf2f(xr[pd]) + p.cmp_pos[l * 64 + d]) * w1[(l * 64 + d) * 64 + e]; } }
            acc = gelu_tanh(acc);
        }
        hid[it] = acc;
    }
}
__device__ __forceinline__ void st_prep_b_naive(const Params& p) {
    int tid_ = threadIdx.x; asm volatile("" : "+v"(tid_)); const int tid = tid_; unsigned char* dob = (unsigned char*)p.out;
    const float* hid = (const float*)(dob + DO_HID); bf16_t* kcmp = (bf16_t*)(dob + DO_KCMP); bf16_t* vcmpT = (bf16_t*)(dob + DO_VCMPT);
    for (int it = blockIdx.x * NTHR + tid; it < 2 * 8 * 2 * 128 * 64; it += gridDim.x * NTHR) {
        const int f = it & 63, n = (it >> 6) & 127, g = (it >> 13) & 1, b = (it >> 14) & 7, kv = it >> 17;
        const float* w2 = kv ? p.w2v : p.w2k; const float* h = hid + (size_t)(it & ~63);
        float acc = 0.f;
        if (n < 127) for (int e = 0; e < 64; ++e) acc += h[e] * w2[e * 64 + f];
        if (kv == 0) kcmp[(((size_t)b * 2 + g) * 128 + n) * 64 + (2 * (f & 31) + (f >> 5))] = f2bf(acc);
        else vcmpT[(((size_t)b * 2 + g) * 64 + f) * 128 + n] = f2bf(acc);
    }
}
__device__ __forceinline__ float dot64(const float* q, const bf16_t* kr) {
    float s = 0.f;
#pragma unroll
    for (int j = 0; j < 8; ++j) { const uint4 v = *(const uint4*)(kr + 8 * j); const float* qq = q + 8 * j;
        s += qq[0] * bflo(v.x) + qq[1] * bfhi(v.x) + qq[2] * bflo(v.y) + qq[3] * bfhi(v.y) + qq[4] * bflo(v.z) + qq[5] * bfhi(v.z) + qq[6] * bflo(v.w) + qq[7] * bfhi(v.w); }
    return s;
}
__device__ __forceinline__ void st_nsa_naive(const Params& p, unsigned char* lds) {
    int tid_ = threadIdx.x; asm volatile("" : "+v"(tid_)); const int tid = tid_, lane = tid & 63, h = tid >> 6, g = h >> 2;
    const bf16_t* Z = (const bf16_t*)(p.ws + WS_Z); unsigned char* dob = (unsigned char*)p.out;
    const bf16_t* kcmp = (const bf16_t*)(dob + DO_KCMP); const bf16_t* vcmpT = (const bf16_t*)(dob + DO_VCMPT);
    bf16_t* onsa = (bf16_t*)(p.ws + WS_ONSA);
    float* qs = (float*)lds;
    float* pc = qs + 512;
    float* vals = pc + 1024;
    u32* selm = (u32*)(vals + 64);
    for (int t = blockIdx.x; t < T; t += gridDim.x) {
        const int b = t >> 11, pos = t & (SEQ - 1); const bf16_t* zr = Z + (size_t)t * NZ;
        __syncthreads();
        qs[h * 64 + lane] = bf2f(zr[ZC_QN + h * 64 + lane]);
        __syncthreads();
        const float* q = qs + h * 64;
        float sc[2]; float m = -1e30f;
#pragma unroll
        for (int c2 = 0; c2 < 2; ++c2) { const int n = c2 * 64 + lane; const bool valid = (n < 127) && (16 * n + 31 <= pos);
            const float s = dot64(q, kcmp + (((size_t)b * 2 + g) * 128 + n) * 64); sc[c2] = valid ? s : -1e30f; m = fmaxf(m, sc[c2]); }
        m = wave_max(m); float l = 0.f;
#pragma unroll
        for (int c2 = 0; c2 < 2; ++c2) { const int n = c2 * 64 + lane; const bool valid = (n < 127) && (16 * n + 31 <= pos); sc[c2] = valid ? __expf(sc[c2] - m) : 0.f; l += sc[c2]; }
        l = wave_sum(l); const float il = 1.0f / fmaxf(l, 1e-30f);
        pc[h * 128 + lane] = sc[0] * il; pc[h * 128 + 64 + lane] = sc[1] * il;
        __syncthreads();
        float ocmp = 0.f; { const bf16_t* vr = vcmpT + (((size_t)b * 2 + g) * 64 + lane) * 128; const float* pp = pc + h * 128;
            for (int n = 0; n < 128; ++n) ocmp += pp[n] * bf2f(vr[n]); }
        if (tid < 64) { const int gg = tid >> 5, j = tid & 31; const float* p0 = pc + gg * 512;
            auto imp = [&](int n) -> float { return (n < 0 || n > 126) ? 0.f : (p0[n] + p0[128 + n] + p0[256 + n] + p0[384 + n]); };
            const float bl = imp(4 * j - 1) + 2.f * imp(4 * j) + 2.f * imp(4 * j + 1) + 2.f * imp(4 * j + 2) + imp(4 * j + 3);
            const int cur = pos >> 6; const bool forced = (j == 0) || (j == cur) || (j == cur - 1); const bool adm = (j * 64 <= pos);
            vals[tid] = forced ? __builtin_inff() : (adm ? bl : -__builtin_inff()); }
        __syncthreads();
        if (tid < 64) { const int gg = tid >> 5, j = tid & 31; const float v = vals[tid]; int rank = 0;
            for (int j2 = 0; j2 < 32; ++j2) { const float v2 = vals[gg * 32 + j2]; rank += (v2 > v || (v2 == v && j2 < j)) ? 1 : 0; }
            const unsigned long long bal = __ballot(rank < 16);
            if (tid == 0) { selm[0] = (u32)bal; selm[1] = (u32)(bal >> 32); } }
        __syncthreads();
        const u32 sel = selm[g];
        float ms = -1e30f, ls = 0.f, os = 0.f;
        for (int j = 0; j * 64 <= pos; ++j) { if (!((sel >> j) & 1u)) continue;
            const int kp = j * 64 + lane; const bool valid = kp <= pos;
            float s = dot64(q, Z + (size_t)(b * SEQ + kp) * NZ + ZC_KS + g * 64); s = valid ? s : -1e30f;
            const float mn = fmaxf(ms, wave_max(s)); const float al = __expf(ms - mn); const float pr = valid ? __expf(s - mn) : 0.f;
            ls = ls * al + wave_sum(pr); os *= al; ms = mn;
            for (int k = 0; k < 64; ++k) { const float pk = __shfl(pr, k); os += pk * bf2f(Z[(size_t)(b * SEQ + j * 64 + k) * NZ + ZC_VS + g * 64 + lane]); } }
        os = os / fmaxf(ls, 1e-30f);
        float mw = -1e30f, lw = 0.f, ow = 0.f;
        for (int c2 = 0; c2 < 8; ++c2) { const int kp = pos - 511 + c2 * 64 + lane; const bool valid = kp >= 0; if (pos - 511 + c2 * 64 + 63 < 0) continue;
            float s = valid ? dot64(q, Z + (size_t)(b * SEQ + kp) * NZ + ZC_KW + g * 64) : -1e30f;
            const float mn = fmaxf(mw, wave_max(s)); const float al = __expf(mw - mn); const float pr = valid ? __expf(s - mn) : 0.f;
            lw = lw * al + wave_sum(pr); ow *= al; mw = mn;
            for (int k = 0; k < 64; ++k) { const float pk = __shfl(pr, k); const int kk = pos - 511 + c2 * 64 + k;
                if (kk >= 0) ow += pk * bf2f(Z[(size_t)(b * SEQ + kk) * NZ + ZC_VW + g * 64 + lane]); } }
        ow = ow / fmaxf(lw, 1e-30f);
        const float gc = bf2f(zr[ZC_GN + h * 3 + 0]), gs = bf2f(zr[ZC_GN + h * 3 + 1]), gw = bf2f(zr[ZC_GN + h * 3 + 2]);
        onsa[(size_t)t * 512 + h * 64 + lane] = f2bf(gc * ocmp + gs * os + gw * ow);
    }
}
__device__ __forceinline__ void st_dsa_naive(const Params& p, unsigned char* lds) {
    int tid_ = threadIdx.x; asm volatile("" : "+v"(tid_)); const int tid = tid_, lane = tid & 63, h = tid >> 6;
    const bf16_t* Z = (const bf16_t*)(p.ws + WS_Z); unsigned char* dob = (unsigned char*)p.out;
    const bf16_t* kd = (const bf16_t*)(dob + DO_KD); const bf16_t* vdT = (const bf16_t*)(dob + DO_VDT); u32* maskg = (u32*)(dob + DO_MASK);
    bf16_t* odsa = (bf16_t*)(p.ws + WS_ODSA);
    float* qi = (float*)lds;
    float* qd = qi + 512;
    float* wv = qd + 512;
    float* scv = wv + 8;
    u32* mk = (u32*)(scv + 2048);
    for (int t = blockIdx.x; t < T; t += gridDim.x) {
        const int b = t >> 11, pos = t & (SEQ - 1); const bf16_t* zr = Z + (size_t)t * NZ;
        __syncthreads();
        qi[tid] = bf2f(zr[ZC_QI + tid]); qd[tid] = bf2f(zr[ZC_QD + tid]);
        if (tid < 8) wv[tid] = bf2f(zr[ZC_WI + tid]) * 0.35355339059327373f;
        __syncthreads();
        for (int i = 0; i < 4; ++i) { const int k = tid + 512 * i; float s = -__builtin_inff();
            if (k <= pos) { s = 0.f; const bf16_t* kr = Z + (size_t)(b * SEQ + k) * NZ + ZC_KI;
                for (int hh = 0; hh < 8; ++hh) { const float lg = dot64(qi + hh * 64, kr); s = fmaf(wv[hh], fmaxf(lg, 0.f), s); } }
            scv[k] = s; }
        __syncthreads();
        for (int i = 0; i < 4; ++i) { const int k = tid + 512 * i; bool selb = false;
            if (k <= pos) { if (pos < 256) selb = true; else { const float v = scv[k]; int rank = 0;
                    for (int j = 0; j <= pos; ++j) { const float v2 = scv[j]; rank += (v2 > v || (v2 == v && j < k)) ? 1 : 0; } selb = rank < 256; } }
            const unsigned long long bal = __ballot(selb);
            if (lane == 0) { const int wi = 16 * i + 2 * h; mk[wi] = (u32)bal; mk[wi + 1] = (u32)(bal >> 32); } }
        __syncthreads();
        if (tid < 64) maskg[(size_t)t * 64 + tid] = mk[tid];
        float m = -1e30f, l = 0.f, o = 0.f; const float* q = qd + h * 64;
        for (int c2 = 0; c2 * 64 <= pos; ++c2) { const int kp = c2 * 64 + lane; const bool valid = (mk[kp >> 5] >> (kp & 31)) & 1u;
            if (__ballot(valid) == 0ull) continue;
            float s = valid ? dot64(q, kd + (size_t)(b * SEQ + kp) * 64) : -1e30f;
            const float mn = fmaxf(m, wave_max(s)); const float al = __expf(m - mn); const float pr = valid ? __expf(s - mn) : 0.f;
            l = l * al + wave_sum(pr); o *= al; m = mn;
            const bf16_t* vr = vdT + ((size_t)b * 64 + lane) * SEQ + c2 * 64;
            for (int k = 0; k < 64; ++k) { const float pk = __shfl(pr, k); o += pk * bf2f(vr[k]); } }
        odsa[(size_t)t * 512 + h * 64 + lane] = f2bf(o / fmaxf(l, 1e-30f));
    }
}
__device__ __forceinline__ void st_merge_naive(const Params& p) {
    int tid_ = threadIdx.x; asm volatile("" : "+v"(tid_)); const int tid = tid_; const bf16_t* Z = (const bf16_t*)(p.ws + WS_Z);
    const bf16_t* onsa = (const bf16_t*)(p.ws + WS_ONSA); const bf16_t* odsa = (const bf16_t*)(p.ws + WS_ODSA); bf16_t* mg = (bf16_t*)(p.ws + WS_MERGED);
    for (int it = blockIdx.x; it < (T / 8) * 2; it += gridDim.x) { const int t0 = (it >> 1) * 8, n = (it & 1) * 512 + tid;
        float a[8], d[8]; naive_dot8(onsa, 512, p.w_nsa, D, 512, t0, n, a); naive_dot8(odsa, 512, p.w_dsa, D, 512, t0, n, d);
#pragma unroll
        for (int i = 0; i < 8; ++i) { const float g1 = bf2f(Z[(size_t)(t0 + i) * NZ + ZC_GM + n]), g2 = bf2f(Z[(size_t)(t0 + i) * NZ + ZC_GM + 1024 + n]);
            mg[(size_t)(t0 + i) * D + n] = f2bf(g1 * a[i] + g2 * d[i]); } }
}
__device__ __forceinline__ void st_out_naive(const Params& p) {
    int tid_ = threadIdx.x; asm volatile("" : "+v"(tid_)); const int tid = tid_; const bf16_t* mg = (const bf16_t*)(p.ws + WS_MERGED); const float* mod = (const float*)(p.ws + WS_MOD);
    for (int it = blockIdx.x; it < (T / 8) * 2; it += gridDim.x) { const int t0 = (it >> 1) * 8, n = (it & 1) * 512 + tid;
        float a[8]; naive_dot8(mg, D, p.w_out, D, D, t0, n, a); const float g1 = mod[(t0 >> 11) * 6144 + 2048 + n];
#pragma unroll
        for (int i = 0; i < 8; ++i) p.out[(size_t)(t0 + i) * D + n] = p.x[(size_t)(t0 + i) * D + n] + g1 * a[i]; }
}
__device__ __forceinline__ void st_peerq_naive(const Params& p) {
    int tid_ = threadIdx.x; asm volatile("" : "+v"(tid_)); const int tid = tid_; const bf16_t* h2 = (const bf16_t*)(p.ws + WS_H2); bf16_t* q = (bf16_t*)(p.ws + WS_MERGED);
    for (int it = blockIdx.x; it < (T / 8) * 2; it += gridDim.x) { const int t0 = (it >> 1) * 8, n = (it & 1) * 512 + tid;
        float a[8]; naive_dot8(h2, D, p.wq, D, D, t0, n, a);
#pragma unroll
        for (int i = 0; i < 8; ++i) q[(size_t)(t0 + i) * D + n] = f2bf(a[i]); }
}
__device__ __forceinline__ void st_ssub_naive(const Params& p) {
    int tid_ = threadIdx.x; asm volatile("" : "+v"(tid_)); const int tid = tid_; const bf16_t* q = (const bf16_t*)(p.ws + WS_MERGED); float* ss = (float*)(p.ws + WS_SSUB);
    for (size_t it = (size_t)blockIdx.x * NTHR + tid; it < (size_t)T * 2048; it += (size_t)gridDim.x * NTHR) {
        const int t = (int)(it >> 11), col = (int)(it & 2047), hc = col >> 7, n = col & 127;
        const bf16_t* qr = q + (size_t)t * D + hc * 64; const float* sk = p.subkeys + ((size_t)hc * 128 + n) * 64;
        float acc = 0.f; for (int d = 0; d < 64; ++d) acc += bf2f(qr[d]) * sk[d];
        ss[it] = acc; }
}
__device__ __forceinline__ u32 ordf(float f);
__device__ __forceinline__ void ins16(u32 (&s)[16], u32 key) {
#pragma unroll
    for (int i = 0; i < 16; ++i) { const u32 mx = s[i] > key ? s[i] : key; key = s[i] > key ? key : s[i]; s[i] = mx; }
}
__device__ __forceinline__ void st_route(const Params& p) {
    int tid_ = threadIdx.x; asm volatile("" : "+v"(tid_)); const int tid = tid_; const float* ss = (const float*)(p.ws + WS_SSUB); int* eidx = (int*)(p.ws + WS_EIDX); float* gate = (float*)(p.ws + WS_GATE);
    for (int it = blockIdx.x * NTHR + tid; it < T * 8; it += gridDim.x * NTHR) {
        const float* s0 = ss + (size_t)it * 256;
        u32 a[16], b[16];
#pragma unroll
        for (int i = 0; i < 16; ++i) { a[i] = 0u; b[i] = 0u; }
        for (int n = 0; n < 128; n += 4) { const float4 x = *(const float4*)(s0 + n), y = *(const float4*)(s0 + 128 + n);
            ins16(a, (ordf(x.x) & ~127u) | (u32)(127 - n)); ins16(a, (ordf(x.y) & ~127u) | (u32)(126 - n)); ins16(a, (ordf(x.z) & ~127u) | (u32)(125 - n)); ins16(a, (ordf(x.w) & ~127u) | (u32)(124 - n));
            ins16(b, (ordf(y.x) & ~127u) | (u32)(127 - n)); ins16(b, (ordf(y.y) & ~127u) | (u32)(126 - n)); ins16(b, (ordf(y.z) & ~127u) | (u32)(125 - n)); ins16(b, (ordf(y.w) & ~127u) | (u32)(124 - n)); }
        float va[16], vb[16]; int na[16], nb[16];
#pragma unroll
        for (int i = 0; i < 16; ++i) { na[i] = 127 - (int)(a[i] & 127u); nb[i] = 127 - (int)(b[i] & 127u); va[i] = s0[na[i]]; vb[i] = s0[128 + nb[i]]; }
        u32 tk[16];
#pragma unroll
        for (int i = 0; i < 16; ++i) tk[i] = 0u;
#pragma unroll
        for (int i = 0; i < 16; ++i)
#pragma unroll
            for (int j = 0; j < 16; ++j) if ((i + 1) * (j + 1) <= 16) ins16(tk, (ordf(va[i] + vb[j]) & ~255u) | (u32)(255 - (i * 16 + j)));
        float ts[16]; int te[16];
#pragma unroll
        for (int r = 0; r < 16; ++r) { const int flat = 255 - (int)(tk[r] & 255u), i = flat >> 4, j = flat & 15; float x = 0.f, y = 0.f; int ni = 0, nj = 0;
#pragma unroll
            for (int q = 0; q < 16; ++q) { if (i == q) { x = va[q]; ni = na[q]; } if (j == q) { y = vb[q]; nj = nb[q]; } }
            ts[r] = x + y; te[r] = ni * 128 + nj; }
        float mx = ts[0];
#pragma unroll
        for (int r = 1; r < 16; ++r) mx = fmaxf(mx, ts[r]);
        float sum = 0.f, ex[16];
#pragma unroll
        for (int r = 0; r < 16; ++r) { ex[r] = __expf(ts[r] - mx); sum += ex[r]; }
        const float inv = 1.0f / sum;
#pragma unroll
        for (int r = 0; r < 16; ++r) { eidx[(size_t)it * 16 + r] = te[r]; gate[(size_t)it * 16 + r] = ex[r] * inv; }
    }
}
__device__ __forceinline__ void st_cvt_uv(const Params& p) {
    int tid_ = threadIdx.x; asm volatile("" : "+v"(tid_)); const int tid = tid_; bf16_t* u16 = (bf16_t*)(p.ws + WS_U16); bf16_t* v16 = (bf16_t*)(p.ws + WS_V16);
    const size_t n4 = (size_t)16384 * 1024 / 4;
    for (size_t i = (size_t)blockIdx.x * NTHR + tid; i < n4; i += (size_t)gridDim.x * NTHR) {
        const float4 a = ((const float4*)p.pu)[i], b = ((const float4*)p.pv)[i];
        uint2 o; o.x = pk2(a.x, a.y); o.y = pk2(a.z, a.w); ((uint2*)u16)[i] = o; o.x = pk2(b.x, b.y); o.y = pk2(b.z, b.w);
        const size_t e = i >> 8; const int col = (int)(i & 255) * 4;
        *(uint2*)(v16 + ((size_t)(col >> 6) * 16384 + e) * 64 + (col & 63)) = o; }
}
__device__ __forceinline__ void st_expert(const Params& p, unsigned char* lds) {
    int tid_ = threadIdx.x; asm volatile("" : "+v"(tid_)); const int tid = tid_, lane = tid & 63, w = tid >> 6;
    const bf16_t* h2 = (const bf16_t*)(p.ws + WS_H2); const bf16_t* u16 = (const bf16_t*)(p.ws + WS_U16); const bf16_t* v16 = (const bf16_t*)(p.ws + WS_V16);
    const int* eidx = (const int*)(p.ws + WS_EIDX); const float* gate = (const float*)(p.ws + WS_GATE); const float* mod = (const float*)(p.ws + WS_MOD);
    float* wl = (float*)lds + w * 128;
    for (int t = blockIdx.x * 8 + w; t < T; t += gridDim.x * 8) {
        float xv[16]; { const uint4 a = *(const uint4*)(h2 + (size_t)t * D + lane * 16), b = *(const uint4*)(h2 + (size_t)t * D + lane * 16 + 8);
            xv[0] = bflo(a.x); xv[1] = bfhi(a.x); xv[2] = bflo(a.y); xv[3] = bfhi(a.y); xv[4] = bflo(a.z); xv[5] = bfhi(a.z); xv[6] = bflo(a.w); xv[7] = bfhi(a.w);
            xv[8] = bflo(b.x); xv[9] = bfhi(b.x); xv[10] = bflo(b.y); xv[11] = bfhi(b.y); xv[12] = bflo(b.z); xv[13] = bfhi(b.z); xv[14] = bflo(b.w); xv[15] = bfhi(b.w); }
        const int e0 = eidx[(size_t)t * 128 + lane], e1 = eidx[(size_t)t * 128 + 64 + lane];
        const float g0 = gate[(size_t)t * 128 + lane], g1 = gate[(size_t)t * 128 + 64 + lane];
        for (int k = 0; k < 128; ++k) { const int e = __shfl(k < 64 ? e0 : e1, k & 63);
            const bf16_t* ur = u16 + (size_t)e * D + lane * 16; const uint4 a = *(const uint4*)ur, b = *(const uint4*)(ur + 8);
            float s = xv[0] * bflo(a.x) + xv[1] * bfhi(a.x) + xv[2] * bflo(a.y) + xv[3] * bfhi(a.y) + xv[4] * bflo(a.z) + xv[5] * bfhi(a.z) + xv[6] * bflo(a.w) + xv[7] * bfhi(a.w)
                    + xv[8] * bflo(b.x) + xv[9] * bfhi(b.x) + xv[10] * bflo(b.y) + xv[11] * bfhi(b.y) + xv[12] * bflo(b.z) + xv[13] * bfhi(b.z) + xv[14] * bflo(b.w) + xv[15] * bfhi(b.w);
            s = wave_sum(s);
            if (lane == (k & 63)) { const float gg = k < 64 ? g0 : g1; wl[k] = gg * gelu_erf(s); } }
        __builtin_amdgcn_s_waitcnt(0);
        float acc[16];
#pragma unroll
        for (int i = 0; i < 16; ++i) acc[i] = 0.f;
        for (int k = 0; k < 128; ++k) { const int e = __shfl(k < 64 ? e0 : e1, k & 63); const float wk = wl[k];
            const bf16_t* vr = v16 + (size_t)e * D + lane * 16; const uint4 a = *(const uint4*)vr, b = *(const uint4*)(vr + 8);
            acc[0] += wk * bflo(a.x); acc[1] += wk * bfhi(a.x); acc[2] += wk * bflo(a.y); acc[3] += wk * bfhi(a.y); acc[4] += wk * bflo(a.z); acc[5] += wk * bfhi(a.z); acc[6] += wk * bflo(a.w); acc[7] += wk * bfhi(a.w);
            acc[8] += wk * bflo(b.x); acc[9] += wk * bfhi(b.x); acc[10] += wk * bflo(b.y); acc[11] += wk * bfhi(b.y); acc[12] += wk * bflo(b.z); acc[13] += wk * bfhi(b.z); acc[14] += wk * bflo(b.w); acc[15] += wk * bfhi(b.w); }
        const float* g2 = mod + (t >> 11) * 6144 + 5120 + lane * 16; float* xr = p.out + (size_t)t * D + lane * 16; float ss = 0.f;
#pragma unroll
        for (int i = 0; i < 16; ++i) { acc[i] = xr[i] + g2[i] * acc[i]; ss += acc[i] * acc[i]; }
        const float r = rsqrtf(wave_sum(ss) * (1.0f / D) + EPS);
#pragma unroll
        for (int i = 0; i < 16; ++i) xr[i] = acc[i] * r * p.final_g[lane * 16 + i];
    }
}


typedef short bf16x8 __attribute__((ext_vector_type(8)));
typedef float f32x16 __attribute__((ext_vector_type(16)));
typedef unsigned u32x2 __attribute__((ext_vector_type(2)));
typedef unsigned u32x4 __attribute__((ext_vector_type(4)));
typedef __bf16 hbf2_t __attribute__((ext_vector_type(2)));
typedef float f32x2_t __attribute__((ext_vector_type(2)));
#define MFMA32(a, b, c) __builtin_amdgcn_mfma_f32_32x32x16_bf16((a), (b), (c), 0, 0, 0)
__device__ __forceinline__ u32 pkbf(float a, float b) { const f32x2_t v = {a, b}; const hbf2_t r = __builtin_convertvector(v, hbf2_t); return __builtin_bit_cast(u32, r); }
__device__ __forceinline__ bf16x8 ld8(const bf16_t* q) { return *(const bf16x8*)q; }
__device__ __forceinline__ bf16x8 ld44(const bf16_t* q) { const u32x2 a = *(const u32x2*)q, b = *(const u32x2*)(q + 8); const u32x4 v = {a.x, a.y, b.x, b.y}; return __builtin_bit_cast(bf16x8, v); }
template <int H> __device__ __forceinline__ bf16x8 pack8(const f32x16& s) {
    const u32x4 v = {pkbf(s[8 * H], s[8 * H + 1]), pkbf(s[8 * H + 2], s[8 * H + 3]), pkbf(s[8 * H + 4], s[8 * H + 5]), pkbf(s[8 * H + 6], s[8 * H + 7])};
    return __builtin_bit_cast(bf16x8, v);
}
__device__ __forceinline__ float dpp_xor1(float v) { return __int_as_float(__builtin_amdgcn_update_dpp(0, __float_as_int(v), 0xB1, 0xF, 0xF, true)); }
__device__ __forceinline__ float dpp_xor2(float v) { return __int_as_float(__builtin_amdgcn_update_dpp(0, __float_as_int(v), 0x4E, 0xF, 0xF, true)); }
__device__ __forceinline__ f32x16 zero16() { f32x16 z;
#pragma unroll
    for (int i = 0; i < 16; ++i) z[i] = 0.f; return z; }
__device__ __forceinline__ void flash_tile(float& m, float& l, f32x16& o0, f32x16& o1, f32x16 s, u32 vm, const bf16_t* vb, size_t dbs) {
    const bf16x8 v00 = ld44(vb), v01 = ld44(vb + 16), v10 = ld44(vb + dbs), v11 = ld44(vb + dbs + 16);
    float mx = -1e30f;
#pragma unroll
    for (int R = 0; R < 16; ++R) { s[R] = ((vm >> R) & 1u) ? s[R] : -1e30f; mx = fmaxf(mx, s[R]); }
    mx = fmaxf(mx, __shfl_xor(mx, 32));
    const float mn = fmaxf(m, mx), al = __expf(m - mn);
    float ps = 0.f;
#pragma unroll
    for (int R = 0; R < 16; ++R) { const float pr = ((vm >> R) & 1u) ? __expf(s[R] - mn) : 0.f; s[R] = pr; ps += pr; }
    ps += __shfl_xor(ps, 32);
    l = l * al + ps; m = mn;
#pragma unroll
    for (int R = 0; R < 16; ++R) { o0[R] *= al; o1[R] *= al; }
    const bf16x8 p0 = pack8<0>(s), p1 = pack8<1>(s);
    o0 = MFMA32(v00, p0, o0); o0 = MFMA32(v01, p1, o0);
    o1 = MFMA32(v10, p0, o1); o1 = MFMA32(v11, p1, o1);
}
__device__ __forceinline__ u32 vm_le(int lim) { u32 vm = 0u;
#pragma unroll
    for (int R = 0; R < 16; ++R) vm |= (((R & 3) + 8 * (R >> 2)) <= lim) ? (1u << R) : 0u;
    return vm; }
__device__ __forceinline__ u32 vm_from_word(u32 word, int hl) { const u32 sh = word >> (4 * hl); return (sh & 0xFu) | (((sh >> 8) & 0xFu) << 4) | (((sh >> 16) & 0xFu) << 8) | (((sh >> 24) & 0xFu) << 12); }
__device__ __forceinline__ void store_ot(bf16_t* orow, const f32x16& o0, const f32x16& o1, int hl) {
#pragma unroll
    for (int q = 0; q < 4; ++q) {
        u32x2 a = {pkbf(o0[4 * q], o0[4 * q + 1]), pkbf(o0[4 * q + 2], o0[4 * q + 3])}; *(u32x2*)(orow + 8 * q + 4 * hl) = a;
        u32x2 b = {pkbf(o1[4 * q], o1[4 * q + 1]), pkbf(o1[4 * q + 2], o1[4 * q + 3])}; *(u32x2*)(orow + 32 + 8 * q + 4 * hl) = b;
    }
}
__device__ __forceinline__ u32 ordf(float f) { const u32 u = __float_as_uint(f); return (u & 0x80000000u) ? ~u : (u | 0x80000000u); }

__device__ __forceinline__ void st_nsa(const Params& p) {
    int tid_ = threadIdx.x; asm volatile("" : "+v"(tid_)); const int tid = tid_, lane = tid & 63, w = __builtin_amdgcn_readfirstlane(tid >> 6), c_ = lane & 31, hl_ = lane >> 5;
    const bf16_t* Z = (const bf16_t*)(p.ws + WS_Z); unsigned char* dob = (unsigned char*)p.out;
    const bf16_t* kcmp = (const bf16_t*)(dob + DO_KCMP); const bf16_t* vcmpT = (const bf16_t*)(dob + DO_VCMPT);
    const bf16_t* vsT = (const bf16_t*)(dob + DO_VST); const bf16_t* vwT = (const bf16_t*)(dob + DO_VWT);
    bf16_t* onsa = (bf16_t*)(p.ws + WS_ONSA);
    for (int ps = blockIdx.x; ps < 256; ps += gridDim.x)
    for (int which = 0; which < 2; ++which) {
        const int b = ps >> 5, g = (ps >> 4) & 1, jj = ps & 15, qb = which ? 31 - jj : jj, cur = qb;
        int c = c_, hl = hl_; asm volatile("" : "+v"(c), "+v"(hl));
        const int pmin = qb * 64 + 8 * w, pos = pmin + (c >> 2), head = 4 * g + (c & 3);
        const bf16_t* zr = Z + (size_t)(b * SEQ + pos) * NZ;
        bf16x8 qfr[4];
#pragma unroll
        for (int kk = 0; kk < 4; ++kk) qfr[kk] = ld8(zr + ZC_QN + head * 64 + 16 * kk + 8 * hl);
        const float gc = bf2f(zr[ZC_GN + head * 3]), gs = bf2f(zr[ZC_GN + head * 3 + 1]), gw = bf2f(zr[ZC_GN + head * 3 + 2]);
        f32x16 out0 = zero16(), out1 = zero16();
        u32 sel;
        {
            const int pmax = pmin + 7; const int nmax = pmax >= 31 ? ((pmax - 31) >> 4) : -1; const int ntile = nmax >= 0 ? (((nmax > 126 ? 126 : nmax) >> 5) + 1) : 0;
            const bf16_t* kb = kcmp + ((size_t)(b * 2 + g) * 128 + c) * 64 + 8 * hl;
            float mx = -1e30f, l = 0.f;
            const int nlim = (pos >= 31 ? (((pos - 31) >> 4) > 126 ? 126 : ((pos - 31) >> 4)) : -1) - 4 * hl;
            for (int kt = 0; kt < ntile; ++kt) {
                f32x16 s = zero16();
#pragma unroll
                for (int kk = 0; kk < 4; ++kk) s = MFMA32(ld8(kb + (size_t)kt * 32 * 64 + 16 * kk), qfr[kk], s);
                const u32 vm = vm_le(nlim - 32 * kt);
                float tm = -1e30f;
#pragma unroll
                for (int R = 0; R < 16; ++R) { s[R] = ((vm >> R) & 1u) ? s[R] : -1e30f; tm = fmaxf(tm, s[R]); }
                const float mn = fmaxf(mx, tm); float ps = 0.f;
#pragma unroll
                for (int R = 0; R < 16; ++R) ps += ((vm >> R) & 1u) ? __expf(s[R] - mn) : 0.f;
                l = l * __expf(mx - mn) + ps; mx = mn;
            }
            {
                const float mo = __shfl_xor(mx, 32), lo_ = __shfl_xor(l, 32); const float mn = fmaxf(mx, mo);
                l = l * __expf(mx - mn) + lo_ * __expf(mo - mn); mx = mn; }
            const float il = 1.0f / fmaxf(l, 1e-30f);
            __builtin_amdgcn_sched_barrier(0);
            f32x16 o0 = zero16(), o1 = zero16();
            const bf16_t* vb = vcmpT + ((size_t)(b * 2 + g) * 64 + c) * 128 + 4 * hl;
            float G[16], L[16];
#pragma unroll
            for (int kt = 0; kt < 4; ++kt) {
                if (kt < ntile) {
                    f32x16 s = zero16();
#pragma unroll
                    for (int kk = 0; kk < 4; ++kk) s = MFMA32(ld8(kb + (size_t)kt * 32 * 64 + 16 * kk), qfr[kk], s);
                    const u32 vm = vm_le(nlim - 32 * kt);
#pragma unroll
                    for (int R = 0; R < 16; ++R) s[R] = ((vm >> R) & 1u) ? __expf(s[R] - mx) * il : 0.f;
                    const bf16x8 p0 = pack8<0>(s), p1 = pack8<1>(s);
                    o0 = MFMA32(ld44(vb + 32 * kt), p0, o0); o0 = MFMA32(ld44(vb + 32 * kt + 16), p1, o0);
                    o1 = MFMA32(ld44(vb + 32 * 128 + 32 * kt), p0, o1); o1 = MFMA32(ld44(vb + 32 * 128 + 32 * kt + 16), p1, o1);
#pragma unroll
                    for (int rg = 0; rg < 4; ++rg) { float gsum = (s[4 * rg] + s[4 * rg + 1]) + (s[4 * rg + 2] + s[4 * rg + 3]); float last = s[4 * rg + 3];
                        gsum += dpp_xor1(gsum); gsum += dpp_xor2(gsum); last += dpp_xor1(last); last += dpp_xor2(last);
                        G[4 * kt + rg] = gsum; L[4 * kt + rg] = last; }
                } else {
#pragma unroll
                    for (int rg = 0; rg < 4; ++rg) { G[4 * kt + rg] = 0.f; L[4 * kt + rg] = 0.f; }
                }
                __builtin_amdgcn_sched_barrier(0);
            }
#pragma unroll
            for (int R = 0; R < 16; ++R) { out0[R] = gc * o0[R]; out1[R] = gc * o1[R]; }
            float v[16], vx[16];
            { float Lx[16];
#pragma unroll
              for (int i = 0; i < 16; ++i) Lx[i] = __shfl_xor(L[i], 32);
#pragma unroll
              for (int i = 0; i < 16; ++i) { const float prevL = hl ? Lx[i] : (i > 0 ? Lx[i > 0 ? i - 1 : 0] : 0.f); const float bl = prevL + 2.f * G[i] - L[i];
                const int j = 2 * i + hl; const bool forced = (j == 0) || (j == cur) || (j == cur - 1);
                v[i] = forced ? __builtin_inff() : (j <= cur ? bl : -__builtin_inff()); } }
#pragma unroll
            for (int i = 0; i < 16; ++i) vx[i] = __shfl_xor(v[i], 32);
            u32 own = 0u;
#pragma unroll
            for (int i = 0; i < 16; ++i) { int rank = 0;
#pragma unroll
                for (int i2 = 0; i2 < 16; ++i2) {
                    if (i2 != i) rank += (v[i2] > v[i] || (v[i2] == v[i] && i2 < i)) ? 1 : 0;
                    const bool xlt = (i2 < i) || (hl && i2 == i);
                    rank += (vx[i2] > v[i] || (vx[i2] == v[i] && xlt)) ? 1 : 0; }
                const int j = 2 * i + hl; own |= ((j <= cur) && rank < 16) ? (1u << j) : 0u; }
            sel = own | (u32)__shfl_xor((int)own, 32);
            __builtin_amdgcn_sched_barrier(0);
        }
        {
            float m = -1e30f, l = 0.f; f32x16 o0 = zero16(), o1 = zero16();
            const bf16_t* kb = Z + (size_t)(b * SEQ + c) * NZ + ZC_KS + g * 64 + 8 * hl;
            const bf16_t* vb = vsT + ((size_t)(b * 2 + g) * 64 + c) * SEQ + 4 * hl;
            for (int jb = 0; jb <= cur; ++jb) {
                const bool mine = (sel >> jb) & 1u;
                if (__ballot(mine) == 0ull) continue;
#pragma unroll
                for (int h2 = 0; h2 < 2; ++h2) { const int key0 = jb * 64 + h2 * 32;
                    f32x16 s = zero16();
#pragma unroll
                    for (int kk = 0; kk < 4; ++kk) s = MFMA32(ld8(kb + (size_t)key0 * NZ + 16 * kk), qfr[kk], s);
                    const u32 vm = mine ? vm_le(pos - key0 - 4 * hl) : 0u;
                    flash_tile(m, l, o0, o1, s, vm, vb + key0, (size_t)32 * SEQ); }
            }
            const float f = gs / fmaxf(l, 1e-30f);
#pragma unroll
            for (int R = 0; R < 16; ++R) { out0[R] += f * o0[R]; out1[R] += f * o1[R]; }
        }
        {
            float m = -1e30f, l = 0.f; f32x16 o0 = zero16(), o1 = zero16();
            const bf16_t* kb = Z + (size_t)(b * SEQ + c) * NZ + ZC_KW + g * 64 + 8 * hl;
            const bf16_t* vb = vwT + ((size_t)(b * 2 + g) * 64 + c) * SEQ + 4 * hl;
            const int kstart = pmin - 511 > 0 ? pmin - 511 : 0;
            for (int kt = kstart >> 5; kt <= (pmin + 7) >> 5; ++kt) { const int key0 = kt * 32;
                f32x16 s = zero16();
#pragma unroll
                for (int kk = 0; kk < 4; ++kk) s = MFMA32(ld8(kb + (size_t)key0 * NZ + 16 * kk), qfr[kk], s);
                const int d1 = pos - key0 - 4 * hl; const u32 vm = vm_le(d1) & ~vm_le(d1 - 512);
                flash_tile(m, l, o0, o1, s, vm, vb + key0, (size_t)32 * SEQ); }
            const float f = gw / fmaxf(l, 1e-30f);
#pragma unroll
            for (int R = 0; R < 16; ++R) { out0[R] += f * o0[R]; out1[R] += f * o1[R]; }
        }
        store_ot(onsa + (size_t)(b * SEQ + pos) * 512 + head * 64, out0, out1, hl);
    }
}

__device__ __forceinline__ void st_dsa(const Params& p, unsigned char* lds) {
    int tid_ = threadIdx.x; asm volatile("" : "+v"(tid_)); const int tid = tid_, lane = tid & 63, w = __builtin_amdgcn_readfirstlane(tid >> 6), c_ = lane & 31, hl_ = lane >> 5;
    const bf16_t* Z = (const bf16_t*)(p.ws + WS_Z); unsigned char* dob = (unsigned char*)p.out;
    const bf16_t* kd = (const bf16_t*)(dob + DO_KD); const bf16_t* vdT = (const bf16_t*)(dob + DO_VDT);
    bf16_t* odsa = (bf16_t*)(p.ws + WS_ODSA);
    u32* mk = (u32*)lds;
    for (int ps = blockIdx.x; ps < 256; ps += gridDim.x)
    for (int which = 0; which < 2; ++which) {
        const int b = ps >> 5, jj = ps & 31, qb = which ? 63 - jj : jj;
        const int tok0 = b * SEQ + qb * 32;
        int c = c_, hl = hl_; asm volatile("" : "+v"(c), "+v"(hl));
        __syncthreads();
        {
            const int r = c; const int qq_r = ((r >> 2) & 1) * 2 + (r >> 4), head_r = ((r >> 3) & 1) * 4 + (r & 3);
            bf16x8 afr[4];
#pragma unroll
            for (int kk = 0; kk < 4; ++kk) afr[kk] = ld8(Z + (size_t)(tok0 + 4 * w + qq_r) * NZ + ZC_QI + head_r * 64 + 16 * kk + 8 * hl);
            float wv[2][8]; int posq[2];
#pragma unroll
            for (int s = 0; s < 2; ++s) { posq[s] = qb * 32 + 4 * w + 2 * hl + s;
                const uint4 ww = *(const uint4*)(Z + (size_t)(tok0 + 4 * w + 2 * hl + s) * NZ + ZC_WI);
                wv[s][0] = bflo(ww.x) * 0.35355339059327373f; wv[s][1] = bfhi(ww.x) * 0.35355339059327373f; wv[s][2] = bflo(ww.y) * 0.35355339059327373f; wv[s][3] = bfhi(ww.y) * 0.35355339059327373f;
                wv[s][4] = bflo(ww.z) * 0.35355339059327373f; wv[s][5] = bfhi(ww.z) * 0.35355339059327373f; wv[s][6] = bflo(ww.w) * 0.35355339059327373f; wv[s][7] = bfhi(ww.w) * 0.35355339059327373f; }
            u32 key[64][2];
            const bf16_t* kib = Z + (size_t)(b * SEQ + c) * NZ + ZC_KI + 8 * hl;
            bf16x8 bc[4];
#pragma unroll
            for (int kk = 0; kk < 4; ++kk) bc[kk] = ld8(kib + 16 * kk);
            const bf16_t* kp = kib;
#pragma unroll
            for (int kt = 0; kt < 64; ++kt) {
                if (kt <= qb) {
                    bf16x8 bn[4];
                    if (kt + 1 <= qb) kp += (size_t)32 * NZ;
                    asm volatile("" : "+v"(kp));
#pragma unroll
                    for (int kk = 0; kk < 4; ++kk) bn[kk] = ld8(kp + 16 * kk);
                    f32x16 acc = zero16();
#pragma unroll
                    for (int kk = 0; kk < 4; ++kk) acc = MFMA32(afr[kk], bc[kk], acc);
#pragma unroll
                    for (int s = 0; s < 2; ++s) { float sc = 0.f;
#pragma unroll
                        for (int e = 0; e < 8; ++e) sc = fmaf(wv[s][e], fmaxf(acc[8 * s + e], 0.f), sc);
                        key[kt][s] = (c <= posq[s] - kt * 32) ? ordf(sc) : 0u; }
#pragma unroll
                    for (int kk = 0; kk < 4; ++kk) bc[kk] = bn[kk];
                } else { key[kt][0] = 0u; key[kt][1] = 0u; }
                __builtin_amdgcn_sched_barrier(0);
            }
            u32 lo[2], hi[2], thr[2]; bool done[2], exact[2];
#pragma unroll
            for (int s = 0; s < 2; ++s) { lo[s] = 0x00800000u; hi[s] = 0xFF800000u; thr[s] = 1u; exact[s] = true; done[s] = posq[s] < 256; }
            for (int iter = 0; iter < 40; ++iter) {
                if (__all(done[0] && done[1])) break;
                u32 mid[2]; int cnt[2];
#pragma unroll
                for (int s = 0; s < 2; ++s) { mid[s] = lo[s] + ((hi[s] - lo[s]) >> 1); cnt[s] = 0; }
#pragma unroll
                for (int kt = 0; kt < 64; ++kt) { cnt[0] += (key[kt][0] >= mid[0]) ? 1 : 0; cnt[1] += (key[kt][1] >= mid[1]) ? 1 : 0; }
#pragma unroll
                for (int s = 0; s < 2; ++s) {
#pragma unroll
                    for (int o = 1; o < 32; o <<= 1) cnt[s] += __shfl_xor(cnt[s], o);
                    if (!done[s]) { if (cnt[s] >= 256) lo[s] = mid[s]; else hi[s] = mid[s];
                        if (cnt[s] == 256) { thr[s] = mid[s]; exact[s] = true; done[s] = true; }
                        else if (hi[s] - lo[s] <= 1u) { thr[s] = lo[s]; exact[s] = false; done[s] = true; } } }
            }
            if (__all(exact[0] && exact[1])) {
#pragma unroll
                for (int kt = 0; kt < 64; ++kt) if (kt <= qb) {
#pragma unroll
                    for (int s = 0; s < 2; ++s) { const unsigned long long bal = __ballot(key[kt][s] >= thr[s]);
                        if (lane == 0) { mk[(4 * w + s) * 65 + kt] = (u32)bal; mk[(4 * w + 2 + s) * 65 + kt] = (u32)(bal >> 32); } } }
            } else {
#pragma unroll
                for (int s = 0; s < 2; ++s) {
                    int cgt = 0; const u32 lowk = exact[s] ? thr[s] : thr[s] + 1u;
#pragma unroll
                    for (int kt = 0; kt < 64; ++kt) cgt += (key[kt][s] >= lowk) ? 1 : 0;
#pragma unroll
                    for (int o = 1; o < 32; o <<= 1) cgt += __shfl_xor(cgt, o);
                    const int need = exact[s] ? 0 : 256 - cgt;
                    int rem0 = __shfl(need, 0), rem1 = __shfl(need, 32);
                    const u32 eqk = exact[s] ? 0xFFFFFFFFu : thr[s];
#pragma unroll
                    for (int kt = 0; kt < 64; ++kt) if (kt <= qb) {
                        const unsigned long long bg = __ballot(key[kt][s] >= lowk), be = __ballot(key[kt][s] == eqk);
                        u32 e0 = (u32)be, e1 = (u32)(be >> 32);
                        while (__popc(e0) > rem0) e0 &= ~(1u << (31 - __clz(e0)));
                        while (__popc(e1) > rem1) e1 &= ~(1u << (31 - __clz(e1)));
                        rem0 -= __popc(e0); rem1 -= __popc(e1);
                        if (lane == 0) { mk[(4 * w + s) * 65 + kt] = (u32)bg | e0; mk[(4 * w + 2 + s) * 65 + kt] = (u32)(bg >> 32) | e1; } }
                }
            }
        }
        __syncthreads();
        {
            bf16x8 qfr[4];
#pragma unroll
            for (int kk = 0; kk < 4; ++kk) qfr[kk] = ld8(Z + (size_t)(tok0 + c) * NZ + ZC_QD + w * 64 + 16 * kk + 8 * hl);
            float m = -1e30f, l = 0.f; f32x16 o0 = zero16(), o1 = zero16();
            const bf16_t* kb = kd + (size_t)(b * SEQ + c) * 64 + 8 * hl;
            const bf16_t* vb = vdT + ((size_t)b * 64 + c) * SEQ + 4 * hl;
            for (int kt = 0; kt <= qb; ++kt) {
                const u32 word = mk[c * 65 + kt];
                if (__ballot(word != 0u) == 0ull) continue;
                f32x16 s = zero16();
#pragma unroll
                for (int kk = 0; kk < 4; ++kk) s = MFMA32(ld8(kb + (size_t)kt * 32 * 64 + 16 * kk), qfr[kk], s);
                flash_tile(m, l, o0, o1, s, vm_from_word(word, hl), vb + kt * 32, (size_t)32 * SEQ);
            }
            const float f = 1.0f / fmaxf(l, 1e-30f);
#pragma unroll
            for (int R = 0; R < 16; ++R) { o0[R] *= f; o1[R] *= f; }
            store_ot(odsa + (size_t)(tok0 + c) * 512 + w * 64, o0, o1, hl);
        }
    }
}

constexpr int TILE_B = 4608;
template <int NT> __device__ __forceinline__ void sk_gload(uint4 (&rk)[NT / 2], const bf16_t* kbase, size_t kstride, int t0c, int tlast, int tid) {
#pragma unroll
    for (int q = 0; q < NT / 2; ++q) { const int idx = tid + 512 * q, tile = idx >> 8, r = (idx >> 3) & 31, ch = idx & 7; int tg = t0c + tile; tg = tg > tlast ? tlast : tg;
        rk[q] = *(const uint4*)(kbase + (size_t)(32 * tg + r) * kstride + 8 * ch); }
}
template <int NT> __device__ __forceinline__ void sk_lwrite(const uint4 (&rk)[NT / 2], LAS unsigned char* kb, int tid) {
#pragma unroll
    for (int q = 0; q < NT / 2; ++q) { const int idx = tid + 512 * q, tile = idx >> 8, r = (idx >> 3) & 31, ch = idx & 7; const u32x4 v = {rk[q].x, rk[q].y, rk[q].z, rk[q].w}; *(LAS u32x4*)(kb + tile * TILE_B + r * 144 + ch * 16) = v; }
}
template <int NT> __device__ __forceinline__ void sv_gload(uint4 (&rv)[NT / 2], const bf16_t* vbase, size_t vstride, int t0c, int tlast, int tid) {
#pragma unroll
    for (int q = 0; q < NT / 2; ++q) { const int idx = tid + 512 * q, tile = idx >> 8, d = (idx >> 2) & 63, sg = idx & 3; int tg = t0c + tile; tg = tg > tlast ? tlast : tg;
        rv[q] = *(const uint4*)(vbase + (size_t)d * vstride + 32 * tg + 8 * sg); }
}
template <int NT> __device__ __forceinline__ void sv_lwrite(const uint4 (&rv)[NT / 2], LAS unsigned char* vb, int tid) {
#pragma unroll
    for (int q = 0; q < NT / 2; ++q) { const int idx = tid + 512 * q, tile = idx >> 8, d = (idx >> 2) & 63, sg = idx & 3; LAS unsigned char* a = vb + tile * TILE_B + d * 72 + sg * 16;
        const u32x2 v0 = {rv[q].x, rv[q].y}, v1 = {rv[q].z, rv[q].w}; *(LAS u32x2*)a = v0; *(LAS u32x2*)(a + 8) = v1; }
}
__device__ __forceinline__ bf16x8 lds_k(const LAS unsigned char* kt, int c, int hl, int kk) { return *(const LAS bf16x8*)(kt + c * 144 + kk * 32 + hl * 16); }
__device__ __forceinline__ bf16x8 lds_v(const LAS unsigned char* vt, int d, int hl, int s) { const LAS unsigned char* q = vt + d * 72 + s * 32 + hl * 8;
    const u32x2 a = *(const LAS u32x2*)q, b = *(const LAS u32x2*)(q + 16); const u32x4 v = {a.x, a.y, b.x, b.y}; return __builtin_bit_cast(bf16x8, v); }
__device__ __forceinline__ void flash_tile_lds(float& m2, float& l, f32x16& o0, f32x16& o1, f32x16 s, u32 vm, bool full, const LAS unsigned char* vt, int c, int hl) {
    const float LOG2E = 1.4426950408889634f;
    const bf16x8 v00 = lds_v(vt, c, hl, 0), v01 = lds_v(vt, c, hl, 1), v10 = lds_v(vt, c + 32, hl, 0), v11 = lds_v(vt, c + 32, hl, 1);
    float mx = -1e30f;
    if (full) {
#pragma unroll
        for (int R = 0; R < 16; ++R) mx = fmaxf(mx, s[R]);
    } else {
#pragma unroll
        for (int R = 0; R < 16; ++R) { s[R] = ((vm >> R) & 1u) ? s[R] : -1e30f; mx = fmaxf(mx, s[R]); }
    }
    mx = fmaxf(mx, __shfl_xor(mx, 32));
    const float mn2 = fmaxf(m2, mx * LOG2E);
    if (!__all(mn2 == m2)) { const float al = __builtin_amdgcn_exp2f(m2 - mn2); l *= al;
#pragma unroll
        for (int R = 0; R < 16; ++R) { o0[R] *= al; o1[R] *= al; }
        m2 = mn2; }
    float ps = 0.f;
    if (full) {
#pragma unroll
        for (int R = 0; R < 16; ++R) { const float pr = __builtin_amdgcn_exp2f(fmaf(s[R], LOG2E, -mn2)); s[R] = pr; ps += pr; }
    } else {
#pragma unroll
        for (int R = 0; R < 16; ++R) { const float pr = ((vm >> R) & 1u) ? __builtin_amdgcn_exp2f(fmaf(s[R], LOG2E, -mn2)) : 0.f; s[R] = pr; ps += pr; }
    }
    ps += __shfl_xor(ps, 32);
    l += ps;
    const bf16x8 p0 = pack8<0>(s), p1 = pack8<1>(s);
    o0 = MFMA32(v00, p0, o0); o0 = MFMA32(v01, p1, o0);
    o1 = MFMA32(v10, p0, o1); o1 = MFMA32(v11, p1, o1);
}
#define HALF_SUM32(v, hl, out) do { int _v = (v); _v += __builtin_amdgcn_update_dpp(0, _v, 0xB1, 0xF, 0xF, true); _v += __builtin_amdgcn_update_dpp(0, _v, 0x4E, 0xF, 0xF, true); \
    _v += __builtin_amdgcn_update_dpp(0, _v, 0x141, 0xF, 0xF, true); _v += __builtin_amdgcn_update_dpp(0, _v, 0x140, 0xF, 0xF, true); \
    const int _r0 = __builtin_amdgcn_readlane(_v, 0) + __builtin_amdgcn_readlane(_v, 16), _r1 = __builtin_amdgcn_readlane(_v, 32) + __builtin_amdgcn_readlane(_v, 48); (out) = (hl) ? _r1 : _r0; } while (0)
constexpr int ATT_CHUNK = 8 * TILE_B;
constexpr int ATT_MK_OFF = 2 * ATT_CHUNK;

#define ATT_STREAM_KV(kbase, kstride, vbase, vstride, tfirst, tlast, BODY) do { \
    const int _tf = (tfirst), _tl = (tlast); const int _nch = (_tl - _tf + 4) >> 2; \
    uint4 _rk[2], _rv[2]; \
    __syncthreads(); \
    sk_gload<4>(_rk, (kbase), (kstride), _tf, _tl, tid); sv_gload<4>(_rv, (vbase), (vstride), _tf, _tl, tid); \
    sk_lwrite<4>(_rk, sm, tid); sv_lwrite<4>(_rv, sm + 4 * TILE_B, tid); \
    if (_nch > 1) { sk_gload<4>(_rk, (kbase), (kstride), _tf + 4, _tl, tid); sv_gload<4>(_rv, (vbase), (vstride), _tf + 4, _tl, tid); } \
    for (int _c = 0; _c < _nch; ++_c) { \
        __syncthreads(); \
        if (_c + 1 < _nch) { LAS unsigned char* _nb = sm + ((_c + 1) & 1) * ATT_CHUNK; sk_lwrite<4>(_rk, _nb, tid); sv_lwrite<4>(_rv, _nb + 4 * TILE_B, tid); \
            if (_c + 2 < _nch) { sk_gload<4>(_rk, (kbase), (kstride), _tf + 4 * (_c + 2), _tl, tid); sv_gload<4>(_rv, (vbase), (vstride), _tf + 4 * (_c + 2), _tl, tid); } } \
        const LAS unsigned char* _cb = sm + (_c & 1) * ATT_CHUNK; \
        _Pragma("unroll") for (int _i = 0; _i < 4; ++_i) { const int tg = _tf + 4 * _c + _i; if (tg <= _tl) { const LAS unsigned char* kt = _cb + _i * TILE_B; const LAS unsigned char* vt = _cb + (4 + _i) * TILE_B; BODY } } \
    } } while (0)

__device__ __forceinline__ void st_nsa2(const Params& p, unsigned char* lds) {
    LAS unsigned char* sm = (LAS unsigned char*)lds;
    const bf16_t* Z = (const bf16_t*)(p.ws + WS_Z); unsigned char* dob = (unsigned char*)p.out;
    const bf16_t* kcmp = (const bf16_t*)(dob + DO_KCMP); const bf16_t* vcmpT = (const bf16_t*)(dob + DO_VCMPT);
    const bf16_t* vsT = (const bf16_t*)(dob + DO_VST); const bf16_t* vwT = (const bf16_t*)(dob + DO_VWT);
    bf16_t* onsa = (bf16_t*)(p.ws + WS_ONSA);
    for (int ps = blockIdx.x; ps < 256; ps += gridDim.x)
    for (int which = 0; which < 2; ++which) {
        const int b = ps >> 5, g = (ps >> 4) & 1, jj = ps & 15, qb = which ? 31 - jj : jj, cur = qb;
        int tid = threadIdx.x; asm volatile("" : "+v"(tid));
        const int lane = tid & 63, w = __builtin_amdgcn_readfirstlane(tid >> 6), c = lane & 31, hl = lane >> 5;
        const int t0 = qb * 64, pmin = t0 + 8 * w, pos = pmin + (c >> 2), head = 4 * g + (c & 3);
        const bf16_t* zr = Z + (size_t)(b * SEQ + pos) * NZ;
        bf16x8 qfr[4];
#pragma unroll
        for (int kk = 0; kk < 4; ++kk) qfr[kk] = ld8(zr + ZC_QN + head * 64 + 16 * kk + 8 * hl);
        const float gc = bf2f(zr[ZC_GN + head * 3]), gs = bf2f(zr[ZC_GN + head * 3 + 1]), gw = bf2f(zr[ZC_GN + head * 3 + 2]);
        f32x16 out0 = zero16(), out1 = zero16();
        u32 sel;
        {
            const int pmax = pmin + 7; const int nmax = pmax >= 31 ? ((pmax - 31) >> 4) : -1; const int ntile = nmax >= 0 ? (((nmax > 126 ? 126 : nmax) >> 5) + 1) : 0;
            const bf16_t* kb = kcmp + ((size_t)(b * 2 + g) * 128 + c) * 64 + 8 * hl;
            float mx = -1e30f, l = 0.f;
            const int nlim = (pos >= 31 ? (((pos - 31) >> 4) > 126 ? 126 : ((pos - 31) >> 4)) : -1) - 4 * hl;
            for (int kt = 0; kt < ntile; ++kt) {
                f32x16 s = zero16();
#pragma unroll
                for (int kk = 0; kk < 4; ++kk) s = MFMA32(ld8(kb + (size_t)kt * 32 * 64 + 16 * kk), qfr[kk], s);
                const u32 vm = vm_le(nlim - 32 * kt);
                float tm = -1e30f;
#pragma unroll
                for (int R = 0; R < 16; ++R) { s[R] = ((vm >> R) & 1u) ? s[R] : -1e30f; tm = fmaxf(tm, s[R]); }
                const float mn = fmaxf(mx, tm); float ps2 = 0.f;
#pragma unroll
                for (int R = 0; R < 16; ++R) ps2 += ((vm >> R) & 1u) ? __expf(s[R] - mn) : 0.f;
                l = l * __expf(mx - mn) + ps2; mx = mn;
            }
            { const float mo = __shfl_xor(mx, 32), lo_ = __shfl_xor(l, 32); const float mn = fmaxf(mx, mo);
              l = l * __expf(mx - mn) + lo_ * __expf(mo - mn); mx = mn; }
            const float il = 1.0f / fmaxf(l, 1e-30f);
            __builtin_amdgcn_sched_barrier(0);
            f32x16 o0 = zero16(), o1 = zero16();
            const bf16_t* vb = vcmpT + ((size_t)(b * 2 + g) * 64 + c) * 128 + 4 * hl;
            float G[16], L[16];
#pragma unroll
            for (int kt = 0; kt < 4; ++kt) {
                if (kt < ntile) {
                    f32x16 s = zero16();
#pragma unroll
                    for (int kk = 0; kk < 4; ++kk) s = MFMA32(ld8(kb + (size_t)kt * 32 * 64 + 16 * kk), qfr[kk], s);
                    const u32 vm = vm_le(nlim - 32 * kt);
#pragma unroll
                    for (int R = 0; R < 16; ++R) s[R] = ((vm >> R) & 1u) ? __expf(s[R] - mx) * il : 0.f;
                    const bf16x8 p0 = pack8<0>(s), p1 = pack8<1>(s);
                    o0 = MFMA32(ld44(vb + 32 * kt), p0, o0); o0 = MFMA32(ld44(vb + 32 * kt + 16), p1, o0);
                    o1 = MFMA32(ld44(vb + 32 * 128 + 32 * kt), p0, o1); o1 = MFMA32(ld44(vb + 32 * 128 + 32 * kt + 16), p1, o1);
#pragma unroll
                    for (int rg = 0; rg < 4; ++rg) { float gsum = (s[4 * rg] + s[4 * rg + 1]) + (s[4 * rg + 2] + s[4 * rg + 3]); float last = s[4 * rg + 3];
                        gsum += dpp_xor1(gsum); gsum += dpp_xor2(gsum); last += dpp_xor1(last); last += dpp_xor2(last);
                        G[4 * kt + rg] = gsum; L[4 * kt + rg] = last; }
                } else {
#pragma unroll
                    for (int rg = 0; rg < 4; ++rg) { G[4 * kt + rg] = 0.f; L[4 * kt + rg] = 0.f; }
                }
                __builtin_amdgcn_sched_barrier(0);
            }
#pragma unroll
            for (int R = 0; R < 16; ++R) { out0[R] = gc * o0[R]; out1[R] = gc * o1[R]; }
            float v[16], vx[16];
            { float Lx[16];
#pragma unroll
              for (int i = 0; i < 16; ++i) Lx[i] = __shfl_xor(L[i], 32);
#pragma unroll
              for (int i = 0; i < 16; ++i) { const float prevL = hl ? Lx[i] : (i > 0 ? Lx[i > 0 ? i - 1 : 0] : 0.f); const float bl = prevL + 2.f * G[i] - L[i];
                const int j = 2 * i + hl; const bool forced = (j == 0) || (j == cur) || (j == cur - 1);
                v[i] = forced ? __builtin_inff() : (j <= cur ? bl : -__builtin_inff()); } }
#pragma unroll
            for (int i = 0; i < 16; ++i) vx[i] = __shfl_xor(v[i], 32);
            u32 own = 0u;
#pragma unroll
            for (int i = 0; i < 16; ++i) { int rank = 0;
#pragma unroll
                for (int i2 = 0; i2 < 16; ++i2) {
                    if (i2 != i) rank += (v[i2] > v[i] || (v[i2] == v[i] && i2 < i)) ? 1 : 0;
                    const bool xlt = (i2 < i) || (hl && i2 == i);
                    rank += (vx[i2] > v[i] || (vx[i2] == v[i] && xlt)) ? 1 : 0; }
                const int j = 2 * i + hl; own |= ((j <= cur) && rank < 16) ? (1u << j) : 0u; }
            sel = own | (u32)__shfl_xor((int)own, 32);
            __builtin_amdgcn_sched_barrier(0);
        }
        {
            float m = -1e30f, l = 0.f; f32x16 o0 = zero16(), o1 = zero16();
            ATT_STREAM_KV(Z + (size_t)(b * SEQ) * NZ + ZC_KS + g * 64, (size_t)NZ, vsT + (size_t)(b * 2 + g) * 64 * SEQ, (size_t)SEQ, 0, 2 * cur + 1, {
                const bool mine = (sel >> (tg >> 1)) & 1u;
                if (__ballot(mine) != 0ull) {
                    f32x16 s = zero16();
                    _Pragma("unroll") for (int kk = 0; kk < 4; ++kk) s = MFMA32(lds_k(kt, c, hl, kk), qfr[kk], s);
                    const bool full = (tg * 32 + 31 <= pmin) && (__ballot(mine) == ~0ull);
                    const u32 vm = full ? 0xFFFFu : (mine ? vm_le(pos - tg * 32 - 4 * hl) : 0u);
                    flash_tile_lds(m, l, o0, o1, s, vm, full, vt, c, hl); } });
            const float f = gs / fmaxf(l, 1e-30f);
#pragma unroll
            for (int R = 0; R < 16; ++R) { out0[R] += f * o0[R]; out1[R] += f * o1[R]; }
        }
        {
            float m = -1e30f, l = 0.f; f32x16 o0 = zero16(), o1 = zero16();
            const int wfirst = (t0 - 511 > 0 ? t0 - 511 : 0) >> 5, wlast = (t0 + 63) >> 5;
            const int myfirst = (pmin - 511 > 0 ? pmin - 511 : 0) >> 5, mylast = (pmin + 7) >> 5;
            ATT_STREAM_KV(Z + (size_t)(b * SEQ) * NZ + ZC_KW + g * 64, (size_t)NZ, vwT + (size_t)(b * 2 + g) * 64 * SEQ, (size_t)SEQ, wfirst, wlast, {
                if (tg >= myfirst && tg <= mylast) {
                    f32x16 s = zero16();
                    _Pragma("unroll") for (int kk = 0; kk < 4; ++kk) s = MFMA32(lds_k(kt, c, hl, kk), qfr[kk], s);
                    const bool full = (tg * 32 + 31 <= pmin) && (tg * 32 + 504 >= pmin);
                    const int d1 = pos - tg * 32 - 4 * hl; const u32 vm = full ? 0xFFFFu : (vm_le(d1) & ~vm_le(d1 - 512));
                    flash_tile_lds(m, l, o0, o1, s, vm, full, vt, c, hl); } });
            const float f = gw / fmaxf(l, 1e-30f);
#pragma unroll
            for (int R = 0; R < 16; ++R) { out0[R] += f * o0[R]; out1[R] += f * o1[R]; }
        }
        store_ot(onsa + (size_t)(b * SEQ + pos) * 512 + head * 64, out0, out1, hl);
    }
    __syncthreads();
}

__device__ __forceinline__ void st_dsa2(const Params& p, unsigned char* lds) {
    LAS unsigned char* sm = (LAS unsigned char*)lds;
    const bf16_t* Z = (const bf16_t*)(p.ws + WS_Z); unsigned char* dob = (unsigned char*)p.out;
    const bf16_t* kd = (const bf16_t*)(dob + DO_KD); const bf16_t* vdT = (const bf16_t*)(dob + DO_VDT);
    bf16_t* odsa = (bf16_t*)(p.ws + WS_ODSA);
    u32* mk = (u32*)(lds + ATT_MK_OFF);
    for (int ps = blockIdx.x; ps < 256; ps += gridDim.x)
    for (int which = 0; which < 2; ++which) {
        const int b = ps >> 5, jj = ps & 31, qb = which ? 63 - jj : jj;
        const int tok0 = b * SEQ + qb * 32;
        int tid = threadIdx.x; asm volatile("" : "+v"(tid));
        const int lane = tid & 63, w = __builtin_amdgcn_readfirstlane(tid >> 6), c = lane & 31, hl = lane >> 5;
        for (int rep_a = 0; rep_a < (PROBE_STAGE == 21 ? 2 : 1); ++rep_a)
        {
            const int r = c; const int qq_r = ((r >> 2) & 1) * 2 + (r >> 4), head_r = ((r >> 3) & 1) * 4 + (r & 3);
            bf16x8 afr[4];
#pragma unroll
            for (int kk = 0; kk < 4; ++kk) afr[kk] = ld8(Z + (size_t)(tok0 + 4 * w + qq_r) * NZ + ZC_QI + head_r * 64 + 16 * kk + 8 * hl);
            float wv[2][8]; int posq[2];
#pragma unroll
            for (int s = 0; s < 2; ++s) { posq[s] = qb * 32 + 4 * w + 2 * hl + s;
                const uint4 ww = *(const uint4*)(Z + (size_t)(tok0 + 4 * w + 2 * hl + s) * NZ + ZC_WI);
                wv[s][0] = bflo(ww.x) * 0.35355339059327373f; wv[s][1] = bfhi(ww.x) * 0.35355339059327373f; wv[s][2] = bflo(ww.y) * 0.35355339059327373f; wv[s][3] = bfhi(ww.y) * 0.35355339059327373f;
                wv[s][4] = bflo(ww.z) * 0.35355339059327373f; wv[s][5] = bfhi(ww.z) * 0.35355339059327373f; wv[s][6] = bflo(ww.w) * 0.35355339059327373f; wv[s][7] = bfhi(ww.w) * 0.35355339059327373f; }
            u32 key[64][2];
            const bf16_t* kib = Z + (size_t)(b * SEQ) * NZ + ZC_KI;
            uint4 rk[4];
            __syncthreads();
            sk_gload<8>(rk, kib, (size_t)NZ, 0, qb, tid); sk_lwrite<8>(rk, sm, tid);
            if (qb >= 8) sk_gload<8>(rk, kib, (size_t)NZ, 8, qb, tid);
#pragma unroll
            for (int ch = 0; ch < 8; ++ch) {
                if (ch * 8 <= qb) {
                    __syncthreads();
                    if ((ch + 1) * 8 <= qb) { sk_lwrite<8>(rk, sm + ((ch + 1) & 1) * ATT_CHUNK, tid);
                        if ((ch + 2) * 8 <= qb) sk_gload<8>(rk, kib, (size_t)NZ, (ch + 2) * 8, qb, tid); }
                    const LAS unsigned char* cb = sm + (ch & 1) * ATT_CHUNK;
#pragma unroll
                    for (int i = 0; i < 8; ++i) { const int kt = ch * 8 + i;
                        if (kt <= qb) {
                            f32x16 acc = zero16();
#pragma unroll
                            for (int kk = 0; kk < 4; ++kk) acc = MFMA32(afr[kk], lds_k(cb + i * TILE_B, c, hl, kk), acc);
#pragma unroll
                            for (int s = 0; s < 2; ++s) { float sc = 0.f;
#pragma unroll
                                for (int e = 0; e < 8; ++e) sc = fmaf(wv[s][e], fmaxf(acc[8 * s + e], 0.f), sc);
                                key[kt][s] = (c <= posq[s] - kt * 32) ? (ordf(sc) >> 1) : 0u; }
                        } else { key[kt][0] = 0u; key[kt][1] = 0u; }
                        __builtin_amdgcn_sched_barrier(0);
                    }
                } else {
#pragma unroll
                    for (int i = 0; i < 8; ++i) { key[ch * 8 + i][0] = 0u; key[ch * 8 + i][1] = 0u; }
                }
            }
            u32 lo[2], hi[2], thr[2]; bool done[2], exact[2];
            for (int rep_bis = 0; rep_bis < (PROBE_STAGE == 23 ? 2 : 1); ++rep_bis) {
#pragma unroll
            for (int s = 0; s < 2; ++s) { lo[s] = 0x00400000u; hi[s] = 0x7FC00000u; thr[s] = 1u; exact[s] = true; done[s] = posq[s] < 256; }
            for (int iter = 0; iter < 40; ++iter) {
                if (__all(done[0] && done[1])) break;
                u32 mid[2]; int cnt[2];
#pragma unroll
                for (int s = 0; s < 2; ++s) { mid[s] = lo[s] + ((hi[s] - lo[s]) >> 1); cnt[s] = 0; }
                {
                    int a0 = 0, a1 = 0, a2 = 0, a3 = 0, b0 = 0, b1 = 0, b2 = 0, b3 = 0;
#pragma unroll
                    for (int kt = 0; kt < 64; kt += 4) {
                        a0 += (int)(key[kt][0] - mid[0]) >> 31; a1 += (int)(key[kt + 1][0] - mid[0]) >> 31; a2 += (int)(key[kt + 2][0] - mid[0]) >> 31; a3 += (int)(key[kt + 3][0] - mid[0]) >> 31;
                        b0 += (int)(key[kt][1] - mid[1]) >> 31; b1 += (int)(key[kt + 1][1] - mid[1]) >> 31; b2 += (int)(key[kt + 2][1] - mid[1]) >> 31; b3 += (int)(key[kt + 3][1] - mid[1]) >> 31; }
                    cnt[0] = 64 + ((a0 + a1) + (a2 + a3)); cnt[1] = 64 + ((b0 + b1) + (b2 + b3)); }
#pragma unroll
                for (int s = 0; s < 2; ++s) {
                    HALF_SUM32(cnt[s], hl, cnt[s]);
                    if (!done[s]) { if (cnt[s] >= 256) lo[s] = mid[s]; else hi[s] = mid[s];
                        if (cnt[s] == 256) { thr[s] = mid[s]; exact[s] = true; done[s] = true; }
                        else if (hi[s] - lo[s] <= 1u) { thr[s] = lo[s]; exact[s] = false; done[s] = true; } } }
            }
            }
            for (int rep_em = 0; rep_em < (PROBE_STAGE == 25 ? 2 : 1); ++rep_em)
            if (__all(exact[0] && exact[1])) {
#pragma unroll
                for (int kt = 0; kt < 64; ++kt) if (kt <= qb) {
#pragma unroll
                    for (int s = 0; s < 2; ++s) { const unsigned long long bal = __ballot(key[kt][s] >= thr[s]);
                        if (lane == 0) { mk[(4 * w + s) * 65 + kt] = (u32)bal; mk[(4 * w + 2 + s) * 65 + kt] = (u32)(bal >> 32); } } }
            } else {
#pragma unroll
                for (int s = 0; s < 2; ++s) {
                    int cgt = 0; const u32 lowk = exact[s] ? thr[s] : thr[s] + 1u;
#pragma unroll
                    for (int kt = 0; kt < 64; ++kt) cgt += (key[kt][s] >= lowk) ? 1 : 0;
                    HALF_SUM32(cgt, hl, cgt);
                    const int need = exact[s] ? 0 : 256 - cgt;
                    int rem0 = __shfl(need, 0), rem1 = __shfl(need, 32);
                    const u32 eqk = exact[s] ? 0xFFFFFFFFu : thr[s];
#pragma unroll
                    for (int kt = 0; kt < 64; ++kt) if (kt <= qb) {
                        const unsigned long long bg = __ballot(key[kt][s] >= lowk), be = __ballot(key[kt][s] == eqk);
                        u32 e0 = (u32)be, e1 = (u32)(be >> 32);
                        while (__popc(e0) > rem0) e0 &= ~(1u << (31 - __clz(e0)));
                        while (__popc(e1) > rem1) e1 &= ~(1u << (31 - __clz(e1)));
                        rem0 -= __popc(e0); rem1 -= __popc(e1);
                        if (lane == 0) { mk[(4 * w + s) * 65 + kt] = (u32)bg | e0; mk[(4 * w + 2 + s) * 65 + kt] = (u32)(bg >> 32) | e1; } }
                }
            }
        }
        for (int rep_b = 0; rep_b < (PROBE_STAGE == 22 ? 2 : 1); ++rep_b)
        {
            bf16x8 qfr[4];
#pragma unroll
            for (int kk = 0; kk < 4; ++kk) qfr[kk] = ld8(Z + (size_t)(tok0 + c) * NZ + ZC_QD + w * 64 + 16 * kk + 8 * hl);
            float m = -1e30f, l = 0.f; f32x16 o0 = zero16(), o1 = zero16();
            ATT_STREAM_KV(kd + (size_t)(b * SEQ) * 64, (size_t)64, vdT + (size_t)b * 64 * SEQ, (size_t)SEQ, 0, qb, {
                const u32 word = mk[c * 65 + tg];
                if (__ballot(word != 0u) != 0ull) {
                    f32x16 s = zero16();
                    _Pragma("unroll") for (int kk = 0; kk < 4; ++kk) s = MFMA32(lds_k(kt, c, hl, kk), qfr[kk], s);
                    flash_tile_lds(m, l, o0, o1, s, vm_from_word(word, hl), false, vt, c, hl); } });
            const float f = 1.0f / fmaxf(l, 1e-30f);
#pragma unroll
            for (int R = 0; R < 16; ++R) { o0[R] *= f; o1[R] *= f; }
            store_ot(odsa + (size_t)(tok0 + c) * 512 + w * 64, o0, o1, hl);
        }
    }
    __syncthreads();
}

typedef __bf16 v2bf_t __attribute__((ext_vector_type(2)));
__device__ __forceinline__ float dot2bf(u32 a, u32 b, float c) { return __builtin_amdgcn_fdot2_f32_bf16(__builtin_bit_cast(v2bf_t, a), __builtin_bit_cast(v2bf_t, b), c, false); }
__device__ __forceinline__ float dpp_hmirror(float v) { return __int_as_float(__builtin_amdgcn_update_dpp(0, __float_as_int(v), 0x141, 0xF, 0xF, true)); }
__device__ __forceinline__ void st_expert2(const Params& p, unsigned char* lds) {
    int tid = threadIdx.x; asm volatile("" : "+v"(tid));
    const int lane = tid & 63, w = __builtin_amdgcn_readfirstlane(tid >> 6), rs = lane >> 3, ch = lane & 7;
    const bf16_t* h2 = (const bf16_t*)(p.ws + WS_H2); const bf16_t* u16 = (const bf16_t*)(p.ws + WS_U16); const bf16_t* v16 = (const bf16_t*)(p.ws + WS_V16);
    const int* eidx = (const int*)(p.ws + WS_EIDX); const float* gate = (const float*)(p.ws + WS_GATE); const float* mod = (const float*)(p.ws + WS_MOD);
    float* wl = (float*)lds + w * 256;
    int* el = (int*)(wl + 128);
    for (int t = blockIdx.x * 8 + w; t < T; t += gridDim.x * 8) {
        u32x4 xq[16];
#pragma unroll
        for (int i = 0; i < 16; ++i) xq[i] = *(const u32x4*)(h2 + (size_t)t * D + (ch + 8 * i) * 8);
        { const int e0 = eidx[(size_t)t * 128 + lane], e1 = eidx[(size_t)t * 128 + 64 + lane]; el[lane] = e0; el[64 + lane] = e1; }
#pragma unroll
        for (int rg = 0; rg < 16; ++rg) {
            const int e = eidx[(size_t)t * 128 + 8 * rg + rs]; const float gt = gate[(size_t)t * 128 + 8 * rg + rs];
            const bf16_t* ur = u16 + (size_t)e * D + ch * 8;
            float s0 = 0.f, s1 = 0.f;
#pragma unroll
            for (int i = 0; i < 16; ++i) { const u32x4 uv = *(const u32x4*)(ur + 64 * i);
                s0 = dot2bf(uv.x, xq[i].x, s0); s1 = dot2bf(uv.y, xq[i].y, s1); s0 = dot2bf(uv.z, xq[i].z, s0); s1 = dot2bf(uv.w, xq[i].w, s1); }
            float s = s0 + s1; s += dpp_hmirror(s); s += dpp_xor1(s); s += dpp_xor2(s);
            if (ch == 0) wl[8 * rg + rs] = gt * gelu_erf(s);
        }
        asm volatile("s_waitcnt lgkmcnt(0)" ::: "memory");
        float acc[16];
#pragma unroll
        for (int i = 0; i < 16; ++i) acc[i] = 0.f;
        for (int k0 = 0; k0 < 128; k0 += 8) {
            u32x4 va[8], vb[8]; float wk[8];
#pragma unroll
            for (int j = 0; j < 8; ++j) { const int e = __builtin_amdgcn_readfirstlane(el[k0 + j]); wk[j] = wl[k0 + j];
                const bf16_t* vr = v16 + (size_t)e * D + lane * 8; va[j] = *(const u32x4*)vr; vb[j] = *(const u32x4*)(vr + 512); }
#pragma unroll
            for (int j = 0; j < 8; ++j) {
                acc[0] += wk[j] * bflo(va[j].x); acc[1] += wk[j] * bfhi(va[j].x); acc[2] += wk[j] * bflo(va[j].y); acc[3] += wk[j] * bfhi(va[j].y);
                acc[4] += wk[j] * bflo(va[j].z); acc[5] += wk[j] * bfhi(va[j].z); acc[6] += wk[j] * bflo(va[j].w); acc[7] += wk[j] * bfhi(va[j].w);
                acc[8] += wk[j] * bflo(vb[j].x); acc[9] += wk[j] * bfhi(vb[j].x); acc[10] += wk[j] * bflo(vb[j].y); acc[11] += wk[j] * bfhi(vb[j].y);
                acc[12] += wk[j] * bflo(vb[j].z); acc[13] += wk[j] * bfhi(vb[j].z); acc[14] += wk[j] * bflo(vb[j].w); acc[15] += wk[j] * bfhi(vb[j].w); }
        }
        const float* g2 = mod + (t >> 11) * 6144 + 5120; float* xr = p.out + (size_t)t * D; float ss = 0.f;
#pragma unroll
        for (int hlf = 0; hlf < 2; ++hlf)
#pragma unroll
            for (int q = 0; q < 2; ++q) { const int d0 = hlf * 512 + lane * 8 + 4 * q; const float4 xv = *(const float4*)(xr + d0), gv = *(const float4*)(g2 + d0);
                float* a = acc + hlf * 8 + 4 * q; a[0] = xv.x + gv.x * a[0]; a[1] = xv.y + gv.y * a[1]; a[2] = xv.z + gv.z * a[2]; a[3] = xv.w + gv.w * a[3];
                ss += a[0] * a[0] + a[1] * a[1] + a[2] * a[2] + a[3] * a[3]; }
        const float r = rsqrtf(wave_sum(ss) * (1.0f / D) + EPS);
#pragma unroll
        for (int hlf = 0; hlf < 2; ++hlf)
#pragma unroll
            for (int q = 0; q < 2; ++q) { const int d0 = hlf * 512 + lane * 8 + 4 * q; const float4 fg = *(const float4*)(p.final_g + d0); const float* a = acc + hlf * 8 + 4 * q;
                float4 o; o.x = a[0] * r * fg.x; o.y = a[1] * r * fg.y; o.z = a[2] * r * fg.z; o.w = a[3] * r * fg.w; *(float4*)(xr + d0) = o; }
        asm volatile("s_waitcnt lgkmcnt(0)" ::: "memory");
    }
}

namespace pg8 {
typedef short bf16x8 __attribute__((ext_vector_type(8)));
typedef float f32x4 __attribute__((ext_vector_type(4)));
typedef unsigned u32x4 __attribute__((ext_vector_type(4)));
constexpr int BM = 256, BK = 64, HALF = 128, HTB = HALF * BK * 2, STAGE_BYTES = 8 * HTB, NXCD = 8, WGM = 8;
__host__ __device__ __forceinline__ int lds_byte(int r, int c) { const int st = (r >> 4) * 2 + (c >> 5), rr = r & 15, cc = c & 31, ob = rr * 64 + cc * 2; return st * 1024 + (ob ^ (((ob >> 9) & 1) << 5)); }
__host__ __device__ __forceinline__ void stage_rc(int b, int& R, int& C) { const int st = b / 1024, sb = b % 1024, swz = sb ^ (((sb >> 9) & 1) << 5); R = (st >> 1) * 16 + swz / 64; C = (st & 1) * 32 + (swz % 64) / 2; }
__host__ __device__ __forceinline__ int perm32(int rho) { const int n = rho >> 4, i = rho & 15; return 8 * (i >> 2) + 4 * n + (i & 3); }
struct Unit { int pm, pn; };
struct Gemm { const bf16_t* A; const bf16_t* Bt; int M, N, K; };
struct StaticOrder {
    int nM, nN, nwg, G, c;
    __host__ __device__ void init(int M, int N, int G_, int c_) { nM = M / BM; nN = N / BM; nwg = nM * nN; G = G_; c = c_; }
    __host__ __device__ bool next(int i, Unit& u) const {
        const long L = (long)i * G + c; if (L >= nwg) return false;
        int wgid = (int)L; { const int q = nwg / NXCD, r = nwg % NXCD, xcd = wgid % NXCD, off = wgid / NXCD; wgid = (xcd < r ? xcd * (q + 1) : r * (q + 1) + (xcd - r) * q) + off; }
        const int nig = WGM * nN, gid = wgid / nig, fm = gid * WGM, gsz = (nM - fm) < WGM ? (nM - fm) : WGM;
        u.pm = fm + ((wgid % nig) % gsz); u.pn = (wgid % nig) / gsz; return true;
    }
    __device__ __forceinline__ void a_ready(const Unit&) const {}
    __device__ __forceinline__ void done(const Unit&) const {}
};
__device__ __forceinline__ unsigned cvt_pk_bf16(float lo, float hi) { unsigned r; asm volatile("v_cvt_pk_bf16_f32 %0, %1, %2" : "=v"(r) : "v"(lo), "v"(hi)); return r; }

template <class Epi, class Sched, bool ALIGN_EPI = false, bool SP2 = false>
__device__ __forceinline__ void gemm_phase(LAS unsigned char* lds, const Gemm g, const Sched& S, const Epi& E) {
    int tid = threadIdx.x; asm volatile("" : "+v"(tid));
    const int wid = __builtin_amdgcn_readfirstlane(tid >> 6), lane = tid & 63, wr = wid >> 2, wc = wid & 3, fr = lane & 15, fq = lane >> 4;
    const int K = g.K, nt = K / BK;
    unsigned voffA[2], voffB[2];
#pragma unroll
    for (int i = 0; i < 2; ++i) { int R, C; stage_rc(tid * 16 + i * 8192, R, C); const int Rb = Epi::PERM ? ((R & ~31) + perm32(R & 31)) : R;
        voffA[i] = (unsigned)(R * K + C) * 2u; voffB[i] = (unsigned)(Rb * K + C) * 2u; }
    const size_t kstep = (size_t)(BK * 2);
    const size_t hstep = (size_t)HALF * K * 2;
    const size_t tstep = 2 * hstep;
    const unsigned ldsw = (unsigned)wid * 1024u;
    const int aoff = lds_byte(wr * 64 + fr, fq * 8), boff = lds_byte(wc * 32 + fr, fq * 8);
#define PG8_SA(b, h) (((b) * 2 + (h)) * HTB)
#define PG8_SB(b, h) ((4 + (b) * 2 + (h)) * HTB)
#define PG8_STAGE(bufoff, gbase, voff) do { _Pragma("unroll") for (int _i = 0; _i < 2; ++_i) \
        __builtin_amdgcn_global_load_lds((const unsigned*)((const char*)(gbase) + (voff)[_i]), (LAS unsigned*)(lds + (bufoff) + ldsw + _i * 8192), 16, 0, 0); } while (0)
#define PG8_LDA(dst, b, h) do { _Pragma("unroll") for (int m = 0; m < 4; ++m) _Pragma("unroll") for (int k = 0; k < 2; ++k) dst[m][k] = *(const LAS bf16x8*)(lds + PG8_SA(b, h) + aoff + m * 2048 + k * 1024); } while (0)
#define PG8_LDB(dst, b, h) do { _Pragma("unroll") for (int n = 0; n < 2; ++n) _Pragma("unroll") for (int k = 0; k < 2; ++k) dst[n][k] = *(const LAS bf16x8*)(lds + PG8_SB(b, h) + boff + n * 2048 + k * 1024); } while (0)
#define PG8_MMA(ai, bj, At, Bt) do { __builtin_amdgcn_s_setprio(1); _Pragma("unroll") for (int m = 0; m < 4; ++m) _Pragma("unroll") for (int n = 0; n < 2; ++n) _Pragma("unroll") for (int k = 0; k < 2; ++k) \
        acc[ai][bj][m][n] = __builtin_amdgcn_mfma_f32_16x16x32_bf16(Bt[n][k], At[m][k], acc[ai][bj][m][n], 0, 0, 0); __builtin_amdgcn_s_setprio(0); } while (0)
#define PG8_WAIT_V(n) asm volatile("s_waitcnt vmcnt(" #n ")" ::: "memory")
#define PG8_WAIT_L(n) asm volatile("s_waitcnt lgkmcnt(" #n ")" ::: "memory")
#define PG8_BAR __builtin_amdgcn_s_barrier()
#define PG8_SCHED __builtin_amdgcn_sched_barrier(0)
    Unit cur, nxt; int ui = 0;
    if (!S.next(0, cur)) return;
    f32x4 acc[2][2][4][2];
#pragma unroll
    for (int a = 0; a < 2; ++a)
#pragma unroll
        for (int b = 0; b < 2; ++b)
#pragma unroll
            for (int m = 0; m < 4; ++m)
#pragma unroll
                for (int n = 0; n < 2; ++n) acc[a][b][m][n] = (f32x4){0.f, 0.f, 0.f, 0.f};
    bf16x8 At[4][2], B0[2][2], B1[2][2];
    const char* cA = (const char*)g.A + (size_t)cur.pm * tstep; const char* cB = (const char*)g.Bt + (size_t)cur.pn * tstep;
    S.a_ready(cur);
    if constexpr (SP2) {
        PG8_STAGE(PG8_SB(0, 0), cB, voffB); PG8_STAGE(PG8_SB(0, 1), cB + hstep, voffB); PG8_STAGE(PG8_SA(0, 0), cA, voffA); PG8_STAGE(PG8_SA(0, 1), cA + hstep, voffA);
        if (wr == 1) PG8_BAR;
        PG8_WAIT_V(2); PG8_BAR;
        PG8_STAGE(PG8_SB(1, 0), cB + kstep, voffB); PG8_STAGE(PG8_SA(1, 0), cA + kstep, voffA); PG8_STAGE(PG8_SB(1, 1), cB + hstep + kstep, voffB);
        PG8_WAIT_V(6); PG8_BAR;
    } else {
        PG8_STAGE(PG8_SB(0, 0), cB, voffB); PG8_STAGE(PG8_SA(0, 0), cA, voffA); PG8_STAGE(PG8_SB(0, 1), cB + hstep, voffB); PG8_STAGE(PG8_SA(0, 1), cA + hstep, voffA);
        if (wr == 1) PG8_BAR;
        PG8_WAIT_V(4); PG8_BAR;
        PG8_STAGE(PG8_SB(1, 0), cB + kstep, voffB); PG8_STAGE(PG8_SA(1, 0), cA + kstep, voffA); PG8_STAGE(PG8_SB(1, 1), cB + hstep + kstep, voffB);
        PG8_WAIT_V(6); PG8_BAR;
    }
    for (;;) {
        const bool has_next = S.next(ui + 1, nxt);
        const char* nA = has_next ? (const char*)g.A + (size_t)nxt.pm * tstep : cA; const char* nB = has_next ? (const char*)g.Bt + (size_t)nxt.pn * tstep : cB;
        for (int t = 0; t < nt; t += 2) {
            const bool last = (t == nt - 2);
            const char* a1 = cA + (size_t)(t + 1) * kstep;
            const char* a2 = last ? nA : cA + (size_t)(t + 2) * kstep; const char* b2 = last ? nB : cB + (size_t)(t + 2) * kstep;
            const char* a3 = a2 + kstep; const char* b3 = b2 + kstep;
            if (last && has_next) S.a_ready(nxt);
            if constexpr (SP2) {
            PG8_LDB(B0, 0, 0); PG8_LDB(B1, 0, 1); PG8_SCHED; PG8_LDA(At, 0, 0); PG8_STAGE(PG8_SA(1, 1), a1 + hstep, voffA);
            PG8_WAIT_V(8); PG8_WAIT_L(0); PG8_BAR; PG8_MMA(0, 0, At, B0); PG8_MMA(0, 1, At, B1); PG8_BAR; PG8_SCHED;
            PG8_LDA(At, 0, 1); PG8_STAGE(PG8_SB(0, 0), b2, voffB); PG8_STAGE(PG8_SB(0, 1), b2 + hstep, voffB); PG8_STAGE(PG8_SA(0, 0), a2, voffA);
            PG8_WAIT_V(8); PG8_WAIT_L(0); PG8_BAR; PG8_MMA(1, 0, At, B0); PG8_MMA(1, 1, At, B1); PG8_BAR; PG8_SCHED;
            PG8_LDB(B0, 1, 0); PG8_LDB(B1, 1, 1); PG8_SCHED; PG8_LDA(At, 1, 0); PG8_STAGE(PG8_SA(0, 1), a2 + hstep, voffA);
            PG8_WAIT_V(8); PG8_WAIT_L(0); PG8_BAR; PG8_MMA(0, 0, At, B0); PG8_MMA(0, 1, At, B1); PG8_BAR; PG8_SCHED;
            PG8_LDA(At, 1, 1); PG8_STAGE(PG8_SB(1, 0), b3, voffB); PG8_STAGE(PG8_SB(1, 1), b3 + hstep, voffB); PG8_STAGE(PG8_SA(1, 0), a3, voffA);
            PG8_WAIT_V(8); PG8_WAIT_L(0); PG8_BAR; PG8_MMA(1, 0, At, B0); PG8_MMA(1, 1, At, B1); PG8_BAR; PG8_SCHED;
            } else {
            PG8_LDB(B0, 0, 0); PG8_SCHED; PG8_LDA(At, 0, 0); PG8_STAGE(PG8_SA(1, 1), a1 + hstep, voffA);
            PG8_WAIT_L(8); PG8_BAR; PG8_WAIT_L(0); PG8_MMA(0, 0, At, B0); PG8_BAR; PG8_SCHED;
            PG8_LDB(B1, 0, 1); PG8_STAGE(PG8_SB(0, 0), b2, voffB);
            PG8_BAR; PG8_WAIT_L(0); PG8_MMA(0, 1, At, B1); PG8_BAR;
            PG8_LDA(At, 0, 1); PG8_STAGE(PG8_SA(0, 0), a2, voffA);
            PG8_BAR; PG8_WAIT_L(0); PG8_MMA(1, 0, At, B0); PG8_BAR; PG8_SCHED;
            PG8_STAGE(PG8_SB(0, 1), b2 + hstep, voffB);
            PG8_WAIT_V(6); PG8_BAR; PG8_MMA(1, 1, At, B1); PG8_BAR;
            PG8_LDB(B0, 1, 0); PG8_SCHED; PG8_LDA(At, 1, 0); PG8_STAGE(PG8_SA(0, 1), a2 + hstep, voffA);
            PG8_WAIT_L(8); PG8_BAR; PG8_WAIT_L(0); PG8_MMA(0, 0, At, B0); PG8_BAR; PG8_SCHED;
            PG8_LDB(B1, 1, 1); PG8_STAGE(PG8_SB(1, 0), b3, voffB);
            PG8_BAR; PG8_WAIT_L(0); PG8_MMA(0, 1, At, B1); PG8_BAR;
            PG8_LDA(At, 1, 1); PG8_STAGE(PG8_SA(1, 0), a3, voffA);
            PG8_BAR; PG8_WAIT_L(0); PG8_MMA(1, 0, At, B0); PG8_BAR; PG8_SCHED;
            PG8_STAGE(PG8_SB(1, 1), b3 + hstep, voffB);
            PG8_WAIT_V(6); PG8_BAR; PG8_MMA(1, 1, At, B1); PG8_BAR;
            }
        }
        if constexpr (ALIGN_EPI) { if (wr == 0) PG8_BAR; }
        if constexpr (!Epi::AFTER_DRAIN) { E(acc, cur, wr, wc, fr, fq); S.done(cur); }
        if (!has_next) break;
#pragma unroll
        for (int a = 0; a < 2; ++a)
#pragma unroll
            for (int b = 0; b < 2; ++b)
#pragma unroll
                for (int m = 0; m < 4; ++m)
#pragma unroll
                    for (int n = 0; n < 2; ++n) acc[a][b][m][n] = (f32x4){0.f, 0.f, 0.f, 0.f};
        cur = nxt; cA = nA; cB = nB; ++ui;
        if constexpr (ALIGN_EPI) { if (wr == 1) PG8_BAR; }
    }
    PG8_WAIT_V(0);
    if constexpr (!ALIGN_EPI) { if (wr == 0) PG8_BAR; }
    PG8_BAR;
#undef PG8_SA
#undef PG8_SB
#undef PG8_STAGE
#undef PG8_LDA
#undef PG8_LDB
#undef PG8_MMA
#undef PG8_WAIT_V
#undef PG8_WAIT_L
#undef PG8_BAR
#undef PG8_SCHED
}
struct EpiZ {
    static constexpr bool PERM = true, AFTER_DRAIN = false;
    bf16_t* Z; const float* cosT; const float* sinT;
    __device__ __forceinline__ void operator()(const f32x4 (&acc)[2][2][4][2], const Unit& u, int wr, int wc, int fr, int fq) const {
#pragma unroll
        for (int bj = 0; bj < 2; ++bj) {
            const int cb = u.pn * BM + bj * HALF + wc * 32;
            const int g64 = cb >> 6; const int c0 = cb + 8 * fq;
            const bool roped = (g64 < 64) && ((ROPE_MASK >> g64) & 1ull);
            const bool sig = (cb >= ZC_GM) || (c0 >= ZC_GN && c0 < ZC_WI);
            const float sc = ((g64 < 64) && ((SCALE_MASK >> g64) & 1ull)) ? 0.125f : 1.0f;
#pragma unroll
            for (int ai = 0; ai < 2; ++ai)
#pragma unroll
                for (int m = 0; m < 4; ++m) {
                    const int row = u.pm * BM + ai * HALF + wr * 64 + m * 16 + fr;
                    f32x4 v0 = acc[ai][bj][m][0], v1 = acc[ai][bj][m][1];
                    if (roped) {
                        const int pos = row & (SEQ - 1), i0 = (c0 & 63) >> 1;
                        const f32x4 cs = *(const f32x4*)(cosT + pos * 32 + i0), sn = *(const f32x4*)(sinT + pos * 32 + i0);
                        const f32x4 a = v0, b = v1;
                        v0[0] = (a[0] * cs[0] - a[1] * sn[0]) * sc; v0[1] = (a[1] * cs[0] + a[0] * sn[0]) * sc;
                        v0[2] = (a[2] * cs[1] - a[3] * sn[1]) * sc; v0[3] = (a[3] * cs[1] + a[2] * sn[1]) * sc;
                        v1[0] = (b[0] * cs[2] - b[1] * sn[2]) * sc; v1[1] = (b[1] * cs[2] + b[0] * sn[2]) * sc;
                        v1[2] = (b[2] * cs[3] - b[3] * sn[3]) * sc; v1[3] = (b[3] * cs[3] + b[2] * sn[3]) * sc;
                    } else if (sig) {
#pragma unroll
                        for (int e = 0; e < 4; ++e) { v0[e] = sigmoidf_(v0[e]); v1[e] = sigmoidf_(v1[e]); }
                    }
                    u32x4 w; w.x = cvt_pk_bf16(v0[0], v0[1]); w.y = cvt_pk_bf16(v0[2], v0[3]); w.z = cvt_pk_bf16(v1[0], v1[1]); w.w = cvt_pk_bf16(v1[2], v1[3]);
                    *(u32x4*)(Z + (size_t)row * NZ + c0) = w;
                }
        }
    }
};
struct EpiMerge {
    static constexpr bool PERM = true, AFTER_DRAIN = false;
    bf16_t* O; const bf16_t* Zg; int mode;
    __device__ __forceinline__ void operator()(const f32x4 (&acc)[2][2][4][2], const Unit& u, int wr, int wc, int fr, int fq) const {
#pragma unroll
        for (int ai = 0; ai < 2; ++ai)
#pragma unroll
            for (int m = 0; m < 4; ++m) { const int row = u.pm * BM + ai * HALF + wr * 64 + m * 16 + fr;
#pragma unroll
                for (int bj = 0; bj < 2; ++bj) { const int c0 = u.pn * BM + bj * HALF + wc * 32 + 8 * fq;
                    const u32x4 gz = *(const u32x4*)(Zg + (size_t)row * NZ + c0);
                    f32x4 v0 = acc[ai][bj][m][0], v1 = acc[ai][bj][m][1];
                    v0[0] *= bflo(gz.x); v0[1] *= bfhi(gz.x); v0[2] *= bflo(gz.y); v0[3] *= bfhi(gz.y); v1[0] *= bflo(gz.z); v1[1] *= bfhi(gz.z); v1[2] *= bflo(gz.w); v1[3] *= bfhi(gz.w);
                    bf16_t* op = O + (size_t)row * D + c0;
                    if (mode) { const u32x4 o = *(const u32x4*)op;
                        v0[0] += bflo(o.x); v0[1] += bfhi(o.x); v0[2] += bflo(o.y); v0[3] += bfhi(o.y); v1[0] += bflo(o.z); v1[1] += bfhi(o.z); v1[2] += bflo(o.w); v1[3] += bfhi(o.w); }
                    u32x4 w; w.x = cvt_pk_bf16(v0[0], v0[1]); w.y = cvt_pk_bf16(v0[2], v0[3]); w.z = cvt_pk_bf16(v1[0], v1[1]); w.w = cvt_pk_bf16(v1[2], v1[3]);
                    *(u32x4*)op = w; } }
    }
};
struct EpiOut {
    static constexpr bool PERM = true, AFTER_DRAIN = false;
    const float* x; float* o; const float* mod;
    __device__ __forceinline__ void operator()(const f32x4 (&acc)[2][2][4][2], const Unit& u, int wr, int wc, int fr, int fq) const {
#pragma unroll
        for (int ai = 0; ai < 2; ++ai)
#pragma unroll
            for (int m = 0; m < 4; ++m) { const int row = u.pm * BM + ai * HALF + wr * 64 + m * 16 + fr; const float* g1 = mod + (row >> 11) * 6144 + 2048;
#pragma unroll
                for (int bj = 0; bj < 2; ++bj) { const int c0 = u.pn * BM + bj * HALF + wc * 32 + 8 * fq;
#pragma unroll
                    for (int n = 0; n < 2; ++n) { const f32x4 gg = *(const f32x4*)(g1 + c0 + 4 * n), xx = *(const f32x4*)(x + (size_t)row * D + c0 + 4 * n);
                        *(f32x4*)(o + (size_t)row * D + c0 + 4 * n) = xx + gg * acc[ai][bj][m][n]; } } }
    }
};
struct EpiF32 {
    static constexpr bool PERM = true, AFTER_DRAIN = false;
    float* O; int ldc;
    __device__ __forceinline__ void operator()(const f32x4 (&acc)[2][2][4][2], const Unit& u, int wr, int wc, int fr, int fq) const {
#pragma unroll
        for (int ai = 0; ai < 2; ++ai)
#pragma unroll
            for (int m = 0; m < 4; ++m) { const int row = u.pm * BM + ai * HALF + wr * 64 + m * 16 + fr;
#pragma unroll
                for (int bj = 0; bj < 2; ++bj) { const int c0 = u.pn * BM + bj * HALF + wc * 32 + 8 * fq;
                    *(f32x4*)(O + (size_t)row * ldc + c0) = acc[ai][bj][m][0]; *(f32x4*)(O + (size_t)row * ldc + c0 + 4) = acc[ai][bj][m][1]; } }
    }
};
}

template <bool ZMAP>
__device__ __forceinline__ void transpose_item(const float* W, int K, int Nsrc, bf16_t* WT, LAS float* scr, int item, int nblk, int lane) {
    const int kb = item / nblk, nb = item % nblk, k0 = 64 * kb, n0 = 32 * nb;
    int sc = n0 + (lane & 31); if (ZMAP) sc = z_logical_col(sc);
#pragma unroll 8
    for (int i = 0; i < 32; ++i) { const int kk = 2 * i + (lane >> 5); scr[kk * 33 + (lane & 31)] = (sc >= 0) ? W[(size_t)(k0 + kk) * Nsrc + sc] : 0.f; }
    asm volatile("s_waitcnt lgkmcnt(0)" ::: "memory");
    const int c = lane & 7;
#pragma unroll
    for (int j = 0; j < 4; ++j) { const int n = (lane >> 3) + 8 * j; const LAS float* s = scr + (8 * c) * 33 + n;
        uint4 o; o.x = pk2(s[0 * 33], s[1 * 33]); o.y = pk2(s[2 * 33], s[3 * 33]); o.z = pk2(s[4 * 33], s[5 * 33]); o.w = pk2(s[6 * 33], s[7 * 33]);
        *(uint4*)(WT + (size_t)(n0 + n) * K + k0 + 8 * c) = o; }
    asm volatile("s_waitcnt lgkmcnt(0)" ::: "memory");
}
__device__ __forceinline__ void st_convert(const Params& p, unsigned char* lds) {
    int tid_ = threadIdx.x; asm volatile("" : "+v"(tid_)); const int tid = tid_, lane = tid & 63, w = __builtin_amdgcn_readfirstlane(tid >> 6);
    LAS float* scr = (LAS float*)((LAS unsigned char*)lds + 49152 + w * 8704);
    const int gw = blockIdx.x * 8 + w, NGW = gridDim.x * 8;
    constexpr int I_IN = 16 * 144, I_BR = 8 * 32, I_OUT = 16 * 32;
    for (int it = gw; it < I_IN + 2 * I_BR + I_OUT; it += NGW) {
        int r = it;
        if (r < I_IN) { transpose_item<true>(p.w_in, D, DIN, (bf16_t*)(p.ws + WS_WINT), scr, r, 144, lane); continue; } r -= I_IN;
        if (r < I_BR) { transpose_item<false>(p.w_nsa, 512, D, (bf16_t*)(p.ws + WS_WNSAT), scr, r, 32, lane); continue; } r -= I_BR;
        if (r < I_BR) { transpose_item<false>(p.w_dsa, 512, D, (bf16_t*)(p.ws + WS_WDSAT), scr, r, 32, lane); continue; } r -= I_BR;
        transpose_item<false>(p.w_out, D, D, (bf16_t*)(p.ws + WS_WOUTT), scr, r, 32, lane);
    }
    { bf16_t* w1t = (bf16_t*)(p.ws + WS_W1T); float* bpos = (float*)(p.ws + WS_BPOS);
      for (int it = blockIdx.x * NTHR + tid; it < 2 * 64 * 2048; it += gridDim.x * NTHR) {
          const int e = it & 63, kidx = (it >> 6) & 2047, kv = it >> 17; const int l = kidx >> 6, dp = kidx & 63; const int d = kv ? dp : ((dp >> 1) + 32 * (dp & 1));
          w1t[((size_t)kv * 64 + e) * 2048 + kidx] = f2bf((kv ? p.w1v : p.w1k)[(l * 64 + d) * 64 + e]); }
      for (int o = gw; o < 128; o += NGW) { const int kv = o >> 6, e = o & 63; const float* w1 = kv ? p.w1v : p.w1k; float s = 0.f;
          for (int i = lane; i < 2048; i += 64) s += p.cmp_pos[i] * w1[i * 64 + e];
          s = wave_sum(s); if (lane == 0) bpos[o] = s; } }
    bf16_t* wf = (bf16_t*)(p.ws + WS_WFOLDT);
    for (int it = blockIdx.x * NTHR + tid; it < 2048 * 1024 / 2; it += gridDim.x * NTHR) {
        const int k = (it & 511) * 2, col = it >> 9, hc = col >> 7;
        const float* sk = p.subkeys + (size_t)col * 64; const float* q0 = p.wq + (size_t)k * D + hc * 64; const float* q1 = q0 + D;
        float a0 = 0.f, a1 = 0.f;
#pragma unroll 8
        for (int d = 0; d < 64; d += 4) { const float4 s4 = *(const float4*)(sk + d), x0 = *(const float4*)(q0 + d), x1 = *(const float4*)(q1 + d);
            a0 += s4.x * x0.x + s4.y * x0.y + s4.z * x0.z + s4.w * x0.w; a1 += s4.x * x1.x + s4.y * x1.y + s4.z * x1.z + s4.w * x1.w; }
        *(u32*)(wf + (size_t)col * D + k) = pk2(a0, a1);
    }
}
__device__ __forceinline__ void st_z_gemm(const Params& p, unsigned char* lds) {
    pg8::Gemm g{(const bf16_t*)(p.ws + WS_HB), (const bf16_t*)(p.ws + WS_WINT), T, NZ, D}; pg8::StaticOrder S; S.init(T, NZ, gridDim.x, blockIdx.x);
    pg8::EpiZ E{(bf16_t*)(p.ws + WS_Z), (const float*)(p.ws + WS_COS), (const float*)(p.ws + WS_SIN)};
    pg8::gemm_phase<pg8::EpiZ, pg8::StaticOrder, true, true>((LAS unsigned char*)lds, g, S, E);
}
__device__ __forceinline__ void st_merge_gemm(const Params& p, unsigned char* lds) {
    pg8::StaticOrder S; S.init(T, D, gridDim.x, blockIdx.x);
    { pg8::Gemm g{(const bf16_t*)(p.ws + WS_ONSA), (const bf16_t*)(p.ws + WS_WNSAT), T, D, 512};
      pg8::EpiMerge E{(bf16_t*)(p.ws + WS_MERGED), (const bf16_t*)(p.ws + WS_Z) + ZC_GM, 0};
      pg8::gemm_phase<pg8::EpiMerge, pg8::StaticOrder, true, true>((LAS unsigned char*)lds, g, S, E); }
    asm volatile("s_waitcnt vmcnt(0)" ::: "memory"); __syncthreads();
    { pg8::Gemm g{(const bf16_t*)(p.ws + WS_ODSA), (const bf16_t*)(p.ws + WS_WDSAT), T, D, 512};
      pg8::EpiMerge E{(bf16_t*)(p.ws + WS_MERGED), (const bf16_t*)(p.ws + WS_Z) + ZC_GM + 1024, 1};
      pg8::gemm_phase<pg8::EpiMerge, pg8::StaticOrder, true, true>((LAS unsigned char*)lds, g, S, E); }
}
__device__ __forceinline__ void st_out_gemm(const Params& p, unsigned char* lds) {
    pg8::Gemm g{(const bf16_t*)(p.ws + WS_MERGED), (const bf16_t*)(p.ws + WS_WOUTT), T, D, D}; pg8::StaticOrder S; S.init(T, D, gridDim.x, blockIdx.x);
    pg8::EpiOut E{p.x, p.out, (const float*)(p.ws + WS_MOD)};
    pg8::gemm_phase<pg8::EpiOut, pg8::StaticOrder, true, true>((LAS unsigned char*)lds, g, S, E);
}
__device__ __forceinline__ void st_ssub_gemm(const Params& p, unsigned char* lds) {
    pg8::Gemm g{(const bf16_t*)(p.ws + WS_H2), (const bf16_t*)(p.ws + WS_WFOLDT), T, 2048, D}; pg8::StaticOrder S; S.init(T, 2048, gridDim.x, blockIdx.x);
    pg8::EpiF32 E{(float*)(p.ws + WS_SSUB), 2048};
    pg8::gemm_phase<pg8::EpiF32, pg8::StaticOrder, true, true>((LAS unsigned char*)lds, g, S, E);
}

typedef float f32x4_t __attribute__((ext_vector_type(4)));
__device__ __forceinline__ void st_prep(const Params& p, unsigned char* lds) {
    int tid = threadIdx.x; asm volatile("" : "+v"(tid));
    const int lane = tid & 63, w = __builtin_amdgcn_readfirstlane(tid >> 6);
    const bf16_t* Z = (const bf16_t*)(p.ws + WS_Z);
    const float* cosT = (const float*)(p.ws + WS_COS); const float* sinT = (const float*)(p.ws + WS_SIN);
    unsigned char* dob = (unsigned char*)p.out;
    bf16_t* kd = (bf16_t*)(dob + DO_KD); bf16_t* vdT = (bf16_t*)(dob + DO_VDT); bf16_t* vsT = (bf16_t*)(dob + DO_VST); bf16_t* vwT = (bf16_t*)(dob + DO_VWT);
    bf16_t* kcmp = (bf16_t*)(dob + DO_KCMP); bf16_t* vcmpT = (bf16_t*)(dob + DO_VCMPT);
    {   float* red = (float*)lds;
        float* hid = red + 8 * 16 * 64;
        const bf16_t* w1t = (const bf16_t*)(p.ws + WS_W1T); const float* bpos = (const float*)(p.ws + WS_BPOS);
        for (int u = blockIdx.x; u < 256; u += gridDim.x) {
            const int kv = u >> 7, b = (u >> 4) & 7, g = (u >> 3) & 1, n0 = (u & 7) * 16;
            const int nl = lane & 15, kq = lane >> 4; int n = n0 + nl; if (n > 126) n = 126;
            pg8::f32x4 acc[4];
#pragma unroll
            for (int ec = 0; ec < 4; ++ec) acc[ec] = (pg8::f32x4){0.f, 0.f, 0.f, 0.f};
            const bf16_t* ab = Z + (size_t)(b * SEQ + 16 * n) * NZ + (kv ? ZC_VC : ZC_KC) + g * 64 + 8 * kq;
            const bf16_t* bb = w1t + ((size_t)kv * 64 + nl) * 2048 + 8 * kq;
#pragma unroll
            for (int i = 0; i < 8; ++i) { const int kk = 8 * w + i;
                const pg8::bf16x8 a = *(const pg8::bf16x8*)(ab + (size_t)(kk >> 1) * NZ + (kk & 1) * 32);
#pragma unroll
                for (int ec = 0; ec < 4; ++ec) { const pg8::bf16x8 bv = *(const pg8::bf16x8*)(bb + (size_t)ec * 16 * 2048 + 32 * kk);
                    acc[ec] = __builtin_amdgcn_mfma_f32_16x16x32_bf16(a, bv, acc[ec], 0, 0, 0); } }
            __syncthreads();
#pragma unroll
            for (int ec = 0; ec < 4; ++ec)
#pragma unroll
                for (int r = 0; r < 4; ++r) red[(w * 16 + 4 * kq + r) * 64 + 16 * ec + nl] = acc[ec][r];
            __syncthreads();
#pragma unroll
            for (int q = 0; q < 2; ++q) { const int o = tid + 512 * q; float s = bpos[kv * 64 + (o & 63)];
#pragma unroll
                for (int ww = 0; ww < 8; ++ww) s += red[ww * 1024 + o];
                hid[o] = gelu_tanh(s); }
            __syncthreads();
            { const int nn = tid >> 5, f0 = (tid & 31) * 2; const float* w2 = kv ? p.w2v : p.w2k; float a0 = 0.f, a1 = 0.f;
              for (int e = 0; e < 64; ++e) { const float h = hid[nn * 64 + e]; const float2 ww = *(const float2*)(w2 + e * 64 + f0); a0 += h * ww.x; a1 += h * ww.y; }
              const int nglob = n0 + nn; if (nglob > 126) { a0 = 0.f; a1 = 0.f; }
              if (kv == 0) { bf16_t* o = kcmp + (((size_t)b * 2 + g) * 128 + nglob) * 64; o[2 * (f0 & 31) + (f0 >> 5)] = f2bf(a0); o[2 * ((f0 + 1) & 31) + ((f0 + 1) >> 5)] = f2bf(a1); }
              else { bf16_t* o = vcmpT + (((size_t)b * 2 + g) * 64 + f0) * 128 + nglob; o[0] = f2bf(a0); o[128] = f2bf(a1); } }
        }
        __syncthreads();
    }
    {   bf16_t* tl = (bf16_t*)lds;
        for (int it = blockIdx.x; it < 512; it += gridDim.x) {
            const int which = it & 1, tt = (it >> 1) & 31, b = it >> 6; const int t0 = b * SEQ + tt * 64;
            __syncthreads();
#pragma unroll
            for (int q = 0; q < 2; ++q) { const int idx = tid + 512 * q, tok = idx >> 4, ch = idx & 15;
                const uint4 v = *(const uint4*)(Z + (size_t)(t0 + tok) * NZ + (which ? ZC_VW : ZC_VS) + ch * 8); bf16_t* d = tl + tok * 130 + ch * 8;
                d[0] = (bf16_t)v.x; d[1] = (bf16_t)(v.x >> 16); d[2] = (bf16_t)v.y; d[3] = (bf16_t)(v.y >> 16); d[4] = (bf16_t)v.z; d[5] = (bf16_t)(v.z >> 16); d[6] = (bf16_t)v.w; d[7] = (bf16_t)(v.w >> 16); }
            __syncthreads();
#pragma unroll
            for (int q = 0; q < 2; ++q) { const int idx = tid + 512 * q, gd = idx >> 3, c8 = idx & 7; const bf16_t* s = tl + (c8 * 8) * 130 + gd;
                uint4 o; o.x = (u32)s[0] | ((u32)s[130] << 16); o.y = (u32)s[260] | ((u32)s[390] << 16); o.z = (u32)s[520] | ((u32)s[650] << 16); o.w = (u32)s[780] | ((u32)s[910] << 16);
                *(uint4*)((which ? vwT : vsT) + ((size_t)b * 128 + gd) * SEQ + tt * 64 + c8 * 8) = o; }
        }
    }
    for (int it = blockIdx.x * NTHR + tid; it < T * 32; it += gridDim.x * NTHR) {
        const int t = it >> 5, i = it & 31; const bf16_t* cr = Z + (size_t)t * NZ + ZC_CKV;
        float ss = 0.f;
#pragma unroll 4
        for (int r = 0; r < 128; r += 8) { const uint4 v = *(const uint4*)(cr + r);
            ss += bflo(v.x) * bflo(v.x) + bfhi(v.x) * bfhi(v.x) + bflo(v.y) * bflo(v.y) + bfhi(v.y) * bfhi(v.y) + bflo(v.z) * bflo(v.z) + bfhi(v.z) * bfhi(v.z) + bflo(v.w) * bflo(v.w) + bfhi(v.w) * bfhi(v.w); }
        const float rn = rsqrtf(ss * (1.0f / 128.0f) + EPS);
        float k1 = 0.f, k2 = 0.f, v1 = 0.f, v2 = 0.f;
#pragma unroll 4
        for (int r = 0; r < 128; ++r) { const float cn = bf2f(cr[r]) * rn * p.kvg[r];
            k1 += cn * p.w_uk[r * 64 + i]; k2 += cn * p.w_uk[r * 64 + i + 32]; v1 += cn * p.w_uv[r * 64 + i]; v2 += cn * p.w_uv[r * 64 + i + 32]; }
        const int pos = t & (SEQ - 1), b = t >> 11; const float c = cosT[pos * 32 + i], s = sinT[pos * 32 + i];
        *(u32*)(kd + (size_t)t * 64 + 2 * i) = pk2(k1 * c - k2 * s, k2 * c + k1 * s);
        vdT[((size_t)b * 64 + i) * SEQ + pos] = f2bf(v1); vdT[((size_t)b * 64 + i + 32) * SEQ + pos] = f2bf(v2);
    }
}

#define XB_TMO      128
#define XB_XCNT(j)  (256  + 64 * (j))
#define XB_XSUB(j)  (1280 + 64 * (j))
#define XB_XGEN(j)  (2304 + 64 * (j))
#define XB_TOP      3328
#define XB_TOPGEN   3392
#define XCD_BAR_WORDS 3456
#define XB_SPIN_CAP (1u << 22)
__device__ __forceinline__ unsigned xb_ld(unsigned* p)              { return __hip_atomic_load(p, __ATOMIC_RELAXED, __HIP_MEMORY_SCOPE_AGENT); }
__device__ __forceinline__ unsigned xb_add(unsigned* p, unsigned v) { return __hip_atomic_fetch_add(p, v, __ATOMIC_RELAXED, __HIP_MEMORY_SCOPE_AGENT); }
__device__ __forceinline__ unsigned xb_xcc_id() { return (unsigned)__builtin_amdgcn_s_getreg((3 << 11) | 20) & 0xFu; }
#define XB_SPIN(cond, bar) do { unsigned _sp = 0; while (cond) { __builtin_amdgcn_s_sleep(1); \
    if ((++_sp & 255u) == 0u) { if (xb_ld(&(bar)[XB_TMO])) break; if (_sp > XB_SPIN_CAP) { atomicAdd(&(bar)[XB_TMO], 1u); break; } } } } while (0)
struct XcdBarrier { unsigned* bar; unsigned x; volatile LAS unsigned* st; };
__device__ __forceinline__ XcdBarrier xcd_barrier_post(unsigned* bar, volatile LAS unsigned* st) {
    XcdBarrier b; b.bar = bar; b.x = xb_xcc_id(); b.st = st;
    if (threadIdx.x == 0) (void)xb_add(&bar[XB_XCNT(b.x)], 1u);
    return b;
}
__device__ __forceinline__ void xcd_barrier_complete(unsigned* bar, unsigned x, unsigned& nloc, unsigned& nx) {
    const unsigned G = gridDim.x * gridDim.y * gridDim.z;
    unsigned sum, cnt, mine, sp = 0u;
    for (;;) {
        sum = 0u; cnt = 0u; mine = 0u;
#pragma unroll
        for (unsigned j = 0; j < 16; ++j) { const unsigned c = xb_ld(&bar[XB_XCNT(j)]); sum += c; cnt += (c > 0u) ? 1u : 0u; mine = (j == x) ? c : mine; }
        if (sum == G) break;
        __builtin_amdgcn_s_sleep(1);
        if ((++sp & 255u) == 0u) { if (xb_ld(&bar[XB_TMO])) break; if (sp > XB_SPIN_CAP) { atomicAdd(&bar[XB_TMO], 1u); break; } }
    }
    nloc = mine > 0u ? mine : 1u; nx = cnt > 0u ? cnt : 1u;
}
__device__ __forceinline__ void xcd_barrier(const XcdBarrier& b) {
    asm volatile("s_waitcnt vmcnt(0)" ::: "memory");
    __syncthreads();
    if (threadIdx.x == 0) {
        unsigned* bar = b.bar;
        __builtin_amdgcn_s_waitcnt(0);
        unsigned nloc = b.st[0], nx = b.st[1];
        if (nloc == 0u) { xcd_barrier_complete(bar, b.x, nloc, nx); b.st[0] = nloc; b.st[1] = nx; }
        const unsigned old = xb_add(&bar[XB_XSUB(b.x)], 1u);
        const unsigned gen = old / nloc;
        if (old + 1u == (gen + 1u) * nloc) {
            __builtin_amdgcn_fence(__ATOMIC_RELEASE, "agent");
            asm volatile("s_waitcnt vmcnt(0)" ::: "memory");
            const unsigned og = xb_add(&bar[XB_TOP], 1u);
            const unsigned tg = og / nx;
            if (og + 1u == (tg + 1u) * nx) xb_add(&bar[XB_TOPGEN], 1u);
            else XB_SPIN(xb_ld(&bar[XB_TOPGEN]) == tg, bar);
            __builtin_amdgcn_fence(__ATOMIC_ACQUIRE, "agent");
            xb_add(&bar[XB_XGEN(b.x)], 1u);
            asm volatile("s_waitcnt vmcnt(0)" ::: "memory");
        } else {
            XB_SPIN(xb_ld(&bar[XB_XGEN(b.x)]) == gen, bar);
            __builtin_amdgcn_fence(__ATOMIC_ACQUIRE, "agent");
            asm volatile("s_waitcnt vmcnt(0)" ::: "memory");
        }
    }
    __syncthreads();
}

#define XB_XRANK(j) (3520 + 16 * (j))
struct XccInfo { int pi, nxp, rank, nloc; };
__device__ __forceinline__ XccInfo xcc_info(const Params& p, int rank, unsigned x) {
    unsigned* bar = (unsigned*)(p.ws + WS_BAR); XccInfo r; r.rank = rank; r.pi = 0; r.nxp = 0; r.nloc = 1;
#pragma unroll
    for (unsigned j = 0; j < 16; ++j) { const unsigned cj = xb_ld(&bar[XB_XRANK(j)]); if (j == x) { r.pi = r.nxp; r.nloc = (int)cj; } r.nxp += (cj > 0u) ? 1 : 0; }
    if (r.nxp < 1) r.nxp = 1; if (r.nloc < 1) r.nloc = 1;
    return r;
}
__device__ __forceinline__ void st_expert_u(const Params& p, unsigned char* lds, const XccInfo xi) {
    int tid_ = threadIdx.x; asm volatile("" : "+v"(tid_)); const int tid = tid_;
    const int lane = tid & 63, w = __builtin_amdgcn_readfirstlane(tid >> 6), rs = lane >> 3, ch = lane & 7;
    const bf16_t* h2 = (const bf16_t*)(p.ws + WS_H2); const bf16_t* u16 = (const bf16_t*)(p.ws + WS_U16);
    const int* eidx = (const int*)(p.ws + WS_EIDX); float* gate = (float*)(p.ws + WS_GATE);
    int* lst = (int*)lds + w * 256;
    const int wid = xi.rank * 8 + w, nw = xi.nloc * 8;
    for (int s = xi.pi; s < 16; s += xi.nxp) {
        for (int t = wid; t < T; t += nw) {
            const int e0 = eidx[(size_t)t * 128 + lane], e1 = eidx[(size_t)t * 128 + 64 + lane];
            const bool b0 = (e0 >> 10) == s, b1 = (e1 >> 10) == s;
            const unsigned long long m0 = __ballot(b0), m1 = __ballot(b1);
            const int n0 = __popcll(m0), n = n0 + __popcll(m1);
            if (n == 0) continue;
            const int p0 = __builtin_amdgcn_mbcnt_hi((unsigned)(m0 >> 32), __builtin_amdgcn_mbcnt_lo((unsigned)m0, 0));
            const int p1 = n0 + __builtin_amdgcn_mbcnt_hi((unsigned)(m1 >> 32), __builtin_amdgcn_mbcnt_lo((unsigned)m1, 0));
            if (b0) { lst[p0] = e0; lst[128 + p0] = lane; }
            if (b1) { lst[p1] = e1; lst[128 + p1] = 64 + lane; }
            u32x4 xq[16];
#pragma unroll
            for (int i = 0; i < 16; ++i) xq[i] = *(const u32x4*)(h2 + (size_t)t * D + (ch + 8 * i) * 8);
            asm volatile("s_waitcnt lgkmcnt(0)" ::: "memory");
            for (int g0 = 0; g0 < n; g0 += 8) {
                const int idx = g0 + rs; const bool valid = idx < n; const int ii = valid ? idx : n - 1;
                const int e = lst[ii], k = lst[128 + ii];
                const bf16_t* ur = u16 + (size_t)e * D + ch * 8;
                float s0 = 0.f, s1 = 0.f;
#pragma unroll
                for (int i = 0; i < 16; ++i) { const u32x4 uv = *(const u32x4*)(ur + 64 * i);
                    s0 = dot2bf(uv.x, xq[i].x, s0); s1 = dot2bf(uv.y, xq[i].y, s1); s0 = dot2bf(uv.z, xq[i].z, s0); s1 = dot2bf(uv.w, xq[i].w, s1); }
                float sm_ = s0 + s1; sm_ += dpp_hmirror(sm_); sm_ += dpp_xor1(sm_); sm_ += dpp_xor2(sm_);
                if (valid && ch == 0) { float* gp = gate + (size_t)t * 128 + k; *gp = *gp * gelu_erf(sm_); }
            }
            asm volatile("s_waitcnt lgkmcnt(0)" ::: "memory");
        }
    }
}
__device__ __forceinline__ void st_expert_v(const Params& p, const XccInfo xi) {
    int tid_ = threadIdx.x; asm volatile("" : "+v"(tid_)); const int tid = tid_;
    const int lane = tid & 63, w = __builtin_amdgcn_readfirstlane(tid >> 6), rs = lane >> 3, ch = lane & 7;
    const bf16_t* v16 = (const bf16_t*)(p.ws + WS_V16);
    const int* eidx = (const int*)(p.ws + WS_EIDX); const float* wgt = (const float*)(p.ws + WS_GATE); const float* mod = (const float*)(p.ws + WS_MOD);
    const int wid = xi.rank * 8 + w, nw = xi.nloc * 8;
    for (int cs = xi.pi; cs < 16; cs += xi.nxp) {
        for (int t = wid; t < T; t += nw) {
            float acc[8];
#pragma unroll
            for (int i = 0; i < 8; ++i) acc[i] = 0.f;
            const bf16_t* vb = v16 + cs * 64 + ch * 8;
#pragma unroll
            for (int g = 0; g < 16; ++g) { const int k = 8 * g + rs; const int e = eidx[(size_t)t * 128 + k]; const float wk = wgt[(size_t)t * 128 + k];
                const u32x4 v = *(const u32x4*)(vb + (size_t)e * D);
                acc[0] += wk * bflo(v.x); acc[1] += wk * bfhi(v.x); acc[2] += wk * bflo(v.y); acc[3] += wk * bfhi(v.y);
                acc[4] += wk * bflo(v.z); acc[5] += wk * bfhi(v.z); acc[6] += wk * bflo(v.w); acc[7] += wk * bfhi(v.w); }
#pragma unroll
            for (int i = 0; i < 8; ++i) { acc[i] += __shfl_xor(acc[i], 8); acc[i] += __shfl_xor(acc[i], 16); acc[i] += __shfl_xor(acc[i], 32); }
            if (rs == 0) { const int d0 = cs * 64 + ch * 8; float* xr = p.out + (size_t)t * D + d0; const float* g2 = mod + (t >> 11) * 6144 + 5120 + d0;
                const float4 x0 = *(const float4*)xr, x1 = *(const float4*)(xr + 4), ga = *(const float4*)g2, gb = *(const float4*)(g2 + 4);
                float4 o0, o1; o0.x = x0.x + ga.x * acc[0]; o0.y = x0.y + ga.y * acc[1]; o0.z = x0.z + ga.z * acc[2]; o0.w = x0.w + ga.w * acc[3];
                o1.x = x1.x + gb.x * acc[4]; o1.y = x1.y + gb.y * acc[5]; o1.z = x1.z + gb.z * acc[6]; o1.w = x1.w + gb.w * acc[7];
                *(float4*)xr = o0; *(float4*)(xr + 4) = o1; }
        }
    }
}
__device__ __forceinline__ void st_final_norm(const Params& p) {
    int tid_ = threadIdx.x; asm volatile("" : "+v"(tid_)); const int tid = tid_;
    const int lane = tid & 63, w = tid >> 6;
    for (int t = blockIdx.x * 8 + w; t < T; t += gridDim.x * 8) {
        float4* xr = (float4*)(p.out + (size_t)t * D);
        float4 v[4]; float ss = 0.f;
#pragma unroll
        for (int j = 0; j < 4; ++j) { v[j] = xr[lane + 64 * j]; ss += v[j].x * v[j].x + v[j].y * v[j].y + v[j].z * v[j].z + v[j].w * v[j].w; }
        const float r = rsqrtf(wave_sum(ss) * (1.0f / D) + EPS);
#pragma unroll
        for (int j = 0; j < 4; ++j) { const float4 g = ((const float4*)p.final_g)[lane + 64 * j]; float4 o; o.x = v[j].x * r * g.x; o.y = v[j].y * r * g.y; o.z = v[j].z * r * g.z; o.w = v[j].w * r * g.w; xr[lane + 64 * j] = o; }
    }
}

constexpr int EXP_LROW = 1040;
constexpr int EXP_LWAVE = 8 * EXP_LROW;
__device__ __forceinline__ void st_expert_u2(const Params& p, unsigned char* lds, const XccInfo xi) {
    int tid_ = threadIdx.x; asm volatile("" : "+v"(tid_)); const int tid = tid_;
    const int lane = tid & 63, w = __builtin_amdgcn_readfirstlane(tid >> 6), rs = lane >> 3, ch = lane & 7;
    const bf16_t* h2 = (const bf16_t*)(p.ws + WS_H2); const bf16_t* u16 = (const bf16_t*)(p.ws + WS_U16);
    const int* eidx = (const int*)(p.ws + WS_EIDX); float* gate = (float*)(p.ws + WS_GATE);
    LAS unsigned char* lw = (LAS unsigned char*)lds + w * EXP_LWAVE;
    const int wid = xi.rank * 8 + w, nw = xi.nloc * 8;
    for (int s = xi.pi; s < 16; s += xi.nxp) {
        for (int tb = wid; tb < T / 8; tb += nw) {
            const int t0 = tb * 8;
            int ea[8], eb[8];
#pragma unroll
            for (int j = 0; j < 8; ++j) { ea[j] = eidx[(size_t)(t0 + j) * 128 + lane]; eb[j] = eidx[(size_t)(t0 + j) * 128 + 64 + lane]; }
            u32x4 xq[16];
#pragma unroll
            for (int i = 0; i < 16; ++i) xq[i] = *(const u32x4*)(h2 + (size_t)(t0 + rs) * D + (ch + 8 * i) * 8);
            int nmine = 0, nmax = 0;
#pragma unroll
            for (int j = 0; j < 8; ++j) {
                const bool b0 = (ea[j] >> 10) == s, b1 = (eb[j] >> 10) == s;
                const unsigned long long m0 = __ballot(b0), m1 = __ballot(b1);
                const int n0 = __popcll(m0), n = n0 + __popcll(m1);
                const int p0 = __builtin_amdgcn_mbcnt_hi((unsigned)(m0 >> 32), __builtin_amdgcn_mbcnt_lo((unsigned)m0, 0));
                const int p1 = n0 + __builtin_amdgcn_mbcnt_hi((unsigned)(m1 >> 32), __builtin_amdgcn_mbcnt_lo((unsigned)m1, 0));
                if (b0) { const u32x2 v = {(u32)ea[j], (u32)lane}; *(LAS u32x2*)(lw + j * EXP_LROW + p0 * 8) = v; }
                if (b1) { const u32x2 v = {(u32)eb[j], (u32)(64 + lane)}; *(LAS u32x2*)(lw + j * EXP_LROW + p1 * 8) = v; }
                nmine = (rs == j) ? n : nmine; nmax = n > nmax ? n : nmax;
            }
            asm volatile("s_waitcnt lgkmcnt(0)" ::: "memory");
            for (int j = 0; j < nmax; ++j) {
                const bool valid = j < nmine;
                u32x2 ek = *(const LAS u32x2*)(lw + rs * EXP_LROW + j * 8);
                const int e = valid ? (int)ek.x : 0;
                const bf16_t* ur = u16 + (size_t)e * D + ch * 8;
                float s0 = 0.f, s1 = 0.f;
#pragma unroll
                for (int i = 0; i < 16; ++i) { const u32x4 uv = *(const u32x4*)(ur + 64 * i);
                    s0 = dot2bf(uv.x, xq[i].x, s0); s1 = dot2bf(uv.y, xq[i].y, s1); s0 = dot2bf(uv.z, xq[i].z, s0); s1 = dot2bf(uv.w, xq[i].w, s1); }
                float sm_ = s0 + s1; sm_ += dpp_hmirror(sm_); sm_ += dpp_xor1(sm_); sm_ += dpp_xor2(sm_);
                if (valid && ch == 0) { float* gp = gate + (size_t)(t0 + rs) * 128 + (int)ek.y; *gp = *gp * gelu_erf(sm_); }
            }
            asm volatile("s_waitcnt lgkmcnt(0)" ::: "memory");
        }
    }
}
__device__ __forceinline__ void st_expert_v2(const Params& p, unsigned char* lds, const XccInfo xi) {
    int tid_ = threadIdx.x; asm volatile("" : "+v"(tid_)); const int tid = tid_;
    const int lane = tid & 63, w = __builtin_amdgcn_readfirstlane(tid >> 6), rs = lane >> 3, ch = lane & 7;
    const bf16_t* v16 = (const bf16_t*)(p.ws + WS_V16);
    const int* eidx = (const int*)(p.ws + WS_EIDX); const float* wgt = (const float*)(p.ws + WS_GATE); const float* mod = (const float*)(p.ws + WS_MOD);
    LAS unsigned char* lw = (LAS unsigned char*)lds + w * EXP_LWAVE;
    const int wid = xi.rank * 8 + w, nw = xi.nloc * 8;
    for (int cs = xi.pi; cs < 16; cs += xi.nxp) {
        const bf16_t* vb = v16 + (size_t)cs * 16384 * 64 + ch * 8;
        for (int tb = wid; tb < T / 8; tb += nw) {
            const int t0 = tb * 8;
#pragma unroll
            for (int q = 0; q < 4; ++q) { const int el = (lane + 64 * q) * 4; const int tk = el >> 7, k = el & 127;
                const uint4 ev = *(const uint4*)(eidx + (size_t)t0 * 128 + el); const float4 wv = *(const float4*)(wgt + (size_t)t0 * 128 + el);
                const u32x4 a = {ev.x, __float_as_uint(wv.x), ev.y, __float_as_uint(wv.y)}, b = {ev.z, __float_as_uint(wv.z), ev.w, __float_as_uint(wv.w)};
                *(LAS u32x4*)(lw + tk * EXP_LROW + k * 8) = a; *(LAS u32x4*)(lw + tk * EXP_LROW + k * 8 + 16) = b; }
            asm volatile("s_waitcnt lgkmcnt(0)" ::: "memory");
            float acc[8];
#pragma unroll
            for (int i = 0; i < 8; ++i) acc[i] = 0.f;
            for (int k0 = 0; k0 < 128; k0 += 16) {
                u32x4 vv[16]; float wk[16];
#pragma unroll
                for (int i = 0; i < 16; ++i) { const u32x2 ew = *(const LAS u32x2*)(lw + rs * EXP_LROW + (k0 + i) * 8); wk[i] = __uint_as_float(ew.y);
                    vv[i] = *(const u32x4*)(vb + (size_t)ew.x * 64); }
#pragma unroll
                for (int i = 0; i < 16; ++i) {
                    acc[0] += wk[i] * bflo(vv[i].x); acc[1] += wk[i] * bfhi(vv[i].x); acc[2] += wk[i] * bflo(vv[i].y); acc[3] += wk[i] * bfhi(vv[i].y);
                    acc[4] += wk[i] * bflo(vv[i].z); acc[5] += wk[i] * bfhi(vv[i].z); acc[6] += wk[i] * bflo(vv[i].w); acc[7] += wk[i] * bfhi(vv[i].w); }
            }
            { const int t = t0 + rs, d0 = cs * 64 + ch * 8; float* xr = p.out + (size_t)t * D + d0; const float* g2 = mod + (t >> 11) * 6144 + 5120 + d0;
              const float4 x0 = *(const float4*)xr, x1 = *(const float4*)(xr + 4), ga = *(const float4*)g2, gb = *(const float4*)(g2 + 4);
              float4 o0, o1; o0.x = x0.x + ga.x * acc[0]; o0.y = x0.y + ga.y * acc[1]; o0.z = x0.z + ga.z * acc[2]; o0.w = x0.w + ga.w * acc[3];
              o1.x = x1.x + gb.x * acc[4]; o1.y = x1.y + gb.y * acc[5]; o1.z = x1.z + gb.z * acc[6]; o1.w = x1.w + gb.w * acc[7];
              *(float4*)xr = o0; *(float4*)(xr + 4) = o1; }
            asm volatile("s_waitcnt lgkmcnt(0)" ::: "memory");
        }
    }
}

constexpr int LDS_BYTES = 131072 + 1024;
constexpr int LDS_CTL = 131072;
__global__ void __launch_bounds__(NTHR, 2) k_mega(Params p) {
    extern __shared__ __attribute__((aligned(16))) unsigned char smem[];
    if (threadIdx.x < 4) ((volatile LAS unsigned*)(smem + LDS_CTL))[threadIdx.x] = 0u;
    __syncthreads();
    XcdBarrier bar = xcd_barrier_post((unsigned*)(p.ws + WS_BAR), (volatile LAS unsigned*)(smem + LDS_CTL));
    if (threadIdx.x == 0) ((volatile LAS unsigned*)(smem + LDS_CTL))[2] = xb_add(&((unsigned*)(p.ws + WS_BAR))[XB_XRANK(bar.x)], 1u);
#define GBAR() xcd_barrier(bar)
#define REP(n, body) do { body; if (PROBE_STAGE == (n)) { __syncthreads(); body; } } while (0)
    REP(1, st_adaln(p, smem); st_convert(p, smem));      GBAR();
    REP(2, st_norm_rows(p, 0));       GBAR();
    REP(3, st_z_gemm(p, smem));       GBAR();
    REP(4, st_prep(p, smem));         GBAR();
    REP(5, st_nsa2(p, smem));         __syncthreads();
    REP(6, st_dsa2(p, smem));         GBAR();
    REP(7, st_merge_gemm(p, smem));   GBAR();
    REP(8, st_out_gemm(p, smem));     GBAR();
    st_norm_rows(p, 1);       GBAR();
    REP(9, st_ssub_gemm(p, smem));    GBAR();
    REP(10, st_route(p));
    REP(11, st_cvt_uv(p));             GBAR();
    {   __syncthreads();
        const int myrank = (int)((volatile LAS unsigned*)(smem + LDS_CTL))[2];
        const XccInfo xi = xcc_info(p, myrank, xb_xcc_id());
        st_expert_u2(p, smem, xi); GBAR();
        st_expert_v2(p, smem, xi); GBAR();
        st_final_norm(p);
    }
}

extern "C" void kernel_launch(void* const* d_in, const int* in_sizes, int n_in, void* d_out, int out_size, void* d_ws, size_t ws_size, hipStream_t stream) {
    static int grid = 0;
    if (grid == 0) {
        int dev = 0, cus = 0, per_cu = 0;
        hipGetDevice(&dev); hipDeviceGetAttribute(&cus, hipDeviceAttributeMultiprocessorCount, dev);
        hipFuncSetAttribute((const void*)k_mega, hipFuncAttributeMaxDynamicSharedMemorySize, LDS_BYTES);
        hipOccupancyMaxActiveBlocksPerMultiprocessor(&per_cu, (const void*)k_mega, NTHR, LDS_BYTES);
        if (per_cu < 1) { fprintf(stderr, "kernel_launch: occupancy query says %d blocks/CU\n", per_cu); per_cu = 1; }
        (void)hipGetLastError();
        grid = cus;
    }
    Params p{};
    const float** f = (const float**)&p;
    for (int i = 0; i < 23; ++i) f[i] = (const float*)d_in[i];
    p.out = (float*)d_out; p.ws = (unsigned char*)d_ws;
    hipMemsetAsync((unsigned char*)d_ws + WS_BAR, 0, 16384, stream);
    hipLaunchKernelGGL(k_mega, dim3(grid), dim3(NTHR), LDS_BYTES, stream, p);
}
#ifdef TESTK
__global__ void __launch_bounds__(NTHR, 2) k_t_nsa(Params p) { st_nsa(p); }
__global__ void __launch_bounds__(NTHR, 2) k_t_dsa(Params p) { extern __shared__ __attribute__((aligned(16))) unsigned char smem[]; st_dsa(p, smem); }
#endif
#ifdef TESTK2
__global__ void __launch_bounds__(NTHR, 2) k_t_nsa2(Params p) { extern __shared__ __attribute__((aligned(16))) unsigned char smem[]; st_nsa2(p, smem); }
__global__ void __launch_bounds__(NTHR, 2) k_t_dsa2(Params p) { extern __shared__ __attribute__((aligned(16))) unsigned char smem[]; st_dsa2(p, smem); }
#endif
```

```cpp
#include <hip/hip_runtime.h>
#include <stdint.h>
#include <stdio.h>

#ifndef PROBE_STAGE
#define PROBE_STAGE 0
#endif
#define LAS __attribute__((address_space(3)))
typedef unsigned short bf16_t;
typedef unsigned int u32;

constexpr int T = 16384, SEQ = 2048, NB = 8, D = 1024, NZ = 4608, DIN = 4576;
constexpr int NTHR = 512;
constexpr float EPS = 1e-6f;
constexpr int ZC_QN = 0, ZC_KC = 512, ZC_VC = 640, ZC_KS = 768, ZC_VS = 896, ZC_KW = 1024, ZC_VW = 1152, ZC_QD = 1280, ZC_CKV = 1792,
              ZC_QI = 1920, ZC_KI = 2432, ZC_GN = 2496, ZC_WI = 2520, ZC_GM = 2560;
constexpr unsigned long long ROPE_MASK = 0xFFull | (3ull << 8) | (3ull << 12) | (3ull << 16) | (0xFFull << 20) | (0xFFull << 30) | (1ull << 38);
constexpr unsigned long long SCALE_MASK = 0xFFull | (0xFFull << 20) | (0xFFull << 30);

constexpr size_t WS_Z = 0;
constexpr size_t WS_SSUB = 0;
constexpr size_t WS_EIDX = 134217728;
constexpr size_t WS_GATE = 142606336;
constexpr size_t WS_WGT = 0;
constexpr size_t WS_MERGED = 150994944;
constexpr size_t WS_U16 = WS_MERGED;
constexpr size_t WS_HB = 184549376;
constexpr size_t WS_ONSA = WS_HB;
constexpr size_t WS_ODSA = WS_HB + 16777216;
constexpr size_t WS_V16 = WS_HB;
constexpr size_t WS_H2 = 218103808;
constexpr size_t WS_W = 251658240;
constexpr size_t WS_WINT = WS_H2;
constexpr size_t WS_WNSAT = WS_W;
constexpr size_t WS_WDSAT = WS_WNSAT + 1048576;
constexpr size_t WS_WOUTT = WS_WDSAT + 1048576;
constexpr size_t WS_WFOLDT = WS_WOUTT + 2097152;
constexpr size_t WS_SMALL = WS_WFOLDT + 4194304;
constexpr size_t WS_MOD = WS_SMALL;
constexpr size_t WS_COS = WS_MOD + 196608;
constexpr size_t WS_SIN = WS_COS + 262144;
constexpr size_t WS_BAR = WS_SIN + 262144;
constexpr size_t WS_W1T = WS_BAR + 16384;
constexpr size_t WS_BPOS = WS_W1T + 524288;
constexpr size_t WS_SU = WS_BPOS + 512;
constexpr size_t WS_SX = WS_SU + 65536;
constexpr size_t WS_END_SMALL = WS_SX + 65536;
constexpr size_t WS_X8 = WS_MERGED + 16777216;
static_assert(WS_END_SMALL <= 268435456, "ws overflow");
constexpr size_t DO_KD = 0;
constexpr size_t DO_VDT = 2097152;
constexpr size_t DO_VST = 4194304;
constexpr size_t DO_VWT = 8388608;
constexpr size_t DO_KCMP = 12582912;
constexpr size_t DO_VCMPT = 12845056;
constexpr size_t DO_HID = 13107200;
constexpr size_t DO_MASK = 14680064;
constexpr size_t DO_END = DO_MASK + 4194304;

struct Params {
    const float *x, *c, *ada_w, *ada_b, *norm1_g, *w_in, *cmp_pos, *w1k, *w2k, *w1v, *w2v, *kvg, *w_uk, *w_uv, *w_nsa, *w_dsa, *w_out, *norm2_g, *wq,
        *subkeys, *pu, *pv, *final_g;
    float* out;
    unsigned char* ws;
};

__device__ __forceinline__ bf16_t f2bf(float f) { u32 u = __float_as_uint(f); u += 0x7fffu + ((u >> 16) & 1u); return (bf16_t)(u >> 16); }
__device__ __forceinline__ float bf2f(bf16_t h) { return __uint_as_float((u32)h << 16); }
__device__ __forceinline__ float bflo(u32 w) { return __uint_as_float(w << 16); }
__device__ __forceinline__ float bfhi(u32 w) { return __uint_as_float(w & 0xffff0000u); }
__device__ __forceinline__ u32 pk2(float lo, float hi) { return (u32)f2bf(lo) | ((u32)f2bf(hi) << 16); }
__device__ __forceinline__ float wave_sum(float v) {
#pragma unroll
    for (int o = 1; o < 64; o <<= 1) v += __shfl_xor(v, o);
    return v;
}
__device__ __forceinline__ float wave_max(float v) {
#pragma unroll
    for (int o = 1; o < 64; o <<= 1) v = fmaxf(v, __shfl_xor(v, o));
    return v;
}
__device__ __forceinline__ float sigmoidf_(float v) { return 1.0f / (1.0f + __expf(-v)); }
__device__ __forceinline__ float gelu_tanh(float v) { const float u = 0.7978845608028654f * (v + 0.044715f * v * v * v); return 0.5f * v * (1.0f + tanhf(u)); }
__device__ __forceinline__ float gelu_erf(float v) { return 0.5f * v * (1.0f + erff(v * 0.7071067811865476f)); }
__device__ __forceinline__ int z_logical_col(int pc) {
    const int g64 = pc >> 6; const int o = pc & 63;
    const int po = (g64 < 64 && ((ROPE_MASK >> g64) & 1ull)) ? ((o >> 1) + 32 * (o & 1)) : o;
    const int pp = (pc & ~63) + po;
    if (pc < 1280) return pp;
    if (pc < 1792) return 1304 + (pp - 1280);
    if (pc < 1920) return 1816 + (pp - 1792);
    if (pc < 2432) return 1944 + (pp - 1920);
    if (pc < 2496) return 2456 + (pp - 2432);
    if (pc < 2520) return 1280 + (pc - 2496);
    if (pc < 2528) return 2520 + (pc - 2520);
    if (pc < 2560) return -1;
    return 2528 + (pc - 2560);
}
__device__ __forceinline__ void z_post(int t, int pc, float& v0, float& v1, const float* cosT, const float* sinT) {
    const int g64 = pc >> 6;
    if (g64 < 64 && ((ROPE_MASK >> g64) & 1ull)) {
        const int i = (pc & 63) >> 1, pos = t & (SEQ - 1);
        const float c = cosT[pos * 32 + i], s = sinT[pos * 32 + i];
        const float a = v0 * c - v1 * s, b = v1 * c + v0 * s;
        const float sc = ((SCALE_MASK >> g64) & 1ull) ? 0.125f : 1.0f;
        v0 = a * sc; v1 = b * sc;
    } else if (pc >= ZC_GM || (pc >= ZC_GN && pc < ZC_WI)) { v0 = sigmoidf_(v0); v1 = sigmoidf_(v1); }
}
__device__ __forceinline__ void sincos_tab(float ang, float& s, float& c) {
    const double a = (double)ang; const double k = rint(a * 0.63661977236758134308);
    const float r = (float)(a - k * 1.57079632679489661923); const float z = r * r;
    const float sp = ((-1.9515295891e-4f * z + 8.3321608736e-3f) * z - 1.6666654611e-1f) * z * r + r;
    const float cp = ((2.443315711809948e-5f * z - 1.388731625493765e-3f) * z + 4.166664568298827e-2f) * z * z - 0.5f * z + 1.0f;
    const int q = ((int)k) & 3;
    s = (q == 0) ? sp : (q == 1) ? cp : (q == 2) ? -sp : -cp;
    c = (q == 0) ? cp : (q == 1) ? -sp : (q == 2) ? -cp : sp;
}

__device__ __forceinline__ void st_adaln(const Params& p, unsigned char* lds) {
    int tid_ = threadIdx.x; asm volatile("" : "+v"(tid_)); const int tid = tid_, lane = tid & 63, w = tid >> 6;
    float* cosT = (float*)(p.ws + WS_COS); float* sinT = (float*)(p.ws + WS_SIN);
    for (int i = blockIdx.x * NTHR + tid; i < SEQ * 32; i += gridDim.x * NTHR) {
        const int pos = i >> 5, f = i & 31; const float inv = powf(10000.0f, -(float)f / 32.0f);
        float s, c; sincos_tab((float)pos * inv, s, c); cosT[i] = c; sinT[i] = s;
    }
    float* sc = (float*)lds;
    float* red = sc + 8192;
    for (int i = tid; i < 8192; i += NTHR) { const float v = p.c[i]; sc[i] = v / (1.0f + __expf(-v)); }
    __syncthreads();
    float* mod = (float*)(p.ws + WS_MOD);
    for (int unit = blockIdx.x; unit < 192; unit += gridDim.x) {
        float acc[8];
#pragma unroll
        for (int b = 0; b < 8; ++b) acc[b] = 0.f;
        const int col = unit * 32 + (lane & 31), ks = lane >> 5;
        for (int kk = 0; kk < 64; ++kk) {
            const int k = w * 128 + kk * 2 + ks; const float wv = p.ada_w[(size_t)k * 6144 + col];
#pragma unroll
            for (int b = 0; b < 8; ++b) acc[b] += sc[b * 1024 + k] * wv;
        }
#pragma unroll
        for (int b = 0; b < 8; ++b) red[((w * 2 + ks) * 8 + b) * 32 + (lane & 31)] = acc[b];
        __syncthreads();
        if (tid < 256) { const int b = tid >> 5, c = tid & 31; float s = 0.f;
            for (int j = 0; j < 16; ++j) s += red[(j * 8 + b) * 32 + c];
            mod[b * 6144 + unit * 32 + c] = s + p.ada_b[unit * 32 + c]; }
        __syncthreads();
    }
}
__device__ __forceinline__ void st_norm_rows(const Params& p, int which) {
    int tid_ = threadIdx.x; asm volatile("" : "+v"(tid_)); const int tid = tid_, lane = tid & 63, w = tid >> 6;
    const float* src = which ? p.out : p.x; const float* g = which ? p.norm2_g : p.norm1_g;
    bf16_t* dst = (bf16_t*)(p.ws + (which ? WS_H2 : WS_HB));
    const float* mod = (const float*)(p.ws + WS_MOD);
    for (int t = blockIdx.x * 8 + w; t < T; t += gridDim.x * 8) {
        const int b = t >> 11; const float* sh = mod + b * 6144 + (which ? 3072 : 0); const float* scl = sh + 1024;
        const float4* xr = (const float4*)(src + (size_t)t * D);
        float4 v[4]; float ss = 0.f;
#pragma unroll
        for (int j = 0; j < 4; ++j) { v[j] = xr[lane + 64 * j]; ss += v[j].x * v[j].x + v[j].y * v[j].y + v[j].z * v[j].z + v[j].w * v[j].w; }
        const float r = rsqrtf(wave_sum(ss) * (1.0f / D) + EPS);
        float am = 0.f;
#pragma unroll
        for (int j = 0; j < 4; ++j) { const int d0 = (lane + 64 * j) * 4;
            const float4 gg = *(const float4*)(g + d0), s4 = *(const float4*)(scl + d0), h4 = *(const float4*)(sh + d0);
            const float o0 = v[j].x * r * gg.x * (1.f + s4.x) + h4.x, o1 = v[j].y * r * gg.y * (1.f + s4.y) + h4.y;
            const float o2 = v[j].z * r * gg.z * (1.f + s4.z) + h4.z, o3 = v[j].w * r * gg.w * (1.f + s4.w) + h4.w;
            uint2 o; o.x = pk2(o0, o1); o.y = pk2(o2, o3); *(uint2*)(dst + (size_t)t * D + d0) = o;
            v[j].x = o0; v[j].y = o1; v[j].z = o2; v[j].w = o3; am = fmaxf(am, fmaxf(fmaxf(fabsf(o0), fabsf(o1)), fmaxf(fabsf(o2), fabsf(o3)))); }
        if (which) {
            am = wave_max(am); const float sx = am > 0.f ? am * (1.0f / 127.0f) : 1.0f; const float isx = 1.0f / sx;
            if (lane == 0) ((float*)(p.ws + WS_SX))[t] = sx;
#pragma unroll
            for (int j = 0; j < 4; ++j) { const int q0 = (int)rintf(v[j].x * isx), q1 = (int)rintf(v[j].y * isx), q2 = (int)rintf(v[j].z * isx), q3 = (int)rintf(v[j].w * isx);
                *(u32*)(p.ws + WS_X8 + (size_t)t * D + (lane + 64 * j) * 4) = (u32)(q0 & 255) | ((u32)(q1 & 255) << 8) | ((u32)(q2 & 255) << 16) | ((u32)(q3 & 255) << 24); }
        }
    }
}
__device__ __forceinline__ void naive_dot8(const bf16_t* A, int lda, const float* W, int ldw, int K, int t0, int col, float (&acc)[8]) {
#pragma unroll
    for (int i = 0; i < 8; ++i) acc[i] = 0.f;
    for (int k = 0; k < K; k += 2) {
        const float w0 = W[(size_t)k * ldw + col], w1 = W[(size_t)(k + 1) * ldw + col];
#pragma unroll
        for (int i = 0; i < 8; ++i) { const u32 a = *(const u32*)(A + (size_t)(t0 + i) * lda + k); acc[i] += bflo(a) * w0 + bfhi(a) * w1; }
    }
}
__device__ __forceinline__ void st_z_naive(const Params& p) {
    int tid_ = threadIdx.x; asm volatile("" : "+v"(tid_)); const int tid = tid_; const bf16_t* hb = (const bf16_t*)(p.ws + WS_HB); bf16_t* Z = (bf16_t*)(p.ws + WS_Z);
    const float* cosT = (const float*)(p.ws + WS_COS); const float* sinT = (const float*)(p.ws + WS_SIN);
    const int nitems = (T / 8) * 9;
    for (int it = blockIdx.x * 2 + (tid >> 8); it < nitems; it += gridDim.x * 2) {
        const int tt = it / 9, ch = it % 9; const int t0 = tt * 8; const int pc = (ch * 256 + (tid & 255)) * 2;
        const int l0 = z_logical_col(pc), l1 = z_logical_col(pc + 1);
        float a0[8], a1[8];
        if (l0 >= 0) { naive_dot8(hb, D, p.w_in, DIN, D, t0, l0, a0); naive_dot8(hb, D, p.w_in, DIN, D, t0, l1, a1); }
        else {
#pragma unroll
            for (int i = 0; i < 8; ++i) { a0[i] = 0.f; a1[i] = 0.f; } }
#pragma unroll
        for (int i = 0; i < 8; ++i) { float v0 = a0[i], v1 = a1[i]; z_post(t0 + i, pc, v0, v1, cosT, sinT); *(u32*)(Z + (size_t)(t0 + i) * NZ + pc) = pk2(v0, v1); }
    }
}
__device__ __forceinline__ void st_prep_a_naive(const Params& p) {
    int tid_ = threadIdx.x; asm volatile("" : "+v"(tid_)); const int tid = tid_; const bf16_t* Z = (const bf16_t*)(p.ws + WS_Z);
    const float* cosT = (const float*)(p.ws + WS_COS); const float* sinT = (const float*)(p.ws + WS_SIN);
    unsigned char* dob = (unsigned char*)p.out;
    bf16_t* kd = (bf16_t*)(dob + DO_KD); bf16_t* vdT = (bf16_t*)(dob + DO_VDT); bf16_t* vsT = (bf16_t*)(dob + DO_VST); bf16_t* vwT = (bf16_t*)(dob + DO_VWT);
    float* hid = (float*)(dob + DO_HID);
    for (int it = blockIdx.x * NTHR + tid; it < T * 32; it += gridDim.x * NTHR) {
        const int t = it >> 5, i = it & 31; const bf16_t* cr = Z + (size_t)t * NZ + ZC_CKV;
        float ss = 0.f; for (int r = 0; r < 128; ++r) { const float v = bf2f(cr[r]); ss += v * v; }
        const float rn = rsqrtf(ss * (1.0f / 128.0f) + EPS);
        float k1 = 0.f, k2 = 0.f, v1 = 0.f, v2 = 0.f;
        for (int r = 0; r < 128; ++r) { const float cn = bf2f(cr[r]) * rn * p.kvg[r];
            k1 += cn * p.w_uk[r * 64 + i]; k2 += cn * p.w_uk[r * 64 + i + 32]; v1 += cn * p.w_uv[r * 64 + i]; v2 += cn * p.w_uv[r * 64 + i + 32]; }
        const int pos = t & (SEQ - 1), b = t >> 11; const float c = cosT[pos * 32 + i], s = sinT[pos * 32 + i];
        *(u32*)(kd + (size_t)t * 64 + 2 * i) = pk2(k1 * c - k2 * s, k2 * c + k1 * s);
        vdT[((size_t)b * 64 + i) * SEQ + pos] = f2bf(v1); vdT[((size_t)b * 64 + i + 32) * SEQ + pos] = f2bf(v2);
    }
    for (int it = blockIdx.x * NTHR + tid; it < T * 128; it += gridDim.x * NTHR) {
        const int t = it >> 7, gd = it & 127, b = t >> 11, pos = t & (SEQ - 1);
        vsT[((size_t)b * 128 + gd) * SEQ + pos] = Z[(size_t)t * NZ + ZC_VS + gd];
        vwT[((size_t)b * 128 + gd) * SEQ + pos] = Z[(size_t)t * NZ + ZC_VW + gd];
    }
    for (int it = blockIdx.x * NTHR + tid; it < 2 * 8 * 2 * 128 * 64; it += gridDim.x * NTHR) {
        const int e = it & 63, n = (it >> 6) & 127, g = (it >> 13) & 1, b = (it >> 14) & 7, kv = it >> 17;
        float acc = 0.f;
        if (n < 127) {
            const float* w1 = kv ? p.w1v : p.w1k;
            for (int l = 0; l < 32; ++l) { const bf16_t* xr = Z + (size_t)(b * SEQ + 16 * n + l) * NZ + (kv ? ZC_VC : ZC_KC) + g * 64;
                for (int d = 0; d < 64; ++d) { const int pd = kv ? d : (2 * (d & 31) + (d >> 5));
                    acc += (bf2f(xr[pd]) + p.cmp_pos[l * 64 + d]) * w1[(l * 64 + d) * 64 + e]; } }
            acc = gelu_tanh(acc);
        }
        hid[it] = acc;
    }
}
__device__ __forceinline__ void st_prep_b_naive(const Params& p) {
    int tid_ = threadIdx.x; asm volatile("" : "+v"(tid_)); const int tid = tid_; unsigned char* dob = (unsigned char*)p.out;
    const float* hid = (const float*)(dob + DO_HID); bf16_t* kcmp = (bf16_t*)(dob + DO_KCMP); bf16_t* vcmpT = (bf16_t*)(dob + DO_VCMPT);
    for (int it = blockIdx.x * NTHR + tid; it < 2 * 8 * 2 * 128 * 64; it += gridDim.x * NTHR) {
        const int f = it & 63, n = (it >> 6) & 127, g = (it >> 13) & 1, b = (it >> 14) & 7, kv = it >> 17;
        const float* w2 = kv ? p.w2v : p.w2k; const float* h = hid + (size_t)(it & ~63);
        float acc = 0.f;
        if (n < 127) for (int e = 0; e < 64; ++e) acc += h[e] * w2[e * 64 + f];
        if (kv == 0) kcmp[(((size_t)b * 2 + g) * 128 + n) * 64 + (2 * (f & 31) + (f >> 5))] = f2bf(acc);
        else vcmpT[(((size_t)b * 2 + g) * 64 + f) * 128 + n] = f2bf(acc);
    }
}
__device__ __forceinline__ float dot64(const float* q, const bf16_t* kr) {
    float s = 0.f;
#pragma unroll
    for (int j = 0; j < 8; ++j) { const uint4 v = *(const uint4*)(kr + 8 * j); const float* qq = q + 8 * j;
        s += qq[0] * bflo(v.x) + qq[1] * bfhi(v.x) + qq[2] * bflo(v.y) + qq[3] * bfhi(v.y) + qq[4] * bflo(v.z) + qq[5] * bfhi(v.z) + qq[6] * bflo(v.w) + qq[7] * bfhi(v.w); }
    return s;
}
__device__ __forceinline__ void st_nsa_naive(const Params& p, unsigned char* lds) {
    int tid_ = threadIdx.x; asm volatile("" : "+v"(tid_)); const int tid = tid_, lane = tid & 63, h = tid >> 6, g = h >> 2;
    const bf16_t* Z = (const bf16_t*)(p.ws + WS_Z); unsigned char* dob = (unsigned char*)p.out;
    const bf16_t* kcmp = (const bf16_t*)(dob + DO_KCMP); const bf16_t* vcmpT = (const bf16_t*)(dob + DO_VCMPT);
    bf16_t* onsa = (bf16_t*)(p.ws + WS_ONSA);
    float* qs = (float*)lds;
    float* pc = qs + 512;
    float* vals = pc + 1024;
    u32* selm = (u32*)(vals + 64);
    for (int t = blockIdx.x; t < T; t += gridDim.x) {
        const int b = t >> 11, pos = t & (SEQ - 1); const bf16_t* zr = Z + (size_t)t * NZ;
        __syncthreads();
        qs[h * 64 + lane] = bf2f(zr[ZC_QN + h * 64 + lane]);
        __syncthreads();
        const float* q = qs + h * 64;
        float sc[2]; float m = -1e30f;
#pragma unroll
        for (int c2 = 0; c2 < 2; ++c2) { const int n = c2 * 64 + lane; const bool valid = (n < 127) && (16 * n + 31 <= pos);
            const float s = dot64(q, kcmp + (((size_t)b * 2 + g) * 128 + n) * 64); sc[c2] = valid ? s : -1e30f; m = fmaxf(m, sc[c2]); }
        m = wave_max(m); float l = 0.f;
#pragma unroll
        for (int c2 = 0; c2 < 2; ++c2) { const int n = c2 * 64 + lane; const bool valid = (n < 127) && (16 * n + 31 <= pos); sc[c2] = valid ? __expf(sc[c2] - m) : 0.f; l += sc[c2]; }
        l = wave_sum(l); const float il = 1.0f / fmaxf(l, 1e-30f);
        pc[h * 128 + lane] = sc[0] * il; pc[h * 128 + 64 + lane] = sc[1] * il;
        __syncthreads();
        float ocmp = 0.f; { const bf16_t* vr = vcmpT + (((size_t)b * 2 + g) * 64 + lane) * 128; const float* pp = pc + h * 128;
            for (int n = 0; n < 128; ++n) ocmp += pp[n] * bf2f(vr[n]); }
        if (tid < 64) { const int gg = tid >> 5, j = tid & 31; const float* p0 = pc + gg * 512;
            auto imp = [&](int n) -> float { return (n < 0 || n > 126) ? 0.f : (p0[n] + p0[128 + n] + p0[256 + n] + p0[384 + n]); };
            const float bl = imp(4 * j - 1) + 2.f * imp(4 * j) + 2.f * imp(4 * j + 1) + 2.f * imp(4 * j + 2) + imp(4 * j + 3);
            const int cur = pos >> 6; const bool forced = (j == 0) || (j == cur) || (j == cur - 1); const bool adm = (j * 64 <= pos);
            vals[tid] = forced ? __builtin_inff() : (adm ? bl : -__builtin_inff()); }
        __syncthreads();
        if (tid < 64) { const int gg = tid >> 5, j = tid & 31; const float v = vals[tid]; int rank = 0;
            for (int j2 = 0; j2 < 32; ++j2) { const float v2 = vals[gg * 32 + j2]; rank += (v2 > v || (v2 == v && j2 < j)) ? 1 : 0; }
            const unsigned long long bal = __ballot(rank < 16);
            if (tid == 0) { selm[0] = (u32)bal; selm[1] = (u32)(bal >> 32); } }
        __syncthreads();
        const u32 sel = selm[g];
        float ms = -1e30f, ls = 0.f, os = 0.f;
        for (int j = 0; j * 64 <= pos; ++j) { if (!((sel >> j) & 1u)) continue;
            const int kp = j * 64 + lane; const bool valid = kp <= pos;
            float s = dot64(q, Z + (size_t)(b * SEQ + kp) * NZ + ZC_KS + g * 64); s = valid ? s : -1e30f;
            const float mn = fmaxf(ms, wave_max(s)); const float al = __expf(ms - mn); const float pr = valid ? __expf(s - mn) : 0.f;
            ls = ls * al + wave_sum(pr); os *= al; ms = mn;
            for (int k = 0; k < 64; ++k) { const float pk = __shfl(pr, k); os += pk * bf2f(Z[(size_t)(b * SEQ + j * 64 + k) * NZ + ZC_VS + g * 64 + lane]); } }
        os = os / fmaxf(ls, 1e-30f);
        float mw = -1e30f, lw = 0.f, ow = 0.f;
        for (int c2 = 0; c2 < 8; ++c2) { const int kp = pos - 511 + c2 * 64 + lane; const bool valid = kp >= 0; if (pos - 511 + c2 * 64 + 63 < 0) continue;
            float s = valid ? dot64(q, Z + (size_t)(b * SEQ + kp) * NZ + ZC_KW + g * 64) : -1e30f;
            const float mn = fmaxf(mw, wave_max(s)); const float al = __expf(mw - mn); const float pr = valid ? __expf(s - mn) : 0.f;
            lw = lw * al + wave_sum(pr); ow *= al; mw = mn;
            for (int k = 0; k < 64; ++k) { const float pk = __shfl(pr, k); const int kk = pos - 511 + c2 * 64 + k;
                if (kk >= 0) ow += pk * bf2f(Z[(size_t)(b * SEQ + kk) * NZ + ZC_VW + g * 64 + lane]); } }
        ow = ow / fmaxf(lw, 1e-30f);
        const float gc = bf2f(zr[ZC_GN + h * 3 + 0]), gs = bf2f(zr[ZC_GN + h * 3 + 1]), gw = bf2f(zr[ZC_GN + h * 3 + 2]);
        onsa[(size_t)t * 512 + h * 64 + lane] = f2bf(gc * ocmp + gs * os + gw * ow);
    }
}
__device__ __forceinline__ void st_dsa_naive(const Params& p, unsigned char* lds) {
    int tid_ = threadIdx.x; asm volatile("" : "+v"(tid_)); const int tid = tid_, lane = tid & 63, h = tid >> 6;
    const bf16_t* Z = (const bf16_t*)(p.ws + WS_Z); unsigned char* dob = (unsigned char*)p.out;
    const bf16_t* kd = (const bf16_t*)(dob + DO_KD); const bf16_t* vdT = (const bf16_t*)(dob + DO_VDT); u32* maskg = (u32*)(dob + DO_MASK);
    bf16_t* odsa = (bf16_t*)(p.ws + WS_ODSA);
    float* qi = (float*)lds;
    float* qd = qi + 512;
    float* wv = qd + 512;
    float* scv = wv + 8;
    u32* mk = (u32*)(scv + 2048);
    for (int t = blockIdx.x; t < T; t += gridDim.x) {
        const int b = t >> 11, pos = t & (SEQ - 1); const bf16_t* zr = Z + (size_t)t * NZ;
        __syncthreads();
        qi[tid] = bf2f(zr[ZC_QI + tid]); qd[tid] = bf2f(zr[ZC_QD + tid]);
        if (tid < 8) wv[tid] = bf2f(zr[ZC_WI + tid]) * 0.35355339059327373f;
        __syncthreads();
        for (int i = 0; i < 4; ++i) { const int k = tid + 512 * i; float s = -__builtin_inff();
            if (k <= pos) { s = 0.f; const bf16_t* kr = Z + (size_t)(b * SEQ + k) * NZ + ZC_KI;
                for (int hh = 0; hh < 8; ++hh) { const float lg = dot64(qi + hh * 64, kr); s = fmaf(wv[hh], fmaxf(lg, 0.f), s); } }
            scv[k] = s; }
        __syncthreads();
        for (int i = 0; i < 4; ++i) { const int k = tid + 512 * i; bool selb = false;
            if (k <= pos) { if (pos < 256) selb = true; else { const float v = scv[k]; int rank = 0;
                    for (int j = 0; j <= pos; ++j) { const float v2 = scv[j]; rank += (v2 > v || (v2 == v && j < k)) ? 1 : 0; } selb = rank < 256; } }
            const unsigned long long bal = __ballot(selb);
            if (lane == 0) { const int wi = 16 * i + 2 * h; mk[wi] = (u32)bal; mk[wi + 1] = (u32)(bal >> 32); } }
        __syncthreads();
        if (tid < 64) maskg[(size_t)t * 64 + tid] = mk[tid];
        float m = -1e30f, l = 0.f, o = 0.f; const float* q = qd + h * 64;
        for (int c2 = 0; c2 * 64 <= pos; ++c2) { const int kp = c2 * 64 + lane; const bool valid = (mk[kp >> 5] >> (kp & 31)) & 1u;
            if (__ballot(valid) == 0ull) continue;
            float s = valid ? dot64(q, kd + (size_t)(b * SEQ + kp) * 64) : -1e30f;
            const float mn = fmaxf(m, wave_max(s)); const float al = __expf(m - mn); const float pr = valid ? __expf(s - mn) : 0.f;
            l = l * al + wave_sum(pr); o *= al; m = mn;
            const bf16_t* vr = vdT + ((size_t)b * 64 + lane) * SEQ + c2 * 64;
            for (int k = 0; k < 64; ++k) { const float pk = __shfl(pr, k); o += pk * bf2f(vr[k]); } }
        odsa[(size_t)t * 512 + h * 64 + lane] = f2bf(o / fmaxf(l, 1e-30f));
    }
}
__device__ __forceinline__ void st_merge_naive(const Params& p) {
    int tid_ = threadIdx.x; asm volatile("" : "+v"(tid_)); const int tid = tid_; const bf16_t* Z = (const bf16_t*)(p.ws + WS_Z);
    const bf16_t* onsa = (const bf16_t*)(p.ws + WS_ONSA); const bf16_t* odsa = (const bf16_t*)(p.ws + WS_ODSA); bf16_t* mg = (bf16_t*)(p.ws + WS_MERGED);
    for (int it = blockIdx.x; it < (T / 8) * 2; it += gridDim.x) { const int t0 = (it >> 1) * 8, n = (it & 1) * 512 + tid;
        float a[8], d[8]; naive_dot8(onsa, 512, p.w_nsa, D, 512, t0, n, a); naive_dot8(odsa, 512, p.w_dsa, D, 512, t0, n, d);
#pragma unroll
        for (int i = 0; i < 8; ++i) { const float g1 = bf2f(Z[(size_t)(t0 + i) * NZ + ZC_GM + n]), g2 = bf2f(Z[(size_t)(t0 + i) * NZ + ZC_GM + 1024 + n]);
            mg[(size_t)(t0 + i) * D + n] = f2bf(g1 * a[i] + g2 * d[i]); } }
}
__device__ __forceinline__ void st_out_naive(const Params& p) {
    int tid_ = threadIdx.x; asm volatile("" : "+v"(tid_)); const int tid = tid_; const bf16_t* mg = (const bf16_t*)(p.ws + WS_MERGED); const float* mod = (const float*)(p.ws + WS_MOD);
    for (int it = blockIdx.x; it < (T / 8) * 2; it += gridDim.x) { const int t0 = (it >> 1) * 8, n = (it & 1) * 512 + tid;
        float a[8]; naive_dot8(mg, D, p.w_out, D, D, t0, n, a); const float g1 = mod[(t0 >> 11) * 6144 + 2048 + n];
#pragma unroll
        for (int i = 0; i < 8; ++i) p.out[(size_t)(t0 + i) * D + n] = p.x[(size_t)(t0 + i) * D + n] + g1 * a[i]; }
}
__device__ __forceinline__ void st_peerq_naive(const Params& p) {
    int tid_ = threadIdx.x; asm volatile("" : "+v"(tid_)); const int tid = tid_; const bf16_t* h2 = (const bf16_t*)(p.ws + WS_H2); bf16_t* q = (bf16_t*)(p.ws + WS_MERGED);
    for (int it = blockIdx.x; it < (T / 8) * 2; it += gridDim.x) { const int t0 = (it >> 1) * 8, n = (it & 1) * 512 + tid;
        float a[8]; naive_dot8(h2, D, p.wq, D, D, t0, n, a);
#pragma unroll
        for (int i = 0; i < 8; ++i) q[(size_t)(t0 + i) * D + n] = f2bf(a[i]); }
}
__device__ __forceinline__ void st_ssub_naive(const Params& p) {
    int tid_ = threadIdx.x; asm volatile("" : "+v"(tid_)); const int tid = tid_; const bf16_t* q = (const bf16_t*)(p.ws + WS_MERGED); float* ss = (float*)(p.ws + WS_SSUB);
    for (size_t it = (size_t)blockIdx.x * NTHR + tid; it < (size_t)T * 2048; it += (size_t)gridDim.x * NTHR) {
        const int t = (int)(it >> 11), col = (int)(it & 2047), hc = col >> 7, n = col & 127;
        const bf16_t* qr = q + (size_t)t * D + hc * 64; const float* sk = p.subkeys + ((size_t)hc * 128 + n) * 64;
        float acc = 0.f; for (int d = 0; d < 64; ++d) acc += bf2f(qr[d]) * sk[d];
        ss[it] = acc; }
}
__device__ __forceinline__ u32 ordf(float f);
__device__ __forceinline__ void ins16(u32 (&s)[16], u32 key) {
#pragma unroll
    for (int i = 0; i < 16; ++i) { const u32 mx = s[i] > key ? s[i] : key; key = s[i] > key ? key : s[i]; s[i] = mx; }
}
__device__ __forceinline__ void st_route(const Params& p) {
    int tid_ = threadIdx.x; asm volatile("" : "+v"(tid_)); const int tid = tid_; const float* ss = (const float*)(p.ws + WS_SSUB); int* eidx = (int*)(p.ws + WS_EIDX); float* gate = (float*)(p.ws + WS_GATE);
    for (int it = blockIdx.x * NTHR + tid; it < T * 8; it += gridDim.x * NTHR) {
        const float* s0 = ss + (size_t)it * 256;
        u32 a[16], b[16];
#pragma unroll
        for (int i = 0; i < 16; ++i) { a[i] = 0u; b[i] = 0u; }
        for (int n = 0; n < 128; n += 4) { const float4 x = *(const float4*)(s0 + n), y = *(const float4*)(s0 + 128 + n);
            ins16(a, (ordf(x.x) & ~127u) | (u32)(127 - n)); ins16(a, (ordf(x.y) & ~127u) | (u32)(126 - n)); ins16(a, (ordf(x.z) & ~127u) | (u32)(125 - n)); ins16(a, (ordf(x.w) & ~127u) | (u32)(124 - n));
            ins16(b, (ordf(y.x) & ~127u) | (u32)(127 - n)); ins16(b, (ordf(y.y) & ~127u) | (u32)(126 - n)); ins16(b, (ordf(y.z) & ~127u) | (u32)(125 - n)); ins16(b, (ordf(y.w) & ~127u) | (u32)(124 - n)); }
        float va[16], vb[16]; int na[16], nb[16];
#pragma unroll
        for (int i = 0; i < 16; ++i) { na[i] = 127 - (int)(a[i] & 127u); nb[i] = 127 - (int)(b[i] & 127u); va[i] = s0[na[i]]; vb[i] = s0[128 + nb[i]]; }
        u32 tk[16];
#pragma unroll
        for (int i = 0; i < 16; ++i) tk[i] = 0u;
#pragma unroll
        for (int i = 0; i < 16; ++i)
#pragma unroll
            for (int j = 0; j < 16; ++j) if ((i + 1) * (j + 1) <= 16) ins16(tk, (ordf(va[i] + vb[j]) & ~255u) | (u32)(255 - (i * 16 + j)));
        float ts[16]; int te[16];
#pragma unroll
        for (int r = 0; r < 16; ++r) { const int flat = 255 - (int)(tk[r] & 255u), i = flat >> 4, j = flat & 15; float x = 0.f, y = 0.f; int ni = 0, nj = 0;
#pragma unroll
            for (int q = 0; q < 16; ++q) { if (i == q) { x = va[q]; ni = na[q]; } if (j == q) { y = vb[q]; nj = nb[q]; } }
            ts[r] = x + y; te[r] = ni * 128 + nj; }
        float mx = ts[0];
#pragma unroll
        for (int r = 1; r < 16; ++r) mx = fmaxf(mx, ts[r]);
        float sum = 0.f, ex[16];
#pragma unroll
        for (int r = 0; r < 16; ++r) { ex[r] = __expf(ts[r] - mx); sum += ex[r]; }
        const float inv = 1.0f / sum;
#pragma unroll
        for (int r = 0; r < 16; ++r) { eidx[(size_t)it * 16 + r] = te[r]; gate[(size_t)it * 16 + r] = ex[r] * inv; }
    }
}
__device__ __forceinline__ u32 pk4_fp8(float a, float b, float c, float d) { int p = 0; p = __builtin_amdgcn_cvt_pk_fp8_f32(a, b, p, false); p = __builtin_amdgcn_cvt_pk_fp8_f32(c, d, p, true); return (u32)p; }
__device__ __forceinline__ void st_cvt_uv(const Params& p) {
    int tid_ = threadIdx.x; asm volatile("" : "+v"(tid_)); const int tid = tid_;
    const int lane = tid & 63, w = tid >> 6;
    unsigned char* u8 = p.ws + WS_U16; unsigned char* v8 = p.ws + WS_V16; float* su = (float*)(p.ws + WS_SU);
    for (int e = blockIdx.x * 8 + w; e < 16384; e += gridDim.x * 8) {
        const float4* a = (const float4*)(p.pu + (size_t)e * D); const float4* b = (const float4*)(p.pv + (size_t)e * D);
        float4 av[4], bv[4]; float am = 0.f;
#pragma unroll
        for (int j = 0; j < 4; ++j) { av[j] = a[lane + 64 * j]; bv[j] = b[lane + 64 * j];
            am = fmaxf(am, fmaxf(fmaxf(fabsf(av[j].x), fabsf(av[j].y)), fmaxf(fabsf(av[j].z), fabsf(av[j].w)))); }
        am = wave_max(am); const float sc = am > 0.f ? am * (1.0f / 127.0f) : 1.0f; const float isc = 1.0f / sc;
        if (lane == 0) su[e] = sc;
#pragma unroll
        for (int j = 0; j < 4; ++j) { const int col = (lane + 64 * j) * 4;
            const int q0 = (int)rintf(av[j].x * isc), q1 = (int)rintf(av[j].y * isc), q2 = (int)rintf(av[j].z * isc), q3 = (int)rintf(av[j].w * isc);
            *(u32*)(u8 + (size_t)e * 1024 + col) = (u32)(q0 & 255) | ((u32)(q1 & 255) << 8) | ((u32)(q2 & 255) << 16) | ((u32)(q3 & 255) << 24);
            *(u32*)(v8 + ((size_t)(col >> 7) * 16384 + e) * 128 + (col & 127)) = pk4_fp8(bv[j].x, bv[j].y, bv[j].z, bv[j].w); }
    }
}
__device__ __forceinline__ void st_expert(const Params& p, unsigned char* lds) {
    int tid_ = threadIdx.x; asm volatile("" : "+v"(tid_)); const int tid = tid_, lane = tid & 63, w = tid >> 6;
    const bf16_t* h2 = (const bf16_t*)(p.ws + WS_H2); const bf16_t* u16 = (const bf16_t*)(p.ws + WS_U16); const bf16_t* v16 = (const bf16_t*)(p.ws + WS_V16);
    const int* eidx = (const int*)(p.ws + WS_EIDX); const float* gate = (const float*)(p.ws + WS_GATE); const float* mod = (const float*)(p.ws + WS_MOD);
    float* wl = (float*)lds + w * 128;
    for (int t = blockIdx.x * 8 + w; t < T; t += gridDim.x * 8) {
        float xv[16]; { const uint4 a = *(const uint4*)(h2 + (size_t)t * D + lane * 16), b = *(const uint4*)(h2 + (size_t)t * D + lane * 16 + 8);
            xv[0] = bflo(a.x); xv[1] = bfhi(a.x); xv[2] = bflo(a.y); xv[3] = bfhi(a.y); xv[4] = bflo(a.z); xv[5] = bfhi(a.z); xv[6] = bflo(a.w); xv[7] = bfhi(a.w);
            xv[8] = bflo(b.x); xv[9] = bfhi(b.x); xv[10] = bflo(b.y); xv[11] = bfhi(b.y); xv[12] = bflo(b.z); xv[13] = bfhi(b.z); xv[14] = bflo(b.w); xv[15] = bfhi(b.w); }
        const int e0 = eidx[(size_t)t * 128 + lane], e1 = eidx[(size_t)t * 128 + 64 + lane];
        const float g0 = gate[(size_t)t * 128 + lane], g1 = gate[(size_t)t * 128 + 64 + lane];
        for (int k = 0; k < 128; ++k) { const int e = __shfl(k < 64 ? e0 : e1, k & 63);
            const bf16_t* ur = u16 + (size_t)e * D + lane * 16; const uint4 a = *(const uint4*)ur, b = *(const uint4*)(ur + 8);
            float s = xv[0] * bflo(a.x) + xv[1] * bfhi(a.x) + xv[2] * bflo(a.y) + xv[3] * bfhi(a.y) + xv[4] * bflo(a.z) + xv[5] * bfhi(a.z) + xv[6] * bflo(a.w) + xv[7] * bfhi(a.w)
                    + xv[8] * bflo(b.x) + xv[9] * bfhi(b.x) + xv[10] * bflo(b.y) + xv[11] * bfhi(b.y) + xv[12] * bflo(b.z) + xv[13] * bfhi(b.z) + xv[14] * bflo(b.w) + xv[15] * bfhi(b.w);
            s = wave_sum(s);
            if (lane == (k & 63)) { const float gg = k < 64 ? g0 : g1; wl[k] = gg * gelu_erf(s); } }
        __builtin_amdgcn_s_waitcnt(0);
        float acc[16];
#pragma unroll
        for (int i = 0; i < 16; ++i) acc[i] = 0.f;
        for (int k = 0; k < 128; ++k) { const int e = __shfl(k < 64 ? e0 : e1, k & 63); const float wk = wl[k];
            const bf16_t* vr = v16 + (size_t)e * D + lane * 16; const uint4 a = *(const uint4*)vr, b = *(const uint4*)(vr + 8);
            acc[0] += wk * bflo(a.x); acc[1] += wk * bfhi(a.x); acc[2] += wk * bflo(a.y); acc[3] += wk * bfhi(a.y); acc[4] += wk * bflo(a.z); acc[5] += wk * bfhi(a.z); acc[6] += wk * bflo(a.w); acc[7] += wk * bfhi(a.w);
            acc[8] += wk * bflo(b.x); acc[9] += wk * bfhi(b.x); acc[10] += wk * bflo(b.y); acc[11] += wk * bfhi(b.y); acc[12] += wk * bflo(b.z); acc[13] += wk * bfhi(b.z); acc[14] += wk * bflo(b.w); acc[15] += wk * bfhi(b.w); }
        const float* g2 = mod + (t >> 11) * 6144 + 5120 + lane * 16; float* xr = p.out + (size_t)t * D + lane * 16; float ss = 0.f;
#pragma unroll
        for (int i = 0; i < 16; ++i) { acc[i] = xr[i] + g2[i] * acc[i]; ss += acc[i] * acc[i]; }
        const float r = rsqrtf(wave_sum(ss) * (1.0f / D) + EPS);
#pragma unroll
        for (int i = 0; i < 16; ++i) xr[i] = acc[i] * r * p.final_g[lane * 16 + i];
    }
}


typedef short bf16x8 __attribute__((ext_vector_type(8)));
typedef float f32x16 __attribute__((ext_vector_type(16)));
typedef unsigned u32x2 __attribute__((ext_vector_type(2)));
typedef unsigned u32x4 __attribute__((ext_vector_type(4)));
typedef __bf16 hbf2_t __attribute__((ext_vector_type(2)));
typedef float f32x2_t __attribute__((ext_vector_type(2)));
#define MFMA32(a, b, c) __builtin_amdgcn_mfma_f32_32x32x16_bf16((a), (b), (c), 0, 0, 0)
__device__ __forceinline__ u32 pkbf(float a, float b) { const f32x2_t v = {a, b}; const hbf2_t r = __builtin_convertvector(v, hbf2_t); return __builtin_bit_cast(u32, r); }
__device__ __forceinline__ bf16x8 ld8(const bf16_t* q) { return *(const bf16x8*)q; }
__device__ __forceinline__ bf16x8 ld44(const bf16_t* q) { const u32x2 a = *(const u32x2*)q, b = *(const u32x2*)(q + 8); const u32x4 v = {a.x, a.y, b.x, b.y}; return __builtin_bit_cast(bf16x8, v); }
template <int H> __device__ __forceinline__ bf16x8 pack8(const f32x16& s) {
    const u32x4 v = {pkbf(s[8 * H], s[8 * H + 1]), pkbf(s[8 * H + 2], s[8 * H + 3]), pkbf(s[8 * H + 4], s[8 * H + 5]), pkbf(s[8 * H + 6], s[8 * H + 7])};
    return __builtin_bit_cast(bf16x8, v);
}
__device__ __forceinline__ float dpp_xor1(float v) { return __int_as_float(__builtin_amdgcn_update_dpp(0, __float_as_int(v), 0xB1, 0xF, 0xF, true)); }
__device__ __forceinline__ float dpp_xor2(float v) { return __int_as_float(__builtin_amdgcn_update_dpp(0, __float_as_int(v), 0x4E, 0xF, 0xF, true)); }
__device__ __forceinline__ f32x16 zero16() { f32x16 z;
#pragma unroll
    for (int i = 0; i < 16; ++i) z[i] = 0.f; return z; }
__device__ __forceinline__ void flash_tile(float& m, float& l, f32x16& o0, f32x16& o1, f32x16 s, u32 vm, const bf16_t* vb, size_t dbs) {
    const bf16x8 v00 = ld44(vb), v01 = ld44(vb + 16), v10 = ld44(vb + dbs), v11 = ld44(vb + dbs + 16);
    float mx = -1e30f;
#pragma unroll
    for (int R = 0; R < 16; ++R) { s[R] = ((vm >> R) & 1u) ? s[R] : -1e30f; mx = fmaxf(mx, s[R]); }
    mx = fmaxf(mx, __shfl_xor(mx, 32));
    const float mn = fmaxf(m, mx), al = __expf(m - mn);
    float ps = 0.f;
#pragma unroll
    for (int R = 0; R < 16; ++R) { const float pr = ((vm >> R) & 1u) ? __expf(s[R] - mn) : 0.f; s[R] = pr; ps += pr; }
    ps += __shfl_xor(ps, 32);
    l = l * al + ps; m = mn;
#pragma unroll
    for (int R = 0; R < 16; ++R) { o0[R] *= al; o1[R] *= al; }
    const bf16x8 p0 = pack8<0>(s), p1 = pack8<1>(s);
    o0 = MFMA32(v00, p0, o0); o0 = MFMA32(v01, p1, o0);
    o1 = MFMA32(v10, p0, o1); o1 = MFMA32(v11, p1, o1);
}
__device__ __forceinline__ u32 vm_le(int lim) { u32 vm = 0u;
#pragma unroll
    for (int R = 0; R < 16; ++R) vm |= (((R & 3) + 8 * (R >> 2)) <= lim) ? (1u << R) : 0u;
    return vm; }
__device__ __forceinline__ u32 vm_from_word(u32 word, int hl) { const u32 sh = word >> (4 * hl); return (sh & 0xFu) | (((sh >> 8) & 0xFu) << 4) | (((sh >> 16) & 0xFu) << 8) | (((sh >> 24) & 0xFu) << 12); }
__device__ __forceinline__ void store_ot(bf16_t* orow, const f32x16& o0, const f32x16& o1, int hl) {
#pragma unroll
    for (int q = 0; q < 4; ++q) {
        u32x2 a = {pkbf(o0[4 * q], o0[4 * q + 1]), pkbf(o0[4 * q + 2], o0[4 * q + 3])}; *(u32x2*)(orow + 8 * q + 4 * hl) = a;
        u32x2 b = {pkbf(o1[4 * q], o1[4 * q + 1]), pkbf(o1[4 * q + 2], o1[4 * q + 3])}; *(u32x2*)(orow + 32 + 8 * q + 4 * hl) = b;
    }
}
__device__ __forceinline__ u32 ordf(float f) { const u32 u = __float_as_uint(f); return (u & 0x80000000u) ? ~u : (u | 0x80000000u); }

__device__ __forceinline__ void st_nsa(const Params& p) {
    int tid_ = threadIdx.x; asm volatile("" : "+v"(tid_)); const int tid = tid_, lane = tid & 63, w = __builtin_amdgcn_readfirstlane(tid >> 6), c_ = lane & 31, hl_ = lane >> 5;
    const bf16_t* Z = (const bf16_t*)(p.ws + WS_Z); unsigned char* dob = (unsigned char*)p.out;
    const bf16_t* kcmp = (const bf16_t*)(dob + DO_KCMP); const bf16_t* vcmpT = (const bf16_t*)(dob + DO_VCMPT);
    const bf16_t* vsT = (const bf16_t*)(dob + DO_VST); const bf16_t* vwT = (const bf16_t*)(dob + DO_VWT);
    bf16_t* onsa = (bf16_t*)(p.ws + WS_ONSA);
    for (int ps = blockIdx.x; ps < 256; ps += gridDim.x)
    for (int which = 0; which < 2; ++which) {
        const int b = ps >> 5, g = (ps >> 4) & 1, jj = ps & 15, qb = which ? 31 - jj : jj, cur = qb;
        int c = c_, hl = hl_; asm volatile("" : "+v"(c), "+v"(hl));
        const int pmin = qb * 64 + 8 * w, pos = pmin + (c >> 2), head = 4 * g + (c & 3);
        const bf16_t* zr = Z + (size_t)(b * SEQ + pos) * NZ;
        bf16x8 qfr[4];
#pragma unroll
        for (int kk = 0; kk < 4; ++kk) qfr[kk] = ld8(zr + ZC_QN + head * 64 + 16 * kk + 8 * hl);
        const float gc = bf2f(zr[ZC_GN + head * 3]), gs = bf2f(zr[ZC_GN + head * 3 + 1]), gw = bf2f(zr[ZC_GN + head * 3 + 2]);
        f32x16 out0 = zero16(), out1 = zero16();
        u32 sel;
        {
            const int pmax = pmin + 7; const int nmax = pmax >= 31 ? ((pmax - 31) >> 4) : -1; const int ntile = nmax >= 0 ? (((nmax > 126 ? 126 : nmax) >> 5) + 1) : 0;
            const bf16_t* kb = kcmp + ((size_t)(b * 2 + g) * 128 + c) * 64 + 8 * hl;
            float mx = -1e30f, l = 0.f;
            const int nlim = (pos >= 31 ? (((pos - 31) >> 4) > 126 ? 126 : ((pos - 31) >> 4)) : -1) - 4 * hl;
            for (int kt = 0; kt < ntile; ++kt) {
                f32x16 s = zero16();
#pragma unroll
                for (int kk = 0; kk < 4; ++kk) s = MFMA32(ld8(kb + (size_t)kt * 32 * 64 + 16 * kk), qfr[kk], s);
                const u32 vm = vm_le(nlim - 32 * kt);
                float tm = -1e30f;
#pragma unroll
                for (int R = 0; R < 16; ++R) { s[R] = ((vm >> R) & 1u) ? s[R] : -1e30f; tm = fmaxf(tm, s[R]); }
                const float mn = fmaxf(mx, tm); float ps = 0.f;
#pragma unroll
                for (int R = 0; R < 16; ++R) ps += ((vm >> R) & 1u) ? __expf(s[R] - mn) : 0.f;
                l = l * __expf(mx - mn) + ps; mx = mn;
            }
            {
                const float mo = __shfl_xor(mx, 32), lo_ = __shfl_xor(l, 32); const float mn = fmaxf(mx, mo);
                l = l * __expf(mx - mn) + lo_ * __expf(mo - mn); mx = mn; }
            const float il = 1.0f / fmaxf(l, 1e-30f);
            __builtin_amdgcn_sched_barrier(0);
            f32x16 o0 = zero16(), o1 = zero16();
            const bf16_t* vb = vcmpT + ((size_t)(b * 2 + g) * 64 + c) * 128 + 4 * hl;
            float G[16], L[16];
#pragma unroll
            for (int kt = 0; kt < 4; ++kt) {
                if (kt < ntile) {
                    f32x16 s = zero16();
#pragma unroll
                    for (int kk = 0; kk < 4; ++kk) s = MFMA32(ld8(kb + (size_t)kt * 32 * 64 + 16 * kk), qfr[kk], s);
                    const u32 vm = vm_le(nlim - 32 * kt);
#pragma unroll
                    for (int R = 0; R < 16; ++R) s[R] = ((vm >> R) & 1u) ? __expf(s[R] - mx) * il : 0.f;
                    const bf16x8 p0 = pack8<0>(s), p1 = pack8<1>(s);
                    o0 = MFMA32(ld44(vb + 32 * kt), p0, o0); o0 = MFMA32(ld44(vb + 32 * kt + 16), p1, o0);
                    o1 = MFMA32(ld44(vb + 32 * 128 + 32 * kt), p0, o1); o1 = MFMA32(ld44(vb + 32 * 128 + 32 * kt + 16), p1, o1);
#pragma unroll
                    for (int rg = 0; rg < 4; ++rg) { float gsum = (s[4 * rg] + s[4 * rg + 1]) + (s[4 * rg + 2] + s[4 * rg + 3]); float last = s[4 * rg + 3];
                        gsum += dpp_xor1(gsum); gsum += dpp_xor2(gsum); last += dpp_xor1(last); last += dpp_xor2(last);
                        G[4 * kt + rg] = gsum; L[4 * kt + rg] = last; }
                } else {
#pragma unroll
                    for (int rg = 0; rg < 4; ++rg) { G[4 * kt + rg] = 0.f; L[4 * kt + rg] = 0.f; }
                }
                __builtin_amdgcn_sched_barrier(0);
            }
#pragma unroll
            for (int R = 0; R < 16; ++R) { out0[R] = gc * o0[R]; out1[R] = gc * o1[R]; }
            float v[16], vx[16];
            { float Lx[16];
#pragma unroll
              for (int i = 0; i < 16; ++i) Lx[i] = __shfl_xor(L[i], 32);
#pragma unroll
              for (int i = 0; i < 16; ++i) { const float prevL = hl ? Lx[i] : (i > 0 ? Lx[i > 0 ? i - 1 : 0] : 0.f); const float bl = prevL + 2.f * G[i] - L[i];
                const int j = 2 * i + hl; const bool forced = (j == 0) || (j == cur) || (j == cur - 1);
                v[i] = forced ? __builtin_inff() : (j <= cur ? bl : -__builtin_inff()); } }
#pragma unroll
            for (int i = 0; i < 16; ++i) vx[i] = __shfl_xor(v[i], 32);
            u32 own = 0u;
#pragma unroll
            for (int i = 0; i < 16; ++i) { int rank = 0;
#pragma unroll
                for (int i2 = 0; i2 < 16; ++i2) {
                    if (i2 != i) rank += (v[i2] > v[i] || (v[i2] == v[i] && i2 < i)) ? 1 : 0;
                    const bool xlt = (i2 < i) || (hl && i2 == i);
                    rank += (vx[i2] > v[i] || (vx[i2] == v[i] && xlt)) ? 1 : 0; }
                const int j = 2 * i + hl; own |= ((j <= cur) && rank < 16) ? (1u << j) : 0u; }
            sel = own | (u32)__shfl_xor((int)own, 32);
            __builtin_amdgcn_sched_barrier(0);
        }
        {
            float m = -1e30f, l = 0.f; f32x16 o0 = zero16(), o1 = zero16();
            const bf16_t* kb = Z + (size_t)(b * SEQ + c) * NZ + ZC_KS + g * 64 + 8 * hl;
            const bf16_t* vb = vsT + ((size_t)(b * 2 + g) * 64 + c) * SEQ + 4 * hl;
            for (int jb = 0; jb <= cur; ++jb) {
                const bool mine = (sel >> jb) & 1u;
                if (__ballot(mine) == 0ull) continue;
#pragma unroll
                for (int h2 = 0; h2 < 2; ++h2) { const int key0 = jb * 64 + h2 * 32;
                    f32x16 s = zero16();
#pragma unroll
                    for (int kk = 0; kk < 4; ++kk) s = MFMA32(ld8(kb + (size_t)key0 * NZ + 16 * kk), qfr[kk], s);
                    const u32 vm = mine ? vm_le(pos - key0 - 4 * hl) : 0u;
                    flash_tile(m, l, o0, o1, s, vm, vb + key0, (size_t)32 * SEQ); }
            }
            const float f = gs / fmaxf(l, 1e-30f);
#pragma unroll
            for (int R = 0; R < 16; ++R) { out0[R] += f * o0[R]; out1[R] += f * o1[R]; }
        }
        {
            float m = -1e30f, l = 0.f; f32x16 o0 = zero16(), o1 = zero16();
            const bf16_t* kb = Z + (size_t)(b * SEQ + c) * NZ + ZC_KW + g * 64 + 8 * hl;
            const bf16_t* vb = vwT + ((size_t)(b * 2 + g) * 64 + c) * SEQ + 4 * hl;
            const int kstart = pmin - 511 > 0 ? pmin - 511 : 0;
            for (int kt = kstart >> 5; kt <= (pmin + 7) >> 5; ++kt) { const int key0 = kt * 32;
                f32x16 s = zero16();
#pragma unroll
                for (int kk = 0; kk < 4; ++kk) s = MFMA32(ld8(kb + (size_t)key0 * NZ + 16 * kk), qfr[kk], s);
                const int d1 = pos - key0 - 4 * hl; const u32 vm = vm_le(d1) & ~vm_le(d1 - 512);
                flash_tile(m, l, o0, o1, s, vm, vb + key0, (size_t)32 * SEQ); }
            const float f = gw / fmaxf(l, 1e-30f);
#pragma unroll
            for (int R = 0; R < 16; ++R) { out0[R] += f * o0[R]; out1[R] += f * o1[R]; }
        }
        store_ot(onsa + (size_t)(b * SEQ + pos) * 512 + head * 64, out0, out1, hl);
    }
}

__device__ __forceinline__ void st_dsa(const Params& p, unsigned char* lds) {
    int tid_ = threadIdx.x; asm volatile("" : "+v"(tid_)); const int tid = tid_, lane = tid & 63, w = __builtin_amdgcn_readfirstlane(tid >> 6), c_ = lane & 31, hl_ = lane >> 5;
    const bf16_t* Z = (const bf16_t*)(p.ws + WS_Z); unsigned char* dob = (unsigned char*)p.out;
    const bf16_t* kd = (const bf16_t*)(dob + DO_KD); const bf16_t* vdT = (const bf16_t*)(dob + DO_VDT);
    bf16_t* odsa = (bf16_t*)(p.ws + WS_ODSA);
    u32* mk = (u32*)lds;
    for (int ps = blockIdx.x; ps < 256; ps += gridDim.x)
    for (int which = 0; which < 2; ++which) {
        const int b = ps >> 5, jj = ps & 31, qb = which ? 63 - jj : jj;
        const int tok0 = b * SEQ + qb * 32;
        int c = c_, hl = hl_; asm volatile("" : "+v"(c), "+v"(hl));
        __syncthreads();
        {
            const int r = c; const int qq_r = ((r >> 2) & 1) * 2 + (r >> 4), head_r = ((r >> 3) & 1) * 4 + (r & 3);
            bf16x8 afr[4];
#pragma unroll
            for (int kk = 0; kk < 4; ++kk) afr[kk] = ld8(Z + (size_t)(tok0 + 4 * w + qq_r) * NZ + ZC_QI + head_r * 64 + 16 * kk + 8 * hl);
            float wv[2][8]; int posq[2];
#pragma unroll
            for (int s = 0; s < 2; ++s) { posq[s] = qb * 32 + 4 * w + 2 * hl + s;
                const uint4 ww = *(const uint4*)(Z + (size_t)(tok0 + 4 * w + 2 * hl + s) * NZ + ZC_WI);
                wv[s][0] = bflo(ww.x) * 0.35355339059327373f; wv[s][1] = bfhi(ww.x) * 0.35355339059327373f; wv[s][2] = bflo(ww.y) * 0.35355339059327373f; wv[s][3] = bfhi(ww.y) * 0.35355339059327373f;
                wv[s][4] = bflo(ww.z) * 0.35355339059327373f; wv[s][5] = bfhi(ww.z) * 0.35355339059327373f; wv[s][6] = bflo(ww.w) * 0.35355339059327373f; wv[s][7] = bfhi(ww.w) * 0.35355339059327373f; }
            u32 key[64][2];
            const bf16_t* kib = Z + (size_t)(b * SEQ + c) * NZ + ZC_KI + 8 * hl;
            bf16x8 bc[4];
#pragma unroll
            for (int kk = 0; kk < 4; ++kk) bc[kk] = ld8(kib + 16 * kk);
            const bf16_t* kp = kib;
#pragma unroll
            for (int kt = 0; kt < 64; ++kt) {
                if (kt <= qb) {
                    bf16x8 bn[4];
                    if (kt + 1 <= qb) kp += (size_t)32 * NZ;
                    asm volatile("" : "+v"(kp));
#pragma unroll
                    for (int kk = 0; kk < 4; ++kk) bn[kk] = ld8(kp + 16 * kk);
                    f32x16 acc = zero16();
#pragma unroll
                    for (int kk = 0; kk < 4; ++kk) acc = MFMA32(afr[kk], bc[kk], acc);
#pragma unroll
                    for (int s = 0; s < 2; ++s) { float sc = 0.f;
#pragma unroll
                        for (int e = 0; e < 8; ++e) sc = fmaf(wv[s][e], fmaxf(acc[8 * s + e], 0.f), sc);
                        key[kt][s] = (c <= posq[s] - kt * 32) ? ordf(sc) : 0u; }
#pragma unroll
                    for (int kk = 0; kk < 4; ++kk) bc[kk] = bn[kk];
                } else { key[kt][0] = 0u; key[kt][1] = 0u; }
                __builtin_amdgcn_sched_barrier(0);
            }
            u32 lo[2], hi[2], thr[2]; bool done[2], exact[2];
#pragma unroll
            for (int s = 0; s < 2; ++s) { lo[s] = 0x00800000u; hi[s] = 0xFF800000u; thr[s] = 1u; exact[s] = true; done[s] = posq[s] < 256; }
            for (int iter = 0; iter < 40; ++iter) {
                if (__all(done[0] && done[1])) break;
                u32 mid[2]; int cnt[2];
#pragma unroll
                for (int s = 0; s < 2; ++s) { mid[s] = lo[s] + ((hi[s] - lo[s]) >> 1); cnt[s] = 0; }
#pragma unroll
                for (int kt = 0; kt < 64; ++kt) { cnt[0] += (key[kt][0] >= mid[0]) ? 1 : 0; cnt[1] += (key[kt][1] >= mid[1]) ? 1 : 0; }
#pragma unroll
                for (int s = 0; s < 2; ++s) {
#pragma unroll
                    for (int o = 1; o < 32; o <<= 1) cnt[s] += __shfl_xor(cnt[s], o);
                    if (!done[s]) { if (cnt[s] >= 256) lo[s] = mid[s]; else hi[s] = mid[s];
                        if (cnt[s] == 256) { thr[s] = mid[s]; exact[s] = true; done[s] = true; }
                        else if (hi[s] - lo[s] <= 1u) { thr[s] = lo[s]; exact[s] = false; done[s] = true; } } }
            }
            if (__all(exact[0] && exact[1])) {
#pragma unroll
                for (int kt = 0; kt < 64; ++kt) if (kt <= qb) {
#pragma unroll
                    for (int s = 0; s < 2; ++s) { const unsigned long long bal = __ballot(key[kt][s] >= thr[s]);
                        if (lane == 0) { mk[(4 * w + s) * 65 + kt] = (u32)bal; mk[(4 * w + 2 + s) * 65 + kt] = (u32)(bal >> 32); } } }
            } else {
#pragma unroll
                for (int s = 0; s < 2; ++s) {
                    int cgt = 0; const u32 lowk = exact[s] ? thr[s] : thr[s] + 1u;
#pragma unroll
                    for (int kt = 0; kt < 64; ++kt) cgt += (key[kt][s] >= lowk) ? 1 : 0;
#pragma unroll
                    for (int o = 1; o < 32; o <<= 1) cgt += __shfl_xor(cgt, o);
                    const int need = exact[s] ? 0 : 256 - cgt;
                    int rem0 = __shfl(need, 0), rem1 = __shfl(need, 32);
                    const u32 eqk = exact[s] ? 0xFFFFFFFFu : thr[s];
#pragma unroll
                    for (int kt = 0; kt < 64; ++kt) if (kt <= qb) {
                        const unsigned long long bg = __ballot(key[kt][s] >= lowk), be = __ballot(key[kt][s] == eqk);
                        u32 e0 = (u32)be, e1 = (u32)(be >> 32);
                        while (__popc(e0) > rem0) e0 &= ~(1u << (31 - __clz(e0)));
                        while (__popc(e1) > rem1) e1 &= ~(1u << (31 - __clz(e1)));
                        rem0 -= __popc(e0); rem1 -= __popc(e1);
                        if (lane == 0) { mk[(4 * w + s) * 65 + kt] = (u32)bg | e0; mk[(4 * w + 2 + s) * 65 + kt] = (u32)(bg >> 32) | e1; } }
                }
            }
        }
        __syncthreads();
        {
            bf16x8 qfr[4];
#pragma unroll
            for (int kk = 0; kk < 4; ++kk) qfr[kk] = ld8(Z + (size_t)(tok0 + c) * NZ + ZC_QD + w * 64 + 16 * kk + 8 * hl);
            float m = -1e30f, l = 0.f; f32x16 o0 = zero16(), o1 = zero16();
            const bf16_t* kb = kd + (size_t)(b * SEQ + c) * 64 + 8 * hl;
            const bf16_t* vb = vdT + ((size_t)b * 64 + c) * SEQ + 4 * hl;
            for (int kt = 0; kt <= qb; ++kt) {
                const u32 word = mk[c * 65 + kt];
                if (__ballot(word != 0u) == 0ull) continue;
                f32x16 s = zero16();
#pragma unroll
                for (int kk = 0; kk < 4; ++kk) s = MFMA32(ld8(kb + (size_t)kt * 32 * 64 + 16 * kk), qfr[kk], s);
                flash_tile(m, l, o0, o1, s, vm_from_word(word, hl), vb + kt * 32, (size_t)32 * SEQ);
            }
            const float f = 1.0f / fmaxf(l, 1e-30f);
#pragma unroll
            for (int R = 0; R < 16; ++R) { o0[R] *= f; o1[R] *= f; }
            store_ot(odsa + (size_t)(tok0 + c) * 512 + w * 64, o0, o1, hl);
        }
    }
}

constexpr int TILE_B = 4608;
template <int NT> __device__ __forceinline__ void sk_gload(uint4 (&rk)[NT / 2], const bf16_t* kbase, size_t kstride, int t0c, int tlast, int tid) {
#pragma unroll
    for (int q = 0; q < NT / 2; ++q) { const int idx = tid + 512 * q, tile = idx >> 8, r = (idx >> 3) & 31, ch = idx & 7; int tg = t0c + tile; tg = tg > tlast ? tlast : tg;
        rk[q] = *(const uint4*)(kbase + (size_t)(32 * tg + r) * kstride + 8 * ch); }
}
template <int NT> __device__ __forceinline__ void sk_lwrite(const uint4 (&rk)[NT / 2], LAS unsigned char* kb, int tid) {
#pragma unroll
    for (int q = 0; q < NT / 2; ++q) { const int idx = tid + 512 * q, tile = idx >> 8, r = (idx >> 3) & 31, ch = idx & 7; const u32x4 v = {rk[q].x, rk[q].y, rk[q].z, rk[q].w}; *(LAS u32x4*)(kb + tile * TILE_B + r * 144 + ch * 16) = v; }
}
template <int NT> __device__ __forceinline__ void sv_gload(uint4 (&rv)[NT / 2], const bf16_t* vbase, size_t vstride, int t0c, int tlast, int tid) {
#pragma unroll
    for (int q = 0; q < NT / 2; ++q) { const int idx = tid + 512 * q, tile = idx >> 8, d = (idx >> 2) & 63, sg = idx & 3; int tg = t0c + tile; tg = tg > tlast ? tlast : tg;
        rv[q] = *(const uint4*)(vbase + (size_t)d * vstride + 32 * tg + 8 * sg); }
}
template <int NT> __device__ __forceinline__ void sv_lwrite(const uint4 (&rv)[NT / 2], LAS unsigned char* vb, int tid) {
#pragma unroll
    for (int q = 0; q < NT / 2; ++q) { const int idx = tid + 512 * q, tile = idx >> 8, d = (idx >> 2) & 63, sg = idx & 3; LAS unsigned char* a = vb + tile * TILE_B + d * 72 + sg * 16;
        const u32x2 v0 = {rv[q].x, rv[q].y}, v1 = {rv[q].z, rv[q].w}; *(LAS u32x2*)a = v0; *(LAS u32x2*)(a + 8) = v1; }
}
__device__ __forceinline__ bf16x8 lds_k(const LAS unsigned char* kt, int c, int hl, int kk) { return *(const LAS bf16x8*)(kt + c * 144 + kk * 32 + hl * 16); }
__device__ __forceinline__ bf16x8 lds_v(const LAS unsigned char* vt, int d, int hl, int s) { const LAS unsigned char* q = vt + d * 72 + s * 32 + hl * 8;
    const u32x2 a = *(const LAS u32x2*)q, b = *(const LAS u32x2*)(q + 16); const u32x4 v = {a.x, a.y, b.x, b.y}; return __builtin_bit_cast(bf16x8, v); }
__device__ __forceinline__ void flash_tile_lds(float& m2, float& l, f32x16& o0, f32x16& o1, f32x16 s, u32 vm, bool full, const LAS unsigned char* vt, int c, int hl) {
    const float LOG2E = 1.4426950408889634f;
    const bf16x8 v00 = lds_v(vt, c, hl, 0), v01 = lds_v(vt, c, hl, 1), v10 = lds_v(vt, c + 32, hl, 0), v11 = lds_v(vt, c + 32, hl, 1);
    float mx = -1e30f;
    if (full) {
#pragma unroll
        for (int R = 0; R < 16; ++R) mx = fmaxf(mx, s[R]);
    } else {
#pragma unroll
        for (int R = 0; R < 16; ++R) { s[R] = ((vm >> R) & 1u) ? s[R] : -1e30f; mx = fmaxf(mx, s[R]); }
    }
    mx = fmaxf(mx, __shfl_xor(mx, 32));
    const float mn2 = fmaxf(m2, mx * LOG2E);
    if (!__all(mn2 == m2)) { const float al = __builtin_amdgcn_exp2f(m2 - mn2); l *= al;
#pragma unroll
        for (int R = 0; R < 16; ++R) { o0[R] *= al; o1[R] *= al; }
        m2 = mn2; }
    float ps = 0.f;
    if (full) {
#pragma unroll
        for (int R = 0; R < 16; ++R) { const float pr = __builtin_amdgcn_exp2f(fmaf(s[R], LOG2E, -mn2)); s[R] = pr; ps += pr; }
    } else {
#pragma unroll
        for (int R = 0; R < 16; ++R) { const float pr = ((vm >> R) & 1u) ? __builtin_amdgcn_exp2f(fmaf(s[R], LOG2E, -mn2)) : 0.f; s[R] = pr; ps += pr; }
    }
    ps += __shfl_xor(ps, 32);
    l += ps;
    const bf16x8 p0 = pack8<0>(s), p1 = pack8<1>(s);
    o0 = MFMA32(v00, p0, o0); o0 = MFMA32(v01, p1, o0);
    o1 = MFMA32(v10, p0, o1); o1 = MFMA32(v11, p1, o1);
}
#define HALF_SUM32(v, hl, out) do { int _v = (v); _v += __builtin_amdgcn_update_dpp(0, _v, 0xB1, 0xF, 0xF, true); _v += __builtin_amdgcn_update_dpp(0, _v, 0x4E, 0xF, 0xF, true); \
    _v += __builtin_amdgcn_update_dpp(0, _v, 0x141, 0xF, 0xF, true); _v += __builtin_amdgcn_update_dpp(0, _v, 0x140, 0xF, 0xF, true); \
    const int _r0 = __builtin_amdgcn_readlane(_v, 0) + __builtin_amdgcn_readlane(_v, 16), _r1 = __builtin_amdgcn_readlane(_v, 32) + __builtin_amdgcn_readlane(_v, 48); (out) = (hl) ? _r1 : _r0; } while (0)
constexpr int ATT_CHUNK = 8 * TILE_B;
constexpr int ATT_MK_OFF = 2 * ATT_CHUNK;

#define ATT_STREAM_KV(kbase, kstride, vbase, vstride, tfirst, tlast, BODY) do { \
    const int _tf = (tfirst), _tl = (tlast); const int _nch = (_tl - _tf + 4) >> 2; \
    uint4 _rk[2], _rv[2]; \
    __syncthreads(); \
    sk_gload<4>(_rk, (kbase), (kstride), _tf, _tl, tid); sv_gload<4>(_rv, (vbase), (vstride), _tf, _tl, tid); \
    sk_lwrite<4>(_rk, sm, tid); sv_lwrite<4>(_rv, sm + 4 * TILE_B, tid); \
    if (_nch > 1) { sk_gload<4>(_rk, (kbase), (kstride), _tf + 4, _tl, tid); sv_gload<4>(_rv, (vbase), (vstride), _tf + 4, _tl, tid); } \
    for (int _c = 0; _c < _nch; ++_c) { \
        __syncthreads(); \
        if (_c + 1 < _nch) { LAS unsigned char* _nb = sm + ((_c + 1) & 1) * ATT_CHUNK; sk_lwrite<4>(_rk, _nb, tid); sv_lwrite<4>(_rv, _nb + 4 * TILE_B, tid); \
            if (_c + 2 < _nch) { sk_gload<4>(_rk, (kbase), (kstride), _tf + 4 * (_c + 2), _tl, tid); sv_gload<4>(_rv, (vbase), (vstride), _tf + 4 * (_c + 2), _tl, tid); } } \
        const LAS unsigned char* _cb = sm + (_c & 1) * ATT_CHUNK; \
        _Pragma("unroll") for (int _i = 0; _i < 4; ++_i) { const int tg = _tf + 4 * _c + _i; if (tg <= _tl) { const LAS unsigned char* kt = _cb + _i * TILE_B; const LAS unsigned char* vt = _cb + (4 + _i) * TILE_B; BODY } } \
    } } while (0)

__device__ __forceinline__ void st_nsa2(const Params& p, unsigned char* lds) {
    LAS unsigned char* sm = (LAS unsigned char*)lds;
    const bf16_t* Z = (const bf16_t*)(p.ws + WS_Z); unsigned char* dob = (unsigned char*)p.out;
    const bf16_t* kcmp = (const bf16_t*)(dob + DO_KCMP); const bf16_t* vcmpT = (const bf16_t*)(dob + DO_VCMPT);
    const bf16_t* vsT = (const bf16_t*)(dob + DO_VST); const bf16_t* vwT = (const bf16_t*)(dob + DO_VWT);
    bf16_t* onsa = (bf16_t*)(p.ws + WS_ONSA);
    for (int ps = blockIdx.x; ps < 256; ps += gridDim.x)
    for (int which = 0; which < 2; ++which) {
        const int b = ps >> 5, g = (ps >> 4) & 1, jj = ps & 15, qb = which ? 31 - jj : jj, cur = qb;
        int tid = threadIdx.x; asm volatile("" : "+v"(tid));
        const int lane = tid & 63, w = __builtin_amdgcn_readfirstlane(tid >> 6), c = lane & 31, hl = lane >> 5;
        const int t0 = qb * 64, pmin = t0 + 8 * w, pos = pmin + (c >> 2), head = 4 * g + (c & 3);
        const bf16_t* zr = Z + (size_t)(b * SEQ + pos) * NZ;
        bf16x8 qfr[4];
#pragma unroll
        for (int kk = 0; kk < 4; ++kk) qfr[kk] = ld8(zr + ZC_QN + head * 64 + 16 * kk + 8 * hl);
        const float gc = bf2f(zr[ZC_GN + head * 3]), gs = bf2f(zr[ZC_GN + head * 3 + 1]), gw = bf2f(zr[ZC_GN + head * 3 + 2]);
        f32x16 out0 = zero16(), out1 = zero16();
        u32 sel;
        {
            const int pmax = pmin + 7; const int nmax = pmax >= 31 ? ((pmax - 31) >> 4) : -1; const int ntile = nmax >= 0 ? (((nmax > 126 ? 126 : nmax) >> 5) + 1) : 0;
            const bf16_t* kb = kcmp + ((size_t)(b * 2 + g) * 128 + c) * 64 + 8 * hl;
            float mx = -1e30f, l = 0.f;
            const int nlim = (pos >= 31 ? (((pos - 31) >> 4) > 126 ? 126 : ((pos - 31) >> 4)) : -1) - 4 * hl;
            for (int kt = 0; kt < ntile; ++kt) {
                f32x16 s = zero16();
#pragma unroll
                for (int kk = 0; kk < 4; ++kk) s = MFMA32(ld8(kb + (size_t)kt * 32 * 64 + 16 * kk), qfr[kk], s);
                const u32 vm = vm_le(nlim - 32 * kt);
                float tm = -1e30f;
#pragma unroll
                for (int R = 0; R < 16; ++R) { s[R] = ((vm >> R) & 1u) ? s[R] : -1e30f; tm = fmaxf(tm, s[R]); }
                const float mn = fmaxf(mx, tm); float ps2 = 0.f;
#pragma unroll
                for (int R = 0; R < 16; ++R) ps2 += ((vm >> R) & 1u) ? __expf(s[R] - mn) : 0.f;
                l = l * __expf(mx - mn) + ps2; mx = mn;
            }
            { const float mo = __shfl_xor(mx, 32), lo_ = __shfl_xor(l, 32); const float mn = fmaxf(mx, mo);
              l = l * __expf(mx - mn) + lo_ * __expf(mo - mn); mx = mn; }
            const float il = 1.0f / fmaxf(l, 1e-30f);
            __builtin_amdgcn_sched_barrier(0);
            f32x16 o0 = zero16(), o1 = zero16();
            const bf16_t* vb = vcmpT + ((size_t)(b * 2 + g) * 64 + c) * 128 + 4 * hl;
            float G[16], L[16];
#pragma unroll
            for (int kt = 0; kt < 4; ++kt) {
                if (kt < ntile) {
                    f32x16 s = zero16();
#pragma unroll
                    for (int kk = 0; kk < 4; ++kk) s = MFMA32(ld8(kb + (size_t)kt * 32 * 64 + 16 * kk), qfr[kk], s);
                    const u32 vm = vm_le(nlim - 32 * kt);
#pragma unroll
                    for (int R = 0; R < 16; ++R) s[R] = ((vm >> R) & 1u) ? __expf(s[R] - mx) * il : 0.f;
                    const bf16x8 p0 = pack8<0>(s), p1 = pack8<1>(s);
                    o0 = MFMA32(ld44(vb + 32 * kt), p0, o0); o0 = MFMA32(ld44(vb + 32 * kt + 16), p1, o0);
                    o1 = MFMA32(ld44(vb + 32 * 128 + 32 * kt), p0, o1); o1 = MFMA32(ld44(vb + 32 * 128 + 32 * kt + 16), p1, o1);
#pragma unroll
                    for (int rg = 0; rg < 4; ++rg) { float gsum = (s[4 * rg] + s[4 * rg + 1]) + (s[4 * rg + 2] + s[4 * rg + 3]); float last = s[4 * rg + 3];
                        gsum += dpp_xor1(gsum); gsum += dpp_xor2(gsum); last += dpp_xor1(last); last += dpp_xor2(last);
                        G[4 * kt + rg] = gsum; L[4 * kt + rg] = last; }
                } else {
#pragma unroll
                    for (int rg = 0; rg < 4; ++rg) { G[4 * kt + rg] = 0.f; L[4 * kt + rg] = 0.f; }
                }
                __builtin_amdgcn_sched_barrier(0);
            }
#pragma unroll
            for (int R = 0; R < 16; ++R) { out0[R] = gc * o0[R]; out1[R] = gc * o1[R]; }
            float v[16], vx[16];
            { float Lx[16];
#pragma unroll
              for (int i = 0; i < 16; ++i) Lx[i] = __shfl_xor(L[i], 32);
#pragma unroll
              for (int i = 0; i < 16; ++i) { const float prevL = hl ? Lx[i] : (i > 0 ? Lx[i > 0 ? i - 1 : 0] : 0.f); const float bl = prevL + 2.f * G[i] - L[i];
                const int j = 2 * i + hl; const bool forced = (j == 0) || (j == cur) || (j == cur - 1);
                v[i] = forced ? __builtin_inff() : (j <= cur ? bl : -__builtin_inff()); } }
#pragma unroll
            for (int i = 0; i < 16; ++i) vx[i] = __shfl_xor(v[i], 32);
            u32 own = 0u;
#pragma unroll
            for (int i = 0; i < 16; ++i) { int rank = 0;
#pragma unroll
                for (int i2 = 0; i2 < 16; ++i2) {
                    if (i2 != i) rank += (v[i2] > v[i] || (v[i2] == v[i] && i2 < i)) ? 1 : 0;
                    const bool xlt = (i2 < i) || (hl && i2 == i);
                    rank += (vx[i2] > v[i] || (vx[i2] == v[i] && xlt)) ? 1 : 0; }
                const int j = 2 * i + hl; own |= ((j <= cur) && rank < 16) ? (1u << j) : 0u; }
            sel = own | (u32)__shfl_xor((int)own, 32);
            __builtin_amdgcn_sched_barrier(0);
        }
        {
            float m = -1e30f, l = 0.f; f32x16 o0 = zero16(), o1 = zero16();
            ATT_STREAM_KV(Z + (size_t)(b * SEQ) * NZ + ZC_KS + g * 64, (size_t)NZ, vsT + (size_t)(b * 2 + g) * 64 * SEQ, (size_t)SEQ, 0, 2 * cur + 1, {
                const bool mine = (sel >> (tg >> 1)) & 1u;
                if (__ballot(mine) != 0ull) {
                    f32x16 s = zero16();
                    _Pragma("unroll") for (int kk = 0; kk < 4; ++kk) s = MFMA32(lds_k(kt, c, hl, kk), qfr[kk], s);
                    const bool full = (tg * 32 + 31 <= pmin) && (__ballot(mine) == ~0ull);
                    const u32 vm = full ? 0xFFFFu : (mine ? vm_le(pos - tg * 32 - 4 * hl) : 0u);
                    flash_tile_lds(m, l, o0, o1, s, vm, full, vt, c, hl); } });
            const float f = gs / fmaxf(l, 1e-30f);
#pragma unroll
            for (int R = 0; R < 16; ++R) { out0[R] += f * o0[R]; out1[R] += f * o1[R]; }
        }
        {
            float m = -1e30f, l = 0.f; f32x16 o0 = zero16(), o1 = zero16();
            const int wfirst = (t0 - 511 > 0 ? t0 - 511 : 0) >> 5, wlast = (t0 + 63) >> 5;
            const int myfirst = (pmin - 511 > 0 ? pmin - 511 : 0) >> 5, mylast = (pmin + 7) >> 5;
            ATT_STREAM_KV(Z + (size_t)(b * SEQ) * NZ + ZC_KW + g * 64, (size_t)NZ, vwT + (size_t)(b * 2 + g) * 64 * SEQ, (size_t)SEQ, wfirst, wlast, {
                if (tg >= myfirst && tg <= mylast) {
                    f32x16 s = zero16();
                    _Pragma("unroll") for (int kk = 0; kk < 4; ++kk) s = MFMA32(lds_k(kt, c, hl, kk), qfr[kk], s);
                    const bool full = (tg * 32 + 31 <= pmin) && (tg * 32 + 504 >= pmin);
                    const int d1 = pos - tg * 32 - 4 * hl; const u32 vm = full ? 0xFFFFu : (vm_le(d1) & ~vm_le(d1 - 512));
                    flash_tile_lds(m, l, o0, o1, s, vm, full, vt, c, hl); } });
            const float f = gw / fmaxf(l, 1e-30f);
#pragma unroll
            for (int R = 0; R < 16; ++R) { out0[R] += f * o0[R]; out1[R] += f * o1[R]; }
        }
        store_ot(onsa + (size_t)(b * SEQ + pos) * 512 + head * 64, out0, out1, hl);
    }
    __syncthreads();
}

__device__ __forceinline__ void st_dsa2(const Params& p, unsigned char* lds) {
    LAS unsigned char* sm = (LAS unsigned char*)lds;
    const bf16_t* Z = (const bf16_t*)(p.ws + WS_Z); unsigned char* dob = (unsigned char*)p.out;
    const bf16_t* kd = (const bf16_t*)(dob + DO_KD); const bf16_t* vdT = (const bf16_t*)(dob + DO_VDT);
    bf16_t* odsa = (bf16_t*)(p.ws + WS_ODSA);
    u32* mk = (u32*)(lds + ATT_MK_OFF);
    for (int ps = blockIdx.x; ps < 256; ps += gridDim.x)
    for (int which = 0; which < 2; ++which) {
        const int b = ps >> 5, jj = ps & 31, qb = which ? 63 - jj : jj;
        const int tok0 = b * SEQ + qb * 32;
        int tid = threadIdx.x; asm volatile("" : "+v"(tid));
        const int lane = tid & 63, w = __builtin_amdgcn_readfirstlane(tid >> 6), c = lane & 31, hl = lane >> 5;
        for (int rep_a = 0; rep_a < (PROBE_STAGE == 21 ? 2 : 1); ++rep_a)
        {
            const int r = c; const int qq_r = ((r >> 2) & 1) * 2 + (r >> 4), head_r = ((r >> 3) & 1) * 4 + (r & 3);
            bf16x8 afr[4];
#pragma unroll
            for (int kk = 0; kk < 4; ++kk) afr[kk] = ld8(Z + (size_t)(tok0 + 4 * w + qq_r) * NZ + ZC_QI + head_r * 64 + 16 * kk + 8 * hl);
            float wv[2][8]; int posq[2];
#pragma unroll
            for (int s = 0; s < 2; ++s) { posq[s] = qb * 32 + 4 * w + 2 * hl + s;
                const uint4 ww = *(const uint4*)(Z + (size_t)(tok0 + 4 * w + 2 * hl + s) * NZ + ZC_WI);
                wv[s][0] = bflo(ww.x) * 0.35355339059327373f; wv[s][1] = bfhi(ww.x) * 0.35355339059327373f; wv[s][2] = bflo(ww.y) * 0.35355339059327373f; wv[s][3] = bfhi(ww.y) * 0.35355339059327373f;
                wv[s][4] = bflo(ww.z) * 0.35355339059327373f; wv[s][5] = bfhi(ww.z) * 0.35355339059327373f; wv[s][6] = bflo(ww.w) * 0.35355339059327373f; wv[s][7] = bfhi(ww.w) * 0.35355339059327373f; }
            u32 key[64][2];
            const bf16_t* kib = Z + (size_t)(b * SEQ) * NZ + ZC_KI;
            uint4 rk[4];
            __syncthreads();
            sk_gload<8>(rk, kib, (size_t)NZ, 0, qb, tid); sk_lwrite<8>(rk, sm, tid);
            if (qb >= 8) sk_gload<8>(rk, kib, (size_t)NZ, 8, qb, tid);
#pragma unroll
            for (int ch = 0; ch < 8; ++ch) {
                if (ch * 8 <= qb) {
                    __syncthreads();
                    if ((ch + 1) * 8 <= qb) { sk_lwrite<8>(rk, sm + ((ch + 1) & 1) * ATT_CHUNK, tid);
                        if ((ch + 2) * 8 <= qb) sk_gload<8>(rk, kib, (size_t)NZ, (ch + 2) * 8, qb, tid); }
                    const LAS unsigned char* cb = sm + (ch & 1) * ATT_CHUNK;
#pragma unroll
                    for (int i = 0; i < 8; ++i) { const int kt = ch * 8 + i;
                        if (kt <= qb) {
                            f32x16 acc = zero16();
#pragma unroll
                            for (int kk = 0; kk < 4; ++kk) acc = MFMA32(afr[kk], lds_k(cb + i * TILE_B, c, hl, kk), acc);
#pragma unroll
                            for (int s = 0; s < 2; ++s) { float sc = 0.f;
#pragma unroll
                                for (int e = 0; e < 8; ++e) sc = fmaf(wv[s][e], fmaxf(acc[8 * s + e], 0.f), sc);
                                key[kt][s] = (c <= posq[s] - kt * 32) ? (ordf(sc) >> 1) : 0u; }
                        } else { key[kt][0] = 0u; key[kt][1] = 0u; }
                        __builtin_amdgcn_sched_barrier(0);
                    }
                } else {
#pragma unroll
                    for (int i = 0; i < 8; ++i) { key[ch * 8 + i][0] = 0u; key[ch * 8 + i][1] = 0u; }
                }
            }
            u32 lo[2], hi[2], thr[2]; bool done[2], exact[2];
            for (int rep_bis = 0; rep_bis < (PROBE_STAGE == 23 ? 2 : 1); ++rep_bis) {
#pragma unroll
            for (int s = 0; s < 2; ++s) { lo[s] = 0x00400000u; hi[s] = 0x7FC00000u; thr[s] = 1u; exact[s] = true; done[s] = posq[s] < 256; }
            for (int iter = 0; iter < 40; ++iter) {
                if (__all(done[0] && done[1])) break;
                u32 mid[2]; int cnt[2];
#pragma unroll
                for (int s = 0; s < 2; ++s) { mid[s] = lo[s] + ((hi[s] - lo[s]) >> 1); cnt[s] = 0; }
                {
                    int a0 = 0, a1 = 0, a2 = 0, a3 = 0, b0 = 0, b1 = 0, b2 = 0, b3 = 0;
#pragma unroll
                    for (int kt = 0; kt < 64; kt += 4) {
                        a0 += (int)(key[kt][0] - mid[0]) >> 31; a1 += (int)(key[kt + 1][0] - mid[0]) >> 31; a2 += (int)(key[kt + 2][0] - mid[0]) >> 31; a3 += (int)(key[kt + 3][0] - mid[0]) >> 31;
                        b0 += (int)(key[kt][1] - mid[1]) >> 31; b1 += (int)(key[kt + 1][1] - mid[1]) >> 31; b2 += (int)(key[kt + 2][1] - mid[1]) >> 31; b3 += (int)(key[kt + 3][1] - mid[1]) >> 31; }
                    cnt[0] = 64 + ((a0 + a1) + (a2 + a3)); cnt[1] = 64 + ((b0 + b1) + (b2 + b3)); }
#pragma unroll
                for (int s = 0; s < 2; ++s) {
                    HALF_SUM32(cnt[s], hl, cnt[s]);
                    if (!done[s]) { if (cnt[s] >= 256) lo[s] = mid[s]; else hi[s] = mid[s];
                        if (cnt[s] == 256) { thr[s] = mid[s]; exact[s] = true; done[s] = true; }
                        else if (hi[s] - lo[s] <= 1u) { thr[s] = lo[s]; exact[s] = false; done[s] = true; } } }
            }
            }
            for (int rep_em = 0; rep_em < (PROBE_STAGE == 25 ? 2 : 1); ++rep_em)
            if (__all(exact[0] && exact[1])) {
#pragma unroll
                for (int kt = 0; kt < 64; ++kt) if (kt <= qb) {
#pragma unroll
                    for (int s = 0; s < 2; ++s) { const unsigned long long bal = __ballot(key[kt][s] >= thr[s]);
                        if (lane == 0) { mk[(4 * w + s) * 65 + kt] = (u32)bal; mk[(4 * w + 2 + s) * 65 + kt] = (u32)(bal >> 32); } } }
            } else {
#pragma unroll
                for (int s = 0; s < 2; ++s) {
                    int cgt = 0; const u32 lowk = exact[s] ? thr[s] : thr[s] + 1u;
#pragma unroll
                    for (int kt = 0; kt < 64; ++kt) cgt += (key[kt][s] >= lowk) ? 1 : 0;
                    HALF_SUM32(cgt, hl, cgt);
                    const int need = exact[s] ? 0 : 256 - cgt;
                    int rem0 = __shfl(need, 0), rem1 = __shfl(need, 32);
                    const u32 eqk = exact[s] ? 0xFFFFFFFFu : thr[s];
#pragma unroll
                    for (int kt = 0; kt < 64; ++kt) if (kt <= qb) {
                        const unsigned long long bg = __ballot(key[kt][s] >= lowk), be = __ballot(key[kt][s] == eqk);
                        u32 e0 = (u32)be, e1 = (u32)(be >> 32);
                        while (__popc(e0) > rem0) e0 &= ~(1u << (31 - __clz(e0)));
                        while (__popc(e1) > rem1) e1 &= ~(1u << (31 - __clz(e1)));
                        rem0 -= __popc(e0); rem1 -= __popc(e1);
                        if (lane == 0) { mk[(4 * w + s) * 65 + kt] = (u32)bg | e0; mk[(4 * w + 2 + s) * 65 + kt] = (u32)(bg >> 32) | e1; } }
                }
            }
        }
        for (int rep_b = 0; rep_b < (PROBE_STAGE == 22 ? 2 : 1); ++rep_b)
        {
            bf16x8 qfr[4];
#pragma unroll
            for (int kk = 0; kk < 4; ++kk) qfr[kk] = ld8(Z + (size_t)(tok0 + c) * NZ + ZC_QD + w * 64 + 16 * kk + 8 * hl);
            float m = -1e30f, l = 0.f; f32x16 o0 = zero16(), o1 = zero16();
            ATT_STREAM_KV(kd + (size_t)(b * SEQ) * 64, (size_t)64, vdT + (size_t)b * 64 * SEQ, (size_t)SEQ, 0, qb, {
                const u32 word = mk[c * 65 + tg];
                if (__ballot(word != 0u) != 0ull) {
                    f32x16 s = zero16();
                    _Pragma("unroll") for (int kk = 0; kk < 4; ++kk) s = MFMA32(lds_k(kt, c, hl, kk), qfr[kk], s);
                    flash_tile_lds(m, l, o0, o1, s, vm_from_word(word, hl), false, vt, c, hl); } });
            const float f = 1.0f / fmaxf(l, 1e-30f);
#pragma unroll
            for (int R = 0; R < 16; ++R) { o0[R] *= f; o1[R] *= f; }
            store_ot(odsa + (size_t)(tok0 + c) * 512 + w * 64, o0, o1, hl);
        }
    }
    __syncthreads();
}

typedef __bf16 v2bf_t __attribute__((ext_vector_type(2)));
__device__ __forceinline__ float dot2bf(u32 a, u32 b, float c) { return __builtin_amdgcn_fdot2_f32_bf16(__builtin_bit_cast(v2bf_t, a), __builtin_bit_cast(v2bf_t, b), c, false); }
__device__ __forceinline__ float dpp_hmirror(float v) { return __int_as_float(__builtin_amdgcn_update_dpp(0, __float_as_int(v), 0x141, 0xF, 0xF, true)); }
__device__ __forceinline__ void st_expert2(const Params& p, unsigned char* lds) {
    int tid = threadIdx.x; asm volatile("" : "+v"(tid));
    const int lane = tid & 63, w = __builtin_amdgcn_readfirstlane(tid >> 6), rs = lane >> 3, ch = lane & 7;
    const bf16_t* h2 = (const bf16_t*)(p.ws + WS_H2); const bf16_t* u16 = (const bf16_t*)(p.ws + WS_U16); const bf16_t* v16 = (const bf16_t*)(p.ws + WS_V16);
    const int* eidx = (const int*)(p.ws + WS_EIDX); const float* gate = (const float*)(p.ws + WS_GATE); const float* mod = (const float*)(p.ws + WS_MOD);
    float* wl = (float*)lds + w * 256;
    int* el = (int*)(wl + 128);
    for (int t = blockIdx.x * 8 + w; t < T; t += gridDim.x * 8) {
        u32x4 xq[16];
#pragma unroll
        for (int i = 0; i < 16; ++i) xq[i] = *(const u32x4*)(h2 + (size_t)t * D + (ch + 8 * i) * 8);
        { const int e0 = eidx[(size_t)t * 128 + lane], e1 = eidx[(size_t)t * 128 + 64 + lane]; el[lane] = e0; el[64 + lane] = e1; }
#pragma unroll
        for (int rg = 0; rg < 16; ++rg) {
            const int e = eidx[(size_t)t * 128 + 8 * rg + rs]; const float gt = gate[(size_t)t * 128 + 8 * rg + rs];
            const bf16_t* ur = u16 + (size_t)e * D + ch * 8;
            float s0 = 0.f, s1 = 0.f;
#pragma unroll
            for (int i = 0; i < 16; ++i) { const u32x4 uv = *(const u32x4*)(ur + 64 * i);
                s0 = dot2bf(uv.x, xq[i].x, s0); s1 = dot2bf(uv.y, xq[i].y, s1); s0 = dot2bf(uv.z, xq[i].z, s0); s1 = dot2bf(uv.w, xq[i].w, s1); }
            float s = s0 + s1; s += dpp_hmirror(s); s += dpp_xor1(s); s += dpp_xor2(s);
            if (ch == 0) wl[8 * rg + rs] = gt * gelu_erf(s);
        }
        asm volatile("s_waitcnt lgkmcnt(0)" ::: "memory");
        float acc[16];
#pragma unroll
        for (int i = 0; i < 16; ++i) acc[i] = 0.f;
        for (int k0 = 0; k0 < 128; k0 += 8) {
            u32x4 va[8], vb[8]; float wk[8];
#pragma unroll
            for (int j = 0; j < 8; ++j) { const int e = __builtin_amdgcn_readfirstlane(el[k0 + j]); wk[j] = wl[k0 + j];
                const bf16_t* vr = v16 + (size_t)e * D + lane * 8; va[j] = *(const u32x4*)vr; vb[j] = *(const u32x4*)(vr + 512); }
#pragma unroll
            for (int j = 0; j < 8; ++j) {
                acc[0] += wk[j] * bflo(va[j].x); acc[1] += wk[j] * bfhi(va[j].x); acc[2] += wk[j] * bflo(va[j].y); acc[3] += wk[j] * bfhi(va[j].y);
                acc[4] += wk[j] * bflo(va[j].z); acc[5] += wk[j] * bfhi(va[j].z); acc[6] += wk[j] * bflo(va[j].w); acc[7] += wk[j] * bfhi(va[j].w);
                acc[8] += wk[j] * bflo(vb[j].x); acc[9] += wk[j] * bfhi(vb[j].x); acc[10] += wk[j] * bflo(vb[j].y); acc[11] += wk[j] * bfhi(vb[j].y);
                acc[12] += wk[j] * bflo(vb[j].z); acc[13] += wk[j] * bfhi(vb[j].z); acc[14] += wk[j] * bflo(vb[j].w); acc[15] += wk[j] * bfhi(vb[j].w); }
        }
        const float* g2 = mod + (t >> 11) * 6144 + 5120; float* xr = p.out + (size_t)t * D; float ss = 0.f;
#pragma unroll
        for (int hlf = 0; hlf < 2; ++hlf)
#pragma unroll
            for (int q = 0; q < 2; ++q) { const int d0 = hlf * 512 + lane * 8 + 4 * q; const float4 xv = *(const float4*)(xr + d0), gv = *(const float4*)(g2 + d0);
                float* a = acc + hlf * 8 + 4 * q; a[0] = xv.x + gv.x * a[0]; a[1] = xv.y + gv.y * a[1]; a[2] = xv.z + gv.z * a[2]; a[3] = xv.w + gv.w * a[3];
                ss += a[0] * a[0] + a[1] * a[1] + a[2] * a[2] + a[3] * a[3]; }
        const float r = rsqrtf(wave_sum(ss) * (1.0f / D) + EPS);
#pragma unroll
        for (int hlf = 0; hlf < 2; ++hlf)
#pragma unroll
            for (int q = 0; q < 2; ++q) { const int d0 = hlf * 512 + lane * 8 + 4 * q; const float4 fg = *(const float4*)(p.final_g + d0); const float* a = acc + hlf * 8 + 4 * q;
                float4 o; o.x = a[0] * r * fg.x; o.y = a[1] * r * fg.y; o.z = a[2] * r * fg.z; o.w = a[3] * r * fg.w; *(float4*)(xr + d0) = o; }
        asm volatile("s_waitcnt lgkmcnt(0)" ::: "memory");
    }
}

namespace pg8 {
typedef short bf16x8 __attribute__((ext_vector_type(8)));
typedef float f32x4 __attribute__((ext_vector_type(4)));
typedef unsigned u32x4 __attribute__((ext_vector_type(4)));
constexpr int BM = 256, BK = 64, HALF = 128, HTB = HALF * BK * 2, STAGE_BYTES = 8 * HTB, NXCD = 8, WGM = 8;
__host__ __device__ __forceinline__ int lds_byte(int r, int c) { const int st = (r >> 4) * 2 + (c >> 5), rr = r & 15, cc = c & 31, ob = rr * 64 + cc * 2; return st * 1024 + (ob ^ (((ob >> 9) & 1) << 5)); }
__host__ __device__ __forceinline__ void stage_rc(int b, int& R, int& C) { const int st = b / 1024, sb = b % 1024, swz = sb ^ (((sb >> 9) & 1) << 5); R = (st >> 1) * 16 + swz / 64; C = (st & 1) * 32 + (swz % 64) / 2; }
__host__ __device__ __forceinline__ int perm32(int rho) { const int n = rho >> 4, i = rho & 15; return 8 * (i >> 2) + 4 * n + (i & 3); }
struct Unit { int pm, pn; };
struct Gemm { const bf16_t* A; const bf16_t* Bt; int M, N, K; };
struct StaticOrder {
    int nM, nN, nwg, G, c;
    __host__ __device__ void init(int M, int N, int G_, int c_) { nM = M / BM; nN = N / BM; nwg = nM * nN; G = G_; c = c_; }
    __host__ __device__ bool next(int i, Unit& u) const {
        const long L = (long)i * G + c; if (L >= nwg) return false;
        int wgid = (int)L; { const int q = nwg / NXCD, r = nwg % NXCD, xcd = wgid % NXCD, off = wgid / NXCD; wgid = (xcd < r ? xcd * (q + 1) : r * (q + 1) + (xcd - r) * q) + off; }
        const int nig = WGM * nN, gid = wgid / nig, fm = gid * WGM, gsz = (nM - fm) < WGM ? (nM - fm) : WGM;
        u.pm = fm + ((wgid % nig) % gsz); u.pn = (wgid % nig) / gsz; return true;
    }
    __device__ __forceinline__ void a_ready(const Unit&) const {}
    __device__ __forceinline__ void done(const Unit&) const {}
};
__device__ __forceinline__ unsigned cvt_pk_bf16(float lo, float hi) { unsigned r; asm volatile("v_cvt_pk_bf16_f32 %0, %1, %2" : "=v"(r) : "v"(lo), "v"(hi)); return r; }

template <class Epi, class Sched, bool ALIGN_EPI = false, bool SP2 = false>
__device__ __forceinline__ void gemm_phase(LAS unsigned char* lds, const Gemm g, const Sched& S, const Epi& E) {
    int tid = threadIdx.x; asm volatile("" : "+v"(tid));
    const int wid = __builtin_amdgcn_readfirstlane(tid >> 6), lane = tid & 63, wr = wid >> 2, wc = wid & 3, fr = lane & 15, fq = lane >> 4;
    const int K = g.K, nt = K / BK;
    unsigned voffA[2], voffB[2];
#pragma unroll
    for (int i = 0; i < 2; ++i) { int R, C; stage_rc(tid * 16 + i * 8192, R, C); const int Rb = Epi::PERM ? ((R & ~31) + perm32(R & 31)) : R;
        voffA[i] = (unsigned)(R * K + C) * 2u; voffB[i] = (unsigned)(Rb * K + C) * 2u; }
    const size_t kstep = (size_t)(BK * 2);
    const size_t hstep = (size_t)HALF * K * 2;
    const size_t tstep = 2 * hstep;
    const unsigned ldsw = (unsigned)wid * 1024u;
    const int aoff = lds_byte(wr * 64 + fr, fq * 8), boff = lds_byte(wc * 32 + fr, fq * 8);
#define PG8_SA(b, h) (((b) * 2 + (h)) * HTB)
#define PG8_SB(b, h) ((4 + (b) * 2 + (h)) * HTB)
#define PG8_STAGE(bufoff, gbase, voff) do { _Pragma("unroll") for (int _i = 0; _i < 2; ++_i) \
        __builtin_amdgcn_global_load_lds((const unsigned*)((const char*)(gbase) + (voff)[_i]), (LAS unsigned*)(lds + (bufoff) + ldsw + _i * 8192), 16, 0, 0); } while (0)
#define PG8_LDA(dst, b, h) do { _Pragma("unroll") for (int m = 0; m < 4; ++m) _Pragma("unroll") for (int k = 0; k < 2; ++k) dst[m][k] = *(const LAS bf16x8*)(lds + PG8_SA(b, h) + aoff + m * 2048 + k * 1024); } while (0)
#define PG8_LDB(dst, b, h) do { _Pragma("unroll") for (int n = 0; n < 2; ++n) _Pragma("unroll") for (int k = 0; k < 2; ++k) dst[n][k] = *(const LAS bf16x8*)(lds + PG8_SB(b, h) + boff + n * 2048 + k * 1024); } while (0)
#define PG8_MMA(ai, bj, At, Bt) do { __builtin_amdgcn_s_setprio(1); _Pragma("unroll") for (int m = 0; m < 4; ++m) _Pragma("unroll") for (int n = 0; n < 2; ++n) _Pragma("unroll") for (int k = 0; k < 2; ++k) \
        acc[ai][bj][m][n] = __builtin_amdgcn_mfma_f32_16x16x32_bf16(Bt[n][k], At[m][k], acc[ai][bj][m][n], 0, 0, 0); __builtin_amdgcn_s_setprio(0); } while (0)
#define PG8_WAIT_V(n) asm volatile("s_waitcnt vmcnt(" #n ")" ::: "memory")
#define PG8_WAIT_L(n) asm volatile("s_waitcnt lgkmcnt(" #n ")" ::: "memory")
#define PG8_BAR __builtin_amdgcn_s_barrier()
#define PG8_SCHED __builtin_amdgcn_sched_barrier(0)
    Unit cur, nxt; int ui = 0;
    if (!S.next(0, cur)) return;
    f32x4 acc[2][2][4][2];
#pragma unroll
    for (int a = 0; a < 2; ++a)
#pragma unroll
        for (int b = 0; b < 2; ++b)
#pragma unroll
            for (int m = 0; m < 4; ++m)
#pragma unroll
                for (int n = 0; n < 2; ++n) acc[a][b][m][n] = (f32x4){0.f, 0.f, 0.f, 0.f};
    bf16x8 At[4][2], B0[2][2], B1[2][2];
    const char* cA = (const char*)g.A + (size_t)cur.pm * tstep; const char* cB = (const char*)g.Bt + (size_t)cur.pn * tstep;
    S.a_ready(cur);
    if constexpr (SP2) {
        PG8_STAGE(PG8_SB(0, 0), cB, voffB); PG8_STAGE(PG8_SB(0, 1), cB + hstep, voffB); PG8_STAGE(PG8_SA(0, 0), cA, voffA); PG8_STAGE(PG8_SA(0, 1), cA + hstep, voffA);
        if (wr == 1) PG8_BAR;
        PG8_WAIT_V(2); PG8_BAR;
        PG8_STAGE(PG8_SB(1, 0), cB + kstep, voffB); PG8_STAGE(PG8_SA(1, 0), cA + kstep, voffA); PG8_STAGE(PG8_SB(1, 1), cB + hstep + kstep, voffB);
        PG8_WAIT_V(6); PG8_BAR;
    } else {
        PG8_STAGE(PG8_SB(0, 0), cB, voffB); PG8_STAGE(PG8_SA(0, 0), cA, voffA); PG8_STAGE(PG8_SB(0, 1), cB + hstep, voffB); PG8_STAGE(PG8_SA(0, 1), cA + hstep, voffA);
        if (wr == 1) PG8_BAR;
        PG8_WAIT_V(4); PG8_BAR;
        PG8_STAGE(PG8_SB(1, 0), cB + kstep, voffB); PG8_STAGE(PG8_SA(1, 0), cA + kstep, voffA); PG8_STAGE(PG8_SB(1, 1), cB + hstep + kstep, voffB);
        PG8_WAIT_V(6); PG8_BAR;
    }
    for (;;) {
        const bool has_next = S.next(ui + 1, nxt);
        const char* nA = has_next ? (const char*)g.A + (size_t)nxt.pm * tstep : cA; const char* nB = has_next ? (const char*)g.Bt + (size_t)nxt.pn * tstep : cB;
        for (int t = 0; t < nt; t += 2) {
            const bool last = (t == nt - 2);
            const char* a1 = cA + (size_t)(t + 1) * kstep;
            const char* a2 = last ? nA : cA + (size_t)(t + 2) * kstep; const char* b2 = last ? nB : cB + (size_t)(t + 2) * kstep;
            const char* a3 = a2 + kstep; const char* b3 = b2 + kstep;
            if (last && has_next) S.a_ready(nxt);
            if constexpr (SP2) {
            PG8_LDB(B0, 0, 0); PG8_LDB(B1, 0, 1); PG8_SCHED; PG8_LDA(At, 0, 0); PG8_STAGE(PG8_SA(1, 1), a1 + hstep, voffA);
            PG8_WAIT_V(8); PG8_WAIT_L(0); PG8_BAR; PG8_MMA(0, 0, At, B0); PG8_MMA(0, 1, At, B1); PG8_BAR; PG8_SCHED;
            PG8_LDA(At, 0, 1); PG8_STAGE(PG8_SB(0, 0), b2, voffB); PG8_STAGE(PG8_SB(0, 1), b2 + hstep, voffB); PG8_STAGE(PG8_SA(0, 0), a2, voffA);
            PG8_WAIT_V(8); PG8_WAIT_L(0); PG8_BAR; PG8_MMA(1, 0, At, B0); PG8_MMA(1, 1, At, B1); PG8_BAR; PG8_SCHED;
            PG8_LDB(B0, 1, 0); PG8_LDB(B1, 1, 1); PG8_SCHED; PG8_LDA(At, 1, 0); PG8_STAGE(PG8_SA(0, 1), a2 + hstep, voffA);
            PG8_WAIT_V(8); PG8_WAIT_L(0); PG8_BAR; PG8_MMA(0, 0, At, B0); PG8_MMA(0, 1, At, B1); PG8_BAR; PG8_SCHED;
            PG8_LDA(At, 1, 1); PG8_STAGE(PG8_SB(1, 0), b3, voffB); PG8_STAGE(PG8_SB(1, 1), b3 + hstep, voffB); PG8_STAGE(PG8_SA(1, 0), a3, voffA);
            PG8_WAIT_V(8); PG8_WAIT_L(0); PG8_BAR; PG8_MMA(1, 0, At, B0); PG8_MMA(1, 1, At, B1); PG8_BAR; PG8_SCHED;
            } else {
            PG8_LDB(B0, 0, 0); PG8_SCHED; PG8_LDA(At, 0, 0); PG8_STAGE(PG8_SA(1, 1), a1 + hstep, voffA);
            PG8_WAIT_L(8); PG8_BAR; PG8_WAIT_L(0); PG8_MMA(0, 0, At, B0); PG8_BAR; PG8_SCHED;
            PG8_LDB(B1, 0, 1); PG8_STAGE(PG8_SB(0, 0), b2, voffB);
            PG8_BAR; PG8_WAIT_L(0); PG8_MMA(0, 1, At, B1); PG8_BAR;
            PG8_LDA(At, 0, 1); PG8_STAGE(PG8_SA(0, 0), a2, voffA);
            PG8_BAR; PG8_WAIT_L(0); PG8_MMA(1, 0, At, B0); PG8_BAR; PG8_SCHED;
            PG8_STAGE(PG8_SB(0, 1), b2 + hstep, voffB);
            PG8_WAIT_V(6); PG8_BAR; PG8_MMA(1, 1, At, B1); PG8_BAR;
            PG8_LDB(B0, 1, 0); PG8_SCHED; PG8_LDA(At, 1, 0); PG8_STAGE(PG8_SA(0, 1), a2 + hstep, voffA);
            PG8_WAIT_L(8); PG8_BAR; PG8_WAIT_L(0); PG8_MMA(0, 0, At, B0); PG8_BAR; PG8_SCHED;
            PG8_LDB(B1, 1, 1); PG8_STAGE(PG8_SB(1, 0), b3, voffB);
            PG8_BAR; PG8_WAIT_L(0); PG8_MMA(0, 1, At, B1); PG8_BAR;
            PG8_LDA(At, 1, 1); PG8_STAGE(PG8_SA(1, 0), a3, voffA);
            PG8_BAR; PG8_WAIT_L(0); PG8_MMA(1, 0, At, B0); PG8_BAR; PG8_SCHED;
            PG8_STAGE(PG8_SB(1, 1), b3 + hstep, voffB);
            PG8_WAIT_V(6); PG8_BAR; PG8_MMA(1, 1, At, B1); PG8_BAR;
            }
        }
        if constexpr (ALIGN_EPI) { if (wr == 0) PG8_BAR; }
        if constexpr (!Epi::AFTER_DRAIN) { E(acc, cur, wr, wc, fr, fq); S.done(cur); }
        if (!has_next) break;
#pragma unroll
        for (int a = 0; a < 2; ++a)
#pragma unroll
            for (int b = 0; b < 2; ++b)
#pragma unroll
                for (int m = 0; m < 4; ++m)
#pragma unroll
                    for (int n = 0; n < 2; ++n) acc[a][b][m][n] = (f32x4){0.f, 0.f, 0.f, 0.f};
        cur = nxt; cA = nA; cB = nB; ++ui;
        if constexpr (ALIGN_EPI) { if (wr == 1) PG8_BAR; }
    }
    PG8_WAIT_V(0);
    if constexpr (!ALIGN_EPI) { if (wr == 0) PG8_BAR; }
    PG8_BAR;
#undef PG8_SA
#undef PG8_SB
#undef PG8_STAGE
#undef PG8_LDA
#undef PG8_LDB
#undef PG8_MMA
#undef PG8_WAIT_V
#undef PG8_WAIT_L
#undef PG8_BAR
#undef PG8_SCHED
}
struct EpiZ {
    static constexpr bool PERM = true, AFTER_DRAIN = false;
    bf16_t* Z; const float* cosT; const float* sinT;
    __device__ __forceinline__ void operator()(const f32x4 (&acc)[2][2][4][2], const Unit& u, int wr, int wc, int fr, int fq) const {
#pragma unroll
        for (int bj = 0; bj < 2; ++bj) {
            const int cb = u.pn * BM + bj * HALF + wc * 32;
            const int g64 = cb >> 6; const int c0 = cb + 8 * fq;
            const bool roped = (g64 < 64) && ((ROPE_MASK >> g64) & 1ull);
            const bool sig = (cb >= ZC_GM) || (c0 >= ZC_GN && c0 < ZC_WI);
            const float sc = ((g64 < 64) && ((SCALE_MASK >> g64) & 1ull)) ? 0.125f : 1.0f;
#pragma unroll
            for (int ai = 0; ai < 2; ++ai)
#pragma unroll
                for (int m = 0; m < 4; ++m) {
                    const int row = u.pm * BM + ai * HALF + wr * 64 + m * 16 + fr;
                    f32x4 v0 = acc[ai][bj][m][0], v1 = acc[ai][bj][m][1];
                    if (roped) {
                        const int pos = row & (SEQ - 1), i0 = (c0 & 63) >> 1;
                        const f32x4 cs = *(const f32x4*)(cosT + pos * 32 + i0), sn = *(const f32x4*)(sinT + pos * 32 + i0);
                        const f32x4 a = v0, b = v1;
                        v0[0] = (a[0] * cs[0] - a[1] * sn[0]) * sc; v0[1] = (a[1] * cs[0] + a[0] * sn[0]) * sc;
                        v0[2] = (a[2] * cs[1] - a[3] * sn[1]) * sc; v0[3] = (a[3] * cs[1] + a[2] * sn[1]) * sc;
                        v1[0] = (b[0] * cs[2] - b[1] * sn[2]) * sc; v1[1] = (b[1] * cs[2] + b[0] * sn[2]) * sc;
                        v1[2] = (b[2] * cs[3] - b[3] * sn[3]) * sc; v1[3] = (b[3] * cs[3] + b[2] * sn[3]) * sc;
                    } else if (sig) {
#pragma unroll
                        for (int e = 0; e < 4; ++e) { v0[e] = sigmoidf_(v0[e]); v1[e] = sigmoidf_(v1[e]); }
                    }
                    u32x4 w; w.x = cvt_pk_bf16(v0[0], v0[1]); w.y = cvt_pk_bf16(v0[2], v0[3]); w.z = cvt_pk_bf16(v1[0], v1[1]); w.w = cvt_pk_bf16(v1[2], v1[3]);
                    *(u32x4*)(Z + (size_t)row * NZ + c0) = w;
                }
        }
    }
};
struct EpiMerge {
    static constexpr bool PERM = true, AFTER_DRAIN = false;
    bf16_t* O; const bf16_t* Zg; int mode;
    __device__ __forceinline__ void operator()(const f32x4 (&acc)[2][2][4][2], const Unit& u, int wr, int wc, int fr, int fq) const {
#pragma unroll
        for (int ai = 0; ai < 2; ++ai)
#pragma unroll
            for (int m = 0; m < 4; ++m) { const int row = u.pm * BM + ai * HALF + wr * 64 + m * 16 + fr;
#pragma unroll
                for (int bj = 0; bj < 2; ++bj) { const int c0 = u.pn * BM + bj * HALF + wc * 32 + 8 * fq;
                    const u32x4 gz = *(const u32x4*)(Zg + (size_t)row * NZ + c0);
                    f32x4 v0 = acc[ai][bj][m][0], v1 = acc[ai][bj][m][1];
                    v0[0] *= bflo(gz.x); v0[1] *= bfhi(gz.x); v0[2] *= bflo(gz.y); v0[3] *= bfhi(gz.y); v1[0] *= bflo(gz.z); v1[1] *= bfhi(gz.z); v1[2] *= bflo(gz.w); v1[3] *= bfhi(gz.w);
                    bf16_t* op = O + (size_t)row * D + c0;
                    if (mode) { const u32x4 o = *(const u32x4*)op;
                        v0[0] += bflo(o.x); v0[1] += bfhi(o.x); v0[2] += bflo(o.y); v0[3] += bfhi(o.y); v1[0] += bflo(o.z); v1[1] += bfhi(o.z); v1[2] += bflo(o.w); v1[3] += bfhi(o.w); }
                    u32x4 w; w.x = cvt_pk_bf16(v0[0], v0[1]); w.y = cvt_pk_bf16(v0[2], v0[3]); w.z = cvt_pk_bf16(v1[0], v1[1]); w.w = cvt_pk_bf16(v1[2], v1[3]);
                    *(u32x4*)op = w; } }
    }
};
struct EpiOut {
    static constexpr bool PERM = true, AFTER_DRAIN = false;
    const float* x; float* o; const float* mod;
    __device__ __forceinline__ void operator()(const f32x4 (&acc)[2][2][4][2], const Unit& u, int wr, int wc, int fr, int fq) const {
#pragma unroll
        for (int ai = 0; ai < 2; ++ai)
#pragma unroll
            for (int m = 0; m < 4; ++m) { const int row = u.pm * BM + ai * HALF + wr * 64 + m * 16 + fr; const float* g1 = mod + (row >> 11) * 6144 + 2048;
#pragma unroll
                for (int bj = 0; bj < 2; ++bj) { const int c0 = u.pn * BM + bj * HALF + wc * 32 + 8 * fq;
#pragma unroll
                    for (int n = 0; n < 2; ++n) { const f32x4 gg = *(const f32x4*)(g1 + c0 + 4 * n), xx = *(const f32x4*)(x + (size_t)row * D + c0 + 4 * n);
                        *(f32x4*)(o + (size_t)row * D + c0 + 4 * n) = xx + gg * acc[ai][bj][m][n]; } } }
    }
};
struct EpiF32 {
    static constexpr bool PERM = true, AFTER_DRAIN = false;
    float* O; int ldc;
    __device__ __forceinline__ void operator()(const f32x4 (&acc)[2][2][4][2], const Unit& u, int wr, int wc, int fr, int fq) const {
#pragma unroll
        for (int ai = 0; ai < 2; ++ai)
#pragma unroll
            for (int m = 0; m < 4; ++m) { const int row = u.pm * BM + ai * HALF + wr * 64 + m * 16 + fr;
#pragma unroll
                for (int bj = 0; bj < 2; ++bj) { const int c0 = u.pn * BM + bj * HALF + wc * 32 + 8 * fq;
                    *(f32x4*)(O + (size_t)row * ldc + c0) = acc[ai][bj][m][0]; *(f32x4*)(O + (size_t)row * ldc + c0 + 4) = acc[ai][bj][m][1]; } }
    }
};
}

template <bool ZMAP>
__device__ __forceinline__ void transpose_item(const float* W, int K, int Nsrc, bf16_t* WT, LAS float* scr, int item, int nblk, int lane) {
    const int kb = item / nblk, nb = item % nblk, k0 = 64 * kb, n0 = 32 * nb;
    int sc = n0 + (lane & 31); if (ZMAP) sc = z_logical_col(sc);
#pragma unroll 8
    for (int i = 0; i < 32; ++i) { const int kk = 2 * i + (lane >> 5); scr[kk * 33 + (lane & 31)] = (sc >= 0) ? W[(size_t)(k0 + kk) * Nsrc + sc] : 0.f; }
    asm volatile("s_waitcnt lgkmcnt(0)" ::: "memory");
    const int c = lane & 7;
#pragma unroll
    for (int j = 0; j < 4; ++j) { const int n = (lane >> 3) + 8 * j; const LAS float* s = scr + (8 * c) * 33 + n;
        uint4 o; o.x = pk2(s[0 * 33], s[1 * 33]); o.y = pk2(s[2 * 33], s[3 * 33]); o.z = pk2(s[4 * 33], s[5 * 33]); o.w = pk2(s[6 * 33], s[7 * 33]);
        *(uint4*)(WT + (size_t)(n0 + n) * K + k0 + 8 * c) = o; }
    asm volatile("s_waitcnt lgkmcnt(0)" ::: "memory");
}
__device__ __forceinline__ void st_convert(const Params& p, unsigned char* lds) {
    int tid_ = threadIdx.x; asm volatile("" : "+v"(tid_)); const int tid = tid_, lane = tid & 63, w = __builtin_amdgcn_readfirstlane(tid >> 6);
    LAS float* scr = (LAS float*)((LAS unsigned char*)lds + 49152 + w * 8704);
    const int gw = blockIdx.x * 8 + w, NGW = gridDim.x * 8;
    constexpr int I_IN = 16 * 144, I_BR = 8 * 32, I_OUT = 16 * 32;
    for (int it = gw; it < I_IN + 2 * I_BR + I_OUT; it += NGW) {
        int r = it;
        if (r < I_IN) { transpose_item<true>(p.w_in, D, DIN, (bf16_t*)(p.ws + WS_WINT), scr, r, 144, lane); continue; } r -= I_IN;
        if (r < I_BR) { transpose_item<false>(p.w_nsa, 512, D, (bf16_t*)(p.ws + WS_WNSAT), scr, r, 32, lane); continue; } r -= I_BR;
        if (r < I_BR) { transpose_item<false>(p.w_dsa, 512, D, (bf16_t*)(p.ws + WS_WDSAT), scr, r, 32, lane); continue; } r -= I_BR;
        transpose_item<false>(p.w_out, D, D, (bf16_t*)(p.ws + WS_WOUTT), scr, r, 32, lane);
    }
    { bf16_t* w1t = (bf16_t*)(p.ws + WS_W1T); float* bpos = (float*)(p.ws + WS_BPOS);
      for (int it = blockIdx.x * NTHR + tid; it < 2 * 64 * 2048; it += gridDim.x * NTHR) {
          const int e = it & 63, kidx = (it >> 6) & 2047, kv = it >> 17; const int l = kidx >> 6, dp = kidx & 63; const int d = kv ? dp : ((dp >> 1) + 32 * (dp & 1));
          w1t[((size_t)kv * 64 + e) * 2048 + kidx] = f2bf((kv ? p.w1v : p.w1k)[(l * 64 + d) * 64 + e]); }
      for (int o = gw; o < 128; o += NGW) { const int kv = o >> 6, e = o & 63; const float* w1 = kv ? p.w1v : p.w1k; float s = 0.f;
          for (int i = lane; i < 2048; i += 64) s += p.cmp_pos[i] * w1[i * 64 + e];
          s = wave_sum(s); if (lane == 0) bpos[o] = s; } }
    bf16_t* wf = (bf16_t*)(p.ws + WS_WFOLDT);
    for (int it = blockIdx.x * NTHR + tid; it < 2048 * 1024 / 2; it += gridDim.x * NTHR) {
        const int k = (it & 511) * 2, col = it >> 9, hc = col >> 7;
        const float* sk = p.subkeys + (size_t)col * 64; const float* q0 = p.wq + (size_t)k * D + hc * 64; const float* q1 = q0 + D;
        float a0 = 0.f, a1 = 0.f;
#pragma unroll 8
        for (int d = 0; d < 64; d += 4) { const float4 s4 = *(const float4*)(sk + d), x0 = *(const float4*)(q0 + d), x1 = *(const float4*)(q1 + d);
            a0 += s4.x * x0.x + s4.y * x0.y + s4.z * x0.z + s4.w * x0.w; a1 += s4.x * x1.x + s4.y * x1.y + s4.z * x1.z + s4.w * x1.w; }
        *(u32*)(wf + (size_t)col * D + k) = pk2(a0, a1);
    }
}
__device__ __forceinline__ void st_z_gemm(const Params& p, unsigned char* lds) {
    pg8::Gemm g{(const bf16_t*)(p.ws + WS_HB), (const bf16_t*)(p.ws + WS_WINT), T, NZ, D}; pg8::StaticOrder S; S.init(T, NZ, gridDim.x, blockIdx.x);
    pg8::EpiZ E{(bf16_t*)(p.ws + WS_Z), (const float*)(p.ws + WS_COS), (const float*)(p.ws + WS_SIN)};
    pg8::gemm_phase<pg8::EpiZ, pg8::StaticOrder, true, true>((LAS unsigned char*)lds, g, S, E);
}
__device__ __forceinline__ void st_merge_gemm(const Params& p, unsigned char* lds) {
    pg8::StaticOrder S; S.init(T, D, gridDim.x, blockIdx.x);
    { pg8::Gemm g{(const bf16_t*)(p.ws + WS_ONSA), (const bf16_t*)(p.ws + WS_WNSAT), T, D, 512};
      pg8::EpiMerge E{(bf16_t*)(p.ws + WS_MERGED), (const bf16_t*)(p.ws + WS_Z) + ZC_GM, 0};
      pg8::gemm_phase<pg8::EpiMerge, pg8::StaticOrder, true, true>((LAS unsigned char*)lds, g, S, E); }
    asm volatile("s_waitcnt vmcnt(0)" ::: "memory"); __syncthreads();
    { pg8::Gemm g{(const bf16_t*)(p.ws + WS_ODSA), (const bf16_t*)(p.ws + WS_WDSAT), T, D, 512};
      pg8::EpiMerge E{(bf16_t*)(p.ws + WS_MERGED), (const bf16_t*)(p.ws + WS_Z) + ZC_GM + 1024, 1};
      pg8::gemm_phase<pg8::EpiMerge, pg8::StaticOrder, true, true>((LAS unsigned char*)lds, g, S, E); }
}
__device__ __forceinline__ void st_out_gemm(const Params& p, unsigned char* lds) {
    pg8::Gemm g{(const bf16_t*)(p.ws + WS_MERGED), (const bf16_t*)(p.ws + WS_WOUTT), T, D, D}; pg8::StaticOrder S; S.init(T, D, gridDim.x, blockIdx.x);
    pg8::EpiOut E{p.x, p.out, (const float*)(p.ws + WS_MOD)};
    pg8::gemm_phase<pg8::EpiOut, pg8::StaticOrder, true, true>((LAS unsigned char*)lds, g, S, E);
}
__device__ __forceinline__ void st_ssub_gemm(const Params& p, unsigned char* lds) {
    pg8::Gemm g{(const bf16_t*)(p.ws + WS_H2), (const bf16_t*)(p.ws + WS_WFOLDT), T, 2048, D}; pg8::StaticOrder S; S.init(T, 2048, gridDim.x, blockIdx.x);
    pg8::EpiF32 E{(float*)(p.ws + WS_SSUB), 2048};
    pg8::gemm_phase<pg8::EpiF32, pg8::StaticOrder, true, true>((LAS unsigned char*)lds, g, S, E);
}

typedef float f32x4_t __attribute__((ext_vector_type(4)));
__device__ __forceinline__ void st_prep(const Params& p, unsigned char* lds) {
    int tid = threadIdx.x; asm volatile("" : "+v"(tid));
    const int lane = tid & 63, w = __builtin_amdgcn_readfirstlane(tid >> 6);
    const bf16_t* Z = (const bf16_t*)(p.ws + WS_Z);
    const float* cosT = (const float*)(p.ws + WS_COS); const float* sinT = (const float*)(p.ws + WS_SIN);
    unsigned char* dob = (unsigned char*)p.out;
    bf16_t* kd = (bf16_t*)(dob + DO_KD); bf16_t* vdT = (bf16_t*)(dob + DO_VDT); bf16_t* vsT = (bf16_t*)(dob + DO_VST); bf16_t* vwT = (bf16_t*)(dob + DO_VWT);
    bf16_t* kcmp = (bf16_t*)(dob + DO_KCMP); bf16_t* vcmpT = (bf16_t*)(dob + DO_VCMPT);
    {   float* red = (float*)lds;
        float* hid = red + 8 * 16 * 64;
        const bf16_t* w1t = (const bf16_t*)(p.ws + WS_W1T); const float* bpos = (const float*)(p.ws + WS_BPOS);
        for (int u = blockIdx.x; u < 256; u += gridDim.x) {
            const int kv = u >> 7, b = (u >> 4) & 7, g = (u >> 3) & 1, n0 = (u & 7) * 16;
            const int nl = lane & 15, kq = lane >> 4; int n = n0 + nl; if (n > 126) n = 126;
            pg8::f32x4 acc[4];
#pragma unroll
            for (int ec = 0; ec < 4; ++ec) acc[ec] = (pg8::f32x4){0.f, 0.f, 0.f, 0.f};
            const bf16_t* ab = Z + (size_t)(b * SEQ + 16 * n) * NZ + (kv ? ZC_VC : ZC_KC) + g * 64 + 8 * kq;
            const bf16_t* bb = w1t + ((size_t)kv * 64 + nl) * 2048 + 8 * kq;
#pragma unroll
            for (int i = 0; i < 8; ++i) { const int kk = 8 * w + i;
                const pg8::bf16x8 a = *(const pg8::bf16x8*)(ab + (size_t)(kk >> 1) * NZ + (kk & 1) * 32);
#pragma unroll
                for (int ec = 0; ec < 4; ++ec) { const pg8::bf16x8 bv = *(const pg8::bf16x8*)(bb + (size_t)ec * 16 * 2048 + 32 * kk);
                    acc[ec] = __builtin_amdgcn_mfma_f32_16x16x32_bf16(a, bv, acc[ec], 0, 0, 0); } }
            __syncthreads();
#pragma unroll
            for (int ec = 0; ec < 4; ++ec)
#pragma unroll
                for (int r = 0; r < 4; ++r) red[(w * 16 + 4 * kq + r) * 64 + 16 * ec + nl] = acc[ec][r];
            __syncthreads();
#pragma unroll
            for (int q = 0; q < 2; ++q) { const int o = tid + 512 * q; float s = bpos[kv * 64 + (o & 63)];
#pragma unroll
                for (int ww = 0; ww < 8; ++ww) s += red[ww * 1024 + o];
                hid[o] = gelu_tanh(s); }
            __syncthreads();
            { const int nn = tid >> 5, f0 = (tid & 31) * 2; const float* w2 = kv ? p.w2v : p.w2k; float a0 = 0.f, a1 = 0.f;
              for (int e = 0; e < 64; ++e) { const float h = hid[nn * 64 + e]; const float2 ww = *(const float2*)(w2 + e * 64 + f0); a0 += h * ww.x; a1 += h * ww.y; }
              const int nglob = n0 + nn; if (nglob > 126) { a0 = 0.f; a1 = 0.f; }
              if (kv == 0) { bf16_t* o = kcmp + (((size_t)b * 2 + g) * 128 + nglob) * 64; o[2 * (f0 & 31) + (f0 >> 5)] = f2bf(a0); o[2 * ((f0 + 1) & 31) + ((f0 + 1) >> 5)] = f2bf(a1); }
              else { bf16_t* o = vcmpT + (((size_t)b * 2 + g) * 64 + f0) * 128 + nglob; o[0] = f2bf(a0); o[128] = f2bf(a1); } }
        }
        __syncthreads();
    }
    {   bf16_t* tl = (bf16_t*)lds;
        for (int it = blockIdx.x; it < 512; it += gridDim.x) {
            const int which = it & 1, tt = (it >> 1) & 31, b = it >> 6; const int t0 = b * SEQ + tt * 64;
            __syncthreads();
#pragma unroll
            for (int q = 0; q < 2; ++q) { const int idx = tid + 512 * q, tok = idx >> 4, ch = idx & 15;
                const uint4 v = *(const uint4*)(Z + (size_t)(t0 + tok) * NZ + (which ? ZC_VW : ZC_VS) + ch * 8); bf16_t* d = tl + tok * 130 + ch * 8;
                d[0] = (bf16_t)v.x; d[1] = (bf16_t)(v.x >> 16); d[2] = (bf16_t)v.y; d[3] = (bf16_t)(v.y >> 16); d[4] = (bf16_t)v.z; d[5] = (bf16_t)(v.z >> 16); d[6] = (bf16_t)v.w; d[7] = (bf16_t)(v.w >> 16); }
            __syncthreads();
#pragma unroll
            for (int q = 0; q < 2; ++q) { const int idx = tid + 512 * q, gd = idx >> 3, c8 = idx & 7; const bf16_t* s = tl + (c8 * 8) * 130 + gd;
                uint4 o; o.x = (u32)s[0] | ((u32)s[130] << 16); o.y = (u32)s[260] | ((u32)s[390] << 16); o.z = (u32)s[520] | ((u32)s[650] << 16); o.w = (u32)s[780] | ((u32)s[910] << 16);
                *(uint4*)((which ? vwT : vsT) + ((size_t)b * 128 + gd) * SEQ + tt * 64 + c8 * 8) = o; }
        }
    }
    for (int it = blockIdx.x * NTHR + tid; it < T * 32; it += gridDim.x * NTHR) {
        const int t = it >> 5, i = it & 31; const bf16_t* cr = Z + (size_t)t * NZ + ZC_CKV;
        float ss = 0.f;
#pragma unroll 4
        for (int r = 0; r < 128; r += 8) { const uint4 v = *(const uint4*)(cr + r);
            ss += bflo(v.x) * bflo(v.x) + bfhi(v.x) * bfhi(v.x) + bflo(v.y) * bflo(v.y) + bfhi(v.y) * bfhi(v.y) + bflo(v.z) * bflo(v.z) + bfhi(v.z) * bfhi(v.z) + bflo(v.w) * bflo(v.w) + bfhi(v.w) * bfhi(v.w); }
        const float rn = rsqrtf(ss * (1.0f / 128.0f) + EPS);
        float k1 = 0.f, k2 = 0.f, v1 = 0.f, v2 = 0.f;
#pragma unroll 4
        for (int r = 0; r < 128; ++r) { const float cn = bf2f(cr[r]) * rn * p.kvg[r];
            k1 += cn * p.w_uk[r * 64 + i]; k2 += cn * p.w_uk[r * 64 + i + 32]; v1 += cn * p.w_uv[r * 64 + i]; v2 += cn * p.w_uv[r * 64 + i + 32]; }
        const int pos = t & (SEQ - 1), b = t >> 11; const float c = cosT[pos * 32 + i], s = sinT[pos * 32 + i];
        *(u32*)(kd + (size_t)t * 64 + 2 * i) = pk2(k1 * c - k2 * s, k2 * c + k1 * s);
        vdT[((size_t)b * 64 + i) * SEQ + pos] = f2bf(v1); vdT[((size_t)b * 64 + i + 32) * SEQ + pos] = f2bf(v2);
    }
}

#define XB_TMO      128
#define XB_XCNT(j)  (256  + 64 * (j))
#define XB_XSUB(j)  (1280 + 64 * (j))
#define XB_XGEN(j)  (2304 + 64 * (j))
#define XB_TOP      3328
#define XB_TOPGEN   3392
#define XCD_BAR_WORDS 3456
#define XB_SPIN_CAP (1u << 22)
__device__ __forceinline__ unsigned xb_ld(unsigned* p)              { return __hip_atomic_load(p, __ATOMIC_RELAXED, __HIP_MEMORY_SCOPE_AGENT); }
__device__ __forceinline__ unsigned xb_add(unsigned* p, unsigned v) { return __hip_atomic_fetch_add(p, v, __ATOMIC_RELAXED, __HIP_MEMORY_SCOPE_AGENT); }
__device__ __forceinline__ unsigned xb_xcc_id() { return (unsigned)__builtin_amdgcn_s_getreg((3 << 11) | 20) & 0xFu; }
#define XB_SPIN(cond, bar) do { unsigned _sp = 0; while (cond) { __builtin_amdgcn_s_sleep(1); \
    if ((++_sp & 255u) == 0u) { if (xb_ld(&(bar)[XB_TMO])) break; if (_sp > XB_SPIN_CAP) { atomicAdd(&(bar)[XB_TMO], 1u); break; } } } } while (0)
struct XcdBarrier { unsigned* bar; unsigned x; volatile LAS unsigned* st; };
__device__ __forceinline__ XcdBarrier xcd_barrier_post(unsigned* bar, volatile LAS unsigned* st) {
    XcdBarrier b; b.bar = bar; b.x = xb_xcc_id(); b.st = st;
    if (threadIdx.x == 0) (void)xb_add(&bar[XB_XCNT(b.x)], 1u);
    return b;
}
__device__ __forceinline__ void xcd_barrier_complete(unsigned* bar, unsigned x, unsigned& nloc, unsigned& nx) {
    const unsigned G = gridDim.x * gridDim.y * gridDim.z;
    unsigned sum, cnt, mine, sp = 0u;
    for (;;) {
        sum = 0u; cnt = 0u; mine = 0u;
#pragma unroll
        for (unsigned j = 0; j < 16; ++j) { const unsigned c = xb_ld(&bar[XB_XCNT(j)]); sum += c; cnt += (c > 0u) ? 1u : 0u; mine = (j == x) ? c : mine; }
        if (sum == G) break;
        __builtin_amdgcn_s_sleep(1);
        if ((++sp & 255u) == 0u) { if (xb_ld(&bar[XB_TMO])) break; if (sp > XB_SPIN_CAP) { atomicAdd(&bar[XB_TMO], 1u); break; } }
    }
    nloc = mine > 0u ? mine : 1u; nx = cnt > 0u ? cnt : 1u;
}
__device__ __forceinline__ void xcd_barrier(const XcdBarrier& b) {
    asm volatile("s_waitcnt vmcnt(0)" ::: "memory");
    __syncthreads();
    if (threadIdx.x == 0) {
        unsigned* bar = b.bar;
        __builtin_amdgcn_s_waitcnt(0);
        unsigned nloc = b.st[0], nx = b.st[1];
        if (nloc == 0u) { xcd_barrier_complete(bar, b.x, nloc, nx); b.st[0] = nloc; b.st[1] = nx; }
        const unsigned old = xb_add(&bar[XB_XSUB(b.x)], 1u);
        const unsigned gen = old / nloc;
        if (old + 1u == (gen + 1u) * nloc) {
            __builtin_amdgcn_fence(__ATOMIC_RELEASE, "agent");
            asm volatile("s_waitcnt vmcnt(0)" ::: "memory");
            const unsigned og = xb_add(&bar[XB_TOP], 1u);
            const unsigned tg = og / nx;
            if (og + 1u == (tg + 1u) * nx) xb_add(&bar[XB_TOPGEN], 1u);
            else XB_SPIN(xb_ld(&bar[XB_TOPGEN]) == tg, bar);
            __builtin_amdgcn_fence(__ATOMIC_ACQUIRE, "agent");
            xb_add(&bar[XB_XGEN(b.x)], 1u);
            asm volatile("s_waitcnt vmcnt(0)" ::: "memory");
        } else {
            XB_SPIN(xb_ld(&bar[XB_XGEN(b.x)]) == gen, bar);
            __builtin_amdgcn_fence(__ATOMIC_ACQUIRE, "agent");
            asm volatile("s_waitcnt vmcnt(0)" ::: "memory");
        }
    }
    __syncthreads();
}

#define XB_XRANK(j) (3520 + 16 * (j))
struct XccInfo { int pi, nxp, rank, nloc; };
__device__ __forceinline__ XccInfo xcc_info(const Params& p, int rank, unsigned x) {
    unsigned* bar = (unsigned*)(p.ws + WS_BAR); XccInfo r; r.rank = rank; r.pi = 0; r.nxp = 0; r.nloc = 1;
#pragma unroll
    for (unsigned j = 0; j < 16; ++j) { const unsigned cj = xb_ld(&bar[XB_XRANK(j)]); if (j == x) { r.pi = r.nxp; r.nloc = (int)cj; } r.nxp += (cj > 0u) ? 1 : 0; }
    if (r.nxp < 1) r.nxp = 1; if (r.nloc < 1) r.nloc = 1;
    return r;
}
__device__ __forceinline__ void st_expert_u(const Params& p, unsigned char* lds, const XccInfo xi) {
    int tid_ = threadIdx.x; asm volatile("" : "+v"(tid_)); const int tid = tid_;
    const int lane = tid & 63, w = __builtin_amdgcn_readfirstlane(tid >> 6), rs = lane >> 3, ch = lane & 7;
    const bf16_t* h2 = (const bf16_t*)(p.ws + WS_H2); const bf16_t* u16 = (const bf16_t*)(p.ws + WS_U16);
    const int* eidx = (const int*)(p.ws + WS_EIDX); float* gate = (float*)(p.ws + WS_GATE);
    int* lst = (int*)lds + w * 256;
    const int wid = xi.rank * 8 + w, nw = xi.nloc * 8;
    for (int s = xi.pi; s < 16; s += xi.nxp) {
        for (int t = wid; t < T; t += nw) {
            const int e0 = eidx[(size_t)t * 128 + lane], e1 = eidx[(size_t)t * 128 + 64 + lane];
            const bool b0 = (e0 >> 10) == s, b1 = (e1 >> 10) == s;
            const unsigned long long m0 = __ballot(b0), m1 = __ballot(b1);
            const int n0 = __popcll(m0), n = n0 + __popcll(m1);
            if (n == 0) continue;
            const int p0 = __builtin_amdgcn_mbcnt_hi((unsigned)(m0 >> 32), __builtin_amdgcn_mbcnt_lo((unsigned)m0, 0));
            const int p1 = n0 + __builtin_amdgcn_mbcnt_hi((unsigned)(m1 >> 32), __builtin_amdgcn_mbcnt_lo((unsigned)m1, 0));
            if (b0) { lst[p0] = e0; lst[128 + p0] = lane; }
            if (b1) { lst[p1] = e1; lst[128 + p1] = 64 + lane; }
            u32x4 xq[16];
#pragma unroll
            for (int i = 0; i < 16; ++i) xq[i] = *(const u32x4*)(h2 + (size_t)t * D + (ch + 8 * i) * 8);
            asm volatile("s_waitcnt lgkmcnt(0)" ::: "memory");
            for (int g0 = 0; g0 < n; g0 += 8) {
                const int idx = g0 + rs; const bool valid = idx < n; const int ii = valid ? idx : n - 1;
                const int e = lst[ii], k = lst[128 + ii];
                const bf16_t* ur = u16 + (size_t)e * D + ch * 8;
                float s0 = 0.f, s1 = 0.f;
#pragma unroll
                for (int i = 0; i < 16; ++i) { const u32x4 uv = *(const u32x4*)(ur + 64 * i);
                    s0 = dot2bf(uv.x, xq[i].x, s0); s1 = dot2bf(uv.y, xq[i].y, s1); s0 = dot2bf(uv.z, xq[i].z, s0); s1 = dot2bf(uv.w, xq[i].w, s1); }
                float sm_ = s0 + s1; sm_ += dpp_hmirror(sm_); sm_ += dpp_xor1(sm_); sm_ += dpp_xor2(sm_);
                if (valid && ch == 0) { float* gp = gate + (size_t)t * 128 + k; *gp = *gp * gelu_erf(sm_); }
            }
            asm volatile("s_waitcnt lgkmcnt(0)" ::: "memory");
        }
    }
}
__device__ __forceinline__ void st_expert_v(const Params& p, const XccInfo xi) {
    int tid_ = threadIdx.x; asm volatile("" : "+v"(tid_)); const int tid = tid_;
    const int lane = tid & 63, w = __builtin_amdgcn_readfirstlane(tid >> 6), rs = lane >> 3, ch = lane & 7;
    const bf16_t* v16 = (const bf16_t*)(p.ws + WS_V16);
    const int* eidx = (const int*)(p.ws + WS_EIDX); const float* wgt = (const float*)(p.ws + WS_GATE); const float* mod = (const float*)(p.ws + WS_MOD);
    const int wid = xi.rank * 8 + w, nw = xi.nloc * 8;
    for (int cs = xi.pi; cs < 16; cs += xi.nxp) {
        for (int t = wid; t < T; t += nw) {
            float acc[8];
#pragma unroll
            for (int i = 0; i < 8; ++i) acc[i] = 0.f;
            const bf16_t* vb = v16 + cs * 64 + ch * 8;
#pragma unroll
            for (int g = 0; g < 16; ++g) { const int k = 8 * g + rs; const int e = eidx[(size_t)t * 128 + k]; const float wk = wgt[(size_t)t * 128 + k];
                const u32x4 v = *(const u32x4*)(vb + (size_t)e * D);
                acc[0] += wk * bflo(v.x); acc[1] += wk * bfhi(v.x); acc[2] += wk * bflo(v.y); acc[3] += wk * bfhi(v.y);
                acc[4] += wk * bflo(v.z); acc[5] += wk * bfhi(v.z); acc[6] += wk * bflo(v.w); acc[7] += wk * bfhi(v.w); }
#pragma unroll
            for (int i = 0; i < 8; ++i) { acc[i] += __shfl_xor(acc[i], 8); acc[i] += __shfl_xor(acc[i], 16); acc[i] += __shfl_xor(acc[i], 32); }
            if (rs == 0) { const int d0 = cs * 64 + ch * 8; float* xr = p.out + (size_t)t * D + d0; const float* g2 = mod + (t >> 11) * 6144 + 5120 + d0;
                const float4 x0 = *(const float4*)xr, x1 = *(const float4*)(xr + 4), ga = *(const float4*)g2, gb = *(const float4*)(g2 + 4);
                float4 o0, o1; o0.x = x0.x + ga.x * acc[0]; o0.y = x0.y + ga.y * acc[1]; o0.z = x0.z + ga.z * acc[2]; o0.w = x0.w + ga.w * acc[3];
                o1.x = x1.x + gb.x * acc[4]; o1.y = x1.y + gb.y * acc[5]; o1.z = x1.z + gb.z * acc[6]; o1.w = x1.w + gb.w * acc[7];
                *(float4*)xr = o0; *(float4*)(xr + 4) = o1; }
        }
    }
}
__device__ __forceinline__ void st_final_norm(const Params& p) {
    int tid_ = threadIdx.x; asm volatile("" : "+v"(tid_)); const int tid = tid_;
    const int lane = tid & 63, w = tid >> 6;
    for (int t = blockIdx.x * 8 + w; t < T; t += gridDim.x * 8) {
        float4* xr = (float4*)(p.out + (size_t)t * D);
        float4 v[4]; float ss = 0.f;
#pragma unroll
        for (int j = 0; j < 4; ++j) { v[j] = xr[lane + 64 * j]; ss += v[j].x * v[j].x + v[j].y * v[j].y + v[j].z * v[j].z + v[j].w * v[j].w; }
        const float r = rsqrtf(wave_sum(ss) * (1.0f / D) + EPS);
#pragma unroll
        for (int j = 0; j < 4; ++j) { const float4 g = ((const float4*)p.final_g)[lane + 64 * j]; float4 o; o.x = v[j].x * r * g.x; o.y = v[j].y * r * g.y; o.z = v[j].z * r * g.z; o.w = v[j].w * r * g.w; xr[lane + 64 * j] = o; }
    }
}

constexpr int EXP_LROW = 1040;
constexpr int EXP_LWAVE = 8 * EXP_LROW;
__device__ __forceinline__ void st_expert_u2(const Params& p, unsigned char* lds, const XccInfo xi) {
    int tid_ = threadIdx.x; asm volatile("" : "+v"(tid_)); const int tid = tid_;
    const int lane = tid & 63, w = __builtin_amdgcn_readfirstlane(tid >> 6), rs = lane >> 3, ch = lane & 7;
    const bf16_t* h2 = (const bf16_t*)(p.ws + WS_H2); const bf16_t* u16 = (const bf16_t*)(p.ws + WS_U16);
    const int* eidx = (const int*)(p.ws + WS_EIDX); float* gate = (float*)(p.ws + WS_GATE);
    LAS unsigned char* lw = (LAS unsigned char*)lds + w * EXP_LWAVE;
    const int wid = xi.rank * 8 + w, nw = xi.nloc * 8;
    for (int s = xi.pi; s < 16; s += xi.nxp) {
        for (int tb = wid; tb < T / 8; tb += nw) {
            const int t0 = tb * 8;
            int ea[8], eb[8];
#pragma unroll
            for (int j = 0; j < 8; ++j) { ea[j] = eidx[(size_t)(t0 + j) * 128 + lane]; eb[j] = eidx[(size_t)(t0 + j) * 128 + 64 + lane]; }
            u32x4 xq[16];
#pragma unroll
            for (int i = 0; i < 16; ++i) xq[i] = *(const u32x4*)(h2 + (size_t)(t0 + rs) * D + (ch + 8 * i) * 8);
            int nmine = 0, nmax = 0;
#pragma unroll
            for (int j = 0; j < 8; ++j) {
                const bool b0 = (ea[j] >> 10) == s, b1 = (eb[j] >> 10) == s;
                const unsigned long long m0 = __ballot(b0), m1 = __ballot(b1);
                const int n0 = __popcll(m0), n = n0 + __popcll(m1);
                const int p0 = __builtin_amdgcn_mbcnt_hi((unsigned)(m0 >> 32), __builtin_amdgcn_mbcnt_lo((unsigned)m0, 0));
                const int p1 = n0 + __builtin_amdgcn_mbcnt_hi((unsigned)(m1 >> 32), __builtin_amdgcn_mbcnt_lo((unsigned)m1, 0));
                if (b0) { const u32x2 v = {(u32)ea[j], (u32)lane}; *(LAS u32x2*)(lw + j * EXP_LROW + p0 * 8) = v; }
                if (b1) { const u32x2 v = {(u32)eb[j], (u32)(64 + lane)}; *(LAS u32x2*)(lw + j * EXP_LROW + p1 * 8) = v; }
                nmine = (rs == j) ? n : nmine; nmax = n > nmax ? n : nmax;
            }
            asm volatile("s_waitcnt lgkmcnt(0)" ::: "memory");
            for (int j = 0; j < nmax; ++j) {
                const bool valid = j < nmine;
                u32x2 ek = *(const LAS u32x2*)(lw + rs * EXP_LROW + j * 8);
                const int e = valid ? (int)ek.x : 0;
                const bf16_t* ur = u16 + (size_t)e * D + ch * 8;
                float s0 = 0.f, s1 = 0.f;
#pragma unroll
                for (int i = 0; i < 16; ++i) { const u32x4 uv = *(const u32x4*)(ur + 64 * i);
                    s0 = dot2bf(uv.x, xq[i].x, s0); s1 = dot2bf(uv.y, xq[i].y, s1); s0 = dot2bf(uv.z, xq[i].z, s0); s1 = dot2bf(uv.w, xq[i].w, s1); }
                float sm_ = s0 + s1; sm_ += dpp_hmirror(sm_); sm_ += dpp_xor1(sm_); sm_ += dpp_xor2(sm_);
                if (valid && ch == 0) { float* gp = gate + (size_t)(t0 + rs) * 128 + (int)ek.y; *gp = *gp * gelu_erf(sm_); }
            }
            asm volatile("s_waitcnt lgkmcnt(0)" ::: "memory");
        }
    }
}
__device__ __forceinline__ void st_expert_v2(const Params& p, unsigned char* lds, const XccInfo xi) {
    int tid_ = threadIdx.x; asm volatile("" : "+v"(tid_)); const int tid = tid_;
    const int lane = tid & 63, w = __builtin_amdgcn_readfirstlane(tid >> 6), rs = lane >> 3, ch = lane & 7;
    const bf16_t* v16 = (const bf16_t*)(p.ws + WS_V16);
    const int* eidx = (const int*)(p.ws + WS_EIDX); const float* wgt = (const float*)(p.ws + WS_GATE); const float* mod = (const float*)(p.ws + WS_MOD);
    LAS unsigned char* lw = (LAS unsigned char*)lds + w * EXP_LWAVE;
    const int wid = xi.rank * 8 + w, nw = xi.nloc * 8;
    for (int cs = xi.pi; cs < 16; cs += xi.nxp) {
        const bf16_t* vb = v16 + (size_t)cs * 16384 * 64 + ch * 8;
        for (int tb = wid; tb < T / 8; tb += nw) {
            const int t0 = tb * 8;
#pragma unroll
            for (int q = 0; q < 4; ++q) { const int el = (lane + 64 * q) * 4; const int tk = el >> 7, k = el & 127;
                const uint4 ev = *(const uint4*)(eidx + (size_t)t0 * 128 + el); const float4 wv = *(const float4*)(wgt + (size_t)t0 * 128 + el);
                const u32x4 a = {ev.x, __float_as_uint(wv.x), ev.y, __float_as_uint(wv.y)}, b = {ev.z, __float_as_uint(wv.z), ev.w, __float_as_uint(wv.w)};
                *(LAS u32x4*)(lw + tk * EXP_LROW + k * 8) = a; *(LAS u32x4*)(lw + tk * EXP_LROW + k * 8 + 16) = b; }
            asm volatile("s_waitcnt lgkmcnt(0)" ::: "memory");
            float acc[8];
#pragma unroll
            for (int i = 0; i < 8; ++i) acc[i] = 0.f;
            for (int k0 = 0; k0 < 128; k0 += 16) {
                u32x4 vv[16]; float wk[16];
#pragma unroll
                for (int i = 0; i < 16; ++i) { const u32x2 ew = *(const LAS u32x2*)(lw + rs * EXP_LROW + (k0 + i) * 8); wk[i] = __uint_as_float(ew.y);
                    vv[i] = *(const u32x4*)(vb + (size_t)ew.x * 64); }
#pragma unroll
                for (int i = 0; i < 16; ++i) {
                    acc[0] += wk[i] * bflo(vv[i].x); acc[1] += wk[i] * bfhi(vv[i].x); acc[2] += wk[i] * bflo(vv[i].y); acc[3] += wk[i] * bfhi(vv[i].y);
                    acc[4] += wk[i] * bflo(vv[i].z); acc[5] += wk[i] * bfhi(vv[i].z); acc[6] += wk[i] * bflo(vv[i].w); acc[7] += wk[i] * bfhi(vv[i].w); }
            }
            { const int t = t0 + rs, d0 = cs * 64 + ch * 8; float* xr = p.out + (size_t)t * D + d0; const float* g2 = mod + (t >> 11) * 6144 + 5120 + d0;
              const float4 x0 = *(const float4*)xr, x1 = *(const float4*)(xr + 4), ga = *(const float4*)g2, gb = *(const float4*)(g2 + 4);
              float4 o0, o1; o0.x = x0.x + ga.x * acc[0]; o0.y = x0.y + ga.y * acc[1]; o0.z = x0.z + ga.z * acc[2]; o0.w = x0.w + ga.w * acc[3];
              o1.x = x1.x + gb.x * acc[4]; o1.y = x1.y + gb.y * acc[5]; o1.z = x1.z + gb.z * acc[6]; o1.w = x1.w + gb.w * acc[7];
              *(float4*)xr = o0; *(float4*)(xr + 4) = o1; }
            asm volatile("s_waitcnt lgkmcnt(0)" ::: "memory");
        }
    }
}

typedef float v2f_t __attribute__((ext_vector_type(2)));
__device__ __forceinline__ void st_expert_u3(const Params& p, unsigned char* lds, const XccInfo xi) {
    int tid_ = threadIdx.x; asm volatile("" : "+v"(tid_)); const int tid = tid_;
    const int lane = tid & 63, w = __builtin_amdgcn_readfirstlane(tid >> 6), rs = lane >> 3, ch = lane & 7;
    const unsigned char* x8 = p.ws + WS_X8; const unsigned char* u8 = p.ws + WS_U16; const float* su = (const float*)(p.ws + WS_SU); const float* sxs = (const float*)(p.ws + WS_SX);
    const int* eidx = (const int*)(p.ws + WS_EIDX); const float* gate = (const float*)(p.ws + WS_GATE); float* wgt = (float*)(p.ws + WS_WGT);
    LAS unsigned char* lw = (LAS unsigned char*)lds + w * EXP_LWAVE;
    const int wid = xi.rank * 8 + w, nw = xi.nloc * 8;
    for (int s = xi.pi; s < 8; s += xi.nxp) {
        for (int tb = wid; tb < T / 8; tb += nw) {
            const int t0 = tb * 8;
            int ea[8], eb[8];
#pragma unroll
            for (int j = 0; j < 8; ++j) { ea[j] = eidx[(size_t)(t0 + j) * 128 + lane]; eb[j] = eidx[(size_t)(t0 + j) * 128 + 64 + lane]; }
            u32x4 xq[8];
#pragma unroll
            for (int i = 0; i < 8; ++i) xq[i] = *(const u32x4*)(x8 + (size_t)(t0 + rs) * D + (ch + 8 * i) * 16);
            const float sx = sxs[t0 + rs];
            int nmine = 0, nmax = 0;
#pragma unroll
            for (int j = 0; j < 8; ++j) {
                const bool b0 = (ea[j] >> 11) == s, b1 = (eb[j] >> 11) == s;
                const unsigned long long m0 = __ballot(b0), m1 = __ballot(b1);
                const int n0 = __popcll(m0), n = n0 + __popcll(m1);
                const int p0 = __builtin_amdgcn_mbcnt_hi((unsigned)(m0 >> 32), __builtin_amdgcn_mbcnt_lo((unsigned)m0, 0));
                const int p1 = n0 + __builtin_amdgcn_mbcnt_hi((unsigned)(m1 >> 32), __builtin_amdgcn_mbcnt_lo((unsigned)m1, 0));
                if (b0) { const u32x2 v = {(u32)ea[j], (u32)lane}; *(LAS u32x2*)(lw + j * EXP_LROW + p0 * 8) = v; }
                if (b1) { const u32x2 v = {(u32)eb[j], (u32)(64 + lane)}; *(LAS u32x2*)(lw + j * EXP_LROW + p1 * 8) = v; }
                nmine = (rs == j) ? n : nmine; nmax = n > nmax ? n : nmax;
            }
            asm volatile("s_waitcnt lgkmcnt(0)" ::: "memory");
            for (int j = 0; j < nmax; j += 4) {
                bool vr[4]; u32x2 ek[4]; u32x4 rr[4][8]; float sr[4];
#pragma unroll
                for (int q = 0; q < 4; ++q) { vr[q] = (j + q) < nmine; ek[q] = *(const LAS u32x2*)(lw + rs * EXP_LROW + ((j + q) & 127) * 8);
                    const u32 e = vr[q] ? ek[q].x : 0u; const unsigned char* ur = u8 + (size_t)e * 1024 + ch * 16; sr[q] = su[e];
#pragma unroll
                    for (int i = 0; i < 8; ++i) rr[q][i] = *(const u32x4*)(ur + 128 * i); }
#pragma unroll
                for (int q = 0; q < 4; ++q) {
                    int s0 = 0, s1 = 0;
#pragma unroll
                    for (int i = 0; i < 8; ++i) { s0 = __builtin_amdgcn_sdot4((int)rr[q][i].x, (int)xq[i].x, s0, false); s1 = __builtin_amdgcn_sdot4((int)rr[q][i].y, (int)xq[i].y, s1, false);
                        s0 = __builtin_amdgcn_sdot4((int)rr[q][i].z, (int)xq[i].z, s0, false); s1 = __builtin_amdgcn_sdot4((int)rr[q][i].w, (int)xq[i].w, s1, false); }
                    int si = s0 + s1; si += __builtin_amdgcn_update_dpp(0, si, 0x141, 0xF, 0xF, true); si += __builtin_amdgcn_update_dpp(0, si, 0xB1, 0xF, 0xF, true); si += __builtin_amdgcn_update_dpp(0, si, 0x4E, 0xF, 0xF, true);
                    const float act = (float)si * (sr[q] * sx);
                    if (vr[q] && ch == 0) { const size_t gi = (size_t)(t0 + rs) * 128 + (int)ek[q].y; wgt[gi] = gate[gi] * gelu_erf(act); }
                }
            }
            asm volatile("s_waitcnt lgkmcnt(0)" ::: "memory");
        }
    }
}
__device__ __forceinline__ void st_expert_v3(const Params& p, unsigned char* lds, const XccInfo xi) {
    int tid_ = threadIdx.x; asm volatile("" : "+v"(tid_)); const int tid = tid_;
    const int lane = tid & 63, w = __builtin_amdgcn_readfirstlane(tid >> 6), rs = lane >> 3, ch = lane & 7;
    const unsigned char* v8 = p.ws + WS_V16;
    const int* eidx = (const int*)(p.ws + WS_EIDX); const float* wgt = (const float*)(p.ws + WS_WGT); const float* mod = (const float*)(p.ws + WS_MOD);
    LAS unsigned char* lw = (LAS unsigned char*)lds + w * EXP_LWAVE;
    const int wid = xi.rank * 8 + w, nw = xi.nloc * 8;
    for (int cs = xi.pi; cs < 8; cs += xi.nxp) {
        const unsigned char* vb = v8 + (size_t)cs * 16384 * 128 + ch * 16;
        for (int tb = wid; tb < T / 8; tb += nw) {
            const int t0 = tb * 8;
#pragma unroll
            for (int q = 0; q < 4; ++q) { const int el = (lane + 64 * q) * 4; const int tk = el >> 7, k = el & 127;
                const uint4 ev = *(const uint4*)(eidx + (size_t)t0 * 128 + el); const float4 wv = *(const float4*)(wgt + (size_t)t0 * 128 + el);
                const u32x4 a = {ev.x, __float_as_uint(wv.x), ev.y, __float_as_uint(wv.y)}, b = {ev.z, __float_as_uint(wv.z), ev.w, __float_as_uint(wv.w)};
                *(LAS u32x4*)(lw + tk * EXP_LROW + k * 8) = a; *(LAS u32x4*)(lw + tk * EXP_LROW + k * 8 + 16) = b; }
            asm volatile("s_waitcnt lgkmcnt(0)" ::: "memory");
            float acc[16];
#pragma unroll
            for (int i = 0; i < 16; ++i) acc[i] = 0.f;
            for (int k0 = 0; k0 < 128; k0 += 16) {
                u32x4 vv[16]; float wk[16];
#pragma unroll
                for (int i = 0; i < 16; ++i) { const u32x2 ew = *(const LAS u32x2*)(lw + rs * EXP_LROW + (k0 + i) * 8); wk[i] = __uint_as_float(ew.y);
                    vv[i] = *(const u32x4*)(vb + (size_t)ew.x * 128); }
#pragma unroll
                for (int i = 0; i < 16; ++i) {
#define EXV3_W(word, o) do { const v2f_t lo_ = __builtin_amdgcn_cvt_pk_f32_fp8((int)(word), false), hi_ = __builtin_amdgcn_cvt_pk_f32_fp8((int)(word), true); \
                        acc[o] += wk[i] * lo_.x; acc[o + 1] += wk[i] * lo_.y; acc[o + 2] += wk[i] * hi_.x; acc[o + 3] += wk[i] * hi_.y; } while (0)
                    EXV3_W(vv[i].x, 0); EXV3_W(vv[i].y, 4); EXV3_W(vv[i].z, 8); EXV3_W(vv[i].w, 12);
#undef EXV3_W
                }
            }
            { const int t = t0 + rs, d0 = cs * 128 + ch * 16; float* xr = p.out + (size_t)t * D + d0; const float* g2 = mod + (t >> 11) * 6144 + 5120 + d0;
#pragma unroll
              for (int q = 0; q < 4; ++q) { const float4 x0 = *(const float4*)(xr + 4 * q), ga = *(const float4*)(g2 + 4 * q);
                  float4 o0; o0.x = x0.x + ga.x * acc[4 * q]; o0.y = x0.y + ga.y * acc[4 * q + 1]; o0.z = x0.z + ga.z * acc[4 * q + 2]; o0.w = x0.w + ga.w * acc[4 * q + 3];
                  *(float4*)(xr + 4 * q) = o0; } }
            asm volatile("s_waitcnt lgkmcnt(0)" ::: "memory");
        }
    }
}

constexpr int LDS_BYTES = 131072 + 1024;
constexpr int LDS_CTL = 131072;
__global__ void __launch_bounds__(NTHR, 2) k_mega(Params p) {
    extern __shared__ __attribute__((aligned(16))) unsigned char smem[];
    if (threadIdx.x < 4) ((volatile LAS unsigned*)(smem + LDS_CTL))[threadIdx.x] = 0u;
    __syncthreads();
    XcdBarrier bar = xcd_barrier_post((unsigned*)(p.ws + WS_BAR), (volatile LAS unsigned*)(smem + LDS_CTL));
    if (threadIdx.x == 0) ((volatile LAS unsigned*)(smem + LDS_CTL))[2] = xb_add(&((unsigned*)(p.ws + WS_BAR))[XB_XRANK(bar.x)], 1u);
#define GBAR() xcd_barrier(bar)
#define REP(n, body) do { body; if (PROBE_STAGE == (n)) { __syncthreads(); body; } } while (0)
    REP(1, st_adaln(p, smem); st_convert(p, smem));      GBAR();
    REP(2, st_norm_rows(p, 0));       GBAR();
    REP(3, st_z_gemm(p, smem));       GBAR();
    REP(4, st_prep(p, smem));         GBAR();
    REP(5, st_nsa2(p, smem));         __syncthreads();
    REP(6, st_dsa2(p, smem));         GBAR();
    REP(7, st_merge_gemm(p, smem));   GBAR();
    REP(8, st_out_gemm(p, smem));     GBAR();
    st_norm_rows(p, 1);       GBAR();
    REP(9, st_ssub_gemm(p, smem));    GBAR();
    REP(10, st_route(p));
    REP(11, st_cvt_uv(p));             GBAR();
    {   __syncthreads();
        const int myrank = (int)((volatile LAS unsigned*)(smem + LDS_CTL))[2];
        const XccInfo xi = xcc_info(p, myrank, xb_xcc_id());
        REP(12, st_expert_u3(p, smem, xi)); GBAR();
        st_expert_v3(p, smem, xi); GBAR();
        st_final_norm(p);
    }
}

extern "C" void kernel_launch(void* const* d_in, const int* in_sizes, int n_in, void* d_out, int out_size, void* d_ws, size_t ws_size, hipStream_t stream) {
    static int grid = 0;
    if (grid == 0) {
        int dev = 0, cus = 0, per_cu = 0;
        hipGetDevice(&dev); hipDeviceGetAttribute(&cus, hipDeviceAttributeMultiprocessorCount, dev);
        hipFuncSetAttribute((const void*)k_mega, hipFuncAttributeMaxDynamicSharedMemorySize, LDS_BYTES);
        hipOccupancyMaxActiveBlocksPerMultiprocessor(&per_cu, (const void*)k_mega, NTHR, LDS_BYTES);
        if (per_cu < 1) { fprintf(stderr, "kernel_launch: occupancy query says %d blocks/CU\n", per_cu); per_cu = 1; }
        (void)hipGetLastError();
        grid = cus;
    }
    Params p{};
    const float** f = (const float**)&p;
    for (int i = 0; i < 23; ++i) f[i] = (const float*)d_in[i];
    p.out = (float*)d_out; p.ws = (unsigned char*)d_ws;
    hipMemsetAsync((unsigned char*)d_ws + WS_BAR, 0, 16384, stream);
    hipLaunchKernelGGL(k_mega, dim3(grid), dim3(NTHR), LDS_BYTES, stream, p);
}
#ifdef TESTK
__global__ void __launch_bounds__(NTHR, 2) k_t_nsa(Params p) { st_nsa(p); }
__global__ void __launch_bounds__(NTHR, 2) k_t_dsa(Params p) { extern __shared__ __attribute__((aligned(16))) unsigned char smem[]; st_dsa(p, smem); }
#endif
#ifdef TESTK2
__global__ void __launch_bounds__(NTHR, 2) k_t_nsa2(Params p) { extern __shared__ __attribute__((aligned(16))) unsigned char smem[]; st_nsa2(p, smem); }
__global__ void __launch_bounds__(NTHR, 2) k_t_dsa2(Params p) { extern __shared__ __attribute__((aligned(16))) unsigned char smem[]; st_dsa2(p, smem); }
#endif
```

```cpp
#include <hip/hip_runtime.h>
#include <stdint.h>
#include <stdio.h>

#ifndef PROBE_STAGE
#define PROBE_STAGE 0
#endif
#define LAS __attribute__((address_space(3)))
typedef unsigned short bf16_t;
typedef unsigned int u32;

constexpr int T = 16384, SEQ = 2048, NB = 8, D = 1024, NZ = 4608, DIN = 4576;
constexpr int NTHR = 512;
constexpr float EPS = 1e-6f;
constexpr int ZC_QN = 0, ZC_KC = 512, ZC_VC = 640, ZC_KS = 768, ZC_VS = 896, ZC_KW = 1024, ZC_VW = 1152, ZC_QD = 1280, ZC_CKV = 1792,
              ZC_QI = 1920, ZC_KI = 2432, ZC_GN = 2496, ZC_WI = 2520, ZC_GM = 2560;
constexpr unsigned long long ROPE_MASK = 0xFFull | (3ull << 8) | (3ull << 12) | (3ull << 16) | (0xFFull << 20) | (0xFFull << 30) | (1ull << 38);
constexpr unsigned long long SCALE_MASK = 0xFFull | (0xFFull << 20) | (0xFFull << 30);

constexpr size_t WS_Z = 0;
constexpr size_t WS_SSUB = 0;
constexpr size_t WS_EIDX = 134217728;
constexpr size_t WS_GATE = 142606336;
constexpr size_t WS_WGT = 0;
constexpr size_t WS_MERGED = 150994944;
constexpr size_t WS_U16 = WS_MERGED;
constexpr size_t WS_HB = 184549376;
constexpr size_t WS_ONSA = WS_HB;
constexpr size_t WS_ODSA = WS_HB + 16777216;
constexpr size_t WS_V16 = WS_HB;
constexpr size_t WS_H2 = 218103808;
constexpr size_t WS_W = 251658240;
constexpr size_t WS_WINT = WS_H2;
constexpr size_t WS_WNSAT = WS_W;
constexpr size_t WS_WDSAT = WS_WNSAT + 1048576;
constexpr size_t WS_WOUTT = WS_WDSAT + 1048576;
constexpr size_t WS_WFOLDT = WS_WOUTT + 2097152;
constexpr size_t WS_SMALL = WS_WFOLDT + 4194304;
constexpr size_t WS_MOD = WS_SMALL;
constexpr size_t WS_COS = WS_MOD + 196608;
constexpr size_t WS_SIN = WS_COS + 262144;
constexpr size_t WS_BAR = WS_SIN + 262144;
constexpr size_t WS_W1T = WS_BAR + 16384;
constexpr size_t WS_BPOS = WS_W1T + 524288;
constexpr size_t WS_WKVT = WS_BPOS + 512;
constexpr size_t WS_SU = WS_WKVT + 32768;
constexpr size_t WS_SX = WS_SU + 65536;
constexpr size_t WS_END_SMALL = WS_SX + 65536;
constexpr size_t WS_X8 = WS_MERGED + 16777216;
static_assert(WS_END_SMALL <= 268435456, "ws overflow");
constexpr size_t DO_KD = 0;
constexpr size_t DO_VDT = 2097152;
constexpr size_t DO_VST = 4194304;
constexpr size_t DO_VWT = 8388608;
constexpr size_t DO_KCMP = 12582912;
constexpr size_t DO_VCMPT = 12845056;
constexpr size_t DO_HID = 13107200;
constexpr size_t DO_MASK = 14680064;
constexpr size_t DO_END = DO_MASK + 4194304;

struct Params {
    const float *x, *c, *ada_w, *ada_b, *norm1_g, *w_in, *cmp_pos, *w1k, *w2k, *w1v, *w2v, *kvg, *w_uk, *w_uv, *w_nsa, *w_dsa, *w_out, *norm2_g, *wq,
        *subkeys, *pu, *pv, *final_g;
    float* out;
    unsigned char* ws;
};

__device__ __forceinline__ bf16_t f2bf(float f) { u32 u = __float_as_uint(f); u += 0x7fffu + ((u >> 16) & 1u); return (bf16_t)(u >> 16); }
__device__ __forceinline__ float bf2f(bf16_t h) { return __uint_as_float((u32)h << 16); }
__device__ __forceinline__ float bflo(u32 w) { return __uint_as_float(w << 16); }
__device__ __forceinline__ float bfhi(u32 w) { return __uint_as_float(w & 0xffff0000u); }
__device__ __forceinline__ u32 pk2(float lo, float hi) { return (u32)f2bf(lo) | ((u32)f2bf(hi) << 16); }
__device__ __forceinline__ float wave_sum(float v) {
#pragma unroll
    for (int o = 1; o < 64; o <<= 1) v += __shfl_xor(v, o);
    return v;
}
__device__ __forceinline__ float wave_max(float v) {
#pragma unroll
    for (int o = 1; o < 64; o <<= 1) v = fmaxf(v, __shfl_xor(v, o));
    return v;
}
__device__ __forceinline__ float sigmoidf_(float v) { return 1.0f / (1.0f + __expf(-v)); }
__device__ __forceinline__ float gelu_tanh(float v) { const float u = 0.7978845608028654f * (v + 0.044715f * v * v * v); return 0.5f * v * (1.0f + tanhf(u)); }
__device__ __forceinline__ float gelu_erf(float v) { return 0.5f * v * (1.0f + erff(v * 0.7071067811865476f)); }

__device__ __forceinline__ float gelu_erf_fast(float v) {
    const float av = fabsf(v), d = av * 0.2316418882f + 1.0f; const float t = __builtin_amdgcn_rcpf(d);
    float q = t * 0.5307027145f + (-0.7265760135f); q = q * t + 0.7107068705f; q = q * t + (-0.142248368f); q = q * t + 0.127414796f; q = q * t;
    const float e = __builtin_amdgcn_exp2f((v * v) * (-0.72134752044f));
    const float m = v * (q * e);
    return v < 0.f ? m : v - m;
}
__device__ __forceinline__ int z_logical_col(int pc) {
    const int g64 = pc >> 6; const int o = pc & 63;
    const int po = (g64 < 64 && ((ROPE_MASK >> g64) & 1ull)) ? ((o >> 1) + 32 * (o & 1)) : o;
    const int pp = (pc & ~63) + po;
    if (pc < 1280) return pp;
    if (pc < 1792) return 1304 + (pp - 1280);
    if (pc < 1920) return 1816 + (pp - 1792);
    if (pc < 2432) return 1944 + (pp - 1920);
    if (pc < 2496) return 2456 + (pp - 2432);
    if (pc < 2520) return 1280 + (pc - 2496);
    if (pc < 2528) return 2520 + (pc - 2520);
    if (pc < 2560) return -1;
    return 2528 + (pc - 2560);
}
__device__ __forceinline__ void z_post(int t, int pc, float& v0, float& v1, const float* cosT, const float* sinT) {
    const int g64 = pc >> 6;
    if (g64 < 64 && ((ROPE_MASK >> g64) & 1ull)) {
        const int i = (pc & 63) >> 1, pos = t & (SEQ - 1);
        const float c = cosT[pos * 32 + i], s = sinT[pos * 32 + i];
        const float a = v0 * c - v1 * s, b = v1 * c + v0 * s;
        const float sc = ((SCALE_MASK >> g64) & 1ull) ? 0.125f : 1.0f;
        v0 = a * sc; v1 = b * sc;
    } else if (pc >= ZC_GM || (pc >= ZC_GN && pc < ZC_WI)) { v0 = sigmoidf_(v0); v1 = sigmoidf_(v1); }
}
__device__ __forceinline__ void sincos_tab(float ang, float& s, float& c) {
    const double a = (double)ang; const double k = rint(a * 0.63661977236758134308);
    const float r = (float)(a - k * 1.57079632679489661923); const float z = r * r;
    const float sp = ((-1.9515295891e-4f * z + 8.3321608736e-3f) * z - 1.6666654611e-1f) * z * r + r;
    const float cp = ((2.443315711809948e-5f * z - 1.388731625493765e-3f) * z + 4.166664568298827e-2f) * z * z - 0.5f * z + 1.0f;
    const int q = ((int)k) & 3;
    s = (q == 0) ? sp : (q == 1) ? cp : (q == 2) ? -sp : -cp;
    c = (q == 0) ? cp : (q == 1) ? -sp : (q == 2) ? -cp : sp;
}

__device__ __forceinline__ void st_adaln(const Params& p, unsigned char* lds) {
    int tid_ = threadIdx.x; asm volatile("" : "+v"(tid_)); const int tid = tid_, lane = tid & 63, w = tid >> 6;
    float* cosT = (float*)(p.ws + WS_COS); float* sinT = (float*)(p.ws + WS_SIN);
    for (int i = blockIdx.x * NTHR + tid; i < SEQ * 32; i += gridDim.x * NTHR) {
        const int pos = i >> 5, f = i & 31; const float inv = powf(10000.0f, -(float)f / 32.0f);
        float s, c; sincos_tab((float)pos * inv, s, c); cosT[i] = c; sinT[i] = s;
    }
    float* sc = (float*)lds;
    float* red = sc + 8192;
    for (int i = tid; i < 8192; i += NTHR) { const float v = p.c[i]; sc[i] = v / (1.0f + __expf(-v)); }
    __syncthreads();
    float* mod = (float*)(p.ws + WS_MOD);
    for (int unit = blockIdx.x; unit < 192; unit += gridDim.x) {
        float acc[8];
#pragma unroll
        for (int b = 0; b < 8; ++b) acc[b] = 0.f;
        const int col = unit * 32 + (lane & 31), ks = lane >> 5;
        for (int k0 = 0; k0 < 64; k0 += 16) {
            float wv[16];
#pragma unroll
            for (int i = 0; i < 16; ++i) wv[i] = p.ada_w[(size_t)(w * 128 + (k0 + i) * 2 + ks) * 6144 + col];
#pragma unroll
            for (int i = 0; i < 16; ++i) { const int k = w * 128 + (k0 + i) * 2 + ks;
#pragma unroll
                for (int b = 0; b < 8; ++b) acc[b] += sc[b * 1024 + k] * wv[i]; }
        }
#pragma unroll
        for (int b = 0; b < 8; ++b) red[((w * 2 + ks) * 8 + b) * 32 + (lane & 31)] = acc[b];
        __syncthreads();
        if (tid < 256) { const int b = tid >> 5, c = tid & 31; float s = 0.f;
            for (int j = 0; j < 16; ++j) s += red[(j * 8 + b) * 32 + c];
            mod[b * 6144 + unit * 32 + c] = s + p.ada_b[unit * 32 + c]; }
        __syncthreads();
    }
}
__device__ __forceinline__ void st_norm_rows(const Params& p, int which) {
    int tid_ = threadIdx.x; asm volatile("" : "+v"(tid_)); const int tid = tid_, lane = tid & 63, w = tid >> 6;
    const float* src = which ? p.out : p.x; const float* g = which ? p.norm2_g : p.norm1_g;
    bf16_t* dst = (bf16_t*)(p.ws + (which ? WS_H2 : WS_HB));
    const float* mod = (const float*)(p.ws + WS_MOD);
    for (int t = blockIdx.x * 8 + w; t < T; t += gridDim.x * 8) {
        const int b = t >> 11; const float* sh = mod + b * 6144 + (which ? 3072 : 0); const float* scl = sh + 1024;
        const float4* xr = (const float4*)(src + (size_t)t * D);
        float4 v[4]; float ss = 0.f;
#pragma unroll
        for (int j = 0; j < 4; ++j) { v[j] = xr[lane + 64 * j]; ss += v[j].x * v[j].x + v[j].y * v[j].y + v[j].z * v[j].z + v[j].w * v[j].w; }
        const float r = rsqrtf(wave_sum(ss) * (1.0f / D) + EPS);
        float am = 0.f;
#pragma unroll
        for (int j = 0; j < 4; ++j) { const int d0 = (lane + 64 * j) * 4;
            const float4 gg = *(const float4*)(g + d0), s4 = *(const float4*)(scl + d0), h4 = *(const float4*)(sh + d0);
            const float o0 = v[j].x * r * gg.x * (1.f + s4.x) + h4.x, o1 = v[j].y * r * gg.y * (1.f + s4.y) + h4.y;
            const float o2 = v[j].z * r * gg.z * (1.f + s4.z) + h4.z, o3 = v[j].w * r * gg.w * (1.f + s4.w) + h4.w;
            uint2 o; o.x = pk2(o0, o1); o.y = pk2(o2, o3); *(uint2*)(dst + (size_t)t * D + d0) = o;
            v[j].x = o0; v[j].y = o1; v[j].z = o2; v[j].w = o3; am = fmaxf(am, fmaxf(fmaxf(fabsf(o0), fabsf(o1)), fmaxf(fabsf(o2), fabsf(o3)))); }
        if (which) {
            am = wave_max(am); const float sx = am > 0.f ? am * (1.0f / 127.0f) : 1.0f; const float isx = 1.0f / sx;
            if (lane == 0) ((float*)(p.ws + WS_SX))[t] = sx;
#pragma unroll
            for (int j = 0; j < 4; ++j) { const int q0 = (int)rintf(v[j].x * isx), q1 = (int)rintf(v[j].y * isx), q2 = (int)rintf(v[j].z * isx), q3 = (int)rintf(v[j].w * isx);
                *(u32*)(p.ws + WS_X8 + (size_t)t * D + (lane + 64 * j) * 4) = (u32)(q0 & 255) | ((u32)(q1 & 255) << 8) | ((u32)(q2 & 255) << 16) | ((u32)(q3 & 255) << 24); }
        }
    }
}
__device__ __forceinline__ u32 ordf(float f);
__device__ __forceinline__ void ins16(u32 (&s)[16], u32 key) {
#pragma unroll
    for (int i = 0; i < 16; ++i) { const u32 mx = s[i] > key ? s[i] : key; key = s[i] > key ? key : s[i]; s[i] = mx; }
}
__device__ __forceinline__ void sort16_desc(u32 (&c)[16]) {
#pragma unroll
    for (int k = 2; k <= 16; k <<= 1)
#pragma unroll
        for (int j = k >> 1; j > 0; j >>= 1)
#pragma unroll
            for (int i = 0; i < 16; ++i) { const int l = i ^ j;
                if (l > i) { const u32 a = c[i], b = c[l]; const u32 mx = a > b ? a : b, mn = a > b ? b : a; if ((i & k) == 0) { c[i] = mx; c[l] = mn; } else { c[i] = mn; c[l] = mx; } } }
}
__device__ __forceinline__ void merge16(u32 (&s)[16], const u32 (&c)[16]) {
#pragma unroll
    for (int i = 0; i < 16; ++i) s[i] = s[i] > c[15 - i] ? s[i] : c[15 - i];
#pragma unroll
    for (int j = 8; j > 0; j >>= 1)
#pragma unroll
        for (int i = 0; i < 16; ++i) { const int l = i ^ j; if (l > i) { const u32 a = s[i], b = s[l]; s[i] = a > b ? a : b; s[l] = a > b ? b : a; } }
}
__device__ __forceinline__ void st_route(const Params& p) {
    int tid_ = threadIdx.x; asm volatile("" : "+v"(tid_)); const int tid = tid_; const float* ss = (const float*)(p.ws + WS_SSUB); int* eidx = (int*)(p.ws + WS_EIDX); float* gate = (float*)(p.ws + WS_GATE);
    for (int it = blockIdx.x * NTHR + tid; it < T * 8; it += gridDim.x * NTHR) {
        const float* s0 = ss + (size_t)it * 256;
        u32 a[16], b[16];
#pragma unroll 1
        for (int n0 = 0; n0 < 128; n0 += 16) {
            u32 ca[16], cb[16];
#pragma unroll
            for (int q = 0; q < 4; ++q) { const float4 x = *(const float4*)(s0 + n0 + 4 * q), y = *(const float4*)(s0 + 128 + n0 + 4 * q); const u32 nb_ = (u32)(127 - n0 - 4 * q);
                ca[4 * q] = (ordf(x.x) & ~127u) | nb_; ca[4 * q + 1] = (ordf(x.y) & ~127u) | (nb_ - 1u); ca[4 * q + 2] = (ordf(x.z) & ~127u) | (nb_ - 2u); ca[4 * q + 3] = (ordf(x.w) & ~127u) | (nb_ - 3u);
                cb[4 * q] = (ordf(y.x) & ~127u) | nb_; cb[4 * q + 1] = (ordf(y.y) & ~127u) | (nb_ - 1u); cb[4 * q + 2] = (ordf(y.z) & ~127u) | (nb_ - 2u); cb[4 * q + 3] = (ordf(y.w) & ~127u) | (nb_ - 3u); }
            sort16_desc(ca); sort16_desc(cb);
            if (n0 == 0) {
#pragma unroll
                for (int i = 0; i < 16; ++i) { a[i] = ca[i]; b[i] = cb[i]; }
            } else { merge16(a, ca); merge16(b, cb); }
        }
        float va[16], vb[16]; int na[16], nb[16];
#pragma unroll
        for (int i = 0; i < 16; ++i) { na[i] = 127 - (int)(a[i] & 127u); nb[i] = 127 - (int)(b[i] & 127u); va[i] = s0[na[i]]; vb[i] = s0[128 + nb[i]]; }
        u32 tk[16];
#pragma unroll
        for (int i = 0; i < 16; ++i) tk[i] = 0u;
#pragma unroll
        for (int i = 0; i < 16; ++i)
#pragma unroll
            for (int j = 0; j < 16; ++j) if ((i + 1) * (j + 1) <= 16) ins16(tk, (ordf(va[i] + vb[j]) & ~255u) | (u32)(255 - (i * 16 + j)));
        float ts[16]; int te[16];
#pragma unroll
        for (int r = 0; r < 16; ++r) { const int flat = 255 - (int)(tk[r] & 255u), i = flat >> 4, j = flat & 15; float x = 0.f, y = 0.f; int ni = 0, nj = 0;
#pragma unroll
            for (int q = 0; q < 16; ++q) { if (i == q) { x = va[q]; ni = na[q]; } if (j == q) { y = vb[q]; nj = nb[q]; } }
            ts[r] = x + y; te[r] = ni * 128 + nj; }
        float mx = ts[0];
#pragma unroll
        for (int r = 1; r < 16; ++r) mx = fmaxf(mx, ts[r]);
        float sum = 0.f, ex[16];
#pragma unroll
        for (int r = 0; r < 16; ++r) { ex[r] = __expf(ts[r] - mx); sum += ex[r]; }
        const float inv = 1.0f / sum;
#pragma unroll
        for (int r = 0; r < 16; ++r) { eidx[(size_t)it * 16 + r] = te[r]; gate[(size_t)it * 16 + r] = ex[r] * inv; }
    }
}
__device__ __forceinline__ u32 pk4_fp8(float a, float b, float c, float d) { int p = 0; p = __builtin_amdgcn_cvt_pk_fp8_f32(a, b, p, false); p = __builtin_amdgcn_cvt_pk_fp8_f32(c, d, p, true); return (u32)p; }
__device__ __forceinline__ void st_cvt_uv(const Params& p) {
    int tid_ = threadIdx.x; asm volatile("" : "+v"(tid_)); const int tid = tid_;
    const int lane = tid & 63, w = tid >> 6;
    unsigned char* u8 = p.ws + WS_U16; unsigned char* v8 = p.ws + WS_V16; float* su = (float*)(p.ws + WS_SU);
    for (int e = blockIdx.x * 8 + w; e < 16384; e += gridDim.x * 8) {
        const float4* a = (const float4*)(p.pu + (size_t)e * D); const float4* b = (const float4*)(p.pv + (size_t)e * D);
        float4 av[4], bv[4]; float am = 0.f;
#pragma unroll
        for (int j = 0; j < 4; ++j) { av[j] = a[lane + 64 * j]; bv[j] = b[lane + 64 * j];
            am = fmaxf(am, fmaxf(fmaxf(fabsf(av[j].x), fabsf(av[j].y)), fmaxf(fabsf(av[j].z), fabsf(av[j].w)))); }
        am = wave_max(am); const float sc = am > 0.f ? am * (1.0f / 127.0f) : 1.0f; const float isc = 1.0f / sc;
        if (lane == 0) su[e] = sc;
#pragma unroll
        for (int j = 0; j < 4; ++j) { const int col = (lane + 64 * j) * 4;
            const int q0 = (int)rintf(av[j].x * isc), q1 = (int)rintf(av[j].y * isc), q2 = (int)rintf(av[j].z * isc), q3 = (int)rintf(av[j].w * isc);
            *(u32*)(u8 + (size_t)e * 1024 + col) = (u32)(q0 & 255) | ((u32)(q1 & 255) << 8) | ((u32)(q2 & 255) << 16) | ((u32)(q3 & 255) << 24);
            *(u32*)(v8 + ((size_t)(col >> 7) * 16384 + e) * 128 + (col & 127)) = pk4_fp8(bv[j].x, bv[j].y, bv[j].z, bv[j].w); }
    }
}


typedef short bf16x8 __attribute__((ext_vector_type(8)));
typedef float f32x16 __attribute__((ext_vector_type(16)));
typedef unsigned u32x2 __attribute__((ext_vector_type(2)));
typedef unsigned u32x4 __attribute__((ext_vector_type(4)));
typedef __bf16 hbf2_t __attribute__((ext_vector_type(2)));
typedef float f32x2_t __attribute__((ext_vector_type(2)));
#define MFMA32(a, b, c) __builtin_amdgcn_mfma_f32_32x32x16_bf16((a), (b), (c), 0, 0, 0)
__device__ __forceinline__ u32 pkbf(float a, float b) { const f32x2_t v = {a, b}; const hbf2_t r = __builtin_convertvector(v, hbf2_t); return __builtin_bit_cast(u32, r); }
__device__ __forceinline__ bf16x8 ld8(const bf16_t* q) { return *(const bf16x8*)q; }
__device__ __forceinline__ bf16x8 ld44(const bf16_t* q) { const u32x2 a = *(const u32x2*)q, b = *(const u32x2*)(q + 8); const u32x4 v = {a.x, a.y, b.x, b.y}; return __builtin_bit_cast(bf16x8, v); }
template <int H> __device__ __forceinline__ bf16x8 pack8(const f32x16& s) {
    const u32x4 v = {pkbf(s[8 * H], s[8 * H + 1]), pkbf(s[8 * H + 2], s[8 * H + 3]), pkbf(s[8 * H + 4], s[8 * H + 5]), pkbf(s[8 * H + 6], s[8 * H + 7])};
    return __builtin_bit_cast(bf16x8, v);
}
__device__ __forceinline__ float dpp_xor1(float v) { return __int_as_float(__builtin_amdgcn_update_dpp(0, __float_as_int(v), 0xB1, 0xF, 0xF, true)); }
__device__ __forceinline__ float dpp_xor2(float v) { return __int_as_float(__builtin_amdgcn_update_dpp(0, __float_as_int(v), 0x4E, 0xF, 0xF, true)); }
__device__ __forceinline__ f32x16 zero16() { f32x16 z;
#pragma unroll
    for (int i = 0; i < 16; ++i) z[i] = 0.f; return z; }
__device__ __forceinline__ u32 vm_le(int lim) { u32 vm = 0u;
#pragma unroll
    for (int R = 0; R < 16; ++R) vm |= (((R & 3) + 8 * (R >> 2)) <= lim) ? (1u << R) : 0u;
    return vm; }
__device__ __forceinline__ u32 vm_from_word(u32 word, int hl) { const u32 sh = word >> (4 * hl); return (sh & 0xFu) | (((sh >> 8) & 0xFu) << 4) | (((sh >> 16) & 0xFu) << 8) | (((sh >> 24) & 0xFu) << 12); }
__device__ __forceinline__ void store_ot(bf16_t* orow, const f32x16& o0, const f32x16& o1, int hl) {
#pragma unroll
    for (int q = 0; q < 4; ++q) {
        u32x2 a = {pkbf(o0[4 * q], o0[4 * q + 1]), pkbf(o0[4 * q + 2], o0[4 * q + 3])}; *(u32x2*)(orow + 8 * q + 4 * hl) = a;
        u32x2 b = {pkbf(o1[4 * q], o1[4 * q + 1]), pkbf(o1[4 * q + 2], o1[4 * q + 3])}; *(u32x2*)(orow + 32 + 8 * q + 4 * hl) = b;
    }
}
__device__ __forceinline__ u32 ordf(float f) { const u32 u = __float_as_uint(f); return (u & 0x80000000u) ? ~u : (u | 0x80000000u); }


constexpr int TILE_B = 4608;
template <int NT> __device__ __forceinline__ void sk_gload(uint4 (&rk)[NT / 2], const bf16_t* kbase, size_t kstride, int t0c, int tlast, int tid) {
#pragma unroll
    for (int q = 0; q < NT / 2; ++q) { const int idx = tid + 512 * q, tile = idx >> 8, r = (idx >> 3) & 31, ch = idx & 7; int tg = t0c + tile; tg = tg > tlast ? tlast : tg;
        rk[q] = *(const uint4*)(kbase + (size_t)(32 * tg + r) * kstride + 8 * ch); }
}
template <int NT> __device__ __forceinline__ void sk_lwrite(const uint4 (&rk)[NT / 2], LAS unsigned char* kb, int tid) {
#pragma unroll
    for (int q = 0; q < NT / 2; ++q) { const int idx = tid + 512 * q, tile = idx >> 8, r = (idx >> 3) & 31, ch = idx & 7; const u32x4 v = {rk[q].x, rk[q].y, rk[q].z, rk[q].w}; *(LAS u32x4*)(kb + tile * TILE_B + r * 144 + ch * 16) = v; }
}
template <int NT> __device__ __forceinline__ void sv_gload(uint4 (&rv)[NT / 2], const bf16_t* vbase, size_t vstride, int t0c, int tlast, int tid) {
#pragma unroll
    for (int q = 0; q < NT / 2; ++q) { const int idx = tid + 512 * q, tile = idx >> 8, d = (idx >> 2) & 63, sg = idx & 3; int tg = t0c + tile; tg = tg > tlast ? tlast : tg;
        rv[q] = *(const uint4*)(vbase + (size_t)d * vstride + 32 * tg + 8 * sg); }
}
template <int NT> __device__ __forceinline__ void sv_lwrite(const uint4 (&rv)[NT / 2], LAS unsigned char* vb, int tid) {
#pragma unroll
    for (int q = 0; q < NT / 2; ++q) { const int idx = tid + 512 * q, tile = idx >> 8, d = (idx >> 2) & 63, sg = idx & 3; LAS unsigned char* a = vb + tile * TILE_B + d * 72 + sg * 16;
        const u32x2 v0 = {rv[q].x, rv[q].y}, v1 = {rv[q].z, rv[q].w}; *(LAS u32x2*)a = v0; *(LAS u32x2*)(a + 8) = v1; }
}
__device__ __forceinline__ bf16x8 lds_k(const LAS unsigned char* kt, int c, int hl, int kk) { return *(const LAS bf16x8*)(kt + c * 144 + kk * 32 + hl * 16); }
__device__ __forceinline__ bf16x8 lds_v(const LAS unsigned char* vt, int d, int hl, int s) { const LAS unsigned char* q = vt + d * 72 + s * 32 + hl * 8;
    const u32x2 a = *(const LAS u32x2*)q, b = *(const LAS u32x2*)(q + 16); const u32x4 v = {a.x, a.y, b.x, b.y}; return __builtin_bit_cast(bf16x8, v); }
__device__ __forceinline__ void flash_tile_lds(float& m2, float& l, f32x16& o0, f32x16& o1, f32x16 s, u32 vm, bool full, const LAS unsigned char* vt, int c, int hl) {
    const float LOG2E = 1.4426950408889634f;
    const bf16x8 v00 = lds_v(vt, c, hl, 0), v01 = lds_v(vt, c, hl, 1), v10 = lds_v(vt, c + 32, hl, 0), v11 = lds_v(vt, c + 32, hl, 1);
    float mx = -1e30f;
    if (full) {
#pragma unroll
        for (int R = 0; R < 16; ++R) mx = fmaxf(mx, s[R]);
    } else {
#pragma unroll
        for (int R = 0; R < 16; ++R) { s[R] = ((vm >> R) & 1u) ? s[R] : -1e30f; mx = fmaxf(mx, s[R]); }
    }
    mx = fmaxf(mx, __shfl_xor(mx, 32));
    const float mn2 = fmaxf(m2, mx * LOG2E);
    if (!__all(mn2 == m2)) { const float al = __builtin_amdgcn_exp2f(m2 - mn2); l *= al;
#pragma unroll
        for (int R = 0; R < 16; ++R) { o0[R] *= al; o1[R] *= al; }
        m2 = mn2; }
    float ps = 0.f;
    if (full) {
#pragma unroll
        for (int R = 0; R < 16; ++R) { const float pr = __builtin_amdgcn_exp2f(fmaf(s[R], LOG2E, -mn2)); s[R] = pr; ps += pr; }
    } else {
#pragma unroll
        for (int R = 0; R < 16; ++R) { const float pr = ((vm >> R) & 1u) ? __builtin_amdgcn_exp2f(fmaf(s[R], LOG2E, -mn2)) : 0.f; s[R] = pr; ps += pr; }
    }
    ps += __shfl_xor(ps, 32);
    l += ps;
    const bf16x8 p0 = pack8<0>(s), p1 = pack8<1>(s);
    o0 = MFMA32(v00, p0, o0); o0 = MFMA32(v01, p1, o0);
    o1 = MFMA32(v10, p0, o1); o1 = MFMA32(v11, p1, o1);
}
#define HALF_SUM32(v, hl, out) do { int _v = (v); _v += __builtin_amdgcn_update_dpp(0, _v, 0xB1, 0xF, 0xF, true); _v += __builtin_amdgcn_update_dpp(0, _v, 0x4E, 0xF, 0xF, true); \
    _v += __builtin_amdgcn_update_dpp(0, _v, 0x141, 0xF, 0xF, true); _v += __builtin_amdgcn_update_dpp(0, _v, 0x140, 0xF, 0xF, true); \
    const int _r0 = __builtin_amdgcn_readlane(_v, 0) + __builtin_amdgcn_readlane(_v, 16), _r1 = __builtin_amdgcn_readlane(_v, 32) + __builtin_amdgcn_readlane(_v, 48); (out) = (hl) ? _r1 : _r0; } while (0)
constexpr int ATT_CHUNK = 8 * TILE_B;
constexpr int ATT_MK_OFF = 2 * ATT_CHUNK;

#define ATT_STREAM_KV(kbase, kstride, vbase, vstride, tfirst, tlast, BODY) do { \
    const int _tf = (tfirst), _tl = (tlast); const int _nch = (_tl - _tf + 4) >> 2; \
    uint4 _rk[2], _rv[2]; \
    __syncthreads(); \
    sk_gload<4>(_rk, (kbase), (kstride), _tf, _tl, tid); sv_gload<4>(_rv, (vbase), (vstride), _tf, _tl, tid); \
    sk_lwrite<4>(_rk, sm, tid); sv_lwrite<4>(_rv, sm + 4 * TILE_B, tid); \
    if (_nch > 1) { sk_gload<4>(_rk, (kbase), (kstride), _tf + 4, _tl, tid); sv_gload<4>(_rv, (vbase), (vstride), _tf + 4, _tl, tid); } \
    for (int _c = 0; _c < _nch; ++_c) { \
        __syncthreads(); \
        if (_c + 1 < _nch) { LAS unsigned char* _nb = sm + ((_c + 1) & 1) * ATT_CHUNK; sk_lwrite<4>(_rk, _nb, tid); sv_lwrite<4>(_rv, _nb + 4 * TILE_B, tid); \
            if (_c + 2 < _nch) { sk_gload<4>(_rk, (kbase), (kstride), _tf + 4 * (_c + 2), _tl, tid); sv_gload<4>(_rv, (vbase), (vstride), _tf + 4 * (_c + 2), _tl, tid); } } \
        const LAS unsigned char* _cb = sm + (_c & 1) * ATT_CHUNK; \
        _Pragma("unroll") for (int _i = 0; _i < 4; ++_i) { const int tg = _tf + 4 * _c + _i; if (tg <= _tl) { const LAS unsigned char* kt = _cb + _i * TILE_B; const LAS unsigned char* vt = _cb + (4 + _i) * TILE_B; BODY } } \
    } } while (0)

__device__ __forceinline__ void st_nsa2(const Params& p, unsigned char* lds) {
    LAS unsigned char* sm = (LAS unsigned char*)lds;
    const bf16_t* Z = (const bf16_t*)(p.ws + WS_Z); unsigned char* dob = (unsigned char*)p.out;
    const bf16_t* kcmp = (const bf16_t*)(dob + DO_KCMP); const bf16_t* vcmpT = (const bf16_t*)(dob + DO_VCMPT);
    const bf16_t* vsT = (const bf16_t*)(dob + DO_VST); const bf16_t* vwT = (const bf16_t*)(dob + DO_VWT);
    bf16_t* onsa = (bf16_t*)(p.ws + WS_ONSA);
    for (int ps = blockIdx.x; ps < 256; ps += gridDim.x)
    for (int which = 0; which < 2; ++which) {
        const int b = ps >> 5, g = (ps >> 4) & 1, jj = ps & 15, qb = which ? 31 - jj : jj, cur = qb;
        int tid = threadIdx.x; asm volatile("" : "+v"(tid));
        const int lane = tid & 63, w = __builtin_amdgcn_readfirstlane(tid >> 6), c = lane & 31, hl = lane >> 5;
        const int t0 = qb * 64, pmin = t0 + 8 * w, pos = pmin + (c >> 2), head = 4 * g + (c & 3);
        const bf16_t* zr = Z + (size_t)(b * SEQ + pos) * NZ;
        bf16x8 qfr[4];
#pragma unroll
        for (int kk = 0; kk < 4; ++kk) qfr[kk] = ld8(zr + ZC_QN + head * 64 + 16 * kk + 8 * hl);
        const float gc = bf2f(zr[ZC_GN + head * 3]), gs = bf2f(zr[ZC_GN + head * 3 + 1]), gw = bf2f(zr[ZC_GN + head * 3 + 2]);
        f32x16 out0 = zero16(), out1 = zero16();
        u32 sel;
        {
            const int pmax = pmin + 7; const int nmax = pmax >= 31 ? ((pmax - 31) >> 4) : -1; const int ntile = nmax >= 0 ? (((nmax > 126 ? 126 : nmax) >> 5) + 1) : 0;
            const bf16_t* kb = kcmp + ((size_t)(b * 2 + g) * 128 + c) * 64 + 8 * hl;
            float mx = -1e30f, l = 0.f;
            const int nlim = (pos >= 31 ? (((pos - 31) >> 4) > 126 ? 126 : ((pos - 31) >> 4)) : -1) - 4 * hl;
            for (int kt = 0; kt < ntile; ++kt) {
                f32x16 s = zero16();
#pragma unroll
                for (int kk = 0; kk < 4; ++kk) s = MFMA32(ld8(kb + (size_t)kt * 32 * 64 + 16 * kk), qfr[kk], s);
                const u32 vm = vm_le(nlim - 32 * kt);
                float tm = -1e30f;
#pragma unroll
                for (int R = 0; R < 16; ++R) { s[R] = ((vm >> R) & 1u) ? s[R] : -1e30f; tm = fmaxf(tm, s[R]); }
                const float mn = fmaxf(mx, tm); float ps2 = 0.f;
#pragma unroll
                for (int R = 0; R < 16; ++R) ps2 += ((vm >> R) & 1u) ? __expf(s[R] - mn) : 0.f;
                l = l * __expf(mx - mn) + ps2; mx = mn;
            }
            { const float mo = __shfl_xor(mx, 32), lo_ = __shfl_xor(l, 32); const float mn = fmaxf(mx, mo);
              l = l * __expf(mx - mn) + lo_ * __expf(mo - mn); mx = mn; }
            const float il = 1.0f / fmaxf(l, 1e-30f);
            __builtin_amdgcn_sched_barrier(0);
            f32x16 o0 = zero16(), o1 = zero16();
            const bf16_t* vb = vcmpT + ((size_t)(b * 2 + g) * 64 + c) * 128 + 4 * hl;
            float G[16], L[16];
#pragma unroll
            for (int kt = 0; kt < 4; ++kt) {
                if (kt < ntile) {
                    f32x16 s = zero16();
#pragma unroll
                    for (int kk = 0; kk < 4; ++kk) s = MFMA32(ld8(kb + (size_t)kt * 32 * 64 + 16 * kk), qfr[kk], s);
                    const u32 vm = vm_le(nlim - 32 * kt);
#pragma unroll
                    for (int R = 0; R < 16; ++R) s[R] = ((vm >> R) & 1u) ? __expf(s[R] - mx) * il : 0.f;
                    const bf16x8 p0 = pack8<0>(s), p1 = pack8<1>(s);
                    o0 = MFMA32(ld44(vb + 32 * kt), p0, o0); o0 = MFMA32(ld44(vb + 32 * kt + 16), p1, o0);
                    o1 = MFMA32(ld44(vb + 32 * 128 + 32 * kt), p0, o1); o1 = MFMA32(ld44(vb + 32 * 128 + 32 * kt + 16), p1, o1);
#pragma unroll
                    for (int rg = 0; rg < 4; ++rg) { float gsum = (s[4 * rg] + s[4 * rg + 1]) + (s[4 * rg + 2] + s[4 * rg + 3]); float last = s[4 * rg + 3];
                        gsum += dpp_xor1(gsum); gsum += dpp_xor2(gsum); last += dpp_xor1(last); last += dpp_xor2(last);
                        G[4 * kt + rg] = gsum; L[4 * kt + rg] = last; }
                } else {
#pragma unroll
                    for (int rg = 0; rg < 4; ++rg) { G[4 * kt + rg] = 0.f; L[4 * kt + rg] = 0.f; }
                }
                __builtin_amdgcn_sched_barrier(0);
            }
#pragma unroll
            for (int R = 0; R < 16; ++R) { out0[R] = gc * o0[R]; out1[R] = gc * o1[R]; }
            float v[16], vx[16];
            { float Lx[16];
#pragma unroll
              for (int i = 0; i < 16; ++i) Lx[i] = __shfl_xor(L[i], 32);
#pragma unroll
              for (int i = 0; i < 16; ++i) { const float prevL = hl ? Lx[i] : (i > 0 ? Lx[i > 0 ? i - 1 : 0] : 0.f); const float bl = prevL + 2.f * G[i] - L[i];
                const int j = 2 * i + hl; const bool forced = (j == 0) || (j == cur) || (j == cur - 1);
                v[i] = forced ? __builtin_inff() : (j <= cur ? bl : -__builtin_inff()); } }
#pragma unroll
            for (int i = 0; i < 16; ++i) vx[i] = __shfl_xor(v[i], 32);
            u32 own = 0u;
#pragma unroll
            for (int i = 0; i < 16; ++i) { int rank = 0;
#pragma unroll
                for (int i2 = 0; i2 < 16; ++i2) {
                    if (i2 != i) rank += (v[i2] > v[i] || (v[i2] == v[i] && i2 < i)) ? 1 : 0;
                    const bool xlt = (i2 < i) || (hl && i2 == i);
                    rank += (vx[i2] > v[i] || (vx[i2] == v[i] && xlt)) ? 1 : 0; }
                const int j = 2 * i + hl; own |= ((j <= cur) && rank < 16) ? (1u << j) : 0u; }
            sel = own | (u32)__shfl_xor((int)own, 32);
            __builtin_amdgcn_sched_barrier(0);
        }
        {
            float m = -1e30f, l = 0.f; f32x16 o0 = zero16(), o1 = zero16();
            ATT_STREAM_KV(Z + (size_t)(b * SEQ) * NZ + ZC_KS + g * 64, (size_t)NZ, vsT + (size_t)(b * 2 + g) * 64 * SEQ, (size_t)SEQ, 0, 2 * cur + 1, {
                const bool mine = (sel >> (tg >> 1)) & 1u;
                if (__ballot(mine) != 0ull) {
                    f32x16 s = zero16();
                    _Pragma("unroll") for (int kk = 0; kk < 4; ++kk) s = MFMA32(lds_k(kt, c, hl, kk), qfr[kk], s);
                    const bool full = (tg * 32 + 31 <= pmin) && (__ballot(mine) == ~0ull);
                    const u32 vm = full ? 0xFFFFu : (mine ? vm_le(pos - tg * 32 - 4 * hl) : 0u);
                    flash_tile_lds(m, l, o0, o1, s, vm, full, vt, c, hl); } });
            const float f = gs / fmaxf(l, 1e-30f);
#pragma unroll
            for (int R = 0; R < 16; ++R) { out0[R] += f * o0[R]; out1[R] += f * o1[R]; }
        }
        {
            float m = -1e30f, l = 0.f; f32x16 o0 = zero16(), o1 = zero16();
            const int wfirst = (t0 - 511 > 0 ? t0 - 511 : 0) >> 5, wlast = (t0 + 63) >> 5;
            const int myfirst = (pmin - 511 > 0 ? pmin - 511 : 0) >> 5, mylast = (pmin + 7) >> 5;
            ATT_STREAM_KV(Z + (size_t)(b * SEQ) * NZ + ZC_KW + g * 64, (size_t)NZ, vwT + (size_t)(b * 2 + g) * 64 * SEQ, (size_t)SEQ, wfirst, wlast, {
                if (tg >= myfirst && tg <= mylast) {
                    f32x16 s = zero16();
                    _Pragma("unroll") for (int kk = 0; kk < 4; ++kk) s = MFMA32(lds_k(kt, c, hl, kk), qfr[kk], s);
                    const bool full = (tg * 32 + 31 <= pmin) && (tg * 32 + 504 >= pmin);
                    const int d1 = pos - tg * 32 - 4 * hl; const u32 vm = full ? 0xFFFFu : (vm_le(d1) & ~vm_le(d1 - 512));
                    flash_tile_lds(m, l, o0, o1, s, vm, full, vt, c, hl); } });
            const float f = gw / fmaxf(l, 1e-30f);
#pragma unroll
            for (int R = 0; R < 16; ++R) { out0[R] += f * o0[R]; out1[R] += f * o1[R]; }
        }
        store_ot(onsa + (size_t)(b * SEQ + pos) * 512 + head * 64, out0, out1, hl);
    }
    __syncthreads();
}

__device__ __forceinline__ void st_dsa2(const Params& p, unsigned char* lds) {
    LAS unsigned char* sm = (LAS unsigned char*)lds;
    const bf16_t* Z = (const bf16_t*)(p.ws + WS_Z); unsigned char* dob = (unsigned char*)p.out;
    const bf16_t* kd = (const bf16_t*)(dob + DO_KD); const bf16_t* vdT = (const bf16_t*)(dob + DO_VDT);
    bf16_t* odsa = (bf16_t*)(p.ws + WS_ODSA);
    u32* mk = (u32*)(lds + ATT_MK_OFF);
    for (int ps = blockIdx.x; ps < 256; ps += gridDim.x)
    for (int which = 0; which < 2; ++which) {
        const int b = ps >> 5, jj = ps & 31, qb = which ? 63 - jj : jj;
        const int tok0 = b * SEQ + qb * 32;
        int tid = threadIdx.x; asm volatile("" : "+v"(tid));
        const int lane = tid & 63, w = __builtin_amdgcn_readfirstlane(tid >> 6), c = lane & 31, hl = lane >> 5;
        for (int rep_a = 0; rep_a < (PROBE_STAGE == 21 ? 2 : 1); ++rep_a)
        {
            const int r = c; const int qq_r = ((r >> 2) & 1) * 2 + (r >> 4), head_r = ((r >> 3) & 1) * 4 + (r & 3);
            bf16x8 afr[4];
#pragma unroll
            for (int kk = 0; kk < 4; ++kk) afr[kk] = ld8(Z + (size_t)(tok0 + 4 * w + qq_r) * NZ + ZC_QI + head_r * 64 + 16 * kk + 8 * hl);
            float wv[2][8]; int posq[2];
#pragma unroll
            for (int s = 0; s < 2; ++s) { posq[s] = qb * 32 + 4 * w + 2 * hl + s;
                const uint4 ww = *(const uint4*)(Z + (size_t)(tok0 + 4 * w + 2 * hl + s) * NZ + ZC_WI);
                wv[s][0] = bflo(ww.x) * 0.35355339059327373f; wv[s][1] = bfhi(ww.x) * 0.35355339059327373f; wv[s][2] = bflo(ww.y) * 0.35355339059327373f; wv[s][3] = bfhi(ww.y) * 0.35355339059327373f;
                wv[s][4] = bflo(ww.z) * 0.35355339059327373f; wv[s][5] = bfhi(ww.z) * 0.35355339059327373f; wv[s][6] = bflo(ww.w) * 0.35355339059327373f; wv[s][7] = bfhi(ww.w) * 0.35355339059327373f; }
            u32 key[64][2];
            const bf16_t* kib = Z + (size_t)(b * SEQ) * NZ + ZC_KI;
            uint4 rk[4];
            __syncthreads();
            sk_gload<8>(rk, kib, (size_t)NZ, 0, qb, tid); sk_lwrite<8>(rk, sm, tid);
            if (qb >= 8) sk_gload<8>(rk, kib, (size_t)NZ, 8, qb, tid);
#pragma unroll
            for (int ch = 0; ch < 8; ++ch) {
                if (ch * 8 <= qb) {
                    __syncthreads();
                    if ((ch + 1) * 8 <= qb) { sk_lwrite<8>(rk, sm + ((ch + 1) & 1) * ATT_CHUNK, tid);
                        if ((ch + 2) * 8 <= qb) sk_gload<8>(rk, kib, (size_t)NZ, (ch + 2) * 8, qb, tid); }
                    const LAS unsigned char* cb = sm + (ch & 1) * ATT_CHUNK;
#pragma unroll
                    for (int i = 0; i < 8; ++i) { const int kt = ch * 8 + i;
                        if (kt <= qb) {
                            f32x16 acc = zero16();
#pragma unroll
                            for (int kk = 0; kk < 4; ++kk) acc = MFMA32(afr[kk], lds_k(cb + i * TILE_B, c, hl, kk), acc);
#pragma unroll
                            for (int s = 0; s < 2; ++s) { float sc = 0.f;
#pragma unroll
                                for (int e = 0; e < 8; ++e) sc = fmaf(wv[s][e], fmaxf(acc[8 * s + e], 0.f), sc);
                                key[kt][s] = (c <= posq[s] - kt * 32) ? (ordf(sc) >> 1) : 0u; }
                        } else { key[kt][0] = 0u; key[kt][1] = 0u; }
                        __builtin_amdgcn_sched_barrier(0);
                    }
                } else {
#pragma unroll
                    for (int i = 0; i < 8; ++i) { key[ch * 8 + i][0] = 0u; key[ch * 8 + i][1] = 0u; }
                }
            }
            u32 lo[2], hi[2], thr[2]; bool done[2], exact[2];
            for (int rep_bis = 0; rep_bis < (PROBE_STAGE == 23 ? 2 : 1); ++rep_bis) {
#pragma unroll
            for (int s = 0; s < 2; ++s) { lo[s] = 0x00400000u; hi[s] = 0x7FC00000u; thr[s] = 1u; exact[s] = true; done[s] = posq[s] < 256; }
            for (int iter = 0; iter < 40; ++iter) {
                if (__all(done[0] && done[1])) break;
                u32 mid[2]; int cnt[2];
#pragma unroll
                for (int s = 0; s < 2; ++s) { mid[s] = lo[s] + ((hi[s] - lo[s]) >> 1); cnt[s] = 0; }
                {
                    int a0 = 0, a1 = 0, a2 = 0, a3 = 0, b0 = 0, b1 = 0, b2 = 0, b3 = 0;
#pragma unroll
                    for (int kt = 0; kt < 64; kt += 4) {
                        a0 += (int)(key[kt][0] - mid[0]) >> 31; a1 += (int)(key[kt + 1][0] - mid[0]) >> 31; a2 += (int)(key[kt + 2][0] - mid[0]) >> 31; a3 += (int)(key[kt + 3][0] - mid[0]) >> 31;
                        b0 += (int)(key[kt][1] - mid[1]) >> 31; b1 += (int)(key[kt + 1][1] - mid[1]) >> 31; b2 += (int)(key[kt + 2][1] - mid[1]) >> 31; b3 += (int)(key[kt + 3][1] - mid[1]) >> 31; }
                    cnt[0] = 64 + ((a0 + a1) + (a2 + a3)); cnt[1] = 64 + ((b0 + b1) + (b2 + b3)); }
#pragma unroll
                for (int s = 0; s < 2; ++s) {
                    HALF_SUM32(cnt[s], hl, cnt[s]);
                    if (!done[s]) { if (cnt[s] >= 256) lo[s] = mid[s]; else hi[s] = mid[s];
                        if (cnt[s] == 256) { thr[s] = mid[s]; exact[s] = true; done[s] = true; }
                        else if (hi[s] - lo[s] <= 1u) { thr[s] = lo[s]; exact[s] = false; done[s] = true; } } }
            }
            }
            for (int rep_em = 0; rep_em < (PROBE_STAGE == 25 ? 2 : 1); ++rep_em)
            if (__all(exact[0] && exact[1])) {
#pragma unroll
                for (int kt = 0; kt < 64; ++kt) if (kt <= qb) {
#pragma unroll
                    for (int s = 0; s < 2; ++s) { const unsigned long long bal = __ballot(key[kt][s] >= thr[s]);
                        if (lane == 0) { mk[(4 * w + s) * 65 + kt] = (u32)bal; mk[(4 * w + 2 + s) * 65 + kt] = (u32)(bal >> 32); } } }
            } else {
#pragma unroll
                for (int s = 0; s < 2; ++s) {
                    int cgt = 0; const u32 lowk = exact[s] ? thr[s] : thr[s] + 1u;
#pragma unroll
                    for (int kt = 0; kt < 64; ++kt) cgt += (key[kt][s] >= lowk) ? 1 : 0;
                    HALF_SUM32(cgt, hl, cgt);
                    const int need = exact[s] ? 0 : 256 - cgt;
                    int rem0 = __shfl(need, 0), rem1 = __shfl(need, 32);
                    const u32 eqk = exact[s] ? 0xFFFFFFFFu : thr[s];
#pragma unroll
                    for (int kt = 0; kt < 64; ++kt) if (kt <= qb) {
                        const unsigned long long bg = __ballot(key[kt][s] >= lowk), be = __ballot(key[kt][s] == eqk);
                        u32 e0 = (u32)be, e1 = (u32)(be >> 32);
                        while (__popc(e0) > rem0) e0 &= ~(1u << (31 - __clz(e0)));
                        while (__popc(e1) > rem1) e1 &= ~(1u << (31 - __clz(e1)));
                        rem0 -= __popc(e0); rem1 -= __popc(e1);
                        if (lane == 0) { mk[(4 * w + s) * 65 + kt] = (u32)bg | e0; mk[(4 * w + 2 + s) * 65 + kt] = (u32)(bg >> 32) | e1; } }
                }
            }
        }
        for (int rep_b = 0; rep_b < (PROBE_STAGE == 22 ? 2 : 1); ++rep_b)
        {
            bf16x8 qfr[4];
#pragma unroll
            for (int kk = 0; kk < 4; ++kk) qfr[kk] = ld8(Z + (size_t)(tok0 + c) * NZ + ZC_QD + w * 64 + 16 * kk + 8 * hl);
            float m = -1e30f, l = 0.f; f32x16 o0 = zero16(), o1 = zero16();
            ATT_STREAM_KV(kd + (size_t)(b * SEQ) * 64, (size_t)64, vdT + (size_t)b * 64 * SEQ, (size_t)SEQ, 0, qb, {
                const u32 word = mk[c * 65 + tg];
                if (__ballot(word != 0u) != 0ull) {
                    f32x16 s = zero16();
                    _Pragma("unroll") for (int kk = 0; kk < 4; ++kk) s = MFMA32(lds_k(kt, c, hl, kk), qfr[kk], s);
                    flash_tile_lds(m, l, o0, o1, s, vm_from_word(word, hl), false, vt, c, hl); } });
            const float f = 1.0f / fmaxf(l, 1e-30f);
#pragma unroll
            for (int R = 0; R < 16; ++R) { o0[R] *= f; o1[R] *= f; }
            store_ot(odsa + (size_t)(tok0 + c) * 512 + w * 64, o0, o1, hl);
        }
    }
    __syncthreads();
}

typedef __bf16 v2bf_t __attribute__((ext_vector_type(2)));
__device__ __forceinline__ float dot2bf(u32 a, u32 b, float c) { return __builtin_amdgcn_fdot2_f32_bf16(__builtin_bit_cast(v2bf_t, a), __builtin_bit_cast(v2bf_t, b), c, false); }
__device__ __forceinline__ float dpp_hmirror(float v) { return __int_as_float(__builtin_amdgcn_update_dpp(0, __float_as_int(v), 0x141, 0xF, 0xF, true)); }

namespace pg8 {
typedef short bf16x8 __attribute__((ext_vector_type(8)));
typedef float f32x4 __attribute__((ext_vector_type(4)));
typedef unsigned u32x4 __attribute__((ext_vector_type(4)));
constexpr int BM = 256, BK = 64, HALF = 128, HTB = HALF * BK * 2, STAGE_BYTES = 8 * HTB, NXCD = 8, WGM = 8;
__host__ __device__ __forceinline__ int lds_byte(int r, int c) { const int st = (r >> 4) * 2 + (c >> 5), rr = r & 15, cc = c & 31, ob = rr * 64 + cc * 2; return st * 1024 + (ob ^ (((ob >> 9) & 1) << 5)); }
__host__ __device__ __forceinline__ void stage_rc(int b, int& R, int& C) { const int st = b / 1024, sb = b % 1024, swz = sb ^ (((sb >> 9) & 1) << 5); R = (st >> 1) * 16 + swz / 64; C = (st & 1) * 32 + (swz % 64) / 2; }
__host__ __device__ __forceinline__ int perm32(int rho) { const int n = rho >> 4, i = rho & 15; return 8 * (i >> 2) + 4 * n + (i & 3); }
struct Unit { int pm, pn; };
struct Gemm { const bf16_t* A; const bf16_t* Bt; int M, N, K; };
struct StaticOrder {
    int nM, nN, nwg, G, c;
    __host__ __device__ void init(int M, int N, int G_, int c_) { nM = M / BM; nN = N / BM; nwg = nM * nN; G = G_; c = c_; }
    __host__ __device__ bool next(int i, Unit& u) const {
        const long L = (long)i * G + c; if (L >= nwg) return false;
        int wgid = (int)L; { const int q = nwg / NXCD, r = nwg % NXCD, xcd = wgid % NXCD, off = wgid / NXCD; wgid = (xcd < r ? xcd * (q + 1) : r * (q + 1) + (xcd - r) * q) + off; }
        const int nig = WGM * nN, gid = wgid / nig, fm = gid * WGM, gsz = (nM - fm) < WGM ? (nM - fm) : WGM;
        u.pm = fm + ((wgid % nig) % gsz); u.pn = (wgid % nig) / gsz; return true;
    }
    __device__ __forceinline__ void a_ready(const Unit&) const {}
    __device__ __forceinline__ void done(const Unit&) const {}
};
__device__ __forceinline__ unsigned cvt_pk_bf16(float lo, float hi) { unsigned r; asm volatile("v_cvt_pk_bf16_f32 %0, %1, %2" : "=v"(r) : "v"(lo), "v"(hi)); return r; }

template <class Epi, class Sched, bool ALIGN_EPI = false, bool SP2 = false>
__device__ __forceinline__ void gemm_phase(LAS unsigned char* lds, const Gemm g, const Sched& S, const Epi& E) {
    int tid = threadIdx.x; asm volatile("" : "+v"(tid));
    const int wid = __builtin_amdgcn_readfirstlane(tid >> 6), lane = tid & 63, wr = wid >> 2, wc = wid & 3, fr = lane & 15, fq = lane >> 4;
    const int K = g.K, nt = K / BK;
    unsigned voffA[2], voffB[2];
#pragma unroll
    for (int i = 0; i < 2; ++i) { int R, C; stage_rc(tid * 16 + i * 8192, R, C); const int Rb = Epi::PERM ? ((R & ~31) + perm32(R & 31)) : R;
        voffA[i] = (unsigned)(R * K + C) * 2u; voffB[i] = (unsigned)(Rb * K + C) * 2u; }
    const size_t kstep = (size_t)(BK * 2);
    const size_t hstep = (size_t)HALF * K * 2;
    const size_t tstep = 2 * hstep;
    const unsigned ldsw = (unsigned)wid * 1024u;
    const int aoff = lds_byte(wr * 64 + fr, fq * 8), boff = lds_byte(wc * 32 + fr, fq * 8);
#define PG8_SA(b, h) (((b) * 2 + (h)) * HTB)
#define PG8_SB(b, h) ((4 + (b) * 2 + (h)) * HTB)
#define PG8_STAGE(bufoff, gbase, voff) do { _Pragma("unroll") for (int _i = 0; _i < 2; ++_i) \
        __builtin_amdgcn_global_load_lds((const unsigned*)((const char*)(gbase) + (voff)[_i]), (LAS unsigned*)(lds + (bufoff) + ldsw + _i * 8192), 16, 0, 0); } while (0)
#define PG8_LDA(dst, b, h) do { _Pragma("unroll") for (int m = 0; m < 4; ++m) _Pragma("unroll") for (int k = 0; k < 2; ++k) dst[m][k] = *(const LAS bf16x8*)(lds + PG8_SA(b, h) + aoff + m * 2048 + k * 1024); } while (0)
#define PG8_LDB(dst, b, h) do { _Pragma("unroll") for (int n = 0; n < 2; ++n) _Pragma("unroll") for (int k = 0; k < 2; ++k) dst[n][k] = *(const LAS bf16x8*)(lds + PG8_SB(b, h) + boff + n * 2048 + k * 1024); } while (0)
#define PG8_MMA(ai, bj, At, Bt) do { __builtin_amdgcn_s_setprio(1); _Pragma("unroll") for (int m = 0; m < 4; ++m) _Pragma("unroll") for (int n = 0; n < 2; ++n) _Pragma("unroll") for (int k = 0; k < 2; ++k) \
        acc[ai][bj][m][n] = __builtin_amdgcn_mfma_f32_16x16x32_bf16(Bt[n][k], At[m][k], acc[ai][bj][m][n], 0, 0, 0); __builtin_amdgcn_s_setprio(0); } while (0)
#define PG8_WAIT_V(n) asm volatile("s_waitcnt vmcnt(" #n ")" ::: "memory")
#define PG8_WAIT_L(n) asm volatile("s_waitcnt lgkmcnt(" #n ")" ::: "memory")
#define PG8_BAR __builtin_amdgcn_s_barrier()
#define PG8_SCHED __builtin_amdgcn_sched_barrier(0)
    Unit cur, nxt; int ui = 0;
    if (!S.next(0, cur)) return;
    f32x4 acc[2][2][4][2];
#pragma unroll
    for (int a = 0; a < 2; ++a)
#pragma unroll
        for (int b = 0; b < 2; ++b)
#pragma unroll
            for (int m = 0; m < 4; ++m)
#pragma unroll
                for (int n = 0; n < 2; ++n) acc[a][b][m][n] = (f32x4){0.f, 0.f, 0.f, 0.f};
    bf16x8 At[4][2], B0[2][2], B1[2][2];
    const char* cA = (const char*)g.A + (size_t)cur.pm * tstep; const char* cB = (const char*)g.Bt + (size_t)cur.pn * tstep;
    S.a_ready(cur);
    if constexpr (SP2) {
        PG8_STAGE(PG8_SB(0, 0), cB, voffB); PG8_STAGE(PG8_SB(0, 1), cB + hstep, voffB); PG8_STAGE(PG8_SA(0, 0), cA, voffA); PG8_STAGE(PG8_SA(0, 1), cA + hstep, voffA);
        if (wr == 1) PG8_BAR;
        PG8_WAIT_V(2); PG8_BAR;
        PG8_STAGE(PG8_SB(1, 0), cB + kstep, voffB); PG8_STAGE(PG8_SA(1, 0), cA + kstep, voffA); PG8_STAGE(PG8_SB(1, 1), cB + hstep + kstep, voffB);
        PG8_WAIT_V(6); PG8_BAR;
    } else {
        PG8_STAGE(PG8_SB(0, 0), cB, voffB); PG8_STAGE(PG8_SA(0, 0), cA, voffA); PG8_STAGE(PG8_SB(0, 1), cB + hstep, voffB); PG8_STAGE(PG8_SA(0, 1), cA + hstep, voffA);
        if (wr == 1) PG8_BAR;
        PG8_WAIT_V(4); PG8_BAR;
        PG8_STAGE(PG8_SB(1, 0), cB + kstep, voffB); PG8_STAGE(PG8_SA(1, 0), cA + kstep, voffA); PG8_STAGE(PG8_SB(1, 1), cB + hstep + kstep, voffB);
        PG8_WAIT_V(6); PG8_BAR;
    }
    for (;;) {
        const bool has_next = S.next(ui + 1, nxt);
        const char* nA = has_next ? (const char*)g.A + (size_t)nxt.pm * tstep : cA; const char* nB = has_next ? (const char*)g.Bt + (size_t)nxt.pn * tstep : cB;
        for (int t = 0; t < nt; t += 2) {
            const bool last = (t == nt - 2);
            const char* a1 = cA + (size_t)(t + 1) * kstep;
            const char* a2 = last ? nA : cA + (size_t)(t + 2) * kstep; const char* b2 = last ? nB : cB + (size_t)(t + 2) * kstep;
            const char* a3 = a2 + kstep; const char* b3 = b2 + kstep;
            if (last && has_next) S.a_ready(nxt);
            if constexpr (SP2) {
            PG8_LDB(B0, 0, 0); PG8_LDB(B1, 0, 1); PG8_SCHED; PG8_LDA(At, 0, 0); PG8_STAGE(PG8_SA(1, 1), a1 + hstep, voffA);
            PG8_WAIT_V(8); PG8_WAIT_L(0); PG8_BAR; PG8_MMA(0, 0, At, B0); PG8_MMA(0, 1, At, B1); PG8_BAR; PG8_SCHED;
            PG8_LDA(At, 0, 1); PG8_STAGE(PG8_SB(0, 0), b2, voffB); PG8_STAGE(PG8_SB(0, 1), b2 + hstep, voffB); PG8_STAGE(PG8_SA(0, 0), a2, voffA);
            PG8_WAIT_V(8); PG8_WAIT_L(0); PG8_BAR; PG8_MMA(1, 0, At, B0); PG8_MMA(1, 1, At, B1); PG8_BAR; PG8_SCHED;
            PG8_LDB(B0, 1, 0); PG8_LDB(B1, 1, 1); PG8_SCHED; PG8_LDA(At, 1, 0); PG8_STAGE(PG8_SA(0, 1), a2 + hstep, voffA);
            PG8_WAIT_V(8); PG8_WAIT_L(0); PG8_BAR; PG8_MMA(0, 0, At, B0); PG8_MMA(0, 1, At, B1); PG8_BAR; PG8_SCHED;
            PG8_LDA(At, 1, 1); PG8_STAGE(PG8_SB(1, 0), b3, voffB); PG8_STAGE(PG8_SB(1, 1), b3 + hstep, voffB); PG8_STAGE(PG8_SA(1, 0), a3, voffA);
            PG8_WAIT_V(8); PG8_WAIT_L(0); PG8_BAR; PG8_MMA(1, 0, At, B0); PG8_MMA(1, 1, At, B1); PG8_BAR; PG8_SCHED;
            } else {
            PG8_LDB(B0, 0, 0); PG8_SCHED; PG8_LDA(At, 0, 0); PG8_STAGE(PG8_SA(1, 1), a1 + hstep, voffA);
            PG8_WAIT_L(8); PG8_BAR; PG8_WAIT_L(0); PG8_MMA(0, 0, At, B0); PG8_BAR; PG8_SCHED;
            PG8_LDB(B1, 0, 1); PG8_STAGE(PG8_SB(0, 0), b2, voffB);
            PG8_BAR; PG8_WAIT_L(0); PG8_MMA(0, 1, At, B1); PG8_BAR;
            PG8_LDA(At, 0, 1); PG8_STAGE(PG8_SA(0, 0), a2, voffA);
            PG8_BAR; PG8_WAIT_L(0); PG8_MMA(1, 0, At, B0); PG8_BAR; PG8_SCHED;
            PG8_STAGE(PG8_SB(0, 1), b2 + hstep, voffB);
            PG8_WAIT_V(6); PG8_BAR; PG8_MMA(1, 1, At, B1); PG8_BAR;
            PG8_LDB(B0, 1, 0); PG8_SCHED; PG8_LDA(At, 1, 0); PG8_STAGE(PG8_SA(0, 1), a2 + hstep, voffA);
            PG8_WAIT_L(8); PG8_BAR; PG8_WAIT_L(0); PG8_MMA(0, 0, At, B0); PG8_BAR; PG8_SCHED;
            PG8_LDB(B1, 1, 1); PG8_STAGE(PG8_SB(1, 0), b3, voffB);
            PG8_BAR; PG8_WAIT_L(0); PG8_MMA(0, 1, At, B1); PG8_BAR;
            PG8_LDA(At, 1, 1); PG8_STAGE(PG8_SA(1, 0), a3, voffA);
            PG8_BAR; PG8_WAIT_L(0); PG8_MMA(1, 0, At, B0); PG8_BAR; PG8_SCHED;
            PG8_STAGE(PG8_SB(1, 1), b3 + hstep, voffB);
            PG8_WAIT_V(6); PG8_BAR; PG8_MMA(1, 1, At, B1); PG8_BAR;
            }
        }
        if constexpr (ALIGN_EPI) { if (wr == 0) PG8_BAR; }
        if constexpr (!Epi::AFTER_DRAIN) { E(acc, cur, wr, wc, fr, fq); S.done(cur); }
        if (!has_next) break;
#pragma unroll
        for (int a = 0; a < 2; ++a)
#pragma unroll
            for (int b = 0; b < 2; ++b)
#pragma unroll
                for (int m = 0; m < 4; ++m)
#pragma unroll
                    for (int n = 0; n < 2; ++n) acc[a][b][m][n] = (f32x4){0.f, 0.f, 0.f, 0.f};
        cur = nxt; cA = nA; cB = nB; ++ui;
        if constexpr (ALIGN_EPI) { if (wr == 1) PG8_BAR; }
    }
    PG8_WAIT_V(0);
    if constexpr (!ALIGN_EPI) { if (wr == 0) PG8_BAR; }
    PG8_BAR;
#undef PG8_SA
#undef PG8_SB
#undef PG8_STAGE
#undef PG8_LDA
#undef PG8_LDB
#undef PG8_MMA
#undef PG8_WAIT_V
#undef PG8_WAIT_L
#undef PG8_BAR
#undef PG8_SCHED
}
struct EpiZ {
    static constexpr bool PERM = true, AFTER_DRAIN = false;
    bf16_t* Z; const float* cosT; const float* sinT;
    __device__ __forceinline__ void operator()(const f32x4 (&acc)[2][2][4][2], const Unit& u, int wr, int wc, int fr, int fq) const {
#pragma unroll
        for (int bj = 0; bj < 2; ++bj) {
            const int cb = u.pn * BM + bj * HALF + wc * 32;
            const int g64 = cb >> 6; const int c0 = cb + 8 * fq;
            const bool roped = (g64 < 64) && ((ROPE_MASK >> g64) & 1ull);
            const bool sig = (cb >= ZC_GM) || (c0 >= ZC_GN && c0 < ZC_WI);
            const float sc = ((g64 < 64) && ((SCALE_MASK >> g64) & 1ull)) ? 0.125f : 1.0f;
#pragma unroll
            for (int ai = 0; ai < 2; ++ai)
#pragma unroll
                for (int m = 0; m < 4; ++m) {
                    const int row = u.pm * BM + ai * HALF + wr * 64 + m * 16 + fr;
                    f32x4 v0 = acc[ai][bj][m][0], v1 = acc[ai][bj][m][1];
                    if (roped) {
                        const int pos = row & (SEQ - 1), i0 = (c0 & 63) >> 1;
                        const f32x4 cs = *(const f32x4*)(cosT + pos * 32 + i0), sn = *(const f32x4*)(sinT + pos * 32 + i0);
                        const f32x4 a = v0, b = v1;
                        v0[0] = (a[0] * cs[0] - a[1] * sn[0]) * sc; v0[1] = (a[1] * cs[0] + a[0] * sn[0]) * sc;
                        v0[2] = (a[2] * cs[1] - a[3] * sn[1]) * sc; v0[3] = (a[3] * cs[1] + a[2] * sn[1]) * sc;
                        v1[0] = (b[0] * cs[2] - b[1] * sn[2]) * sc; v1[1] = (b[1] * cs[2] + b[0] * sn[2]) * sc;
                        v1[2] = (b[2] * cs[3] - b[3] * sn[3]) * sc; v1[3] = (b[3] * cs[3] + b[2] * sn[3]) * sc;
                    } else if (sig) {
#pragma unroll
                        for (int e = 0; e < 4; ++e) { v0[e] = sigmoidf_(v0[e]); v1[e] = sigmoidf_(v1[e]); }
                    }
                    u32x4 w; w.x = cvt_pk_bf16(v0[0], v0[1]); w.y = cvt_pk_bf16(v0[2], v0[3]); w.z = cvt_pk_bf16(v1[0], v1[1]); w.w = cvt_pk_bf16(v1[2], v1[3]);
                    *(u32x4*)(Z + (size_t)row * NZ + c0) = w;
                }
        }
    }
};
struct EpiMerge {
    static constexpr bool PERM = true, AFTER_DRAIN = false;
    bf16_t* O; const bf16_t* Zg; int mode;
    __device__ __forceinline__ void operator()(const f32x4 (&acc)[2][2][4][2], const Unit& u, int wr, int wc, int fr, int fq) const {
#pragma unroll
        for (int ai = 0; ai < 2; ++ai)
#pragma unroll
            for (int m = 0; m < 4; ++m) { const int row = u.pm * BM + ai * HALF + wr * 64 + m * 16 + fr;
#pragma unroll
                for (int bj = 0; bj < 2; ++bj) { const int c0 = u.pn * BM + bj * HALF + wc * 32 + 8 * fq;
                    const u32x4 gz = *(const u32x4*)(Zg + (size_t)row * NZ + c0);
                    f32x4 v0 = acc[ai][bj][m][0], v1 = acc[ai][bj][m][1];
                    v0[0] *= bflo(gz.x); v0[1] *= bfhi(gz.x); v0[2] *= bflo(gz.y); v0[3] *= bfhi(gz.y); v1[0] *= bflo(gz.z); v1[1] *= bfhi(gz.z); v1[2] *= bflo(gz.w); v1[3] *= bfhi(gz.w);
                    bf16_t* op = O + (size_t)row * D + c0;
                    if (mode) { const u32x4 o = *(const u32x4*)op;
                        v0[0] += bflo(o.x); v0[1] += bfhi(o.x); v0[2] += bflo(o.y); v0[3] += bfhi(o.y); v1[0] += bflo(o.z); v1[1] += bfhi(o.z); v1[2] += bflo(o.w); v1[3] += bfhi(o.w); }
                    u32x4 w; w.x = cvt_pk_bf16(v0[0], v0[1]); w.y = cvt_pk_bf16(v0[2], v0[3]); w.z = cvt_pk_bf16(v1[0], v1[1]); w.w = cvt_pk_bf16(v1[2], v1[3]);
                    *(u32x4*)op = w; } }
    }
};
struct EpiOut {
    static constexpr bool PERM = true, AFTER_DRAIN = false;
    const float* x; float* o; const float* mod;
    __device__ __forceinline__ void operator()(const f32x4 (&acc)[2][2][4][2], const Unit& u, int wr, int wc, int fr, int fq) const {
#pragma unroll
        for (int ai = 0; ai < 2; ++ai)
#pragma unroll
            for (int m = 0; m < 4; ++m) { const int row = u.pm * BM + ai * HALF + wr * 64 + m * 16 + fr; const float* g1 = mod + (row >> 11) * 6144 + 2048;
#pragma unroll
                for (int bj = 0; bj < 2; ++bj) { const int c0 = u.pn * BM + bj * HALF + wc * 32 + 8 * fq;
#pragma unroll
                    for (int n = 0; n < 2; ++n) { const f32x4 gg = *(const f32x4*)(g1 + c0 + 4 * n), xx = *(const f32x4*)(x + (size_t)row * D + c0 + 4 * n);
                        *(f32x4*)(o + (size_t)row * D + c0 + 4 * n) = xx + gg * acc[ai][bj][m][n]; } } }
    }
};
struct EpiF32 {
    static constexpr bool PERM = true, AFTER_DRAIN = false;
    float* O; int ldc;
    __device__ __forceinline__ void operator()(const f32x4 (&acc)[2][2][4][2], const Unit& u, int wr, int wc, int fr, int fq) const {
#pragma unroll
        for (int ai = 0; ai < 2; ++ai)
#pragma unroll
            for (int m = 0; m < 4; ++m) { const int row = u.pm * BM + ai * HALF + wr * 64 + m * 16 + fr;
#pragma unroll
                for (int bj = 0; bj < 2; ++bj) { const int c0 = u.pn * BM + bj * HALF + wc * 32 + 8 * fq;
                    *(f32x4*)(O + (size_t)row * ldc + c0) = acc[ai][bj][m][0]; *(f32x4*)(O + (size_t)row * ldc + c0 + 4) = acc[ai][bj][m][1]; } }
    }
};
}

template <bool ZMAP>
__device__ __forceinline__ void transpose_item(const float* W, int K, int Nsrc, bf16_t* WT, LAS float* scr, int item, int nblk, int lane) {
    const int kb = item / nblk, nb = item % nblk, k0 = 64 * kb, n0 = 32 * nb;
    int sc = n0 + (lane & 31); if (ZMAP) sc = z_logical_col(sc);
#pragma unroll 8
    for (int i = 0; i < 32; ++i) { const int kk = 2 * i + (lane >> 5); scr[kk * 33 + (lane & 31)] = (sc >= 0) ? W[(size_t)(k0 + kk) * Nsrc + sc] : 0.f; }
    asm volatile("s_waitcnt lgkmcnt(0)" ::: "memory");
    const int c = lane & 7;
#pragma unroll
    for (int j = 0; j < 4; ++j) { const int n = (lane >> 3) + 8 * j; const LAS float* s = scr + (8 * c) * 33 + n;
        uint4 o; o.x = pk2(s[0 * 33], s[1 * 33]); o.y = pk2(s[2 * 33], s[3 * 33]); o.z = pk2(s[4 * 33], s[5 * 33]); o.w = pk2(s[6 * 33], s[7 * 33]);
        *(uint4*)(WT + (size_t)(n0 + n) * K + k0 + 8 * c) = o; }
    asm volatile("s_waitcnt lgkmcnt(0)" ::: "memory");
}
__device__ __forceinline__ void st_convert(const Params& p, unsigned char* lds) {
    int tid_ = threadIdx.x; asm volatile("" : "+v"(tid_)); const int tid = tid_, lane = tid & 63, w = __builtin_amdgcn_readfirstlane(tid >> 6);
    LAS float* scr = (LAS float*)((LAS unsigned char*)lds + 49152 + w * 8704);
    const int gw = blockIdx.x * 8 + w, NGW = gridDim.x * 8;
    constexpr int I_IN = 16 * 144, I_BR = 8 * 32, I_OUT = 16 * 32;
    for (int it = gw; it < I_IN + 2 * I_BR + I_OUT; it += NGW) {
        int r = it;
        if (r < I_IN) { transpose_item<true>(p.w_in, D, DIN, (bf16_t*)(p.ws + WS_WINT), scr, r, 144, lane); continue; } r -= I_IN;
        if (r < I_BR) { transpose_item<false>(p.w_nsa, 512, D, (bf16_t*)(p.ws + WS_WNSAT), scr, r, 32, lane); continue; } r -= I_BR;
        if (r < I_BR) { transpose_item<false>(p.w_dsa, 512, D, (bf16_t*)(p.ws + WS_WDSAT), scr, r, 32, lane); continue; } r -= I_BR;
        transpose_item<false>(p.w_out, D, D, (bf16_t*)(p.ws + WS_WOUTT), scr, r, 32, lane);
    }
    { bf16_t* w1t = (bf16_t*)(p.ws + WS_W1T); float* bpos = (float*)(p.ws + WS_BPOS);
      for (int it = blockIdx.x * NTHR + tid; it < 2 * 64 * 2048; it += gridDim.x * NTHR) {
          const int e = it & 63, kidx = (it >> 6) & 2047, kv = it >> 17; const int l = kidx >> 6, dp = kidx & 63; const int d = kv ? dp : ((dp >> 1) + 32 * (dp & 1));
          w1t[((size_t)kv * 64 + e) * 2048 + kidx] = f2bf((kv ? p.w1v : p.w1k)[(l * 64 + d) * 64 + e]); }
      for (int o = gw; o < 128; o += NGW) { const int kv = o >> 6, e = o & 63; const float* w1 = kv ? p.w1v : p.w1k; float s = 0.f;
          for (int i = lane; i < 2048; i += 64) s += p.cmp_pos[i] * w1[i * 64 + e];
          s = wave_sum(s); if (lane == 0) bpos[o] = s; } }
    { bf16_t* wk = (bf16_t*)(p.ws + WS_WKVT);
      for (int it = blockIdx.x * NTHR + tid; it < 128 * 128; it += gridDim.x * NTHR) { const int o = it & 127, r = it >> 7;
          wk[o * 128 + r] = f2bf(p.kvg[r] * (o < 64 ? p.w_uk[r * 64 + o] : p.w_uv[r * 64 + o - 64])); } }
    bf16_t* wf = (bf16_t*)(p.ws + WS_WFOLDT);
    for (int it = blockIdx.x * NTHR + tid; it < 512 * 256; it += gridDim.x * NTHR) {
        const int kb = it & 255, cb = it >> 8, k0 = 4 * kb, c0 = 4 * cb, hc = c0 >> 7;
        const float* sk = p.subkeys + (size_t)c0 * 64; const float* qr = p.wq + (size_t)k0 * D + hc * 64;
        float acc[4][4];
#pragma unroll
        for (int i = 0; i < 4; ++i)
#pragma unroll
            for (int j = 0; j < 4; ++j) acc[i][j] = 0.f;
#pragma unroll 4
        for (int d = 0; d < 64; d += 4) { float4 sv[4], xv[4];
#pragma unroll
            for (int i = 0; i < 4; ++i) { sv[i] = *(const float4*)(sk + i * 64 + d); xv[i] = *(const float4*)(qr + (size_t)i * D + d); }
#pragma unroll
            for (int i = 0; i < 4; ++i)
#pragma unroll
                for (int j = 0; j < 4; ++j) acc[i][j] += sv[i].x * xv[j].x + sv[i].y * xv[j].y + sv[i].z * xv[j].z + sv[i].w * xv[j].w; }
#pragma unroll
        for (int i = 0; i < 4; ++i) { uint2 o; o.x = pk2(acc[i][0], acc[i][1]); o.y = pk2(acc[i][2], acc[i][3]); *(uint2*)(wf + (size_t)(c0 + i) * D + k0) = o; }
    }
}
__device__ __forceinline__ void st_z_gemm(const Params& p, unsigned char* lds) {
    pg8::Gemm g{(const bf16_t*)(p.ws + WS_HB), (const bf16_t*)(p.ws + WS_WINT), T, NZ, D}; pg8::StaticOrder S; S.init(T, NZ, gridDim.x, blockIdx.x);
    pg8::EpiZ E{(bf16_t*)(p.ws + WS_Z), (const float*)(p.ws + WS_COS), (const float*)(p.ws + WS_SIN)};
    pg8::gemm_phase<pg8::EpiZ, pg8::StaticOrder, true, true>((LAS unsigned char*)lds, g, S, E);
}
__device__ __forceinline__ void st_merge_gemm(const Params& p, unsigned char* lds) {
    pg8::StaticOrder S; S.init(T, D, gridDim.x, blockIdx.x);
    { pg8::Gemm g{(const bf16_t*)(p.ws + WS_ONSA), (const bf16_t*)(p.ws + WS_WNSAT), T, D, 512};
      pg8::EpiMerge E{(bf16_t*)(p.ws + WS_MERGED), (const bf16_t*)(p.ws + WS_Z) + ZC_GM, 0};
      pg8::gemm_phase<pg8::EpiMerge, pg8::StaticOrder, true, true>((LAS unsigned char*)lds, g, S, E); }
    asm volatile("s_waitcnt vmcnt(0)" ::: "memory"); __syncthreads();
    { pg8::Gemm g{(const bf16_t*)(p.ws + WS_ODSA), (const bf16_t*)(p.ws + WS_WDSAT), T, D, 512};
      pg8::EpiMerge E{(bf16_t*)(p.ws + WS_MERGED), (const bf16_t*)(p.ws + WS_Z) + ZC_GM + 1024, 1};
      pg8::gemm_phase<pg8::EpiMerge, pg8::StaticOrder, true, true>((LAS unsigned char*)lds, g, S, E); }
}
__device__ __forceinline__ void st_out_gemm(const Params& p, unsigned char* lds) {
    pg8::Gemm g{(const bf16_t*)(p.ws + WS_MERGED), (const bf16_t*)(p.ws + WS_WOUTT), T, D, D}; pg8::StaticOrder S; S.init(T, D, gridDim.x, blockIdx.x);
    pg8::EpiOut E{p.x, p.out, (const float*)(p.ws + WS_MOD)};
    pg8::gemm_phase<pg8::EpiOut, pg8::StaticOrder, true, true>((LAS unsigned char*)lds, g, S, E);
}
__device__ __forceinline__ void st_ssub_gemm(const Params& p, unsigned char* lds) {
    pg8::Gemm g{(const bf16_t*)(p.ws + WS_H2), (const bf16_t*)(p.ws + WS_WFOLDT), T, 2048, D}; pg8::StaticOrder S; S.init(T, 2048, gridDim.x, blockIdx.x);
    pg8::EpiF32 E{(float*)(p.ws + WS_SSUB), 2048};
    pg8::gemm_phase<pg8::EpiF32, pg8::StaticOrder, true, true>((LAS unsigned char*)lds, g, S, E);
}

typedef float f32x4_t __attribute__((ext_vector_type(4)));
__device__ __forceinline__ void st_prep(const Params& p, unsigned char* lds) {
    int tid = threadIdx.x; asm volatile("" : "+v"(tid));
    const int lane = tid & 63, w = __builtin_amdgcn_readfirstlane(tid >> 6);
    const bf16_t* Z = (const bf16_t*)(p.ws + WS_Z);
    const float* cosT = (const float*)(p.ws + WS_COS); const float* sinT = (const float*)(p.ws + WS_SIN);
    unsigned char* dob = (unsigned char*)p.out;
    bf16_t* kd = (bf16_t*)(dob + DO_KD); bf16_t* vdT = (bf16_t*)(dob + DO_VDT); bf16_t* vsT = (bf16_t*)(dob + DO_VST); bf16_t* vwT = (bf16_t*)(dob + DO_VWT);
    bf16_t* kcmp = (bf16_t*)(dob + DO_KCMP); bf16_t* vcmpT = (bf16_t*)(dob + DO_VCMPT);
    {   float* red = (float*)lds;
        float* hid = red + 8 * 16 * 64;
        const bf16_t* w1t = (const bf16_t*)(p.ws + WS_W1T); const float* bpos = (const float*)(p.ws + WS_BPOS);
        for (int u = blockIdx.x; u < 256; u += gridDim.x) {
            const int kv = u >> 7, b = (u >> 4) & 7, g = (u >> 3) & 1, n0 = (u & 7) * 16;
            const int nl = lane & 15, kq = lane >> 4; int n = n0 + nl; if (n > 126) n = 126;
            pg8::f32x4 acc[4];
#pragma unroll
            for (int ec = 0; ec < 4; ++ec) acc[ec] = (pg8::f32x4){0.f, 0.f, 0.f, 0.f};
            const bf16_t* ab = Z + (size_t)(b * SEQ + 16 * n) * NZ + (kv ? ZC_VC : ZC_KC) + g * 64 + 8 * kq;
            const bf16_t* bb = w1t + ((size_t)kv * 64 + nl) * 2048 + 8 * kq;
#pragma unroll
            for (int i = 0; i < 8; ++i) { const int kk = 8 * w + i;
                const pg8::bf16x8 a = *(const pg8::bf16x8*)(ab + (size_t)(kk >> 1) * NZ + (kk & 1) * 32);
#pragma unroll
                for (int ec = 0; ec < 4; ++ec) { const pg8::bf16x8 bv = *(const pg8::bf16x8*)(bb + (size_t)ec * 16 * 2048 + 32 * kk);
                    acc[ec] = __builtin_amdgcn_mfma_f32_16x16x32_bf16(a, bv, acc[ec], 0, 0, 0); } }
            __syncthreads();
#pragma unroll
            for (int ec = 0; ec < 4; ++ec)
#pragma unroll
                for (int r = 0; r < 4; ++r) red[(w * 16 + 4 * kq + r) * 64 + 16 * ec + nl] = acc[ec][r];
            __syncthreads();
#pragma unroll
            for (int q = 0; q < 2; ++q) { const int o = tid + 512 * q; float s = bpos[kv * 64 + (o & 63)];
#pragma unroll
                for (int ww = 0; ww < 8; ++ww) s += red[ww * 1024 + o];
                hid[o] = gelu_tanh(s); }
            __syncthreads();
            { const int nn = tid >> 5, f0 = (tid & 31) * 2; const float* w2 = kv ? p.w2v : p.w2k; float a0 = 0.f, a1 = 0.f;
              for (int e = 0; e < 64; ++e) { const float h = hid[nn * 64 + e]; const float2 ww = *(const float2*)(w2 + e * 64 + f0); a0 += h * ww.x; a1 += h * ww.y; }
              const int nglob = n0 + nn; if (nglob > 126) { a0 = 0.f; a1 = 0.f; }
              if (kv == 0) { bf16_t* o = kcmp + (((size_t)b * 2 + g) * 128 + nglob) * 64; o[2 * (f0 & 31) + (f0 >> 5)] = f2bf(a0); o[2 * ((f0 + 1) & 31) + ((f0 + 1) >> 5)] = f2bf(a1); }
              else { bf16_t* o = vcmpT + (((size_t)b * 2 + g) * 64 + f0) * 128 + nglob; o[0] = f2bf(a0); o[128] = f2bf(a1); } }
        }
        __syncthreads();
    }
    {   bf16_t* tl = (bf16_t*)lds;
        for (int it = blockIdx.x; it < 512; it += gridDim.x) {
            const int which = it & 1, tt = (it >> 1) & 31, b = it >> 6; const int t0 = b * SEQ + tt * 64;
            __syncthreads();
#pragma unroll
            for (int q = 0; q < 2; ++q) { const int idx = tid + 512 * q, tok = idx >> 4, ch = idx & 15;
                const uint4 v = *(const uint4*)(Z + (size_t)(t0 + tok) * NZ + (which ? ZC_VW : ZC_VS) + ch * 8); bf16_t* d = tl + tok * 130 + ch * 8;
                d[0] = (bf16_t)v.x; d[1] = (bf16_t)(v.x >> 16); d[2] = (bf16_t)v.y; d[3] = (bf16_t)(v.y >> 16); d[4] = (bf16_t)v.z; d[5] = (bf16_t)(v.z >> 16); d[6] = (bf16_t)v.w; d[7] = (bf16_t)(v.w >> 16); }
            __syncthreads();
#pragma unroll
            for (int q = 0; q < 2; ++q) { const int idx = tid + 512 * q, gd = idx >> 3, c8 = idx & 7; const bf16_t* s = tl + (c8 * 8) * 130 + gd;
                uint4 o; o.x = (u32)s[0] | ((u32)s[130] << 16); o.y = (u32)s[260] | ((u32)s[390] << 16); o.z = (u32)s[520] | ((u32)s[650] << 16); o.w = (u32)s[780] | ((u32)s[910] << 16);
                *(uint4*)((which ? vwT : vsT) + ((size_t)b * 128 + gd) * SEQ + tt * 64 + c8 * 8) = o; }
        }
    }
    {   const bf16_t* wk = (const bf16_t*)(p.ws + WS_WKVT);
        const int nl = lane & 15, kq = lane >> 4;
        for (int task = blockIdx.x * 8 + w; task < T / 16; task += gridDim.x * 8) {
            const int t0 = task * 16, b = t0 >> 11, pos0 = t0 & (SEQ - 1);
            pg8::bf16x8 a[4]; float ss = 0.f;
#pragma unroll
            for (int ks = 0; ks < 4; ++ks) { a[ks] = *(const pg8::bf16x8*)(Z + (size_t)(t0 + nl) * NZ + ZC_CKV + 32 * ks + 8 * kq);
#pragma unroll
                for (int j = 0; j < 8; ++j) { const float f = bf2f((bf16_t)a[ks][j]); ss += f * f; } }
            ss += __shfl_xor(ss, 16); ss += __shfl_xor(ss, 32);
            const float rn = rsqrtf(ss * (1.0f / 128.0f) + EPS);
            float rnr[4];
#pragma unroll
            for (int r = 0; r < 4; ++r) rnr[r] = __shfl(rn, 4 * kq + r);
            pg8::f32x4 acc[8];
#pragma unroll
            for (int ct = 0; ct < 8; ++ct) { acc[ct] = (pg8::f32x4){0.f, 0.f, 0.f, 0.f};
#pragma unroll
                for (int ks = 0; ks < 4; ++ks) acc[ct] = __builtin_amdgcn_mfma_f32_16x16x32_bf16(a[ks], *(const pg8::bf16x8*)(wk + (size_t)(16 * ct + nl) * 128 + 32 * ks + 8 * kq), acc[ct], 0, 0, 0); }
#pragma unroll
            for (int ct = 0; ct < 2; ++ct) { const int i = 16 * ct + nl;
#pragma unroll
                for (int r = 0; r < 4; ++r) { const int tr = 4 * kq + r, pos = pos0 + tr; const float c = cosT[pos * 32 + i], s = sinT[pos * 32 + i];
                    const float k1 = acc[ct][r] * rnr[r], k2 = acc[ct + 2][r] * rnr[r];
                    *(u32*)(kd + (size_t)(t0 + tr) * 64 + 2 * i) = pk2(k1 * c - k2 * s, k2 * c + k1 * s); } }
#pragma unroll
            for (int ct = 4; ct < 8; ++ct) { const int d = 16 * (ct - 4) + nl;
                uint2 o; o.x = pk2(acc[ct][0] * rnr[0], acc[ct][1] * rnr[1]); o.y = pk2(acc[ct][2] * rnr[2], acc[ct][3] * rnr[3]);
                *(uint2*)(vdT + ((size_t)b * 64 + d) * SEQ + pos0 + 4 * kq) = o; }
        }
    }
}

#define XB_TMO      128
#define XB_XCNT(j)  (256  + 64 * (j))
#define XB_XSUB(j)  (1280 + 64 * (j))
#define XB_XGEN(j)  (2304 + 64 * (j))
#define XB_TOP      3328
#define XB_TOPGEN   3392
#define XCD_BAR_WORDS 3456
#define XB_SPIN_CAP (1u << 22)
__device__ __forceinline__ unsigned xb_ld(unsigned* p)              { return __hip_atomic_load(p, __ATOMIC_RELAXED, __HIP_MEMORY_SCOPE_AGENT); }
__device__ __forceinline__ unsigned xb_add(unsigned* p, unsigned v) { return __hip_atomic_fetch_add(p, v, __ATOMIC_RELAXED, __HIP_MEMORY_SCOPE_AGENT); }
__device__ __forceinline__ unsigned xb_xcc_id() { return (unsigned)__builtin_amdgcn_s_getreg((3 << 11) | 20) & 0xFu; }
#define XB_SPIN(cond, bar) do { unsigned _sp = 0; while (cond) { __builtin_amdgcn_s_sleep(1); \
    if ((++_sp & 255u) == 0u) { if (xb_ld(&(bar)[XB_TMO])) break; if (_sp > XB_SPIN_CAP) { atomicAdd(&(bar)[XB_TMO], 1u); break; } } } } while (0)
struct XcdBarrier { unsigned* bar; unsigned x; volatile LAS unsigned* st; };
__device__ __forceinline__ XcdBarrier xcd_barrier_post(unsigned* bar, volatile LAS unsigned* st) {
    XcdBarrier b; b.bar = bar; b.x = xb_xcc_id(); b.st = st;
    if (threadIdx.x == 0) (void)xb_add(&bar[XB_XCNT(b.x)], 1u);
    return b;
}
__device__ __forceinline__ void xcd_barrier_complete(unsigned* bar, unsigned x, unsigned& nloc, unsigned& nx) {
    const unsigned G = gridDim.x * gridDim.y * gridDim.z;
    unsigned sum, cnt, mine, sp = 0u;
    for (;;) {
        sum = 0u; cnt = 0u; mine = 0u;
#pragma unroll
        for (unsigned j = 0; j < 16; ++j) { const unsigned c = xb_ld(&bar[XB_XCNT(j)]); sum += c; cnt += (c > 0u) ? 1u : 0u; mine = (j == x) ? c : mine; }
        if (sum == G) break;
        __builtin_amdgcn_s_sleep(1);
        if ((++sp & 255u) == 0u) { if (xb_ld(&bar[XB_TMO])) break; if (sp > XB_SPIN_CAP) { atomicAdd(&bar[XB_TMO], 1u); break; } }
    }
    nloc = mine > 0u ? mine : 1u; nx = cnt > 0u ? cnt : 1u;
}
__device__ __forceinline__ void xcd_barrier(const XcdBarrier& b) {
    asm volatile("s_waitcnt vmcnt(0)" ::: "memory");
    __syncthreads();
    if (threadIdx.x == 0) {
        unsigned* bar = b.bar;
        __builtin_amdgcn_s_waitcnt(0);
        unsigned nloc = b.st[0], nx = b.st[1];
        if (nloc == 0u) { xcd_barrier_complete(bar, b.x, nloc, nx); b.st[0] = nloc; b.st[1] = nx; }
        const unsigned old = xb_add(&bar[XB_XSUB(b.x)], 1u);
        const unsigned gen = old / nloc;
        if (old + 1u == (gen + 1u) * nloc) {
            __builtin_amdgcn_fence(__ATOMIC_RELEASE, "agent");
            asm volatile("s_waitcnt vmcnt(0)" ::: "memory");
            const unsigned og = xb_add(&bar[XB_TOP], 1u);
            const unsigned tg = og / nx;
            if (og + 1u == (tg + 1u) * nx) xb_add(&bar[XB_TOPGEN], 1u);
            else XB_SPIN(xb_ld(&bar[XB_TOPGEN]) == tg, bar);
            __builtin_amdgcn_fence(__ATOMIC_ACQUIRE, "agent");
            xb_add(&bar[XB_XGEN(b.x)], 1u);
            asm volatile("s_waitcnt vmcnt(0)" ::: "memory");
        } else {
            XB_SPIN(xb_ld(&bar[XB_XGEN(b.x)]) == gen, bar);
            __builtin_amdgcn_fence(__ATOMIC_ACQUIRE, "agent");
            asm volatile("s_waitcnt vmcnt(0)" ::: "memory");
        }
    }
    __syncthreads();
}

#define XB_XRANK(j) (3520 + 16 * (j))
struct XccInfo { int pi, nxp, rank, nloc; };
__device__ __forceinline__ XccInfo xcc_info(const Params& p, int rank, unsigned x) {
    unsigned* bar = (unsigned*)(p.ws + WS_BAR); XccInfo r; r.rank = rank; r.pi = 0; r.nxp = 0; r.nloc = 1;
#pragma unroll
    for (unsigned j = 0; j < 16; ++j) { const unsigned cj = xb_ld(&bar[XB_XRANK(j)]); if (j == x) { r.pi = r.nxp; r.nloc = (int)cj; } r.nxp += (cj > 0u) ? 1 : 0; }
    if (r.nxp < 1) r.nxp = 1; if (r.nloc < 1) r.nloc = 1;
    return r;
}
__device__ __forceinline__ void st_final_norm(const Params& p) {
    int tid_ = threadIdx.x; asm volatile("" : "+v"(tid_)); const int tid = tid_;
    const int lane = tid & 63, w = tid >> 6;
    for (int t = blockIdx.x * 8 + w; t < T; t += gridDim.x * 8) {
        float4* xr = (float4*)(p.out + (size_t)t * D);
        float4 v[4]; float ss = 0.f;
#pragma unroll
        for (int j = 0; j < 4; ++j) { v[j] = xr[lane + 64 * j]; ss += v[j].x * v[j].x + v[j].y * v[j].y + v[j].z * v[j].z + v[j].w * v[j].w; }
        const float r = rsqrtf(wave_sum(ss) * (1.0f / D) + EPS);
#pragma unroll
        for (int j = 0; j < 4; ++j) { const float4 g = ((const float4*)p.final_g)[lane + 64 * j]; float4 o; o.x = v[j].x * r * g.x; o.y = v[j].y * r * g.y; o.z = v[j].z * r * g.z; o.w = v[j].w * r * g.w; xr[lane + 64 * j] = o; }
    }
}

constexpr int EXP_LROW = 1040;
constexpr int EXP_LWAVE = 8 * EXP_LROW;

typedef float v2f_t __attribute__((ext_vector_type(2)));
__device__ __forceinline__ void st_expert_u3(const Params& p, unsigned char* lds, const XccInfo xi) {
    int tid_ = threadIdx.x; asm volatile("" : "+v"(tid_)); const int tid = tid_;
    const int lane = tid & 63, w = __builtin_amdgcn_readfirstlane(tid >> 6), rs = lane >> 3, ch = lane & 7;
    const unsigned char* x8 = p.ws + WS_X8; const unsigned char* u8 = p.ws + WS_U16; const float* su = (const float*)(p.ws + WS_SU); const float* sxs = (const float*)(p.ws + WS_SX);
    const int* eidx = (const int*)(p.ws + WS_EIDX); const float* gate = (const float*)(p.ws + WS_GATE); float* wgt = (float*)(p.ws + WS_WGT);
    LAS unsigned char* lw = (LAS unsigned char*)lds + w * EXP_LWAVE;
    const int wid = xi.rank * 8 + w, nw = xi.nloc * 8;
    for (int s = xi.pi; s < 8; s += xi.nxp) {
        for (int tb = wid; tb < T / 8; tb += nw) {
            const int t0 = tb * 8;
            int ea[8], eb[8];
#pragma unroll
            for (int j = 0; j < 8; ++j) { ea[j] = eidx[(size_t)(t0 + j) * 128 + lane]; eb[j] = eidx[(size_t)(t0 + j) * 128 + 64 + lane]; }
            u32x4 xq[8];
#pragma unroll
            for (int i = 0; i < 8; ++i) xq[i] = *(const u32x4*)(x8 + (size_t)(t0 + rs) * D + (ch + 8 * i) * 16);
            const float sx = sxs[t0 + rs];
            int nmine = 0, nmax = 0;
#pragma unroll
            for (int j = 0; j < 8; ++j) {
                const bool b0 = (ea[j] >> 11) == s, b1 = (eb[j] >> 11) == s;
                const unsigned long long m0 = __ballot(b0), m1 = __ballot(b1);
                const int n0 = __popcll(m0), n = n0 + __popcll(m1);
                const int p0 = __builtin_amdgcn_mbcnt_hi((unsigned)(m0 >> 32), __builtin_amdgcn_mbcnt_lo((unsigned)m0, 0));
                const int p1 = n0 + __builtin_amdgcn_mbcnt_hi((unsigned)(m1 >> 32), __builtin_amdgcn_mbcnt_lo((unsigned)m1, 0));
                if (b0) { const u32x2 v = {(u32)ea[j], (u32)lane}; *(LAS u32x2*)(lw + j * EXP_LROW + p0 * 8) = v; }
                if (b1) { const u32x2 v = {(u32)eb[j], (u32)(64 + lane)}; *(LAS u32x2*)(lw + j * EXP_LROW + p1 * 8) = v; }
                nmine = (rs == j) ? n : nmine; nmax = n > nmax ? n : nmax;
            }
            asm volatile("s_waitcnt lgkmcnt(0)" ::: "memory");
            for (int j = 0; j < nmax; j += 4) {
                bool vr[4]; u32x2 ek[4]; u32x4 rr[4][8]; float sr[4];
#pragma unroll
                for (int q = 0; q < 4; ++q) { vr[q] = (j + q) < nmine; ek[q] = *(const LAS u32x2*)(lw + rs * EXP_LROW + ((j + q) & 127) * 8);
                    const u32 e = vr[q] ? ek[q].x : 0u; const unsigned char* ur = u8 + (size_t)e * 1024 + ch * 16; sr[q] = su[e];
#pragma unroll
                    for (int i = 0; i < 8; ++i) rr[q][i] = *(const u32x4*)(ur + 128 * i); }
                float act4[4];
#pragma unroll
                for (int q = 0; q < 4; ++q) {
                    int s0 = 0, s1 = 0;
#pragma unroll
                    for (int i = 0; i < 8; ++i) { s0 = __builtin_amdgcn_sdot4((int)rr[q][i].x, (int)xq[i].x, s0, false); s1 = __builtin_amdgcn_sdot4((int)rr[q][i].y, (int)xq[i].y, s1, false);
                        s0 = __builtin_amdgcn_sdot4((int)rr[q][i].z, (int)xq[i].z, s0, false); s1 = __builtin_amdgcn_sdot4((int)rr[q][i].w, (int)xq[i].w, s1, false); }
                    int si = s0 + s1; si += __builtin_amdgcn_update_dpp(0, si, 0x141, 0xF, 0xF, true); si += __builtin_amdgcn_update_dpp(0, si, 0xB1, 0xF, 0xF, true); si += __builtin_amdgcn_update_dpp(0, si, 0x4E, 0xF, 0xF, true);
                    act4[q] = (float)si * (sr[q] * sx);
                }
                {
                    const float a_ = ch == 0 ? act4[0] : ch == 1 ? act4[1] : ch == 2 ? act4[2] : act4[3];
                    const bool v_ = ch == 0 ? vr[0] : ch == 1 ? vr[1] : ch == 2 ? vr[2] : vr[3];
                    const u32 k_ = ch == 0 ? ek[0].y : ch == 1 ? ek[1].y : ch == 2 ? ek[2].y : ek[3].y;
                    if (v_ && ch < 4) { const size_t gi = (size_t)(t0 + rs) * 128 + (int)k_; wgt[gi] = gate[gi] * gelu_erf_fast(a_); }
                }
            }
            asm volatile("s_waitcnt lgkmcnt(0)" ::: "memory");
        }
    }
}
__device__ __forceinline__ void st_expert_v3(const Params& p, unsigned char* lds, const XccInfo xi) {
    int tid_ = threadIdx.x; asm volatile("" : "+v"(tid_)); const int tid = tid_;
    const int lane = tid & 63, w = __builtin_amdgcn_readfirstlane(tid >> 6), rs = lane >> 3, ch = lane & 7;
    const unsigned char* v8 = p.ws + WS_V16;
    const int* eidx = (const int*)(p.ws + WS_EIDX); const float* wgt = (const float*)(p.ws + WS_WGT); const float* mod = (const float*)(p.ws + WS_MOD);
    LAS unsigned char* lw = (LAS unsigned char*)lds + w * EXP_LWAVE;
    const int wid = xi.rank * 8 + w, nw = xi.nloc * 8;
    for (int cs = xi.pi; cs < 8; cs += xi.nxp) {
        const unsigned char* vb = v8 + (size_t)cs * 16384 * 128 + ch * 16;
        for (int tb = wid; tb < T / 8; tb += nw) {
            const int t0 = tb * 8;
#pragma unroll
            for (int q = 0; q < 4; ++q) { const int el = (lane + 64 * q) * 4; const int tk = el >> 7, k = el & 127;
                const uint4 ev = *(const uint4*)(eidx + (size_t)t0 * 128 + el); const float4 wv = *(const float4*)(wgt + (size_t)t0 * 128 + el);
                const u32x4 a = {ev.x, __float_as_uint(wv.x), ev.y, __float_as_uint(wv.y)}, b = {ev.z, __float_as_uint(wv.z), ev.w, __float_as_uint(wv.w)};
                *(LAS u32x4*)(lw + tk * EXP_LROW + k * 8) = a; *(LAS u32x4*)(lw + tk * EXP_LROW + k * 8 + 16) = b; }
            asm volatile("s_waitcnt lgkmcnt(0)" ::: "memory");
            float acc[16];
#pragma unroll
            for (int i = 0; i < 16; ++i) acc[i] = 0.f;
            for (int k0 = 0; k0 < 128; k0 += 16) {
                u32x4 vv[16]; float wk[16];
#pragma unroll
                for (int i = 0; i < 16; ++i) { const u32x2 ew = *(const LAS u32x2*)(lw + rs * EXP_LROW + (k0 + i) * 8); wk[i] = __uint_as_float(ew.y);
                    vv[i] = *(const u32x4*)(vb + (size_t)ew.x * 128); }
#pragma unroll
                for (int i = 0; i < 16; ++i) {
#define EXV3_W(word, o) do { const v2f_t lo_ = __builtin_amdgcn_cvt_pk_f32_fp8((int)(word), false), hi_ = __builtin_amdgcn_cvt_pk_f32_fp8((int)(word), true); \
                        acc[o] += wk[i] * lo_.x; acc[o + 1] += wk[i] * lo_.y; acc[o + 2] += wk[i] * hi_.x; acc[o + 3] += wk[i] * hi_.y; } while (0)
                    EXV3_W(vv[i].x, 0); EXV3_W(vv[i].y, 4); EXV3_W(vv[i].z, 8); EXV3_W(vv[i].w, 12);
#undef EXV3_W
                }
            }
            { const int t = t0 + rs, d0 = cs * 128 + ch * 16; float* xr = p.out + (size_t)t * D + d0; const float* g2 = mod + (t >> 11) * 6144 + 5120 + d0;
#pragma unroll
              for (int q = 0; q < 4; ++q) { const float4 x0 = *(const float4*)(xr + 4 * q), ga = *(const float4*)(g2 + 4 * q);
                  float4 o0; o0.x = x0.x + ga.x * acc[4 * q]; o0.y = x0.y + ga.y * acc[4 * q + 1]; o0.z = x0.z + ga.z * acc[4 * q + 2]; o0.w = x0.w + ga.w * acc[4 * q + 3];
                  *(float4*)(xr + 4 * q) = o0; } }
            asm volatile("s_waitcnt lgkmcnt(0)" ::: "memory");
        }
    }
}

constexpr int LDS_BYTES = 131072 + 1024;
constexpr int LDS_CTL = 131072;
__global__ void __launch_bounds__(NTHR, 2) k_mega(Params p) {
    extern __shared__ __attribute__((aligned(16))) unsigned char smem[];
    if (threadIdx.x < 4) ((volatile LAS unsigned*)(smem + LDS_CTL))[threadIdx.x] = 0u;
    __syncthreads();
    XcdBarrier bar = xcd_barrier_post((unsigned*)(p.ws + WS_BAR), (volatile LAS unsigned*)(smem + LDS_CTL));
    if (threadIdx.x == 0) ((volatile LAS unsigned*)(smem + LDS_CTL))[2] = xb_add(&((unsigned*)(p.ws + WS_BAR))[XB_XRANK(bar.x)], 1u);
#define GBAR() xcd_barrier(bar)
#define REP(n, body) do { body; if (PROBE_STAGE == (n)) { __syncthreads(); body; } } while (0)
    REP(1, st_adaln(p, smem); st_convert(p, smem));      GBAR();
    REP(2, st_norm_rows(p, 0));       GBAR();
    REP(3, st_z_gemm(p, smem));       GBAR();
    REP(4, st_prep(p, smem));         GBAR();
    REP(5, st_nsa2(p, smem));         __syncthreads();
    REP(6, st_dsa2(p, smem));         GBAR();
    REP(7, st_merge_gemm(p, smem));   GBAR();
    REP(8, st_out_gemm(p, smem));     GBAR();
    st_norm_rows(p, 1);       GBAR();
    REP(9, st_ssub_gemm(p, smem));    GBAR();
    REP(10, st_route(p));
    REP(11, st_cvt_uv(p));             GBAR();
    {   __syncthreads();
        const int myrank = (int)((volatile LAS unsigned*)(smem + LDS_CTL))[2];
        const XccInfo xi = xcc_info(p, myrank, xb_xcc_id());
        REP(12, st_expert_u3(p, smem, xi)); GBAR();
        st_expert_v3(p, smem, xi); GBAR();
        st_final_norm(p);
    }
}

extern "C" void kernel_launch(void* const* d_in, const int* in_sizes, int n_in, void* d_out, int out_size, void* d_ws, size_t ws_size, hipStream_t stream) {
    static int grid = 0;
    if (grid == 0) {
        int dev = 0, cus = 0, per_cu = 0;
        hipGetDevice(&dev); hipDeviceGetAttribute(&cus, hipDeviceAttributeMultiprocessorCount, dev);
        hipFuncSetAttribute((const void*)k_mega, hipFuncAttributeMaxDynamicSharedMemorySize, LDS_BYTES);
        hipOccupancyMaxActiveBlocksPerMultiprocessor(&per_cu, (const void*)k_mega, NTHR, LDS_BYTES);
        if (per_cu < 1) { fprintf(stderr, "kernel_launch: occupancy query says %d blocks/CU\n", per_cu); per_cu = 1; }
        (void)hipGetLastError();
        grid = cus;
    }
    Params p{};
    const float** f = (const float**)&p;
    for (int i = 0; i < 23; ++i) f[i] = (const float*)d_in[i];
    p.out = (float*)d_out; p.ws = (unsigned char*)d_ws;
    hipMemsetAsync((unsigned char*)d_ws + WS_BAR, 0, 16384, stream);
    hipLaunchKernelGGL(k_mega, dim3(grid), dim3(NTHR), LDS_BYTES, stream, p);
}
```

```cpp
#include <hip/hip_runtime.h>
#include <stdint.h>
#include <stdio.h>

#ifndef PROBE_STAGE
#define PROBE_STAGE 0
#endif
#define LAS __attribute__((address_space(3)))
typedef unsigned short bf16_t;
typedef unsigned int u32;

constexpr int T = 16384, SEQ = 2048, NB = 8, D = 1024, NZ = 4608, DIN = 4576;
constexpr int NTHR = 512;
constexpr float EPS = 1e-6f;
constexpr int ZC_QN = 0, ZC_KC = 512, ZC_VC = 640, ZC_KS = 768, ZC_VS = 896, ZC_KW = 1024, ZC_VW = 1152, ZC_QD = 1280, ZC_CKV = 1792,
              ZC_QI = 1920, ZC_KI = 2432, ZC_GN = 2496, ZC_WI = 2520, ZC_GM = 2560;
constexpr unsigned long long ROPE_MASK = 0xFFull | (3ull << 8) | (3ull << 12) | (3ull << 16) | (0xFFull << 20) | (0xFFull << 30) | (1ull << 38);
constexpr unsigned long long SCALE_MASK = 0xFFull | (0xFFull << 20) | (0xFFull << 30);

constexpr size_t WS_Z = 0;
constexpr size_t WS_SSUB = 0;
constexpr size_t WS_EIDX = 134217728;
constexpr size_t WS_GATE = 142606336;
constexpr size_t WS_WGT = 0;
constexpr size_t WS_MERGED = 150994944;
constexpr size_t WS_U16 = WS_MERGED;
constexpr size_t WS_HB = 184549376;
constexpr size_t WS_ONSA = WS_HB;
constexpr size_t WS_ODSA = WS_HB + 16777216;
constexpr size_t WS_V16 = WS_HB;
constexpr size_t WS_H2 = 218103808;
constexpr size_t WS_W = 251658240;
constexpr size_t WS_WINT = WS_H2;
constexpr size_t WS_WNSAT = WS_W;
constexpr size_t WS_WDSAT = WS_WNSAT + 1048576;
constexpr size_t WS_WOUTT = WS_WDSAT + 1048576;
constexpr size_t WS_WFOLDT = WS_WOUTT + 2097152;
constexpr size_t WS_SMALL = WS_WFOLDT + 4194304;
constexpr size_t WS_MOD = WS_SMALL;
constexpr size_t WS_COS = WS_MOD + 196608;
constexpr size_t WS_SIN = WS_COS + 262144;
constexpr size_t WS_BAR = WS_SIN + 262144;
constexpr size_t WS_W1T = WS_BAR + 16384;
constexpr size_t WS_BPOS = WS_W1T + 524288;
constexpr size_t WS_WKVT = WS_BPOS + 512;
constexpr size_t WS_SU = WS_WKVT + 32768;
constexpr size_t WS_SX = WS_SU + 65536;
constexpr size_t WS_END_SMALL = WS_SX + 65536;
constexpr size_t WS_X8 = WS_MERGED + 16777216;
static_assert(WS_END_SMALL <= 268435456, "ws overflow");
constexpr size_t DO_KD = 0;
constexpr size_t DO_VDT = 2097152;
constexpr size_t DO_VST = 4194304;
constexpr size_t DO_VWT = 8388608;
constexpr size_t DO_KCMP = 12582912;
constexpr size_t DO_VCMPT = 12845056;
constexpr size_t DO_HID = 13107200;
constexpr size_t DO_MASK = 14680064;
constexpr size_t DO_END = DO_MASK + 4194304;

struct Params {
    const float *x, *c, *ada_w, *ada_b, *norm1_g, *w_in, *cmp_pos, *w1k, *w2k, *w1v, *w2v, *kvg, *w_uk, *w_uv, *w_nsa, *w_dsa, *w_out, *norm2_g, *wq,
        *subkeys, *pu, *pv, *final_g;
    float* out;
    unsigned char* ws;
};

__device__ __forceinline__ bf16_t f2bf(float f) { u32 u = __float_as_uint(f); u += 0x7fffu + ((u >> 16) & 1u); return (bf16_t)(u >> 16); }
__device__ __forceinline__ float bf2f(bf16_t h) { return __uint_as_float((u32)h << 16); }
__device__ __forceinline__ float bflo(u32 w) { return __uint_as_float(w << 16); }
__device__ __forceinline__ float bfhi(u32 w) { return __uint_as_float(w & 0xffff0000u); }
__device__ __forceinline__ u32 pk2(float lo, float hi) { return (u32)f2bf(lo) | ((u32)f2bf(hi) << 16); }
__device__ __forceinline__ float wave_sum(float v) {
#pragma unroll
    for (int o = 1; o < 64; o <<= 1) v += __shfl_xor(v, o);
    return v;
}
__device__ __forceinline__ float wave_max(float v) {
#pragma unroll
    for (int o = 1; o < 64; o <<= 1) v = fmaxf(v, __shfl_xor(v, o));
    return v;
}
__device__ __forceinline__ float sigmoidf_(float v) { return 1.0f / (1.0f + __expf(-v)); }
__device__ __forceinline__ float gelu_tanh(float v) { const float u = 0.7978845608028654f * (v + 0.044715f * v * v * v); return 0.5f * v * (1.0f + tanhf(u)); }
__device__ __forceinline__ float gelu_erf(float v) { return 0.5f * v * (1.0f + erff(v * 0.7071067811865476f)); }

__device__ __forceinline__ float gelu_erf_fast(float v) {
    const float av = fabsf(v), d = av * 0.2316418882f + 1.0f; const float t = __builtin_amdgcn_rcpf(d);
    float q = t * 0.5307027145f + (-0.7265760135f); q = q * t + 0.7107068705f; q = q * t + (-0.142248368f); q = q * t + 0.127414796f; q = q * t;
    const float e = __builtin_amdgcn_exp2f((v * v) * (-0.72134752044f));
    const float m = v * (q * e);
    return v < 0.f ? m : v - m;
}
__device__ __forceinline__ int z_logical_col(int pc) {
    const int g64 = pc >> 6; const int o = pc & 63;
    const int po = (g64 < 64 && ((ROPE_MASK >> g64) & 1ull)) ? ((o >> 1) + 32 * (o & 1)) : o;
    const int pp = (pc & ~63) + po;
    if (pc < 1280) return pp;
    if (pc < 1792) return 1304 + (pp - 1280);
    if (pc < 1920) return 1816 + (pp - 1792);
    if (pc < 2432) return 1944 + (pp - 1920);
    if (pc < 2496) return 2456 + (pp - 2432);
    if (pc < 2520) return 1280 + (pc - 2496);
    if (pc < 2528) return 2520 + (pc - 2520);
    if (pc < 2560) return -1;
    return 2528 + (pc - 2560);
}
__device__ __forceinline__ void z_post(int t, int pc, float& v0, float& v1, const float* cosT, const float* sinT) {
    const int g64 = pc >> 6;
    if (g64 < 64 && ((ROPE_MASK >> g64) & 1ull)) {
        const int i = (pc & 63) >> 1, pos = t & (SEQ - 1);
        const float c = cosT[pos * 32 + i], s = sinT[pos * 32 + i];
        const float a = v0 * c - v1 * s, b = v1 * c + v0 * s;
        const float sc = ((SCALE_MASK >> g64) & 1ull) ? 0.125f : 1.0f;
        v0 = a * sc; v1 = b * sc;
    } else if (pc >= ZC_GM || (pc >= ZC_GN && pc < ZC_WI)) { v0 = sigmoidf_(v0); v1 = sigmoidf_(v1); }
}
__device__ __forceinline__ void sincos_tab(float ang, float& s, float& c) {
    const double a = (double)ang; const double k = rint(a * 0.63661977236758134308);
    const float r = (float)(a - k * 1.57079632679489661923); const float z = r * r;
    const float sp = ((-1.9515295891e-4f * z + 8.3321608736e-3f) * z - 1.6666654611e-1f) * z * r + r;
    const float cp = ((2.443315711809948e-5f * z - 1.388731625493765e-3f) * z + 4.166664568298827e-2f) * z * z - 0.5f * z + 1.0f;
    const int q = ((int)k) & 3;
    s = (q == 0) ? sp : (q == 1) ? cp : (q == 2) ? -sp : -cp;
    c = (q == 0) ? cp : (q == 1) ? -sp : (q == 2) ? -cp : sp;
}

__device__ __forceinline__ void st_adaln(const Params& p, unsigned char* lds) {
    int tid_ = threadIdx.x; asm volatile("" : "+v"(tid_)); const int tid = tid_, lane = tid & 63, w = tid >> 6;
    float* cosT = (float*)(p.ws + WS_COS); float* sinT = (float*)(p.ws + WS_SIN);
    for (int i = blockIdx.x * NTHR + tid; i < SEQ * 32; i += gridDim.x * NTHR) {
        const int pos = i >> 5, f = i & 31; const float inv = powf(10000.0f, -(float)f / 32.0f);
        float s, c; sincos_tab((float)pos * inv, s, c); cosT[i] = c; sinT[i] = s;
    }
    float* sc = (float*)lds;
    float* red = sc + 8192;
    for (int i = tid; i < 8192; i += NTHR) { const float v = p.c[i]; sc[i] = v / (1.0f + __expf(-v)); }
    __syncthreads();
    float* mod = (float*)(p.ws + WS_MOD);
    for (int unit = blockIdx.x; unit < 192; unit += gridDim.x) {
        float acc[8];
#pragma unroll
        for (int b = 0; b < 8; ++b) acc[b] = 0.f;
        const int col = unit * 32 + (lane & 31), ks = lane >> 5;
        for (int k0 = 0; k0 < 64; k0 += 16) {
            float wv[16];
#pragma unroll
            for (int i = 0; i < 16; ++i) wv[i] = p.ada_w[(size_t)(w * 128 + (k0 + i) * 2 + ks) * 6144 + col];
#pragma unroll
            for (int i = 0; i < 16; ++i) { const int k = w * 128 + (k0 + i) * 2 + ks;
#pragma unroll
                for (int b = 0; b < 8; ++b) acc[b] += sc[b * 1024 + k] * wv[i]; }
        }
#pragma unroll
        for (int b = 0; b < 8; ++b) red[((w * 2 + ks) * 8 + b) * 32 + (lane & 31)] = acc[b];
        __syncthreads();
        if (tid < 256) { const int b = tid >> 5, c = tid & 31; float s = 0.f;
            for (int j = 0; j < 16; ++j) s += red[(j * 8 + b) * 32 + c];
            mod[b * 6144 + unit * 32 + c] = s + p.ada_b[unit * 32 + c]; }
        __syncthreads();
    }
}
__device__ __forceinline__ void st_norm_rows(const Params& p, int which) {
    int tid_ = threadIdx.x; asm volatile("" : "+v"(tid_)); const int tid = tid_, lane = tid & 63, w = tid >> 6;
    const float* src = which ? p.out : p.x; const float* g = which ? p.norm2_g : p.norm1_g;
    bf16_t* dst = (bf16_t*)(p.ws + (which ? WS_H2 : WS_HB));
    const float* mod = (const float*)(p.ws + WS_MOD);
    for (int t = blockIdx.x * 8 + w; t < T; t += gridDim.x * 8) {
        const int b = t >> 11; const float* sh = mod + b * 6144 + (which ? 3072 : 0); const float* scl = sh + 1024;
        const float4* xr = (const float4*)(src + (size_t)t * D);
        float4 v[4]; float ss = 0.f;
#pragma unroll
        for (int j = 0; j < 4; ++j) { v[j] = xr[lane + 64 * j]; ss += v[j].x * v[j].x + v[j].y * v[j].y + v[j].z * v[j].z + v[j].w * v[j].w; }
        const float r = rsqrtf(wave_sum(ss) * (1.0f / D) + EPS);
        float am = 0.f;
#pragma unroll
        for (int j = 0; j < 4; ++j) { const int d0 = (lane + 64 * j) * 4;
            const float4 gg = *(const float4*)(g + d0), s4 = *(const float4*)(scl + d0), h4 = *(const float4*)(sh + d0);
            const float o0 = v[j].x * r * gg.x * (1.f + s4.x) + h4.x, o1 = v[j].y * r * gg.y * (1.f + s4.y) + h4.y;
            const float o2 = v[j].z * r * gg.z * (1.f + s4.z) + h4.z, o3 = v[j].w * r * gg.w * (1.f + s4.w) + h4.w;
            uint2 o; o.x = pk2(o0, o1); o.y = pk2(o2, o3); *(uint2*)(dst + (size_t)t * D + d0) = o;
            v[j].x = o0; v[j].y = o1; v[j].z = o2; v[j].w = o3; am = fmaxf(am, fmaxf(fmaxf(fabsf(o0), fabsf(o1)), fmaxf(fabsf(o2), fabsf(o3)))); }
        if (which) {
            am = wave_max(am); const float sx = am > 0.f ? am * (1.0f / 127.0f) : 1.0f; const float isx = 1.0f / sx;
            if (lane == 0) ((float*)(p.ws + WS_SX))[t] = sx;
#pragma unroll
            for (int j = 0; j < 4; ++j) { const int q0 = (int)rintf(v[j].x * isx), q1 = (int)rintf(v[j].y * isx), q2 = (int)rintf(v[j].z * isx), q3 = (int)rintf(v[j].w * isx);
                *(u32*)(p.ws + WS_X8 + (size_t)t * D + (lane + 64 * j) * 4) = (u32)(q0 & 255) | ((u32)(q1 & 255) << 8) | ((u32)(q2 & 255) << 16) | ((u32)(q3 & 255) << 24); }
        }
    }
}
__device__ __forceinline__ u32 ordf(float f);
__device__ __forceinline__ void ins16(u32 (&s)[16], u32 key) {
#pragma unroll
    for (int i = 0; i < 16; ++i) { const u32 mx = s[i] > key ? s[i] : key; key = s[i] > key ? key : s[i]; s[i] = mx; }
}
__device__ __forceinline__ void sort16_desc(u32 (&c)[16]) {
#pragma unroll
    for (int k = 2; k <= 16; k <<= 1)
#pragma unroll
        for (int j = k >> 1; j > 0; j >>= 1)
#pragma unroll
            for (int i = 0; i < 16; ++i) { const int l = i ^ j;
                if (l > i) { const u32 a = c[i], b = c[l]; const u32 mx = a > b ? a : b, mn = a > b ? b : a; if ((i & k) == 0) { c[i] = mx; c[l] = mn; } else { c[i] = mn; c[l] = mx; } } }
}
__device__ __forceinline__ void merge16(u32 (&s)[16], const u32 (&c)[16]) {
#pragma unroll
    for (int i = 0; i < 16; ++i) s[i] = s[i] > c[15 - i] ? s[i] : c[15 - i];
#pragma unroll
    for (int j = 8; j > 0; j >>= 1)
#pragma unroll
        for (int i = 0; i < 16; ++i) { const int l = i ^ j; if (l > i) { const u32 a = s[i], b = s[l]; s[i] = a > b ? a : b; s[l] = a > b ? b : a; } }
}
__device__ __forceinline__ void st_route(const Params& p) {
    int tid_ = threadIdx.x; asm volatile("" : "+v"(tid_)); const int tid = tid_; const float* ss = (const float*)(p.ws + WS_SSUB); int* eidx = (int*)(p.ws + WS_EIDX); float* gate = (float*)(p.ws + WS_GATE);
    for (int it = blockIdx.x * NTHR + tid; it < T * 8; it += gridDim.x * NTHR) {
        const float* s0 = ss + (size_t)it * 256;
        u32 a[16], b[16];
#pragma unroll 1
        for (int n0 = 0; n0 < 128; n0 += 16) {
            u32 ca[16], cb[16];
#pragma unroll
            for (int q = 0; q < 4; ++q) { const float4 x = *(const float4*)(s0 + n0 + 4 * q), y = *(const float4*)(s0 + 128 + n0 + 4 * q); const u32 nb_ = (u32)(127 - n0 - 4 * q);
                ca[4 * q] = (ordf(x.x) & ~127u) | nb_; ca[4 * q + 1] = (ordf(x.y) & ~127u) | (nb_ - 1u); ca[4 * q + 2] = (ordf(x.z) & ~127u) | (nb_ - 2u); ca[4 * q + 3] = (ordf(x.w) & ~127u) | (nb_ - 3u);
                cb[4 * q] = (ordf(y.x) & ~127u) | nb_; cb[4 * q + 1] = (ordf(y.y) & ~127u) | (nb_ - 1u); cb[4 * q + 2] = (ordf(y.z) & ~127u) | (nb_ - 2u); cb[4 * q + 3] = (ordf(y.w) & ~127u) | (nb_ - 3u); }
            sort16_desc(ca); sort16_desc(cb);
            if (n0 == 0) {
#pragma unroll
                for (int i = 0; i < 16; ++i) { a[i] = ca[i]; b[i] = cb[i]; }
            } else { merge16(a, ca); merge16(b, cb); }
        }
        float va[16], vb[16]; int na[16], nb[16];
#pragma unroll
        for (int i = 0; i < 16; ++i) { na[i] = 127 - (int)(a[i] & 127u); nb[i] = 127 - (int)(b[i] & 127u); va[i] = s0[na[i]]; vb[i] = s0[128 + nb[i]]; }
        u32 tk[16];
#pragma unroll
        for (int i = 0; i < 16; ++i) tk[i] = 0u;
#pragma unroll
        for (int i = 0; i < 16; ++i)
#pragma unroll
            for (int j = 0; j < 16; ++j) if ((i + 1) * (j + 1) <= 16) ins16(tk, (ordf(va[i] + vb[j]) & ~255u) | (u32)(255 - (i * 16 + j)));
        float ts[16]; int te[16];
#pragma unroll
        for (int r = 0; r < 16; ++r) { const int flat = 255 - (int)(tk[r] & 255u), i = flat >> 4, j = flat & 15; float x = 0.f, y = 0.f; int ni = 0, nj = 0;
#pragma unroll
            for (int q = 0; q < 16; ++q) { if (i == q) { x = va[q]; ni = na[q]; } if (j == q) { y = vb[q]; nj = nb[q]; } }
            ts[r] = x + y; te[r] = ni * 128 + nj; }
        float mx = ts[0];
#pragma unroll
        for (int r = 1; r < 16; ++r) mx = fmaxf(mx, ts[r]);
        float sum = 0.f, ex[16];
#pragma unroll
        for (int r = 0; r < 16; ++r) { ex[r] = __expf(ts[r] - mx); sum += ex[r]; }
        const float inv = 1.0f / sum;
#pragma unroll
        for (int r = 0; r < 16; ++r) { eidx[(size_t)it * 16 + r] = te[r]; gate[(size_t)it * 16 + r] = ex[r] * inv; }
    }
}
__device__ __forceinline__ u32 pk4_fp8(float a, float b, float c, float d) { int p = 0; p = __builtin_amdgcn_cvt_pk_fp8_f32(a, b, p, false); p = __builtin_amdgcn_cvt_pk_fp8_f32(c, d, p, true); return (u32)p; }
__device__ __forceinline__ void st_cvt_uv(const Params& p) {
    int tid_ = threadIdx.x; asm volatile("" : "+v"(tid_)); const int tid = tid_;
    const int lane = tid & 63, w = tid >> 6;
    unsigned char* u8 = p.ws + WS_U16; unsigned char* v8 = p.ws + WS_V16; float* su = (float*)(p.ws + WS_SU);
    for (int e = blockIdx.x * 8 + w; e < 16384; e += gridDim.x * 8) {
        const float4* a = (const float4*)(p.pu + (size_t)e * D); const float4* b = (const float4*)(p.pv + (size_t)e * D);
        float4 av[4], bv[4]; float am = 0.f;
#pragma unroll
        for (int j = 0; j < 4; ++j) { av[j] = a[lane + 64 * j]; bv[j] = b[lane + 64 * j];
            am = fmaxf(am, fmaxf(fmaxf(fabsf(av[j].x), fabsf(av[j].y)), fmaxf(fabsf(av[j].z), fabsf(av[j].w)))); }
        am = wave_max(am); const float sc = am > 0.f ? am * (1.0f / 127.0f) : 1.0f; const float isc = 1.0f / sc;
        if (lane == 0) su[e] = sc;
#pragma unroll
        for (int j = 0; j < 4; ++j) { const int col = (lane + 64 * j) * 4;
            const int q0 = (int)rintf(av[j].x * isc), q1 = (int)rintf(av[j].y * isc), q2 = (int)rintf(av[j].z * isc), q3 = (int)rintf(av[j].w * isc);
            *(u32*)(u8 + (size_t)e * 1024 + col) = (u32)(q0 & 255) | ((u32)(q1 & 255) << 8) | ((u32)(q2 & 255) << 16) | ((u32)(q3 & 255) << 24);
            *(u32*)(v8 + ((size_t)(col >> 7) * 16384 + e) * 128 + (col & 127)) = pk4_fp8(bv[j].x, bv[j].y, bv[j].z, bv[j].w); }
    }
}


typedef short bf16x8 __attribute__((ext_vector_type(8)));
typedef float f32x16 __attribute__((ext_vector_type(16)));
typedef unsigned u32x2 __attribute__((ext_vector_type(2)));
typedef unsigned u32x4 __attribute__((ext_vector_type(4)));
typedef __bf16 hbf2_t __attribute__((ext_vector_type(2)));
typedef float f32x2_t __attribute__((ext_vector_type(2)));
#define MFMA32(a, b, c) __builtin_amdgcn_mfma_f32_32x32x16_bf16((a), (b), (c), 0, 0, 0)
__device__ __forceinline__ u32 pkbf(float a, float b) { const f32x2_t v = {a, b}; const hbf2_t r = __builtin_convertvector(v, hbf2_t); return __builtin_bit_cast(u32, r); }
__device__ __forceinline__ bf16x8 ld8(const bf16_t* q) { return *(const bf16x8*)q; }
__device__ __forceinline__ bf16x8 ld44(const bf16_t* q) { const u32x2 a = *(const u32x2*)q, b = *(const u32x2*)(q + 8); const u32x4 v = {a.x, a.y, b.x, b.y}; return __builtin_bit_cast(bf16x8, v); }
template <int H> __device__ __forceinline__ bf16x8 pack8(const f32x16& s) {
    const u32x4 v = {pkbf(s[8 * H], s[8 * H + 1]), pkbf(s[8 * H + 2], s[8 * H + 3]), pkbf(s[8 * H + 4], s[8 * H + 5]), pkbf(s[8 * H + 6], s[8 * H + 7])};
    return __builtin_bit_cast(bf16x8, v);
}
__device__ __forceinline__ float dpp_xor1(float v) { return __int_as_float(__builtin_amdgcn_update_dpp(0, __float_as_int(v), 0xB1, 0xF, 0xF, true)); }
__device__ __forceinline__ float dpp_xor2(float v) { return __int_as_float(__builtin_amdgcn_update_dpp(0, __float_as_int(v), 0x4E, 0xF, 0xF, true)); }
__device__ __forceinline__ f32x16 zero16() { f32x16 z;
#pragma unroll
    for (int i = 0; i < 16; ++i) z[i] = 0.f; return z; }
__device__ __forceinline__ u32 vm_le(int lim) { u32 vm = 0u;
#pragma unroll
    for (int R = 0; R < 16; ++R) vm |= (((R & 3) + 8 * (R >> 2)) <= lim) ? (1u << R) : 0u;
    return vm; }
__device__ __forceinline__ u32 vm_from_word(u32 word, int hl) { const u32 sh = word >> (4 * hl); return (sh & 0xFu) | (((sh >> 8) & 0xFu) << 4) | (((sh >> 16) & 0xFu) << 8) | (((sh >> 24) & 0xFu) << 12); }
__device__ __forceinline__ void store_ot(bf16_t* orow, const f32x16& o0, const f32x16& o1, int hl) {
#pragma unroll
    for (int q = 0; q < 4; ++q) {
        u32x2 a = {pkbf(o0[4 * q], o0[4 * q + 1]), pkbf(o0[4 * q + 2], o0[4 * q + 3])}; *(u32x2*)(orow + 8 * q + 4 * hl) = a;
        u32x2 b = {pkbf(o1[4 * q], o1[4 * q + 1]), pkbf(o1[4 * q + 2], o1[4 * q + 3])}; *(u32x2*)(orow + 32 + 8 * q + 4 * hl) = b;
    }
}
__device__ __forceinline__ u32 ordf(float f) { const u32 u = __float_as_uint(f); return (u & 0x80000000u) ? ~u : (u | 0x80000000u); }


constexpr int TILE_B = 4608;
template <int NT> __device__ __forceinline__ void sk_gload(uint4 (&rk)[NT / 2], const bf16_t* kbase, size_t kstride, int t0c, int tlast, int tid) {
#pragma unroll
    for (int q = 0; q < NT / 2; ++q) { const int idx = tid + 512 * q, tile = idx >> 8, r = (idx >> 3) & 31, ch = idx & 7; int tg = t0c + tile; tg = tg > tlast ? tlast : tg;
        rk[q] = *(const uint4*)(kbase + (size_t)(32 * tg + r) * kstride + 8 * ch); }
}
template <int NT> __device__ __forceinline__ void sk_lwrite(const uint4 (&rk)[NT / 2], LAS unsigned char* kb, int tid) {
#pragma unroll
    for (int q = 0; q < NT / 2; ++q) { const int idx = tid + 512 * q, tile = idx >> 8, r = (idx >> 3) & 31, ch = idx & 7; const u32x4 v = {rk[q].x, rk[q].y, rk[q].z, rk[q].w}; *(LAS u32x4*)(kb + tile * TILE_B + r * 144 + ch * 16) = v; }
}
template <int NT> __device__ __forceinline__ void sv_gload(uint4 (&rv)[NT / 2], const bf16_t* vbase, size_t vstride, int t0c, int tlast, int tid) {
#pragma unroll
    for (int q = 0; q < NT / 2; ++q) { const int idx = tid + 512 * q, tile = idx >> 8, d = (idx >> 2) & 63, sg = idx & 3; int tg = t0c + tile; tg = tg > tlast ? tlast : tg;
        rv[q] = *(const uint4*)(vbase + (size_t)d * vstride + 32 * tg + 8 * sg); }
}
template <int NT> __device__ __forceinline__ void sv_lwrite(const uint4 (&rv)[NT / 2], LAS unsigned char* vb, int tid) {
#pragma unroll
    for (int q = 0; q < NT / 2; ++q) { const int idx = tid + 512 * q, tile = idx >> 8, d = (idx >> 2) & 63, sg = idx & 3; LAS unsigned char* a = vb + tile * TILE_B + d * 72 + sg * 16;
        const u32x2 v0 = {rv[q].x, rv[q].y}, v1 = {rv[q].z, rv[q].w}; *(LAS u32x2*)a = v0; *(LAS u32x2*)(a + 8) = v1; }
}
__device__ __forceinline__ bf16x8 lds_k(const LAS unsigned char* kt, int c, int hl, int kk) { return *(const LAS bf16x8*)(kt + c * 144 + kk * 32 + hl * 16); }
__device__ __forceinline__ bf16x8 lds_v(const LAS unsigned char* vt, int d, int hl, int s) { const LAS unsigned char* q = vt + d * 72 + s * 32 + hl * 8;
    const u32x2 a = *(const LAS u32x2*)q, b = *(const LAS u32x2*)(q + 16); const u32x4 v = {a.x, a.y, b.x, b.y}; return __builtin_bit_cast(bf16x8, v); }
__device__ __forceinline__ float xhalf_max(float x) { const auto r = __builtin_amdgcn_permlane32_swap(__float_as_uint(x), __float_as_uint(x), false, false); return fmaxf(__uint_as_float(r[0]), __uint_as_float(r[1])); }
__device__ __forceinline__ float xhalf_sum(float x) { const auto r = __builtin_amdgcn_permlane32_swap(__float_as_uint(x), __float_as_uint(x), false, false); return __uint_as_float(r[0]) + __uint_as_float(r[1]); }
__device__ __forceinline__ void flash_tile_lds(float& m2, float& l, f32x16& o0, f32x16& o1, f32x16 s, u32 vm, bool full, const LAS unsigned char* vt, int c, int hl) {
    const float LOG2E = 1.4426950408889634f;
    const bf16x8 v00 = lds_v(vt, c, hl, 0), v01 = lds_v(vt, c, hl, 1), v10 = lds_v(vt, c + 32, hl, 0), v11 = lds_v(vt, c + 32, hl, 1);
    float mx = -1e30f;
    if (full) {
#pragma unroll
        for (int R = 0; R < 16; ++R) mx = fmaxf(mx, s[R]);
    } else {
#pragma unroll
        for (int R = 0; R < 16; ++R) { s[R] = ((vm >> R) & 1u) ? s[R] : -1e30f; mx = fmaxf(mx, s[R]); }
    }
    mx = xhalf_max(mx);
    const float mn2 = fmaxf(m2, mx * LOG2E);
    if (!__all(mn2 == m2)) { const float al = __builtin_amdgcn_exp2f(m2 - mn2); l *= al;
#pragma unroll
        for (int R = 0; R < 16; ++R) { o0[R] *= al; o1[R] *= al; }
        m2 = mn2; }
    float ps = 0.f;
#pragma unroll
    for (int R = 0; R < 16; ++R) { const float pr = __builtin_amdgcn_exp2f(fmaf(s[R], LOG2E, -mn2)); s[R] = pr; ps += pr; }
    l += xhalf_sum(ps);
    const bf16x8 p0 = pack8<0>(s), p1 = pack8<1>(s);
    o0 = MFMA32(v00, p0, o0); o0 = MFMA32(v01, p1, o0);
    o1 = MFMA32(v10, p0, o1); o1 = MFMA32(v11, p1, o1);
}
#define HALF_SUM32(v, hl, out) do { int _v = (v); _v += __builtin_amdgcn_update_dpp(0, _v, 0xB1, 0xF, 0xF, true); _v += __builtin_amdgcn_update_dpp(0, _v, 0x4E, 0xF, 0xF, true); \
    _v += __builtin_amdgcn_update_dpp(0, _v, 0x141, 0xF, 0xF, true); _v += __builtin_amdgcn_update_dpp(0, _v, 0x140, 0xF, 0xF, true); \
    const int _r0 = __builtin_amdgcn_readlane(_v, 0) + __builtin_amdgcn_readlane(_v, 16), _r1 = __builtin_amdgcn_readlane(_v, 32) + __builtin_amdgcn_readlane(_v, 48); (out) = (hl) ? _r1 : _r0; } while (0)
constexpr int ATT_CHUNK = 8 * TILE_B;
constexpr int ATT_MK_OFF = 2 * ATT_CHUNK;

#define ATT_STREAM_KV(kbase, kstride, vbase, vstride, tfirst, tlast, BODY) do { \
    const int _tf = (tfirst), _tl = (tlast); const int _nch = (_tl - _tf + 4) >> 2; \
    uint4 _rk[2], _rv[2]; \
    __syncthreads(); \
    sk_gload<4>(_rk, (kbase), (kstride), _tf, _tl, tid); sv_gload<4>(_rv, (vbase), (vstride), _tf, _tl, tid); \
    sk_lwrite<4>(_rk, sm, tid); sv_lwrite<4>(_rv, sm + 4 * TILE_B, tid); \
    if (_nch > 1) { sk_gload<4>(_rk, (kbase), (kstride), _tf + 4, _tl, tid); sv_gload<4>(_rv, (vbase), (vstride), _tf + 4, _tl, tid); } \
    for (int _c = 0; _c < _nch; ++_c) { \
        __syncthreads(); \
        if (_c + 1 < _nch) { LAS unsigned char* _nb = sm + ((_c + 1) & 1) * ATT_CHUNK; sk_lwrite<4>(_rk, _nb, tid); sv_lwrite<4>(_rv, _nb + 4 * TILE_B, tid); \
            if (_c + 2 < _nch) { sk_gload<4>(_rk, (kbase), (kstride), _tf + 4 * (_c + 2), _tl, tid); sv_gload<4>(_rv, (vbase), (vstride), _tf + 4 * (_c + 2), _tl, tid); } } \
        const LAS unsigned char* _cb = sm + (_c & 1) * ATT_CHUNK; \
        _Pragma("unroll") for (int _i = 0; _i < 4; ++_i) { const int tg = _tf + 4 * _c + _i; if (tg <= _tl) { const LAS unsigned char* kt = _cb + _i * TILE_B; const LAS unsigned char* vt = _cb + (4 + _i) * TILE_B; BODY } } \
    } } while (0)

__device__ __forceinline__ void st_nsa2(const Params& p, unsigned char* lds) {
    LAS unsigned char* sm = (LAS unsigned char*)lds;
    const bf16_t* Z = (const bf16_t*)(p.ws + WS_Z); unsigned char* dob = (unsigned char*)p.out;
    const bf16_t* kcmp = (const bf16_t*)(dob + DO_KCMP); const bf16_t* vcmpT = (const bf16_t*)(dob + DO_VCMPT);
    const bf16_t* vsT = (const bf16_t*)(dob + DO_VST); const bf16_t* vwT = (const bf16_t*)(dob + DO_VWT);
    bf16_t* onsa = (bf16_t*)(p.ws + WS_ONSA);
    for (int ps = blockIdx.x; ps < 256; ps += gridDim.x)
    for (int which = 0; which < 2; ++which) {
        const int b = ps >> 5, g = (ps >> 4) & 1, jj = ps & 15, qb = which ? 31 - jj : jj, cur = qb;
        int tid = threadIdx.x; asm volatile("" : "+v"(tid));
        const int lane = tid & 63, w = __builtin_amdgcn_readfirstlane(tid >> 6), c = lane & 31, hl = lane >> 5;
        const int t0 = qb * 64, pmin = t0 + 8 * w, pos = pmin + (c >> 2), head = 4 * g + (c & 3);
        const bf16_t* zr = Z + (size_t)(b * SEQ + pos) * NZ;
        bf16x8 qfr[4];
#pragma unroll
        for (int kk = 0; kk < 4; ++kk) qfr[kk] = ld8(zr + ZC_QN + head * 64 + 16 * kk + 8 * hl);
        const float gc = bf2f(zr[ZC_GN + head * 3]), gs = bf2f(zr[ZC_GN + head * 3 + 1]), gw = bf2f(zr[ZC_GN + head * 3 + 2]);
        f32x16 out0 = zero16(), out1 = zero16();
        u32 sel;
        {
            const int pmax = pmin + 7; const int nmax = pmax >= 31 ? ((pmax - 31) >> 4) : -1; const int ntile = nmax >= 0 ? (((nmax > 126 ? 126 : nmax) >> 5) + 1) : 0;
            const bf16_t* kb = kcmp + ((size_t)(b * 2 + g) * 128 + c) * 64 + 8 * hl;
            float mx = -1e30f, l = 0.f;
            const int nlim = (pos >= 31 ? (((pos - 31) >> 4) > 126 ? 126 : ((pos - 31) >> 4)) : -1) - 4 * hl;
            for (int kt = 0; kt < ntile; ++kt) {
                f32x16 s = zero16();
#pragma unroll
                for (int kk = 0; kk < 4; ++kk) s = MFMA32(ld8(kb + (size_t)kt * 32 * 64 + 16 * kk), qfr[kk], s);
                const u32 vm = vm_le(nlim - 32 * kt);
                float tm = -1e30f;
#pragma unroll
                for (int R = 0; R < 16; ++R) { s[R] = ((vm >> R) & 1u) ? s[R] : -1e30f; tm = fmaxf(tm, s[R]); }
                const float mn = fmaxf(mx, tm); float ps2 = 0.f;
#pragma unroll
                for (int R = 0; R < 16; ++R) ps2 += ((vm >> R) & 1u) ? __expf(s[R] - mn) : 0.f;
                l = l * __expf(mx - mn) + ps2; mx = mn;
            }
            { const float mo = __shfl_xor(mx, 32), lo_ = __shfl_xor(l, 32); const float mn = fmaxf(mx, mo);
              l = l * __expf(mx - mn) + lo_ * __expf(mo - mn); mx = mn; }
            const float il = 1.0f / fmaxf(l, 1e-30f);
            __builtin_amdgcn_sched_barrier(0);
            f32x16 o0 = zero16(), o1 = zero16();
            const bf16_t* vb = vcmpT + ((size_t)(b * 2 + g) * 64 + c) * 128 + 4 * hl;
            float G[16], L[16];
#pragma unroll
            for (int kt = 0; kt < 4; ++kt) {
                if (kt < ntile) {
                    f32x16 s = zero16();
#pragma unroll
                    for (int kk = 0; kk < 4; ++kk) s = MFMA32(ld8(kb + (size_t)kt * 32 * 64 + 16 * kk), qfr[kk], s);
                    const u32 vm = vm_le(nlim - 32 * kt);
#pragma unroll
                    for (int R = 0; R < 16; ++R) s[R] = ((vm >> R) & 1u) ? __expf(s[R] - mx) * il : 0.f;
                    const bf16x8 p0 = pack8<0>(s), p1 = pack8<1>(s);
                    o0 = MFMA32(ld44(vb + 32 * kt), p0, o0); o0 = MFMA32(ld44(vb + 32 * kt + 16), p1, o0);
                    o1 = MFMA32(ld44(vb + 32 * 128 + 32 * kt), p0, o1); o1 = MFMA32(ld44(vb + 32 * 128 + 32 * kt + 16), p1, o1);
#pragma unroll
                    for (int rg = 0; rg < 4; ++rg) { float gsum = (s[4 * rg] + s[4 * rg + 1]) + (s[4 * rg + 2] + s[4 * rg + 3]); float last = s[4 * rg + 3];
                        gsum += dpp_xor1(gsum); gsum += dpp_xor2(gsum); last += dpp_xor1(last); last += dpp_xor2(last);
                        G[4 * kt + rg] = gsum; L[4 * kt + rg] = last; }
                } else {
#pragma unroll
                    for (int rg = 0; rg < 4; ++rg) { G[4 * kt + rg] = 0.f; L[4 * kt + rg] = 0.f; }
                }
                __builtin_amdgcn_sched_barrier(0);
            }
#pragma unroll
            for (int R = 0; R < 16; ++R) { out0[R] = gc * o0[R]; out1[R] = gc * o1[R]; }
            float v[16], vx[16];
            { float Lx[16];
#pragma unroll
              for (int i = 0; i < 16; ++i) Lx[i] = __shfl_xor(L[i], 32);
#pragma unroll
              for (int i = 0; i < 16; ++i) { const float prevL = hl ? Lx[i] : (i > 0 ? Lx[i > 0 ? i - 1 : 0] : 0.f); const float bl = prevL + 2.f * G[i] - L[i];
                const int j = 2 * i + hl; const bool forced = (j == 0) || (j == cur) || (j == cur - 1);
                v[i] = forced ? __builtin_inff() : (j <= cur ? bl : -__builtin_inff()); } }
#pragma unroll
            for (int i = 0; i < 16; ++i) vx[i] = __shfl_xor(v[i], 32);
            u32 own = 0u;
#pragma unroll
            for (int i = 0; i < 16; ++i) { int rank = 0;
#pragma unroll
                for (int i2 = 0; i2 < 16; ++i2) {
                    if (i2 != i) rank += (v[i2] > v[i] || (v[i2] == v[i] && i2 < i)) ? 1 : 0;
                    const bool xlt = (i2 < i) || (hl && i2 == i);
                    rank += (vx[i2] > v[i] || (vx[i2] == v[i] && xlt)) ? 1 : 0; }
                const int j = 2 * i + hl; own |= ((j <= cur) && rank < 16) ? (1u << j) : 0u; }
            sel = own | (u32)__shfl_xor((int)own, 32);
            __builtin_amdgcn_sched_barrier(0);
        }
        {
            float m = -1e30f, l = 0.f; f32x16 o0 = zero16(), o1 = zero16();
            ATT_STREAM_KV(Z + (size_t)(b * SEQ) * NZ + ZC_KS + g * 64, (size_t)NZ, vsT + (size_t)(b * 2 + g) * 64 * SEQ, (size_t)SEQ, 0, 2 * cur + 1, {
                const bool mine = (sel >> (tg >> 1)) & 1u;
                if (__ballot(mine) != 0ull) {
                    f32x16 s = zero16();
                    _Pragma("unroll") for (int kk = 0; kk < 4; ++kk) s = MFMA32(lds_k(kt, c, hl, kk), qfr[kk], s);
                    const bool full = (tg * 32 + 31 <= pmin) && (__ballot(mine) == ~0ull);
                    const u32 vm = full ? 0xFFFFu : (mine ? vm_le(pos - tg * 32 - 4 * hl) : 0u);
                    flash_tile_lds(m, l, o0, o1, s, vm, full, vt, c, hl); } });
            const float f = gs / fmaxf(l, 1e-30f);
#pragma unroll
            for (int R = 0; R < 16; ++R) { out0[R] += f * o0[R]; out1[R] += f * o1[R]; }
        }
        {
            float m = -1e30f, l = 0.f; f32x16 o0 = zero16(), o1 = zero16();
            const int wfirst = (t0 - 511 > 0 ? t0 - 511 : 0) >> 5, wlast = (t0 + 63) >> 5;
            const int myfirst = (pmin - 511 > 0 ? pmin - 511 : 0) >> 5, mylast = (pmin + 7) >> 5;
            ATT_STREAM_KV(Z + (size_t)(b * SEQ) * NZ + ZC_KW + g * 64, (size_t)NZ, vwT + (size_t)(b * 2 + g) * 64 * SEQ, (size_t)SEQ, wfirst, wlast, {
                if (tg >= myfirst && tg <= mylast) {
                    f32x16 s = zero16();
                    _Pragma("unroll") for (int kk = 0; kk < 4; ++kk) s = MFMA32(lds_k(kt, c, hl, kk), qfr[kk], s);
                    const bool full = (tg * 32 + 31 <= pmin) && (tg * 32 + 504 >= pmin);
                    const int d1 = pos - tg * 32 - 4 * hl; const u32 vm = full ? 0xFFFFu : (vm_le(d1) & ~vm_le(d1 - 512));
                    flash_tile_lds(m, l, o0, o1, s, vm, full, vt, c, hl); } });
            const float f = gw / fmaxf(l, 1e-30f);
#pragma unroll
            for (int R = 0; R < 16; ++R) { out0[R] += f * o0[R]; out1[R] += f * o1[R]; }
        }
        store_ot(onsa + (size_t)(b * SEQ + pos) * 512 + head * 64, out0, out1, hl);
    }
    __syncthreads();
}

__device__ __forceinline__ void st_dsa2(const Params& p, unsigned char* lds) {
    LAS unsigned char* sm = (LAS unsigned char*)lds;
    const bf16_t* Z = (const bf16_t*)(p.ws + WS_Z); unsigned char* dob = (unsigned char*)p.out;
    const bf16_t* kd = (const bf16_t*)(dob + DO_KD); const bf16_t* vdT = (const bf16_t*)(dob + DO_VDT);
    bf16_t* odsa = (bf16_t*)(p.ws + WS_ODSA);
    u32* mk = (u32*)(lds + ATT_MK_OFF);
    for (int ps = blockIdx.x; ps < 256; ps += gridDim.x)
    for (int which = 0; which < 2; ++which) {
        const int b = ps >> 5, jj = ps & 31, qb = which ? 63 - jj : jj;
        const int tok0 = b * SEQ + qb * 32;
        int tid = threadIdx.x; asm volatile("" : "+v"(tid));
        const int lane = tid & 63, w = __builtin_amdgcn_readfirstlane(tid >> 6), c = lane & 31, hl = lane >> 5;
        for (int rep_a = 0; rep_a < (PROBE_STAGE == 21 ? 2 : 1); ++rep_a)
        {
            const int r = c; const int qq_r = ((r >> 2) & 1) * 2 + (r >> 4), head_r = ((r >> 3) & 1) * 4 + (r & 3);
            bf16x8 afr[4];
#pragma unroll
            for (int kk = 0; kk < 4; ++kk) afr[kk] = ld8(Z + (size_t)(tok0 + 4 * w + qq_r) * NZ + ZC_QI + head_r * 64 + 16 * kk + 8 * hl);
            float wv[2][8]; int posq[2];
#pragma unroll
            for (int s = 0; s < 2; ++s) { posq[s] = qb * 32 + 4 * w + 2 * hl + s;
                const uint4 ww = *(const uint4*)(Z + (size_t)(tok0 + 4 * w + 2 * hl + s) * NZ + ZC_WI);
                wv[s][0] = bflo(ww.x) * 0.35355339059327373f; wv[s][1] = bfhi(ww.x) * 0.35355339059327373f; wv[s][2] = bflo(ww.y) * 0.35355339059327373f; wv[s][3] = bfhi(ww.y) * 0.35355339059327373f;
                wv[s][4] = bflo(ww.z) * 0.35355339059327373f; wv[s][5] = bfhi(ww.z) * 0.35355339059327373f; wv[s][6] = bflo(ww.w) * 0.35355339059327373f; wv[s][7] = bfhi(ww.w) * 0.35355339059327373f; }
            u32 key[64][2];
            const bf16_t* kib = Z + (size_t)(b * SEQ) * NZ + ZC_KI;
            uint4 rk[4];
            __syncthreads();
            sk_gload<8>(rk, kib, (size_t)NZ, 0, qb, tid); sk_lwrite<8>(rk, sm, tid);
            if (qb >= 8) sk_gload<8>(rk, kib, (size_t)NZ, 8, qb, tid);
#pragma unroll
            for (int ch = 0; ch < 8; ++ch) {
                if (ch * 8 <= qb) {
                    __syncthreads();
                    if ((ch + 1) * 8 <= qb) { sk_lwrite<8>(rk, sm + ((ch + 1) & 1) * ATT_CHUNK, tid);
                        if ((ch + 2) * 8 <= qb) sk_gload<8>(rk, kib, (size_t)NZ, (ch + 2) * 8, qb, tid); }
                    const LAS unsigned char* cb = sm + (ch & 1) * ATT_CHUNK;
#pragma unroll
                    for (int i = 0; i < 8; ++i) { const int kt = ch * 8 + i;
                        if (kt <= qb) {
                            f32x16 acc = zero16();
#pragma unroll
                            for (int kk = 0; kk < 4; ++kk) acc = MFMA32(afr[kk], lds_k(cb + i * TILE_B, c, hl, kk), acc);
#pragma unroll
                            for (int s = 0; s < 2; ++s) { float sc = 0.f;
#pragma unroll
                                for (int e = 0; e < 8; ++e) sc = fmaf(wv[s][e], fmaxf(acc[8 * s + e], 0.f), sc);
                                key[kt][s] = (c <= posq[s] - kt * 32) ? (ordf(sc) >> 1) : 0u; }
                        } else { key[kt][0] = 0u; key[kt][1] = 0u; }
                        if ((i & 1) == 1) __builtin_amdgcn_sched_barrier(0);
                    }
                } else {
#pragma unroll
                    for (int i = 0; i < 8; ++i) { key[ch * 8 + i][0] = 0u; key[ch * 8 + i][1] = 0u; }
                }
            }
            u32 lo[2], hi[2], thr[2]; bool done[2], exact[2];
            for (int rep_bis = 0; rep_bis < (PROBE_STAGE == 23 ? 2 : 1); ++rep_bis) {
            {
                typedef unsigned short u16x2_t __attribute__((ext_vector_type(2)));
                u32 pk[32][2];
                __builtin_amdgcn_sched_barrier(0);
#pragma unroll
                for (int i = 0; i < 32; ++i) { pk[i][0] = (key[2 * i][0] >> 16) | (key[2 * i + 1][0] & 0xFFFF0000u); pk[i][1] = (key[2 * i][1] >> 16) | (key[2 * i + 1][1] & 0xFFFF0000u); }
                LAS u32* park = (LAS u32*)(sm + ATT_MK_OFF + 8320) + w * 1024 + lane;
#pragma unroll
                for (int i = 0; i < 8; ++i) { park[(2 * i) * 64] = key[56 + i][0]; park[(2 * i + 1) * 64] = key[56 + i][1]; }
                __builtin_amdgcn_sched_barrier(0);
                bool p1[2];
#pragma unroll
                for (int s = 0; s < 2; ++s) { lo[s] = 0x0040u; hi[s] = 0x7FC0u; thr[s] = 1u; exact[s] = true; done[s] = posq[s] < 256; p1[s] = done[s]; }
                for (int iter = 0; iter < 17; ++iter) {
                    if (__all(p1[0] && p1[1])) break;
                    u32 mid[2]; int cnt[2];
#pragma unroll
                    for (int s = 0; s < 2; ++s) { mid[s] = (lo[s] + hi[s]) >> 1;
                        const u32 m2 = mid[s] | (mid[s] << 16); const u16x2_t mv = __builtin_bit_cast(u16x2_t, m2);
                        u16x2_t a0 = {0, 0}, a1 = {0, 0}, a2 = {0, 0}, a3 = {0, 0};
#pragma unroll
                        for (int i = 0; i < 32; i += 4) {
                            a0 += (__builtin_bit_cast(u16x2_t, pk[i][s]) - mv) >> 15; a1 += (__builtin_bit_cast(u16x2_t, pk[i + 1][s]) - mv) >> 15;
                            a2 += (__builtin_bit_cast(u16x2_t, pk[i + 2][s]) - mv) >> 15; a3 += (__builtin_bit_cast(u16x2_t, pk[i + 3][s]) - mv) >> 15; }
                        const u32 at = __builtin_bit_cast(u32, (u16x2_t)((a0 + a1) + (a2 + a3)));
                        cnt[s] = 64 - (int)((at & 0xFFFFu) + (at >> 16));
                        HALF_SUM32(cnt[s], hl, cnt[s]);
                        if (!p1[s]) { if (cnt[s] >= 256) lo[s] = mid[s]; else hi[s] = mid[s];
                            if (cnt[s] == 256) { thr[s] = mid[s] << 16; exact[s] = true; done[s] = true; p1[s] = true; }
                            else if (hi[s] - lo[s] <= 1u) p1[s] = true; } }
                }
#pragma unroll
                for (int s = 0; s < 2; ++s) { lo[s] <<= 16; hi[s] <<= 16; }
                __builtin_amdgcn_sched_barrier(0);
#pragma unroll
                for (int i = 0; i < 8; ++i) { key[56 + i][0] = park[(2 * i) * 64]; key[56 + i][1] = park[(2 * i + 1) * 64]; }
            }
            for (int iter = 0; iter < 40; ++iter) {
                if (__all(done[0] && done[1])) break;
                u32 mid[2]; int cnt[2];
#pragma unroll
                for (int s = 0; s < 2; ++s) { mid[s] = lo[s] + ((hi[s] - lo[s]) >> 1); cnt[s] = 0; }
                {
                    int a0 = 0, a1 = 0, a2 = 0, a3 = 0, b0 = 0, b1 = 0, b2 = 0, b3 = 0;
#pragma unroll
                    for (int kt = 0; kt < 64; kt += 4) {
                        a0 += (int)(key[kt][0] - mid[0]) >> 31; a1 += (int)(key[kt + 1][0] - mid[0]) >> 31; a2 += (int)(key[kt + 2][0] - mid[0]) >> 31; a3 += (int)(key[kt + 3][0] - mid[0]) >> 31;
                        b0 += (int)(key[kt][1] - mid[1]) >> 31; b1 += (int)(key[kt + 1][1] - mid[1]) >> 31; b2 += (int)(key[kt + 2][1] - mid[1]) >> 31; b3 += (int)(key[kt + 3][1] - mid[1]) >> 31; }
                    cnt[0] = 64 + ((a0 + a1) + (a2 + a3)); cnt[1] = 64 + ((b0 + b1) + (b2 + b3)); }
#pragma unroll
                for (int s = 0; s < 2; ++s) {
                    HALF_SUM32(cnt[s], hl, cnt[s]);
                    if (!done[s]) { if (cnt[s] >= 256) lo[s] = mid[s]; else hi[s] = mid[s];
                        if (cnt[s] == 256) { thr[s] = mid[s]; exact[s] = true; done[s] = true; }
                        else if (hi[s] - lo[s] <= 1u) { thr[s] = lo[s]; exact[s] = false; done[s] = true; } } }
            }
            }
            for (int rep_em = 0; rep_em < (PROBE_STAGE == 25 ? 2 : 1); ++rep_em)
            if (__all(exact[0] && exact[1])) {
#pragma unroll
                for (int kt = 0; kt < 64; ++kt) if (kt <= qb) {
#pragma unroll
                    for (int s = 0; s < 2; ++s) { const unsigned long long bal = __ballot(key[kt][s] >= thr[s]);
                        if (lane == 0) { mk[(4 * w + s) * 65 + kt] = (u32)bal; mk[(4 * w + 2 + s) * 65 + kt] = (u32)(bal >> 32); } } }
            } else {
#pragma unroll
                for (int s = 0; s < 2; ++s) {
                    int cgt = 0; const u32 lowk = exact[s] ? thr[s] : thr[s] + 1u;
#pragma unroll
                    for (int kt = 0; kt < 64; ++kt) cgt += (key[kt][s] >= lowk) ? 1 : 0;
                    HALF_SUM32(cgt, hl, cgt);
                    const int need = exact[s] ? 0 : 256 - cgt;
                    int rem0 = __shfl(need, 0), rem1 = __shfl(need, 32);
                    const u32 eqk = exact[s] ? 0xFFFFFFFFu : thr[s];
#pragma unroll
                    for (int kt = 0; kt < 64; ++kt) if (kt <= qb) {
                        const unsigned long long bg = __ballot(key[kt][s] >= lowk), be = __ballot(key[kt][s] == eqk);
                        u32 e0 = (u32)be, e1 = (u32)(be >> 32);
                        while (__popc(e0) > rem0) e0 &= ~(1u << (31 - __clz(e0)));
                        while (__popc(e1) > rem1) e1 &= ~(1u << (31 - __clz(e1)));
                        rem0 -= __popc(e0); rem1 -= __popc(e1);
                        if (lane == 0) { mk[(4 * w + s) * 65 + kt] = (u32)bg | e0; mk[(4 * w + 2 + s) * 65 + kt] = (u32)(bg >> 32) | e1; } }
                }
            }
        }
        for (int rep_b = 0; rep_b < (PROBE_STAGE == 22 ? 2 : 1); ++rep_b)
        {
            bf16x8 qfr[4];
#pragma unroll
            for (int kk = 0; kk < 4; ++kk) qfr[kk] = ld8(Z + (size_t)(tok0 + c) * NZ + ZC_QD + w * 64 + 16 * kk + 8 * hl);
            float m = -1e30f, l = 0.f; f32x16 o0 = zero16(), o1 = zero16();
            ATT_STREAM_KV(kd + (size_t)(b * SEQ) * 64, (size_t)64, vdT + (size_t)b * 64 * SEQ, (size_t)SEQ, 0, qb, {
                const u32 word = mk[c * 65 + tg];
                if (__ballot(word != 0u) != 0ull) {
                    f32x16 s = zero16();
                    _Pragma("unroll") for (int kk = 0; kk < 4; ++kk) s = MFMA32(lds_k(kt, c, hl, kk), qfr[kk], s);
                    flash_tile_lds(m, l, o0, o1, s, vm_from_word(word, hl), false, vt, c, hl); } });
            const float f = 1.0f / fmaxf(l, 1e-30f);
#pragma unroll
            for (int R = 0; R < 16; ++R) { o0[R] *= f; o1[R] *= f; }
            store_ot(odsa + (size_t)(tok0 + c) * 512 + w * 64, o0, o1, hl);
        }
    }
    __syncthreads();
}

typedef __bf16 v2bf_t __attribute__((ext_vector_type(2)));
__device__ __forceinline__ float dot2bf(u32 a, u32 b, float c) { return __builtin_amdgcn_fdot2_f32_bf16(__builtin_bit_cast(v2bf_t, a), __builtin_bit_cast(v2bf_t, b), c, false); }
__device__ __forceinline__ float dpp_hmirror(float v) { return __int_as_float(__builtin_amdgcn_update_dpp(0, __float_as_int(v), 0x141, 0xF, 0xF, true)); }

namespace pg8 {
typedef short bf16x8 __attribute__((ext_vector_type(8)));
typedef float f32x4 __attribute__((ext_vector_type(4)));
typedef unsigned u32x4 __attribute__((ext_vector_type(4)));
constexpr int BM = 256, BK = 64, HALF = 128, HTB = HALF * BK * 2, STAGE_BYTES = 8 * HTB, NXCD = 8, WGM = 8;
__host__ __device__ __forceinline__ int lds_byte(int r, int c) { const int st = (r >> 4) * 2 + (c >> 5), rr = r & 15, cc = c & 31, ob = rr * 64 + cc * 2; return st * 1024 + (ob ^ (((ob >> 9) & 1) << 5)); }
__host__ __device__ __forceinline__ void stage_rc(int b, int& R, int& C) { const int st = b / 1024, sb = b % 1024, swz = sb ^ (((sb >> 9) & 1) << 5); R = (st >> 1) * 16 + swz / 64; C = (st & 1) * 32 + (swz % 64) / 2; }
__host__ __device__ __forceinline__ int perm32(int rho) { const int n = rho >> 4, i = rho & 15; return 8 * (i >> 2) + 4 * n + (i & 3); }
struct Unit { int pm, pn; };
struct Gemm { const bf16_t* A; const bf16_t* Bt; int M, N, K; };
struct StaticOrder {
    int nM, nN, nwg, G, c;
    __host__ __device__ void init(int M, int N, int G_, int c_) { nM = M / BM; nN = N / BM; nwg = nM * nN; G = G_; c = c_; }
    __host__ __device__ bool next(int i, Unit& u) const {
        const long L = (long)i * G + c; if (L >= nwg) return false;
        int wgid = (int)L; { const int q = nwg / NXCD, r = nwg % NXCD, xcd = wgid % NXCD, off = wgid / NXCD; wgid = (xcd < r ? xcd * (q + 1) : r * (q + 1) + (xcd - r) * q) + off; }
        const int nig = WGM * nN, gid = wgid / nig, fm = gid * WGM, gsz = (nM - fm) < WGM ? (nM - fm) : WGM;
        u.pm = fm + ((wgid % nig) % gsz); u.pn = (wgid % nig) / gsz; return true;
    }
    __device__ __forceinline__ void a_ready(const Unit&) const {}
    __device__ __forceinline__ void done(const Unit&) const {}
};
__device__ __forceinline__ unsigned cvt_pk_bf16(float lo, float hi) { unsigned r; asm volatile("v_cvt_pk_bf16_f32 %0, %1, %2" : "=v"(r) : "v"(lo), "v"(hi)); return r; }

template <class Epi, class Sched, bool ALIGN_EPI = false, bool SP2 = false>
__device__ __forceinline__ void gemm_phase(LAS unsigned char* lds, const Gemm g, const Sched& S, const Epi& E) {
    int tid = threadIdx.x; asm volatile("" : "+v"(tid));
    const int wid = __builtin_amdgcn_readfirstlane(tid >> 6), lane = tid & 63, wr = wid >> 2, wc = wid & 3, fr = lane & 15, fq = lane >> 4;
    const int K = g.K, nt = K / BK;
    unsigned voffA[2], voffB[2];
#pragma unroll
    for (int i = 0; i < 2; ++i) { int R, C; stage_rc(tid * 16 + i * 8192, R, C); const int Rb = Epi::PERM ? ((R & ~31) + perm32(R & 31)) : R;
        voffA[i] = (unsigned)(R * K + C) * 2u; voffB[i] = (unsigned)(Rb * K + C) * 2u; }
    const size_t kstep = (size_t)(BK * 2);
    const size_t hstep = (size_t)HALF * K * 2;
    const size_t tstep = 2 * hstep;
    const unsigned ldsw = (unsigned)wid * 1024u;
    const int aoff = lds_byte(wr * 64 + fr, fq * 8), boff = lds_byte(wc * 32 + fr, fq * 8);
#define PG8_SA(b, h) (((b) * 2 + (h)) * HTB)
#define PG8_SB(b, h) ((4 + (b) * 2 + (h)) * HTB)
#define PG8_STAGE(bufoff, gbase, voff) do { _Pragma("unroll") for (int _i = 0; _i < 2; ++_i) \
        __builtin_amdgcn_global_load_lds((const unsigned*)((const char*)(gbase) + (voff)[_i]), (LAS unsigned*)(lds + (bufoff) + ldsw + _i * 8192), 16, 0, 0); } while (0)
#define PG8_LDA(dst, b, h) do { _Pragma("unroll") for (int m = 0; m < 4; ++m) _Pragma("unroll") for (int k = 0; k < 2; ++k) dst[m][k] = *(const LAS bf16x8*)(lds + PG8_SA(b, h) + aoff + m * 2048 + k * 1024); } while (0)
#define PG8_LDB(dst, b, h) do { _Pragma("unroll") for (int n = 0; n < 2; ++n) _Pragma("unroll") for (int k = 0; k < 2; ++k) dst[n][k] = *(const LAS bf16x8*)(lds + PG8_SB(b, h) + boff + n * 2048 + k * 1024); } while (0)
#define PG8_MMA(ai, bj, At, Bt) do { __builtin_amdgcn_s_setprio(1); _Pragma("unroll") for (int m = 0; m < 4; ++m) _Pragma("unroll") for (int n = 0; n < 2; ++n) _Pragma("unroll") for (int k = 0; k < 2; ++k) \
        acc[ai][bj][m][n] = __builtin_amdgcn_mfma_f32_16x16x32_bf16(Bt[n][k], At[m][k], acc[ai][bj][m][n], 0, 0, 0); __builtin_amdgcn_s_setprio(0); } while (0)
#define PG8_WAIT_V(n) asm volatile("s_waitcnt vmcnt(" #n ")" ::: "memory")
#define PG8_WAIT_L(n) asm volatile("s_waitcnt lgkmcnt(" #n ")" ::: "memory")
#define PG8_BAR __builtin_amdgcn_s_barrier()
#define PG8_SCHED __builtin_amdgcn_sched_barrier(0)
    Unit cur, nxt; int ui = 0;
    if (!S.next(0, cur)) return;
    f32x4 acc[2][2][4][2];
#pragma unroll
    for (int a = 0; a < 2; ++a)
#pragma unroll
        for (int b = 0; b < 2; ++b)
#pragma unroll
            for (int m = 0; m < 4; ++m)
#pragma unroll
                for (int n = 0; n < 2; ++n) acc[a][b][m][n] = (f32x4){0.f, 0.f, 0.f, 0.f};
    bf16x8 At[4][2], B0[2][2], B1[2][2];
    const char* cA = (const char*)g.A + (size_t)cur.pm * tstep; const char* cB = (const char*)g.Bt + (size_t)cur.pn * tstep;
    S.a_ready(cur);
    if constexpr (SP2) {
        PG8_STAGE(PG8_SB(0, 0), cB, voffB); PG8_STAGE(PG8_SB(0, 1), cB + hstep, voffB); PG8_STAGE(PG8_SA(0, 0), cA, voffA); PG8_STAGE(PG8_SA(0, 1), cA + hstep, voffA);
        if (wr == 1) PG8_BAR;
        PG8_WAIT_V(2); PG8_BAR;
        PG8_STAGE(PG8_SB(1, 0), cB + kstep, voffB); PG8_STAGE(PG8_SA(1, 0), cA + kstep, voffA); PG8_STAGE(PG8_SB(1, 1), cB + hstep + kstep, voffB);
        PG8_WAIT_V(6); PG8_BAR;
    } else {
        PG8_STAGE(PG8_SB(0, 0), cB, voffB); PG8_STAGE(PG8_SA(0, 0), cA, voffA); PG8_STAGE(PG8_SB(0, 1), cB + hstep, voffB); PG8_STAGE(PG8_SA(0, 1), cA + hstep, voffA);
        if (wr == 1) PG8_BAR;
        PG8_WAIT_V(4); PG8_BAR;
        PG8_STAGE(PG8_SB(1, 0), cB + kstep, voffB); PG8_STAGE(PG8_SA(1, 0), cA + kstep, voffA); PG8_STAGE(PG8_SB(1, 1), cB + hstep + kstep, voffB);
        PG8_WAIT_V(6); PG8_BAR;
    }
    for (;;) {
        const bool has_next = S.next(ui + 1, nxt);
        const char* nA = has_next ? (const char*)g.A + (size_t)nxt.pm * tstep : cA; const char* nB = has_next ? (const char*)g.Bt + (size_t)nxt.pn * tstep : cB;
        for (int t = 0; t < nt; t += 2) {
            const bool last = (t == nt - 2);
            const char* a1 = cA + (size_t)(t + 1) * kstep;
            const char* a2 = last ? nA : cA + (size_t)(t + 2) * kstep; const char* b2 = last ? nB : cB + (size_t)(t + 2) * kstep;
            const char* a3 = a2 + kstep; const char* b3 = b2 + kstep;
            if (last && has_next) S.a_ready(nxt);
            if constexpr (SP2) {
            PG8_LDB(B0, 0, 0); PG8_LDB(B1, 0, 1); PG8_SCHED; PG8_LDA(At, 0, 0); PG8_STAGE(PG8_SA(1, 1), a1 + hstep, voffA);
            PG8_WAIT_V(8); PG8_WAIT_L(0); PG8_BAR; PG8_MMA(0, 0, At, B0); PG8_MMA(0, 1, At, B1); PG8_BAR; PG8_SCHED;
            PG8_LDA(At, 0, 1); PG8_STAGE(PG8_SB(0, 0), b2, voffB); PG8_STAGE(PG8_SB(0, 1), b2 + hstep, voffB); PG8_STAGE(PG8_SA(0, 0), a2, voffA);
            PG8_WAIT_V(8); PG8_WAIT_L(0); PG8_BAR; PG8_MMA(1, 0, At, B0); PG8_MMA(1, 1, At, B1); PG8_BAR; PG8_SCHED;
            PG8_LDB(B0, 1, 0); PG8_LDB(B1, 1, 1); PG8_SCHED; PG8_LDA(At, 1, 0); PG8_STAGE(PG8_SA(0, 1), a2 + hstep, voffA);
            PG8_WAIT_V(8); PG8_WAIT_L(0); PG8_BAR; PG8_MMA(0, 0, At, B0); PG8_MMA(0, 1, At, B1); PG8_BAR; PG8_SCHED;
            PG8_LDA(At, 1, 1); PG8_STAGE(PG8_SB(1, 0), b3, voffB); PG8_STAGE(PG8_SB(1, 1), b3 + hstep, voffB); PG8_STAGE(PG8_SA(1, 0), a3, voffA);
            PG8_WAIT_V(8); PG8_WAIT_L(0); PG8_BAR; PG8_MMA(1, 0, At, B0); PG8_MMA(1, 1, At, B1); PG8_BAR; PG8_SCHED;
            } else {
            PG8_LDB(B0, 0, 0); PG8_SCHED; PG8_LDA(At, 0, 0); PG8_STAGE(PG8_SA(1, 1), a1 + hstep, voffA);
            PG8_WAIT_L(8); PG8_BAR; PG8_WAIT_L(0); PG8_MMA(0, 0, At, B0); PG8_BAR; PG8_SCHED;
            PG8_LDB(B1, 0, 1); PG8_STAGE(PG8_SB(0, 0), b2, voffB);
            PG8_BAR; PG8_WAIT_L(0); PG8_MMA(0, 1, At, B1); PG8_BAR;
            PG8_LDA(At, 0, 1); PG8_STAGE(PG8_SA(0, 0), a2, voffA);
            PG8_BAR; PG8_WAIT_L(0); PG8_MMA(1, 0, At, B0); PG8_BAR; PG8_SCHED;
            PG8_STAGE(PG8_SB(0, 1), b2 + hstep, voffB);
            PG8_WAIT_V(6); PG8_BAR; PG8_MMA(1, 1, At, B1); PG8_BAR;
            PG8_LDB(B0, 1, 0); PG8_SCHED; PG8_LDA(At, 1, 0); PG8_STAGE(PG8_SA(0, 1), a2 + hstep, voffA);
            PG8_WAIT_L(8); PG8_BAR; PG8_WAIT_L(0); PG8_MMA(0, 0, At, B0); PG8_BAR; PG8_SCHED;
            PG8_LDB(B1, 1, 1); PG8_STAGE(PG8_SB(1, 0), b3, voffB);
            PG8_BAR; PG8_WAIT_L(0); PG8_MMA(0, 1, At, B1); PG8_BAR;
            PG8_LDA(At, 1, 1); PG8_STAGE(PG8_SA(1, 0), a3, voffA);
            PG8_BAR; PG8_WAIT_L(0); PG8_MMA(1, 0, At, B0); PG8_BAR; PG8_SCHED;
            PG8_STAGE(PG8_SB(1, 1), b3 + hstep, voffB);
            PG8_WAIT_V(6); PG8_BAR; PG8_MMA(1, 1, At, B1); PG8_BAR;
            }
        }
        if constexpr (ALIGN_EPI) { if (wr == 0) PG8_BAR; }
        if constexpr (!Epi::AFTER_DRAIN) { E(acc, cur, wr, wc, fr, fq); S.done(cur); }
        if (!has_next) break;
#pragma unroll
        for (int a = 0; a < 2; ++a)
#pragma unroll
            for (int b = 0; b < 2; ++b)
#pragma unroll
                for (int m = 0; m < 4; ++m)
#pragma unroll
                    for (int n = 0; n < 2; ++n) acc[a][b][m][n] = (f32x4){0.f, 0.f, 0.f, 0.f};
        cur = nxt; cA = nA; cB = nB; ++ui;
        if constexpr (ALIGN_EPI) { if (wr == 1) PG8_BAR; }
    }
    PG8_WAIT_V(0);
    if constexpr (!ALIGN_EPI) { if (wr == 0) PG8_BAR; }
    PG8_BAR;
#undef PG8_SA
#undef PG8_SB
#undef PG8_STAGE
#undef PG8_LDA
#undef PG8_LDB
#undef PG8_MMA
#undef PG8_WAIT_V
#undef PG8_WAIT_L
#undef PG8_BAR
#undef PG8_SCHED
}
struct EpiZ {
    static constexpr bool PERM = true, AFTER_DRAIN = false;
    bf16_t* Z; const float* cosT; const float* sinT;
    __device__ __forceinline__ void operator()(const f32x4 (&acc)[2][2][4][2], const Unit& u, int wr, int wc, int fr, int fq) const {
#pragma unroll
        for (int bj = 0; bj < 2; ++bj) {
            const int cb = u.pn * BM + bj * HALF + wc * 32;
            const int g64 = cb >> 6; const int c0 = cb + 8 * fq;
            const bool roped = (g64 < 64) && ((ROPE_MASK >> g64) & 1ull);
            const bool sig = (cb >= ZC_GM) || (c0 >= ZC_GN && c0 < ZC_WI);
            const float sc = ((g64 < 64) && ((SCALE_MASK >> g64) & 1ull)) ? 0.125f : 1.0f;
#pragma unroll
            for (int ai = 0; ai < 2; ++ai)
#pragma unroll
                for (int m = 0; m < 4; ++m) {
                    const int row = u.pm * BM + ai * HALF + wr * 64 + m * 16 + fr;
                    f32x4 v0 = acc[ai][bj][m][0], v1 = acc[ai][bj][m][1];
                    if (roped) {
                        const int pos = row & (SEQ - 1), i0 = (c0 & 63) >> 1;
                        const f32x4 cs = *(const f32x4*)(cosT + pos * 32 + i0), sn = *(const f32x4*)(sinT + pos * 32 + i0);
                        const f32x4 a = v0, b = v1;
                        v0[0] = (a[0] * cs[0] - a[1] * sn[0]) * sc; v0[1] = (a[1] * cs[0] + a[0] * sn[0]) * sc;
                        v0[2] = (a[2] * cs[1] - a[3] * sn[1]) * sc; v0[3] = (a[3] * cs[1] + a[2] * sn[1]) * sc;
                        v1[0] = (b[0] * cs[2] - b[1] * sn[2]) * sc; v1[1] = (b[1] * cs[2] + b[0] * sn[2]) * sc;
                        v1[2] = (b[2] * cs[3] - b[3] * sn[3]) * sc; v1[3] = (b[3] * cs[3] + b[2] * sn[3]) * sc;
                    } else if (sig) {
#pragma unroll
                        for (int e = 0; e < 4; ++e) { v0[e] = sigmoidf_(v0[e]); v1[e] = sigmoidf_(v1[e]); }
                    }
                    u32x4 w; w.x = cvt_pk_bf16(v0[0], v0[1]); w.y = cvt_pk_bf16(v0[2], v0[3]); w.z = cvt_pk_bf16(v1[0], v1[1]); w.w = cvt_pk_bf16(v1[2], v1[3]);
                    *(u32x4*)(Z + (size_t)row * NZ + c0) = w;
                }
        }
    }
};
struct EpiMerge {
    static constexpr bool PERM = true, AFTER_DRAIN = false;
    bf16_t* O; const bf16_t* Zg; int mode;
    __device__ __forceinline__ void operator()(const f32x4 (&acc)[2][2][4][2], const Unit& u, int wr, int wc, int fr, int fq) const {
#pragma unroll
        for (int ai = 0; ai < 2; ++ai)
#pragma unroll
            for (int m = 0; m < 4; ++m) { const int row = u.pm * BM + ai * HALF + wr * 64 + m * 16 + fr;
#pragma unroll
                for (int bj = 0; bj < 2; ++bj) { const int c0 = u.pn * BM + bj * HALF + wc * 32 + 8 * fq;
                    const u32x4 gz = *(const u32x4*)(Zg + (size_t)row * NZ + c0);
                    f32x4 v0 = acc[ai][bj][m][0], v1 = acc[ai][bj][m][1];
                    v0[0] *= bflo(gz.x); v0[1] *= bfhi(gz.x); v0[2] *= bflo(gz.y); v0[3] *= bfhi(gz.y); v1[0] *= bflo(gz.z); v1[1] *= bfhi(gz.z); v1[2] *= bflo(gz.w); v1[3] *= bfhi(gz.w);
                    bf16_t* op = O + (size_t)row * D + c0;
                    if (mode) { const u32x4 o = *(const u32x4*)op;
                        v0[0] += bflo(o.x); v0[1] += bfhi(o.x); v0[2] += bflo(o.y); v0[3] += bfhi(o.y); v1[0] += bflo(o.z); v1[1] += bfhi(o.z); v1[2] += bflo(o.w); v1[3] += bfhi(o.w); }
                    u32x4 w; w.x = cvt_pk_bf16(v0[0], v0[1]); w.y = cvt_pk_bf16(v0[2], v0[3]); w.z = cvt_pk_bf16(v1[0], v1[1]); w.w = cvt_pk_bf16(v1[2], v1[3]);
                    *(u32x4*)op = w; } }
    }
};
struct EpiOut {
    static constexpr bool PERM = true, AFTER_DRAIN = false;
    const float* x; float* o; const float* mod;
    __device__ __forceinline__ void operator()(const f32x4 (&acc)[2][2][4][2], const Unit& u, int wr, int wc, int fr, int fq) const {
#pragma unroll
        for (int ai = 0; ai < 2; ++ai)
#pragma unroll
            for (int m = 0; m < 4; ++m) { const int row = u.pm * BM + ai * HALF + wr * 64 + m * 16 + fr; const float* g1 = mod + (row >> 11) * 6144 + 2048;
#pragma unroll
                for (int bj = 0; bj < 2; ++bj) { const int c0 = u.pn * BM + bj * HALF + wc * 32 + 8 * fq;
#pragma unroll
                    for (int n = 0; n < 2; ++n) { const f32x4 gg = *(const f32x4*)(g1 + c0 + 4 * n), xx = *(const f32x4*)(x + (size_t)row * D + c0 + 4 * n);
                        *(f32x4*)(o + (size_t)row * D + c0 + 4 * n) = xx + gg * acc[ai][bj][m][n]; } } }
    }
};
struct EpiF32 {
    static constexpr bool PERM = true, AFTER_DRAIN = false;
    float* O; int ldc;
    __device__ __forceinline__ void operator()(const f32x4 (&acc)[2][2][4][2], const Unit& u, int wr, int wc, int fr, int fq) const {
#pragma unroll
        for (int ai = 0; ai < 2; ++ai)
#pragma unroll
            for (int m = 0; m < 4; ++m) { const int row = u.pm * BM + ai * HALF + wr * 64 + m * 16 + fr;
#pragma unroll
                for (int bj = 0; bj < 2; ++bj) { const int c0 = u.pn * BM + bj * HALF + wc * 32 + 8 * fq;
                    *(f32x4*)(O + (size_t)row * ldc + c0) = acc[ai][bj][m][0]; *(f32x4*)(O + (size_t)row * ldc + c0 + 4) = acc[ai][bj][m][1]; } }
    }
};
}

template <bool ZMAP>
__device__ __forceinline__ void transpose_item(const float* W, int K, int Nsrc, bf16_t* WT, LAS float* scr, int item, int nblk, int lane) {
    const int kb = item / nblk, nb = item % nblk, k0 = 64 * kb, n0 = 32 * nb;
    int sc = n0 + (lane & 31); if (ZMAP) sc = z_logical_col(sc);
#pragma unroll 8
    for (int i = 0; i < 32; ++i) { const int kk = 2 * i + (lane >> 5); scr[kk * 33 + (lane & 31)] = (sc >= 0) ? W[(size_t)(k0 + kk) * Nsrc + sc] : 0.f; }
    asm volatile("s_waitcnt lgkmcnt(0)" ::: "memory");
    const int c = lane & 7;
#pragma unroll
    for (int j = 0; j < 4; ++j) { const int n = (lane >> 3) + 8 * j; const LAS float* s = scr + (8 * c) * 33 + n;
        uint4 o; o.x = pk2(s[0 * 33], s[1 * 33]); o.y = pk2(s[2 * 33], s[3 * 33]); o.z = pk2(s[4 * 33], s[5 * 33]); o.w = pk2(s[6 * 33], s[7 * 33]);
        *(uint4*)(WT + (size_t)(n0 + n) * K + k0 + 8 * c) = o; }
    asm volatile("s_waitcnt lgkmcnt(0)" ::: "memory");
}
__device__ __forceinline__ void st_convert(const Params& p, unsigned char* lds) {
    int tid_ = threadIdx.x; asm volatile("" : "+v"(tid_)); const int tid = tid_, lane = tid & 63, w = __builtin_amdgcn_readfirstlane(tid >> 6);
    LAS float* scr = (LAS float*)((LAS unsigned char*)lds + 49152 + w * 8704);
    const int gw = blockIdx.x * 8 + w, NGW = gridDim.x * 8;
    constexpr int I_IN = 16 * 144, I_BR = 8 * 32, I_OUT = 16 * 32;
    for (int it = gw; it < I_IN + 2 * I_BR + I_OUT; it += NGW) {
        int r = it;
        if (r < I_IN) { transpose_item<true>(p.w_in, D, DIN, (bf16_t*)(p.ws + WS_WINT), scr, r, 144, lane); continue; } r -= I_IN;
        if (r < I_BR) { transpose_item<false>(p.w_nsa, 512, D, (bf16_t*)(p.ws + WS_WNSAT), scr, r, 32, lane); continue; } r -= I_BR;
        if (r < I_BR) { transpose_item<false>(p.w_dsa, 512, D, (bf16_t*)(p.ws + WS_WDSAT), scr, r, 32, lane); continue; } r -= I_BR;
        transpose_item<false>(p.w_out, D, D, (bf16_t*)(p.ws + WS_WOUTT), scr, r, 32, lane);
    }
    { bf16_t* w1t = (bf16_t*)(p.ws + WS_W1T); float* bpos = (float*)(p.ws + WS_BPOS);
      for (int it = blockIdx.x * NTHR + tid; it < 2 * 64 * 2048; it += gridDim.x * NTHR) {
          const int e = it & 63, kidx = (it >> 6) & 2047, kv = it >> 17; const int l = kidx >> 6, dp = kidx & 63; const int d = kv ? dp : ((dp >> 1) + 32 * (dp & 1));
          w1t[((size_t)kv * 64 + e) * 2048 + kidx] = f2bf((kv ? p.w1v : p.w1k)[(l * 64 + d) * 64 + e]); }
      for (int o = gw; o < 128; o += NGW) { const int kv = o >> 6, e = o & 63; const float* w1 = kv ? p.w1v : p.w1k; float s = 0.f;
          for (int i = lane; i < 2048; i += 64) s += p.cmp_pos[i] * w1[i * 64 + e];
          s = wave_sum(s); if (lane == 0) bpos[o] = s; } }
    { bf16_t* wk = (bf16_t*)(p.ws + WS_WKVT);
      for (int it = blockIdx.x * NTHR + tid; it < 128 * 128; it += gridDim.x * NTHR) { const int o = it & 127, r = it >> 7;
          wk[o * 128 + r] = f2bf(p.kvg[r] * (o < 64 ? p.w_uk[r * 64 + o] : p.w_uv[r * 64 + o - 64])); } }
    bf16_t* wf = (bf16_t*)(p.ws + WS_WFOLDT);
    for (int it = blockIdx.x * NTHR + tid; it < 512 * 256; it += gridDim.x * NTHR) {
        const int kb = it & 255, cb = it >> 8, k0 = 4 * kb, c0 = 4 * cb, hc = c0 >> 7;
        const float* sk = p.subkeys + (size_t)c0 * 64; const float* qr = p.wq + (size_t)k0 * D + hc * 64;
        float acc[4][4];
#pragma unroll
        for (int i = 0; i < 4; ++i)
#pragma unroll
            for (int j = 0; j < 4; ++j) acc[i][j] = 0.f;
#pragma unroll 4
        for (int d = 0; d < 64; d += 4) { float4 sv[4], xv[4];
#pragma unroll
            for (int i = 0; i < 4; ++i) { sv[i] = *(const float4*)(sk + i * 64 + d); xv[i] = *(const float4*)(qr + (size_t)i * D + d); }
#pragma unroll
            for (int i = 0; i < 4; ++i)
#pragma unroll
                for (int j = 0; j < 4; ++j) acc[i][j] += sv[i].x * xv[j].x + sv[i].y * xv[j].y + sv[i].z * xv[j].z + sv[i].w * xv[j].w; }
#pragma unroll
        for (int i = 0; i < 4; ++i) { uint2 o; o.x = pk2(acc[i][0], acc[i][1]); o.y = pk2(acc[i][2], acc[i][3]); *(uint2*)(wf + (size_t)(c0 + i) * D + k0) = o; }
    }
}
__device__ __forceinline__ void st_z_gemm(const Params& p, unsigned char* lds) {
    pg8::Gemm g{(const bf16_t*)(p.ws + WS_HB), (const bf16_t*)(p.ws + WS_WINT), T, NZ, D}; pg8::StaticOrder S; S.init(T, NZ, gridDim.x, blockIdx.x);
    pg8::EpiZ E{(bf16_t*)(p.ws + WS_Z), (const float*)(p.ws + WS_COS), (const float*)(p.ws + WS_SIN)};
    pg8::gemm_phase<pg8::EpiZ, pg8::StaticOrder, true, true>((LAS unsigned char*)lds, g, S, E);
}
__device__ __forceinline__ void st_merge_gemm(const Params& p, unsigned char* lds) {
    pg8::StaticOrder S; S.init(T, D, gridDim.x, blockIdx.x);
    { pg8::Gemm g{(const bf16_t*)(p.ws + WS_ONSA), (const bf16_t*)(p.ws + WS_WNSAT), T, D, 512};
      pg8::EpiMerge E{(bf16_t*)(p.ws + WS_MERGED), (const bf16_t*)(p.ws + WS_Z) + ZC_GM, 0};
      pg8::gemm_phase<pg8::EpiMerge, pg8::StaticOrder, true, true>((LAS unsigned char*)lds, g, S, E); }
    asm volatile("s_waitcnt vmcnt(0)" ::: "memory"); __syncthreads();
    { pg8::Gemm g{(const bf16_t*)(p.ws + WS_ODSA), (const bf16_t*)(p.ws + WS_WDSAT), T, D, 512};
      pg8::EpiMerge E{(bf16_t*)(p.ws + WS_MERGED), (const bf16_t*)(p.ws + WS_Z) + ZC_GM + 1024, 1};
      pg8::gemm_phase<pg8::EpiMerge, pg8::StaticOrder, true, true>((LAS unsigned char*)lds, g, S, E); }
}
__device__ __forceinline__ void st_out_gemm(const Params& p, unsigned char* lds) {
    pg8::Gemm g{(const bf16_t*)(p.ws + WS_MERGED), (const bf16_t*)(p.ws + WS_WOUTT), T, D, D}; pg8::StaticOrder S; S.init(T, D, gridDim.x, blockIdx.x);
    pg8::EpiOut E{p.x, p.out, (const float*)(p.ws + WS_MOD)};
    pg8::gemm_phase<pg8::EpiOut, pg8::StaticOrder, true, true>((LAS unsigned char*)lds, g, S, E);
}
__device__ __forceinline__ void st_ssub_gemm(const Params& p, unsigned char* lds) {
    pg8::Gemm g{(const bf16_t*)(p.ws + WS_H2), (const bf16_t*)(p.ws + WS_WFOLDT), T, 2048, D}; pg8::StaticOrder S; S.init(T, 2048, gridDim.x, blockIdx.x);
    pg8::EpiF32 E{(float*)(p.ws + WS_SSUB), 2048};
    pg8::gemm_phase<pg8::EpiF32, pg8::StaticOrder, true, true>((LAS unsigned char*)lds, g, S, E);
}

typedef float f32x4_t __attribute__((ext_vector_type(4)));
__device__ __forceinline__ void st_prep(const Params& p, unsigned char* lds) {
    int tid = threadIdx.x; asm volatile("" : "+v"(tid));
    const int lane = tid & 63, w = __builtin_amdgcn_readfirstlane(tid >> 6);
    const bf16_t* Z = (const bf16_t*)(p.ws + WS_Z);
    const float* cosT = (const float*)(p.ws + WS_COS); const float* sinT = (const float*)(p.ws + WS_SIN);
    unsigned char* dob = (unsigned char*)p.out;
    bf16_t* kd = (bf16_t*)(dob + DO_KD); bf16_t* vdT = (bf16_t*)(dob + DO_VDT); bf16_t* vsT = (bf16_t*)(dob + DO_VST); bf16_t* vwT = (bf16_t*)(dob + DO_VWT);
    bf16_t* kcmp = (bf16_t*)(dob + DO_KCMP); bf16_t* vcmpT = (bf16_t*)(dob + DO_VCMPT);
    {   float* red = (float*)lds;
        float* hid = red + 8 * 16 * 64;
        const bf16_t* w1t = (const bf16_t*)(p.ws + WS_W1T); const float* bpos = (const float*)(p.ws + WS_BPOS);
        for (int u = blockIdx.x; u < 256; u += gridDim.x) {
            const int kv = u >> 7, b = (u >> 4) & 7, g = (u >> 3) & 1, n0 = (u & 7) * 16;
            const int nl = lane & 15, kq = lane >> 4; int n = n0 + nl; if (n > 126) n = 126;
            pg8::f32x4 acc[4];
#pragma unroll
            for (int ec = 0; ec < 4; ++ec) acc[ec] = (pg8::f32x4){0.f, 0.f, 0.f, 0.f};
            const bf16_t* ab = Z + (size_t)(b * SEQ + 16 * n) * NZ + (kv ? ZC_VC : ZC_KC) + g * 64 + 8 * kq;
            const bf16_t* bb = w1t + ((size_t)kv * 64 + nl) * 2048 + 8 * kq;
#pragma unroll
            for (int i = 0; i < 8; ++i) { const int kk = 8 * w + i;
                const pg8::bf16x8 a = *(const pg8::bf16x8*)(ab + (size_t)(kk >> 1) * NZ + (kk & 1) * 32);
#pragma unroll
                for (int ec = 0; ec < 4; ++ec) { const pg8::bf16x8 bv = *(const pg8::bf16x8*)(bb + (size_t)ec * 16 * 2048 + 32 * kk);
                    acc[ec] = __builtin_amdgcn_mfma_f32_16x16x32_bf16(a, bv, acc[ec], 0, 0, 0); } }
            __syncthreads();
#pragma unroll
            for (int ec = 0; ec < 4; ++ec)
#pragma unroll
                for (int r = 0; r < 4; ++r) red[(w * 16 + 4 * kq + r) * 64 + 16 * ec + nl] = acc[ec][r];
            __syncthreads();
#pragma unroll
            for (int q = 0; q < 2; ++q) { const int o = tid + 512 * q; float s = bpos[kv * 64 + (o & 63)];
#pragma unroll
                for (int ww = 0; ww < 8; ++ww) s += red[ww * 1024 + o];
                hid[o] = gelu_tanh(s); }
            __syncthreads();
            { const int nn = tid >> 5, f0 = (tid & 31) * 2; const float* w2 = kv ? p.w2v : p.w2k; float a0 = 0.f, a1 = 0.f;
              for (int e = 0; e < 64; ++e) { const float h = hid[nn * 64 + e]; const float2 ww = *(const float2*)(w2 + e * 64 + f0); a0 += h * ww.x; a1 += h * ww.y; }
              const int nglob = n0 + nn; if (nglob > 126) { a0 = 0.f; a1 = 0.f; }
              if (kv == 0) { bf16_t* o = kcmp + (((size_t)b * 2 + g) * 128 + nglob) * 64; o[2 * (f0 & 31) + (f0 >> 5)] = f2bf(a0); o[2 * ((f0 + 1) & 31) + ((f0 + 1) >> 5)] = f2bf(a1); }
              else { bf16_t* o = vcmpT + (((size_t)b * 2 + g) * 64 + f0) * 128 + nglob; o[0] = f2bf(a0); o[128] = f2bf(a1); } }
        }
        __syncthreads();
    }
    {   bf16_t* tl = (bf16_t*)lds;
        for (int it = blockIdx.x; it < 512; it += gridDim.x) {
            const int which = it & 1, tt = (it >> 1) & 31, b = it >> 6; const int t0 = b * SEQ + tt * 64;
            __syncthreads();
#pragma unroll
            for (int q = 0; q < 2; ++q) { const int idx = tid + 512 * q, tok = idx >> 4, ch = idx & 15;
                const uint4 v = *(const uint4*)(Z + (size_t)(t0 + tok) * NZ + (which ? ZC_VW : ZC_VS) + ch * 8); bf16_t* d = tl + tok * 130 + ch * 8;
                d[0] = (bf16_t)v.x; d[1] = (bf16_t)(v.x >> 16); d[2] = (bf16_t)v.y; d[3] = (bf16_t)(v.y >> 16); d[4] = (bf16_t)v.z; d[5] = (bf16_t)(v.z >> 16); d[6] = (bf16_t)v.w; d[7] = (bf16_t)(v.w >> 16); }
            __syncthreads();
#pragma unroll
            for (int q = 0; q < 2; ++q) { const int idx = tid + 512 * q, gd = idx >> 3, c8 = idx & 7; const bf16_t* s = tl + (c8 * 8) * 130 + gd;
                uint4 o; o.x = (u32)s[0] | ((u32)s[130] << 16); o.y = (u32)s[260] | ((u32)s[390] << 16); o.z = (u32)s[520] | ((u32)s[650] << 16); o.w = (u32)s[780] | ((u32)s[910] << 16);
                *(uint4*)((which ? vwT : vsT) + ((size_t)b * 128 + gd) * SEQ + tt * 64 + c8 * 8) = o; }
        }
    }
    {   const bf16_t* wk = (const bf16_t*)(p.ws + WS_WKVT);
        const int nl = lane & 15, kq = lane >> 4;
        for (int task = blockIdx.x * 8 + w; task < T / 16; task += gridDim.x * 8) {
            const int t0 = task * 16, b = t0 >> 11, pos0 = t0 & (SEQ - 1);
            pg8::bf16x8 a[4]; float ss = 0.f;
#pragma unroll
            for (int ks = 0; ks < 4; ++ks) { a[ks] = *(const pg8::bf16x8*)(Z + (size_t)(t0 + nl) * NZ + ZC_CKV + 32 * ks + 8 * kq);
#pragma unroll
                for (int j = 0; j < 8; ++j) { const float f = bf2f((bf16_t)a[ks][j]); ss += f * f; } }
            ss += __shfl_xor(ss, 16); ss += __shfl_xor(ss, 32);
            const float rn = rsqrtf(ss * (1.0f / 128.0f) + EPS);
            float rnr[4];
#pragma unroll
            for (int r = 0; r < 4; ++r) rnr[r] = __shfl(rn, 4 * kq + r);
            pg8::f32x4 acc[8];
#pragma unroll
            for (int ct = 0; ct < 8; ++ct) { acc[ct] = (pg8::f32x4){0.f, 0.f, 0.f, 0.f};
#pragma unroll
                for (int ks = 0; ks < 4; ++ks) acc[ct] = __builtin_amdgcn_mfma_f32_16x16x32_bf16(a[ks], *(const pg8::bf16x8*)(wk + (size_t)(16 * ct + nl) * 128 + 32 * ks + 8 * kq), acc[ct], 0, 0, 0); }
#pragma unroll
            for (int ct = 0; ct < 2; ++ct) { const int i = 16 * ct + nl;
#pragma unroll
                for (int r = 0; r < 4; ++r) { const int tr = 4 * kq + r, pos = pos0 + tr; const float c = cosT[pos * 32 + i], s = sinT[pos * 32 + i];
                    const float k1 = acc[ct][r] * rnr[r], k2 = acc[ct + 2][r] * rnr[r];
                    *(u32*)(kd + (size_t)(t0 + tr) * 64 + 2 * i) = pk2(k1 * c - k2 * s, k2 * c + k1 * s); } }
#pragma unroll
            for (int ct = 4; ct < 8; ++ct) { const int d = 16 * (ct - 4) + nl;
                uint2 o; o.x = pk2(acc[ct][0] * rnr[0], acc[ct][1] * rnr[1]); o.y = pk2(acc[ct][2] * rnr[2], acc[ct][3] * rnr[3]);
                *(uint2*)(vdT + ((size_t)b * 64 + d) * SEQ + pos0 + 4 * kq) = o; }
        }
    }
}

#define XB_TMO      128
#define XB_XCNT(j)  (256  + 64 * (j))
#define XB_XSUB(j)  (1280 + 64 * (j))
#define XB_XGEN(j)  (2304 + 64 * (j))
#define XB_TOP      3328
#define XB_TOPGEN   3392
#define XCD_BAR_WORDS 3456
#define XB_SPIN_CAP (1u << 22)
__device__ __forceinline__ unsigned xb_ld(unsigned* p)              { return __hip_atomic_load(p, __ATOMIC_RELAXED, __HIP_MEMORY_SCOPE_AGENT); }
__device__ __forceinline__ unsigned xb_add(unsigned* p, unsigned v) { return __hip_atomic_fetch_add(p, v, __ATOMIC_RELAXED, __HIP_MEMORY_SCOPE_AGENT); }
__device__ __forceinline__ unsigned xb_xcc_id() { return (unsigned)__builtin_amdgcn_s_getreg((3 << 11) | 20) & 0xFu; }
#define XB_SPIN(cond, bar) do { unsigned _sp = 0; while (cond) { __builtin_amdgcn_s_sleep(1); \
    if ((++_sp & 255u) == 0u) { if (xb_ld(&(bar)[XB_TMO])) break; if (_sp > XB_SPIN_CAP) { atomicAdd(&(bar)[XB_TMO], 1u); break; } } } } while (0)
struct XcdBarrier { unsigned* bar; unsigned x; volatile LAS unsigned* st; };
__device__ __forceinline__ XcdBarrier xcd_barrier_post(unsigned* bar, volatile LAS unsigned* st) {
    XcdBarrier b; b.bar = bar; b.x = xb_xcc_id(); b.st = st;
    if (threadIdx.x == 0) (void)xb_add(&bar[XB_XCNT(b.x)], 1u);
    return b;
}
__device__ __forceinline__ void xcd_barrier_complete(unsigned* bar, unsigned x, unsigned& nloc, unsigned& nx) {
    const unsigned G = gridDim.x * gridDim.y * gridDim.z;
    unsigned sum, cnt, mine, sp = 0u;
    for (;;) {
        sum = 0u; cnt = 0u; mine = 0u;
#pragma unroll
        for (unsigned j = 0; j < 16; ++j) { const unsigned c = xb_ld(&bar[XB_XCNT(j)]); sum += c; cnt += (c > 0u) ? 1u : 0u; mine = (j == x) ? c : mine; }
        if (sum == G) break;
        __builtin_amdgcn_s_sleep(1);
        if ((++sp & 255u) == 0u) { if (xb_ld(&bar[XB_TMO])) break; if (sp > XB_SPIN_CAP) { atomicAdd(&bar[XB_TMO], 1u); break; } }
    }
    nloc = mine > 0u ? mine : 1u; nx = cnt > 0u ? cnt : 1u;
}
__device__ __forceinline__ void xcd_barrier(const XcdBarrier& b) {
    asm volatile("s_waitcnt vmcnt(0)" ::: "memory");
    __syncthreads();
    if (threadIdx.x == 0) {
        unsigned* bar = b.bar;
        __builtin_amdgcn_s_waitcnt(0);
        unsigned nloc = b.st[0], nx = b.st[1];
        if (nloc == 0u) { xcd_barrier_complete(bar, b.x, nloc, nx); b.st[0] = nloc; b.st[1] = nx; }
        const unsigned old = xb_add(&bar[XB_XSUB(b.x)], 1u);
        const unsigned gen = old / nloc;
        if (old + 1u == (gen + 1u) * nloc) {
            __builtin_amdgcn_fence(__ATOMIC_RELEASE, "agent");
            asm volatile("s_waitcnt vmcnt(0)" ::: "memory");
            const unsigned og = xb_add(&bar[XB_TOP], 1u);
            const unsigned tg = og / nx;
            if (og + 1u == (tg + 1u) * nx) xb_add(&bar[XB_TOPGEN], 1u);
            else XB_SPIN(xb_ld(&bar[XB_TOPGEN]) == tg, bar);
            __builtin_amdgcn_fence(__ATOMIC_ACQUIRE, "agent");
            xb_add(&bar[XB_XGEN(b.x)], 1u);
            asm volatile("s_waitcnt vmcnt(0)" ::: "memory");
        } else {
            XB_SPIN(xb_ld(&bar[XB_XGEN(b.x)]) == gen, bar);
            __builtin_amdgcn_fence(__ATOMIC_ACQUIRE, "agent");
            asm volatile("s_waitcnt vmcnt(0)" ::: "memory");
        }
    }
    __syncthreads();
}

#define XB_XRANK(j) (3520 + 16 * (j))
struct XccInfo { int pi, nxp, rank, nloc; };
__device__ __forceinline__ XccInfo xcc_info(const Params& p, int rank, unsigned x) {
    unsigned* bar = (unsigned*)(p.ws + WS_BAR); XccInfo r; r.rank = rank; r.pi = 0; r.nxp = 0; r.nloc = 1;
#pragma unroll
    for (unsigned j = 0; j < 16; ++j) { const unsigned cj = xb_ld(&bar[XB_XRANK(j)]); if (j == x) { r.pi = r.nxp; r.nloc = (int)cj; } r.nxp += (cj > 0u) ? 1 : 0; }
    if (r.nxp < 1) r.nxp = 1; if (r.nloc < 1) r.nloc = 1;
    return r;
}
__device__ __forceinline__ void st_final_norm(const Params& p) {
    int tid_ = threadIdx.x; asm volatile("" : "+v"(tid_)); const int tid = tid_;
    const int lane = tid & 63, w = tid >> 6;
    for (int t = blockIdx.x * 8 + w; t < T; t += gridDim.x * 8) {
        float4* xr = (float4*)(p.out + (size_t)t * D);
        float4 v[4]; float ss = 0.f;
#pragma unroll
        for (int j = 0; j < 4; ++j) { v[j] = xr[lane + 64 * j]; ss += v[j].x * v[j].x + v[j].y * v[j].y + v[j].z * v[j].z + v[j].w * v[j].w; }
        const float r = rsqrtf(wave_sum(ss) * (1.0f / D) + EPS);
#pragma unroll
        for (int j = 0; j < 4; ++j) { const float4 g = ((const float4*)p.final_g)[lane + 64 * j]; float4 o; o.x = v[j].x * r * g.x; o.y = v[j].y * r * g.y; o.z = v[j].z * r * g.z; o.w = v[j].w * r * g.w; xr[lane + 64 * j] = o; }
    }
}

constexpr int EXP_LROW = 1040;
constexpr int EXP_LWAVE = 8 * EXP_LROW;

typedef float v2f_t __attribute__((ext_vector_type(2)));
__device__ __forceinline__ void st_expert_u3(const Params& p, unsigned char* lds, const XccInfo xi) {
    int tid_ = threadIdx.x; asm volatile("" : "+v"(tid_)); const int tid = tid_;
    const int lane = tid & 63, w = __builtin_amdgcn_readfirstlane(tid >> 6), rs = lane >> 3, ch = lane & 7;
    const unsigned char* x8 = p.ws + WS_X8; const unsigned char* u8 = p.ws + WS_U16; const float* su = (const float*)(p.ws + WS_SU); const float* sxs = (const float*)(p.ws + WS_SX);
    const int* eidx = (const int*)(p.ws + WS_EIDX); const float* gate = (const float*)(p.ws + WS_GATE); float* wgt = (float*)(p.ws + WS_WGT);
    LAS unsigned char* lw = (LAS unsigned char*)lds + w * EXP_LWAVE;
    const int wid = xi.rank * 8 + w, nw = xi.nloc * 8;
    for (int s = xi.pi; s < 8; s += xi.nxp) {
        for (int tb = wid; tb < T / 8; tb += nw) {
            const int t0 = tb * 8;
            int ea[8], eb[8]; float ga[8], gb[8];
#pragma unroll
            for (int j = 0; j < 8; ++j) { ea[j] = eidx[(size_t)(t0 + j) * 128 + lane]; eb[j] = eidx[(size_t)(t0 + j) * 128 + 64 + lane];
                ga[j] = gate[(size_t)(t0 + j) * 128 + lane]; gb[j] = gate[(size_t)(t0 + j) * 128 + 64 + lane]; }
            u32x4 xq[8];
#pragma unroll
            for (int i = 0; i < 8; ++i) xq[i] = *(const u32x4*)(x8 + (size_t)(t0 + rs) * D + (ch + 8 * i) * 16);
            const float sx = sxs[t0 + rs];
            int nmine = 0, nmax = 0;
#pragma unroll
            for (int j = 0; j < 8; ++j) {
                const bool b0 = (ea[j] >> 11) == s, b1 = (eb[j] >> 11) == s;
                const unsigned long long m0 = __ballot(b0), m1 = __ballot(b1);
                const int n0 = __popcll(m0), n = n0 + __popcll(m1);
                const int p0 = __builtin_amdgcn_mbcnt_hi((unsigned)(m0 >> 32), __builtin_amdgcn_mbcnt_lo((unsigned)m0, 0));
                const int p1 = n0 + __builtin_amdgcn_mbcnt_hi((unsigned)(m1 >> 32), __builtin_amdgcn_mbcnt_lo((unsigned)m1, 0));
                if (b0) { const u32x2 v = {(u32)ea[j] | ((u32)lane << 14), __float_as_uint(ga[j])}; *(LAS u32x2*)(lw + j * EXP_LROW + p0 * 8) = v; }
                if (b1) { const u32x2 v = {(u32)eb[j] | ((u32)(64 + lane) << 14), __float_as_uint(gb[j])}; *(LAS u32x2*)(lw + j * EXP_LROW + p1 * 8) = v; }
                nmine = (rs == j) ? n : nmine; nmax = n > nmax ? n : nmax;
            }
            asm volatile("s_waitcnt lgkmcnt(0)" ::: "memory");
            for (int j = 0; j < nmax; j += 4) {
                bool vr[4]; u32x2 ek[4]; u32x4 rr[4][8]; float sr[4];
#pragma unroll
                for (int q = 0; q < 4; ++q) { vr[q] = (j + q) < nmine; ek[q] = *(const LAS u32x2*)(lw + rs * EXP_LROW + ((j + q) & 127) * 8);
                    const u32 e = vr[q] ? (ek[q].x & 16383u) : 0u; const unsigned char* ur = u8 + (size_t)e * 1024 + ch * 16; sr[q] = su[e];
#pragma unroll
                    for (int i = 0; i < 8; ++i) rr[q][i] = *(const u32x4*)(ur + 128 * i); }
                float act4[4];
#pragma unroll
                for (int q = 0; q < 4; ++q) {
                    int s0 = 0, s1 = 0;
#pragma unroll
                    for (int i = 0; i < 8; ++i) { s0 = __builtin_amdgcn_sdot4((int)rr[q][i].x, (int)xq[i].x, s0, false); s1 = __builtin_amdgcn_sdot4((int)rr[q][i].y, (int)xq[i].y, s1, false);
                        s0 = __builtin_amdgcn_sdot4((int)rr[q][i].z, (int)xq[i].z, s0, false); s1 = __builtin_amdgcn_sdot4((int)rr[q][i].w, (int)xq[i].w, s1, false); }
                    int si = s0 + s1; si += __builtin_amdgcn_update_dpp(0, si, 0x141, 0xF, 0xF, true); si += __builtin_amdgcn_update_dpp(0, si, 0xB1, 0xF, 0xF, true); si += __builtin_amdgcn_update_dpp(0, si, 0x4E, 0xF, 0xF, true);
                    act4[q] = (float)si * (sr[q] * sx);
                }
                {
                    const float a_ = ch == 0 ? act4[0] : ch == 1 ? act4[1] : ch == 2 ? act4[2] : act4[3];
                    const bool v_ = ch == 0 ? vr[0] : ch == 1 ? vr[1] : ch == 2 ? vr[2] : vr[3];
                    const u32 k_ = (ch == 0 ? ek[0].x : ch == 1 ? ek[1].x : ch == 2 ? ek[2].x : ek[3].x) >> 14;
                    const float g_ = __uint_as_float(ch == 0 ? ek[0].y : ch == 1 ? ek[1].y : ch == 2 ? ek[2].y : ek[3].y);
                    if (v_ && ch < 4) wgt[(size_t)(t0 + rs) * 128 + (int)k_] = g_ * gelu_erf_fast(a_);
                }
            }
            asm volatile("s_waitcnt lgkmcnt(0)" ::: "memory");
        }
    }
}
__device__ __forceinline__ void st_expert_v3(const Params& p, unsigned char* lds, const XccInfo xi) {
    int tid_ = threadIdx.x; asm volatile("" : "+v"(tid_)); const int tid = tid_;
    const int lane = tid & 63, w = __builtin_amdgcn_readfirstlane(tid >> 6), rs = lane >> 3, ch = lane & 7;
    const unsigned char* v8 = p.ws + WS_V16;
    const int* eidx = (const int*)(p.ws + WS_EIDX); const float* wgt = (const float*)(p.ws + WS_WGT); const float* mod = (const float*)(p.ws + WS_MOD);
    LAS unsigned char* lw = (LAS unsigned char*)lds + w * EXP_LWAVE;
    const int wid = xi.rank * 8 + w, nw = xi.nloc * 8;
    for (int cs = xi.pi; cs < 8; cs += xi.nxp) {
        const unsigned char* vb = v8 + (size_t)cs * 16384 * 128 + ch * 16;
        for (int tb = wid; tb < T / 8; tb += nw) {
            const int t0 = tb * 8;
#pragma unroll
            for (int q = 0; q < 4; ++q) { const int el = (lane + 64 * q) * 4; const int tk = el >> 7, k = el & 127;
                const uint4 ev = *(const uint4*)(eidx + (size_t)t0 * 128 + el); const float4 wv = *(const float4*)(wgt + (size_t)t0 * 128 + el);
                const u32x4 a = {ev.x, __float_as_uint(wv.x), ev.y, __float_as_uint(wv.y)}, b = {ev.z, __float_as_uint(wv.z), ev.w, __float_as_uint(wv.w)};
                *(LAS u32x4*)(lw + tk * EXP_LROW + k * 8) = a; *(LAS u32x4*)(lw + tk * EXP_LROW + k * 8 + 16) = b; }
            asm volatile("s_waitcnt lgkmcnt(0)" ::: "memory");
            float acc[16];
#pragma unroll
            for (int i = 0; i < 16; ++i) acc[i] = 0.f;
#define EXV3_LOAD(vv, wk, k0) do { _Pragma("unroll") for (int i = 0; i < 16; ++i) { const u32x2 ew = *(const LAS u32x2*)(lw + rs * EXP_LROW + ((k0) + i) * 8); wk[i] = __uint_as_float(ew.y); \
                    vv[i] = *(const u32x4*)(vb + (size_t)ew.x * 128); } } while (0)
#define EXV3_W(word, o, wgt_) do { const v2f_t lo_ = __builtin_amdgcn_cvt_pk_f32_fp8((int)(word), false), hi_ = __builtin_amdgcn_cvt_pk_f32_fp8((int)(word), true); \
                    acc[o] += wgt_ * lo_.x; acc[o + 1] += wgt_ * lo_.y; acc[o + 2] += wgt_ * hi_.x; acc[o + 3] += wgt_ * hi_.y; } while (0)
#define EXV3_COMP(vv, wk) do { _Pragma("unroll") for (int i = 0; i < 16; ++i) { EXV3_W(vv[i].x, 0, wk[i]); EXV3_W(vv[i].y, 4, wk[i]); EXV3_W(vv[i].z, 8, wk[i]); EXV3_W(vv[i].w, 12, wk[i]); } } while (0)
            {   u32x4 va[16]; float wa[16];
#pragma unroll 1
                for (int gq = 0; gq < 8; ++gq) { EXV3_LOAD(va, wa, 16 * gq); EXV3_COMP(va, wa); }
            }
#undef EXV3_LOAD
#undef EXV3_W
#undef EXV3_COMP
            { const int t = t0 + rs, d0 = cs * 128 + ch * 16; float* xr = p.out + (size_t)t * D + d0; const float* g2 = mod + (t >> 11) * 6144 + 5120 + d0;
#pragma unroll
              for (int q = 0; q < 4; ++q) { const float4 x0 = *(const float4*)(xr + 4 * q), ga = *(const float4*)(g2 + 4 * q);
                  float4 o0; o0.x = x0.x + ga.x * acc[4 * q]; o0.y = x0.y + ga.y * acc[4 * q + 1]; o0.z = x0.z + ga.z * acc[4 * q + 2]; o0.w = x0.w + ga.w * acc[4 * q + 3];
                  *(float4*)(xr + 4 * q) = o0; } }
            asm volatile("s_waitcnt lgkmcnt(0)" ::: "memory");
        }
    }
}

constexpr int LDS_BYTES = 131072 + 1024;
constexpr int LDS_CTL = 131072;
__global__ void __launch_bounds__(NTHR, 2) k_mega(Params p) {
    extern __shared__ __attribute__((aligned(16))) unsigned char smem[];
    if (threadIdx.x < 4) ((volatile LAS unsigned*)(smem + LDS_CTL))[threadIdx.x] = 0u;
    __syncthreads();
    XcdBarrier bar = xcd_barrier_post((unsigned*)(p.ws + WS_BAR), (volatile LAS unsigned*)(smem + LDS_CTL));
    if (threadIdx.x == 0) ((volatile LAS unsigned*)(smem + LDS_CTL))[2] = xb_add(&((unsigned*)(p.ws + WS_BAR))[XB_XRANK(bar.x)], 1u);
#define GBAR() xcd_barrier(bar)
#define REP(n, body) do { body; if (PROBE_STAGE == (n)) { __syncthreads(); body; } } while (0)
    REP(1, st_adaln(p, smem); st_convert(p, smem));      GBAR();
    REP(2, st_norm_rows(p, 0));       GBAR();
    REP(3, st_z_gemm(p, smem));       GBAR();
    REP(4, st_prep(p, smem));         GBAR();
    REP(5, st_nsa2(p, smem));         __syncthreads();
    REP(6, st_dsa2(p, smem));         GBAR();
    REP(7, st_merge_gemm(p, smem));   GBAR();
    REP(8, st_out_gemm(p, smem));     GBAR();
    st_norm_rows(p, 1);       GBAR();
    REP(9, st_ssub_gemm(p, smem));    GBAR();
    REP(10, st_route(p));
    REP(11, st_cvt_uv(p));             GBAR();
    {   __syncthreads();
        const int myrank = (int)((volatile LAS unsigned*)(smem + LDS_CTL))[2];
        const XccInfo xi = xcc_info(p, myrank, xb_xcc_id());
        REP(12, st_expert_u3(p, smem, xi)); GBAR();
        st_expert_v3(p, smem, xi); GBAR();
        st_final_norm(p);
    }
}

extern "C" void kernel_launch(void* const* d_in, const int* in_sizes, int n_in, void* d_out, int out_size, void* d_ws, size_t ws_size, hipStream_t stream) {
    static int grid = 0;
    if (grid == 0) {
        int dev = 0, cus = 0, per_cu = 0;
        hipGetDevice(&dev); hipDeviceGetAttribute(&cus, hipDeviceAttributeMultiprocessorCount, dev);
        hipFuncSetAttribute((const void*)k_mega, hipFuncAttributeMaxDynamicSharedMemorySize, LDS_BYTES);
        hipOccupancyMaxActiveBlocksPerMultiprocessor(&per_cu, (const void*)k_mega, NTHR, LDS_BYTES);
        if (per_cu < 1) { fprintf(stderr, "kernel_launch: occupancy query says %d blocks/CU\n", per_cu); per_cu = 1; }
        (void)hipGetLastError();
        grid = cus;
    }
    Params p{};
    const float** f = (const float**)&p;
    for (int i = 0; i < 23; ++i) f[i] = (const float*)d_in[i];
    p.out = (float*)d_out; p.ws = (unsigned char*)d_ws;
    hipMemsetAsync((unsigned char*)d_ws + WS_BAR, 0, 16384, stream);
    hipLaunchKernelGGL(k_mega, dim3(grid), dim3(NTHR), LDS_BYTES, stream, p);
}
```
